# Optimizing an MI355X kernel written in HIP

```python
import jax, jax.numpy as jnp
from jax import lax
import numpy as np


D_MODEL = 1024
BATCH = 16
SEQ = 2048
DEPTH = 2

CTX_LEN = 256
GRID_W = 64
N_EVEN = (DEPTH + 1) // 2
N_ODD = DEPTH // 2
RMS_EPS = 1e-6
ADA_STD = 0.5 * D_MODEL ** -0.5

A_HEADS = 4
A_DK = 128
A_DV = 128
A_CHUNK = 64
A_WIDTH = A_HEADS * A_DV
B_GROUPS = 4
B_CH = 128
B_CHUNK = 128
B_WIDTH = B_GROUPS * B_CH
MIX_WIDTH = A_WIDTH + B_WIDTH
EVEN_IN = 3 * A_HEADS * A_DK + 2 * A_WIDTH + 2 * B_WIDTH
C_HEADS = 8
C_NOPE = 128
C_ROPE = 64
C_V = 128
C_QRANK = 384
C_KVRANK = 256
C_IN = C_QRANK + C_KVRANK + C_ROPE
Q_BLOCK = 128
ROPE_THETA = 10000.0
ATTN_SCALE = (C_NOPE + C_ROPE) ** -0.5
M_GROUPS = 4
M_PER_GROUP = 8
M_EXPERTS = M_GROUPS * M_PER_GROUP
M_TOPK = 2
M_FF = 512
M_ROWS = 256

kernel_name = 'hybrid_hgrn2_gmlp_mla_hmoe_dit'


def rmsnorm(x, g):
    xf = x.astype(jnp.float32)
    y = xf * lax.rsqrt(jnp.mean(xf * xf, axis=-1, keepdims=True) + RMS_EPS)
    return (y * g.astype(jnp.float32)).astype(x.dtype)


def layernorm(x, g):
    xf = x.astype(jnp.float32)
    mu = jnp.mean(xf, axis=-1, keepdims=True)
    var = jnp.mean(jnp.square(xf - mu), axis=-1, keepdims=True)
    return ((xf - mu) * lax.rsqrt(var + RMS_EPS) * g.astype(jnp.float32)).astype(x.dtype)


def adaln(cond, w, b):
    return jnp.split(jax.nn.silu(cond) @ w + b, 6, axis=-1)


def modulate(h, shift, scale):
    return h * (1 + scale) + shift


def axial_angles(rows):
    half = C_ROPE // 2
    inv = ROPE_THETA ** (-jnp.arange(0, half, 2, dtype=jnp.float32) / half)
    r = jnp.repeat(jnp.arange(rows, dtype=jnp.float32), GRID_W)
    col = jnp.tile(jnp.arange(GRID_W, dtype=jnp.float32), rows)
    return r[:, None] * inv, col[:, None] * inv


def _rotate(x, ang):
    x1, x2 = jnp.split(x.astype(jnp.float32), 2, axis=-1)
    cos, sin = jnp.cos(ang), jnp.sin(ang)
    return jnp.concatenate([x1 * cos - x2 * sin, x1 * sin + x2 * cos], axis=-1)


def rope2d(x, ang_r, ang_c):
    half = C_ROPE // 2
    shape = (x.shape[1],) + (1,) * (x.ndim - 3) + (ang_r.shape[-1],)
    out = jnp.concatenate([_rotate(x[..., :half], ang_r.reshape(shape)),
                           _rotate(x[..., half:], ang_c.reshape(shape))], axis=-1)
    return out.astype(x.dtype)


def gla_chunk(q, k, v, logf, s0):
    bsz, t, h, _ = q.shape
    dv = v.shape[-1]
    n = t // A_CHUNK
    cf = lambda a: a.astype(jnp.float32).reshape(bsz, n, A_CHUNK, h, a.shape[-1])
    q, k, v, logf = cf(q), cf(k), cf(v), cf(logf)
    b = jnp.cumsum(logf, axis=2)
    b_last = b[:, :, -1]
    q_dec = q * jnp.exp(b)
    k_dec = k * jnp.exp(-b)
    k_tail = k * jnp.exp(b_last[:, :, None] - b)
    incl = jnp.tril(jnp.ones((A_CHUNK, A_CHUNK), dtype=bool))
    scores = jnp.where(incl, jnp.einsum('bnthk,bnshk->bnhts', q_dec, k_dec), 0.0)
    o_intra = jnp.einsum('bnhts,bnshv->bnthv', scores, v)
    ds = jnp.einsum('bnshk,bnshv->bnhkv', k_tail, v)
    decay = jnp.exp(b_last)

    def step(s, inp):
        d, u = inp
        return d[..., None] * s + u, s

    s_fin, s_in = lax.scan(step, s0.astype(jnp.float32),
                           (jnp.moveaxis(decay, 1, 0), jnp.moveaxis(ds, 1, 0)))
    s_in = jnp.moveaxis(s_in, 0, 1)
    o_inter = jnp.einsum('bnthk,bnhkv->bnthv', q_dec, s_in)
    return (o_intra + o_inter).reshape(bsz, t, h, dv), s_fin


def hgrn_out(o, g_raw, gain):
    o = rmsnorm(o, gain)
    g = g_raw.reshape(o.shape).astype(jnp.float32)
    return (o * jax.nn.silu(g)).reshape(o.shape[0], o.shape[1], A_WIDTH).astype(g_raw.dtype)


def spatial_gating(u, v, gain, w_s, b_s):
    u = jax.nn.gelu(u)
    v = layernorm(jax.nn.gelu(v), gain)
    bsz, t, _ = v.shape
    vb = v.reshape(bsz, t // B_CHUNK, B_CHUNK, B_GROUPS, B_CH)
    sv = jnp.einsum('gts,bnsgc->bntgc', w_s, vb) + b_s.T[:, :, None]
    return u * sv.reshape(bsz, t, B_WIDTH)


def even_mixer(hx, hc, w_in, lb, onorm_g, sgu_g, w_s, b_s, w_out, need_ctx):
    qk = A_HEADS * A_DK
    cuts = [qk, 2 * qk, 3 * qk, 3 * qk + A_WIDTH, 3 * qk + 2 * A_WIDTH, 3 * qk + 2 * A_WIDTH + B_WIDTH]
    px = jnp.split(hx @ w_in, cuts, axis=-1)
    pc = jnp.split(hc @ w_in, cuts, axis=-1)
    heads = lambda a: a.reshape(a.shape[0], a.shape[1], A_HEADS, -1)
    lb_h = lb.reshape(A_HEADS, A_DK)

    def gates(f_raw):
        f = lb_h + (1.0 - lb_h) * jax.nn.sigmoid(heads(f_raw).astype(jnp.float32))
        return 1.0 - f, jnp.log(f)

    qx, ix, qc, ic = heads(px[0]), heads(px[3]), heads(pc[0]), heads(pc[3])
    bsz = hx.shape[0]
    zeros = jnp.zeros((bsz, A_HEADS, A_DK, A_DV), jnp.float32)
    o_x = 0.0
    o_c = 0.0
    for f_idx, rev in ((1, False), (2, True)):
        tr = (lambda a: jnp.flip(a, axis=1)) if rev else (lambda a: a)
        kc, lfc = gates(pc[f_idx])
        kx, lfx = gates(px[f_idx])
        oc_d, s_ctx = gla_chunk(tr(qc), tr(kc), tr(ic), tr(lfc), zeros)
        ox_d, _ = gla_chunk(tr(qx), tr(kx), tr(ix), tr(lfx), s_ctx)
        o_c = o_c + tr(oc_d)
        o_x = o_x + tr(ox_d)
    y_x = jnp.concatenate([hgrn_out(o_x, px[4], onorm_g),
                           spatial_gating(px[5], px[6], sgu_g, w_s, b_s)], axis=-1) @ w_out
    if not need_ctx:
        return y_x, None
    y_c = jnp.concatenate([hgrn_out(o_c, pc[4], onorm_g),
                           spatial_gating(pc[5], pc[6], sgu_g, w_s, b_s)], axis=-1) @ w_out
    return y_x, y_c


def attend(qn, qr, kn, kr, v):
    s = (jnp.einsum('bqhd,bkhd->bhqk', qn, kn).astype(jnp.float32)
         + jnp.einsum('bqhr,bkr->bhqk', qr, kr).astype(jnp.float32))
    p = jax.nn.softmax(s * ATTN_SCALE, axis=-1)
    return jnp.einsum('bhqk,bkhv->bqhv', p.astype(v.dtype), v)


def mla_mixer(hx, hc, w_in, q_g, w_uq, kv_g, w_ukv, w_out, ang_r, ang_c, need_ctx):
    def q_side(p):
        q = (rmsnorm(p, q_g) @ w_uq).reshape(p.shape[0], p.shape[1], C_HEADS, C_NOPE + C_ROPE)
        return q[..., :C_NOPE], q[..., C_NOPE:]

    def kv_side(p):
        kv = (rmsnorm(p[..., :C_KVRANK], kv_g) @ w_ukv).reshape(p.shape[0], p.shape[1], C_HEADS, C_NOPE + C_V)
        return kv[..., :C_NOPE], p[..., C_KVRANK:], kv[..., C_NOPE:]

    bsz, t = hx.shape[0], hx.shape[1]
    px = hx @ w_in
    qn_x, qr_x = q_side(px[..., :C_QRANK])
    kn_x, kr_x, v_x = kv_side(px[..., C_QRANK:])
    kn_c, kr_c, v_c = kv_side(hc @ w_in[:, C_QRANK:])
    qr_x = rope2d(qr_x, ang_r, ang_c)
    kr_x = rope2d(kr_x, ang_r, ang_c)
    kn = jnp.concatenate([kn_c, kn_x], axis=1)
    kr = jnp.concatenate([kr_c, kr_x], axis=1)
    v = jnp.concatenate([v_c, v_x], axis=1)
    nb = t // Q_BLOCK
    blk = lambda a: jnp.swapaxes(a.reshape((bsz, nb, Q_BLOCK) + a.shape[2:]), 0, 1)
    o_x = lax.map(lambda qs: attend(qs[0], qs[1], kn, kr, v), (blk(qn_x), blk(qr_x)))
    y_x = jnp.swapaxes(o_x, 0, 1).reshape(bsz, t, C_HEADS * C_V) @ w_out
    if not need_ctx:
        return y_x, None
    qn_c, qr_c = q_side(hc @ w_in[:, :C_QRANK])
    o_c = attend(qn_c, qr_c, kn_c, kr_c, v_c)
    return y_x, o_c.reshape(bsz, hc.shape[1], C_HEADS * C_V) @ w_out


def hier_moe(h, w_r1, b_r1, w_r2, b_r2, w_gu, w_dn):
    n_tok, d = h.shape
    hf = h.astype(jnp.float32)
    p1 = jax.nn.softmax(hf @ w_r1.astype(jnp.float32) + b_r1, axis=-1)
    p_grp, grp = lax.top_k(p1, 1)
    logits2 = jnp.einsum('nd,gde->nge', hf, w_r2.astype(jnp.float32)) + b_r2
    logits2 = jnp.take_along_axis(logits2, grp[:, :, None], axis=1)[:, 0]
    p_top, e_top = lax.top_k(jax.nn.softmax(logits2, axis=-1), M_TOPK)
    weight = p_grp * p_top / jnp.sum(p_top, axis=-1, keepdims=True)
    assign = (grp * M_PER_GROUP + e_top).reshape(-1)
    n_assign = n_tok * M_TOPK
    order = jnp.argsort(assign)
    tok = order // M_TOPK
    e_sorted = assign[order]
    counts = jnp.zeros((M_EXPERTS,), jnp.int32).at[assign].add(1)
    padded = (counts + M_ROWS - 1) // M_ROWS * M_ROWS
    pad_end = jnp.cumsum(padded)
    pad_start = pad_end - padded
    start = jnp.cumsum(counts) - counts
    dest = pad_start[e_sorted] + jnp.arange(n_assign, dtype=jnp.int32) - start[e_sorted]
    n_rows = -(-(n_assign + M_EXPERTS * (M_ROWS - 1)) // M_ROWS) * M_ROWS
    n_blocks = n_rows // M_ROWS
    xs = jnp.zeros((n_rows, d), h.dtype).at[dest].set(h[tok])
    block_expert = jnp.minimum(
        jnp.searchsorted(pad_end, jnp.arange(n_blocks, dtype=jnp.int32) * M_ROWS, side='right'),
        M_EXPERTS - 1)

    def expert_block(args):
        xb, e = args
        g, u = jnp.split(xb @ w_gu[e], 2, axis=-1)
        return (jax.nn.silu(g) * u) @ w_dn[e]

    ys = lax.map(expert_block, (xs.reshape(n_blocks, M_ROWS, d), block_expert)).reshape(n_rows, d)
    y = ys[dest] * weight.reshape(-1)[order][:, None].astype(h.dtype)
    return jnp.zeros_like(h).at[tok].add(y)


def setup_inputs(seed: int = 0) -> dict:
    key = jax.random.key(seed)
    ks = iter(jax.random.split(key, 32))
    nrm = lambda shape, s: jax.random.normal(next(ks), shape, jnp.float32) * s
    gain = lambda shape: 1.0 + nrm(shape, 0.01)
    D = D_MODEL
    return {
        'x': nrm((BATCH, SEQ, D), 1.0),
        'c': nrm((BATCH, D), 1.0),
        'ctx': nrm((BATCH, CTX_LEN, D), 1.0),
        'c_ctx': nrm((D,), 1.0),
        'ada_w': nrm((DEPTH, D, 6 * D), ADA_STD),
        'ada_b': nrm((DEPTH, 6 * D), 0.01),
        'norm_mix_g': gain((DEPTH, D)),
        'norm_ffn_g': gain((DEPTH, D)),
        'ev_w_in': nrm((N_EVEN, D, EVEN_IN), D ** -0.5),
        'ev_lb_logits': nrm((N_EVEN + 1, A_HEADS * A_DK), 0.1),
        'ev_onorm_g': gain((N_EVEN, A_DV)),
        'ev_sgu_g': gain((N_EVEN, B_WIDTH)),
        'ev_w_s': nrm((N_EVEN, B_GROUPS, B_CHUNK, B_CHUNK), B_CHUNK ** -0.5),
        'ev_b_s': 1.0 + nrm((N_EVEN, B_GROUPS, B_CHUNK), 0.01),
        'ev_w_out': nrm((N_EVEN, MIX_WIDTH, D), MIX_WIDTH ** -0.5),
        'od_w_in': nrm((N_ODD, D, C_IN), D ** -0.5),
        'od_q_norm_g': gain((N_ODD, C_QRANK)),
        'od_w_uq': nrm((N_ODD, C_QRANK, C_HEADS * (C_NOPE + C_ROPE)), C_QRANK ** -0.5),
        'od_kv_norm_g': gain((N_ODD, C_KVRANK)),
        'od_w_ukv': nrm((N_ODD, C_KVRANK, C_HEADS * (C_NOPE + C_V)), C_KVRANK ** -0.5),
        'od_w_out': nrm((N_ODD, C_HEADS * C_V, D), (C_HEADS * C_V) ** -0.5),
        'moe_w_r1': nrm((DEPTH, D, M_GROUPS), D ** -0.5),
        'moe_b_r1': nrm((DEPTH, M_GROUPS), 0.01),
        'moe_w_r2': nrm((DEPTH, M_GROUPS, D, M_PER_GROUP), D ** -0.5),
        'moe_b_r2': nrm((DEPTH, M_GROUPS, M_PER_GROUP), 0.01),
        'moe_w_gu': nrm((DEPTH, M_EXPERTS, D, 2 * M_FF), D ** -0.5),
        'moe_w_dn': nrm((DEPTH, M_EXPERTS, M_FF, D), M_FF ** -0.5),
        'final_g': gain((D,)),
    }


def reference(x, c, ctx, c_ctx, ada_w, ada_b, norm_mix_g, norm_ffn_g,
              ev_w_in, ev_lb_logits, ev_onorm_g, ev_sgu_g, ev_w_s, ev_b_s, ev_w_out,
              od_w_in, od_q_norm_g, od_w_uq, od_kv_norm_g, od_w_ukv, od_w_out,
              moe_w_r1, moe_b_r1, moe_w_r2, moe_b_r2, moe_w_gu, moe_w_dn, final_g):
    bsz, n, d = x.shape
    rows = n // GRID_W
    ang_r, ang_c = axial_angles(rows)
    lb_all = jnp.cumsum(jax.nn.softmax(ev_lb_logits.astype(jnp.float32), axis=0), axis=0)
    for layer in range(DEPTH):
        last = layer == DEPTH - 1
        j = layer // 2
        mx = [m[:, None, :] for m in adaln(c, ada_w[layer], ada_b[layer])]
        mc = adaln(c_ctx, ada_w[layer], ada_b[layer])
        hx = modulate(rmsnorm(x, norm_mix_g[layer]), mx[0], mx[1])
        hc = modulate(rmsnorm(ctx, norm_mix_g[layer]), mc[0], mc[1])
        if layer % 2 == 0:
            ox, oc = even_mixer(hx, hc, ev_w_in[j], lb_all[j], ev_onorm_g[j], ev_sgu_g[j],
                                ev_w_s[j], ev_b_s[j], ev_w_out[j], not last)
        else:
            ox, oc = mla_mixer(hx, hc, od_w_in[j], od_q_norm_g[j], od_w_uq[j], od_kv_norm_g[j],
                               od_w_ukv[j], od_w_out[j], ang_r, ang_c, not last)
        x = x + mx[2] * ox
        moe_args = (moe_w_r1[layer], moe_b_r1[layer], moe_w_r2[layer], moe_b_r2[layer],
                    moe_w_gu[layer], moe_w_dn[layer])
        hx2 = modulate(rmsnorm(x, norm_ffn_g[layer]), mx[3], mx[4])
        if last:
            x = x + mx[5] * hier_moe(hx2.reshape(-1, d), *moe_args).reshape(bsz, n, d)
        else:
            ctx = ctx + mc[2] * oc
            hc2 = modulate(rmsnorm(ctx, norm_ffn_g[layer]), mc[3], mc[4])
            y = hier_moe(jnp.concatenate([hx2.reshape(-1, d), hc2.reshape(-1, d)], axis=0), *moe_args)
            x = x + mx[5] * y[:bsz * n].reshape(bsz, n, d)
            ctx = ctx + mc[5] * y[bsz * n:].reshape(bsz, ctx.shape[1], d)
    return rmsnorm(x, final_g)
```

```cpp
#include <hip/hip_runtime.h>
#include <cstdio>
#include <cstdint>
#define MK_N_LAUNCHES 1
#define DBG_MODE 0

#define LAS __attribute__((address_space(3)))
#define GAS __attribute__((address_space(1)))
typedef unsigned short bf16_t;
typedef short bf16x8 __attribute__((ext_vector_type(8)));
typedef short s16x4 __attribute__((ext_vector_type(4)));
typedef float f32x2 __attribute__((ext_vector_type(2)));
typedef float f32x4 __attribute__((ext_vector_type(4)));
typedef float f32x16 __attribute__((ext_vector_type(16)));
typedef unsigned u32x2 __attribute__((ext_vector_type(2)));
typedef unsigned u32x4 __attribute__((ext_vector_type(4)));

constexpr int DM = 1024, NB = 16, SEQ = 2048, CTXL = 256, PB = SEQ + CTXL  , R = NB * PB  ;
constexpr int NTILE = R / 256  , NXTILE = NB * SEQ / 256  ;
constexpr int EVIN = 3584;
constexpr int CIN = 704, CINP = 768, QRANK = 384, KVRANK = 256, NQ = 1536, NKV = 2048;
constexpr int NEXP = 32, MFF = 512;
constexpr int MAXSLOT = 81920;
constexpr float RMS_EPS = 1e-6f;
constexpr float ATT_C2 = 0.07216878364870322f * 1.4426950408889634f;

constexpr size_t MiB = 1u << 20;
constexpr size_t WS_CTL = 0, CTL_ZERO_BYTES = 1 * MiB;
constexpr size_t WS_MOD = 1 * MiB;
constexpr size_t WS_PART = 2 * MiB;
constexpr size_t WS_STATS = 9 * MiB;
constexpr size_t WS_ROUTE = 13 * MiB;
constexpr size_t WS_WIN0 = 16 * MiB, WS_WOUT0 = 23 * MiB, WS_WIN1 = 25 * MiB, WS_WUQ = 27 * MiB, WS_WUKV = 29 * MiB, WS_WOUT1 = 30 * MiB;
constexpr size_t WS_WGU = 32 * MiB;
constexpr size_t WS_WDN = 160 * MiB;
constexpr size_t WS_XS = 224 * MiB;
constexpr size_t WS_HX = 368 * MiB;
constexpr size_t WS_MIX = 440 * MiB;
constexpr size_t WS_RA = 512 * MiB;
constexpr size_t WS_PX0 = WS_RA, WS_Q = WS_RA, WS_KB = WS_RA + 108 * MiB, WS_ACT = WS_RA;
constexpr size_t WS_RB = 764 * MiB;
constexpr size_t WS_YS = WS_RB, WS_PX1 = WS_RB, WS_VB = WS_RB + 54 * MiB, WS_OG = WS_RB;
constexpr size_t WS_END = 908 * MiB;
constexpr size_t RT_AE = 0, RT_AP = 512 * 1024, RT_AW = 1024 * 1024, RT_PERM = 1536 * 1024, RT_CNTB = 2048 * 1024, RT_BLKE = 2048 * 1024 + 64 * 1024, RT_NBLK = RT_BLKE + 4096;
constexpr int CW_BAR = 4096;

constexpr int RING_BYTES = 131072;
constexpr int LDSCTL_OFF = 147456, MISC_OFF = LDSCTL_OFF + 320;
constexpr int LDS_BYTES = 149504;

#define LDS_WAIT() asm volatile("s_waitcnt lgkmcnt(0)" ::: "memory")
#define VM_WAIT() asm volatile("s_waitcnt vmcnt(0)" ::: "memory")
#define SBAR() __builtin_amdgcn_sched_barrier(0)
__device__ __forceinline__ unsigned f2bf(float f) { unsigned u = __builtin_bit_cast(unsigned, f); return (u + 0x7fffu + ((u >> 16) & 1u)) >> 16; }
__device__ __forceinline__ unsigned pk2(float lo, float hi) { return f2bf(lo) | (f2bf(hi) << 16); }
typedef __bf16 bf16x2_t __attribute__((ext_vector_type(2)));
__device__ __forceinline__ unsigned cvtpk(float lo, float hi) { f32x2 v = {lo, hi}; bf16x2_t b = __builtin_convertvector(v, bf16x2_t); return __builtin_bit_cast(unsigned, b); }
__device__ __forceinline__ float bf2f(unsigned short h) { return __builtin_bit_cast(float, (unsigned)h << 16); }
__device__ __forceinline__ float bflo(unsigned w) { return __builtin_bit_cast(float, w << 16); }
__device__ __forceinline__ float bfhi(unsigned w) { return __builtin_bit_cast(float, w & 0xffff0000u); }
__device__ __forceinline__ float wave_sum(float v) {
#pragma unroll
    for (int o = 1; o < 64; o <<= 1) v += __shfl_xor(v, o);
    return v;
}
__device__ __forceinline__ float sigmoidf_(float x) { return 1.0f / (1.0f + __expf(-x)); }
__device__ __forceinline__ float siluf_(float x) { return x / (1.0f + __expf(-x)); }
__device__ __forceinline__ float geluf_(float x) { const float z = 1.5957691216057308f * (x + 0.044715f * x * x * x); return x / (1.0f + __expf(-z)); }

#define XB_TMO      128
#define XB_XCNT(j)  (256  + 64 * (j))
#define XB_XSUB(j)  (1280 + 64 * (j))
#define XB_XGEN(j)  (2304 + 64 * (j))
#define XB_TOP      3328
#define XB_TOPGEN   3392
#define XCD_BAR_WORDS 3456
#define XB_SPIN_CAP (1u << 22)
__device__ __forceinline__ unsigned xb_ld(unsigned* p)              { return __hip_atomic_load(p, __ATOMIC_RELAXED, __HIP_MEMORY_SCOPE_AGENT); }
__device__ __forceinline__ unsigned xb_add(unsigned* p, unsigned v) { return __hip_atomic_fetch_add(p, v, __ATOMIC_RELAXED, __HIP_MEMORY_SCOPE_AGENT); }
__device__ __forceinline__ unsigned xb_xcc_id() { return (unsigned)__builtin_amdgcn_s_getreg((3 << 11) | 20) & 0xFu; }
#define XB_SPIN(cond, bar) do { unsigned _sp = 0; while (cond) { __builtin_amdgcn_s_sleep(1); \
    if ((++_sp & 255u) == 0u) { if (xb_ld(&(bar)[XB_TMO])) break; if (_sp > XB_SPIN_CAP) { atomicAdd(&(bar)[XB_TMO], 1u); break; } } } } while (0)
struct XcdBarrier { unsigned* bar; unsigned x; volatile LAS unsigned* st; };
__device__ __forceinline__ XcdBarrier xcd_barrier_post(unsigned* bar, volatile LAS unsigned* st) {
    XcdBarrier b; b.bar = bar; b.x = xb_xcc_id(); b.st = st;
    if (threadIdx.x == 0) (void)xb_add(&bar[XB_XCNT(b.x)], 1u);
    return b;
}
__device__ __forceinline__ void xcd_barrier_complete(unsigned* bar, unsigned x, unsigned& nloc, unsigned& nx) {
    const unsigned G = gridDim.x * gridDim.y * gridDim.z;
    unsigned sum, cnt, mine, sp = 0u;
    for (;;) {
        sum = 0u; cnt = 0u; mine = 0u;
#pragma unroll
        for (unsigned j = 0; j < 16; ++j) { const unsigned c = xb_ld(&bar[XB_XCNT(j)]); sum += c; cnt += (c > 0u) ? 1u : 0u; mine = (j == x) ? c : mine; }
        if (sum == G) break;
        __builtin_amdgcn_s_sleep(1);
        if ((++sp & 255u) == 0u) { if (xb_ld(&bar[XB_TMO])) break; if (sp > XB_SPIN_CAP) { atomicAdd(&bar[XB_TMO], 1u); break; } }
    }
    nloc = mine > 0u ? mine : 1u; nx = cnt > 0u ? cnt : 1u;
}
__device__ __forceinline__ void xcd_barrier(const XcdBarrier& b) {
    asm volatile("s_waitcnt vmcnt(0)" ::: "memory");
    __syncthreads();
    if (threadIdx.x == 0) {
        unsigned* bar = b.bar;
        __builtin_amdgcn_s_waitcnt(0);
        unsigned nloc = b.st[0], nx = b.st[1];
        if (nloc == 0u) { xcd_barrier_complete(bar, b.x, nloc, nx); b.st[0] = nloc; b.st[1] = nx; }
        const unsigned old = xb_add(&bar[XB_XSUB(b.x)], 1u);
        const unsigned gen = old / nloc;
        if (old + 1u == (gen + 1u) * nloc) {
            __builtin_amdgcn_fence(__ATOMIC_RELEASE, "agent");
            asm volatile("s_waitcnt vmcnt(0)" ::: "memory");
            const unsigned og = xb_add(&bar[XB_TOP], 1u);
            const unsigned tg = og / nx;
            if (og + 1u == (tg + 1u) * nx) xb_add(&bar[XB_TOPGEN], 1u);
            else XB_SPIN(xb_ld(&bar[XB_TOPGEN]) == tg, bar);
            __builtin_amdgcn_fence(__ATOMIC_ACQUIRE, "agent");
            xb_add(&bar[XB_XGEN(b.x)], 1u);
            asm volatile("s_waitcnt vmcnt(0)" ::: "memory");
        } else {
            XB_SPIN(xb_ld(&bar[XB_XGEN(b.x)]) == gen, bar);
            __builtin_amdgcn_fence(__ATOMIC_ACQUIRE, "agent");
            asm volatile("s_waitcnt vmcnt(0)" ::: "memory");
        }
    }
    __syncthreads();
}

namespace pg8 {
constexpr int BM = 256, BK = 64, HALF = 128, HTB = HALF * BK * 2, STAGE_BYTES = 8 * HTB, NXCD = 8, WGM = 8;
__host__ __device__ __forceinline__ int lds_byte(int r, int c) { const int st = (r >> 4) * 2 + (c >> 5), rr = r & 15, cc = c & 31, ob = rr * 64 + cc * 2; return st * 1024 + (ob ^ (((ob >> 9) & 1) << 5)); }
__host__ __device__ __forceinline__ void stage_rc(int b, int& Rr, int& C) { const int st = b / 1024, sb = b % 1024, swz = sb ^ (((sb >> 9) & 1) << 5); Rr = (st >> 1) * 16 + swz / 64; C = (st & 1) * 32 + (swz % 64) / 2; }
__host__ __device__ __forceinline__ int perm32(int rho) { const int n = rho >> 4, i = rho & 15; return 8 * (i >> 2) + 4 * n + (i & 3); }

struct Unit { int arow0, brow0, pm, pn, ex; };
struct Gemm { const bf16_t* A; const bf16_t* Bt; int lda, ldb, K; const int* rowidx; };

template <class Epi, class Sched, bool GATHER>
__device__ __forceinline__ void gemm_phase(LAS unsigned char* lds, const Gemm g, const Sched& S, const Epi& E) {
    int tidl = threadIdx.x; asm volatile("" : "+v"(tidl));
    const int tid = tidl, wid = __builtin_amdgcn_readfirstlane(tid >> 6), lane = tid & 63, wr = wid >> 2, wc = wid & 3, fr = lane & 15, fq = lane >> 4;
    const int K = g.K, nt = K / BK;
    int sR[2], sC[2]; unsigned voffB[2], voffA[2];
#pragma unroll
    for (int i = 0; i < 2; ++i) { stage_rc(tid * 16 + i * 8192, sR[i], sC[i]); const int Rb = Epi::PERM ? ((sR[i] & ~31) + perm32(sR[i] & 31)) : sR[i];
        voffB[i] = (unsigned)(Rb * g.ldb + sC[i]) * 2u; voffA[i] = (unsigned)(sR[i] * g.lda + sC[i]) * 2u; }
    const size_t kstep = (size_t)(BK * 2);
    const size_t hstepB = (size_t)HALF * g.ldb * 2, hstepA = (size_t)HALF * g.lda * 2;
    const unsigned ldsw = (unsigned)wid * 1024u;
    const int aoff = lds_byte(wr * 64 + fr, fq * 8), boff = lds_byte(wc * 32 + fr, fq * 8);
#define PG8_SA(b, h) (((b) * 2 + (h)) * HTB)
#define PG8_SB(b, h) ((4 + (b) * 2 + (h)) * HTB)
#define PG8_GLDS(src, bufoff, i) __builtin_amdgcn_global_load_lds((const unsigned*)(src), (LAS unsigned*)(lds + (bufoff) + ldsw + (i) * 8192), 16, 0, 0)
#define PG8_STAGEB(bufoff, gbase) do { _Pragma("unroll") for (int _i = 0; _i < 2; ++_i) PG8_GLDS((const char*)(gbase) + voffB[_i], bufoff, _i); } while (0)
#define PG8_STAGEA(bufoff, h, isnext, kb) do { \
        if constexpr (GATHER) { _Pragma("unroll") for (int _i = 0; _i < 2; ++_i) PG8_GLDS(gA + (kb) + ((isnext) ? nvo[h][_i] : cvo[h][_i]), bufoff, _i); } \
        else { const char* _b = ((isnext) ? nA : cA) + (h) * hstepA + (kb); _Pragma("unroll") for (int _i = 0; _i < 2; ++_i) PG8_GLDS(_b + voffA[_i], bufoff, _i); } } while (0)
#define PG8_LDA(dst, b, h) do { _Pragma("unroll") for (int m = 0; m < 4; ++m) _Pragma("unroll") for (int k = 0; k < 2; ++k) dst[m][k] = *(const LAS bf16x8*)(lds + PG8_SA(b, h) + aoff + m * 2048 + k * 1024); } while (0)
#define PG8_LDB(dst, b, h) do { _Pragma("unroll") for (int n = 0; n < 2; ++n) _Pragma("unroll") for (int k = 0; k < 2; ++k) dst[n][k] = *(const LAS bf16x8*)(lds + PG8_SB(b, h) + boff + n * 2048 + k * 1024); } while (0)
#define PG8_MMA(ai, bj, At, Bt) do { __builtin_amdgcn_s_setprio(1); _Pragma("unroll") for (int m = 0; m < 4; ++m) _Pragma("unroll") for (int n = 0; n < 2; ++n) _Pragma("unroll") for (int k = 0; k < 2; ++k) \
        acc[ai][bj][m][n] = __builtin_amdgcn_mfma_f32_16x16x32_bf16(Bt[n][k], At[m][k], acc[ai][bj][m][n], 0, 0, 0); __builtin_amdgcn_s_setprio(0); } while (0)
#define PG8_WAIT_V(n) asm volatile("s_waitcnt vmcnt(" #n ")" ::: "memory")
#define PG8_WAIT_L(n) asm volatile("s_waitcnt lgkmcnt(" #n ")" ::: "memory")
#define PG8_BAR __builtin_amdgcn_s_barrier()
#define PG8_SCHED __builtin_amdgcn_sched_barrier(0)
    unsigned cvo[2][2], nvo[2][2];
    auto a_offsets = [&](const Unit& u, unsigned (&vo)[2][2]) {
#pragma unroll
        for (int h = 0; h < 2; ++h)
#pragma unroll
            for (int i = 0; i < 2; ++i) { const int a = g.rowidx[u.arow0 + h * HALF + sR[i]]; const int row = a < 0 ? 0 : (a >> 1); vo[h][i] = (unsigned)((size_t)row * g.lda + sC[i]) * 2u; }
    };
    Unit cur, nxt; int ui = 0;
    if (!S.next(0, cur)) return;
    f32x4 acc[2][2][4][2];
#pragma unroll
    for (int a = 0; a < 2; ++a)
#pragma unroll
        for (int b = 0; b < 2; ++b)
#pragma unroll
            for (int m = 0; m < 4; ++m)
#pragma unroll
                for (int n = 0; n < 2; ++n) acc[a][b][m][n] = (f32x4){0.f, 0.f, 0.f, 0.f};
    bf16x8 At[4][2], B0[2][2], B1[2][2];
    const char* gA = (const char*)g.A;
    const char* cA = gA + (size_t)cur.arow0 * g.lda * 2; const char* nA = cA;
    const char* cB = (const char*)g.Bt + (size_t)cur.brow0 * g.ldb * 2;
    if constexpr (GATHER) { a_offsets(cur, cvo);
#pragma unroll
        for (int h = 0; h < 2; ++h)
#pragma unroll
            for (int i = 0; i < 2; ++i) nvo[h][i] = cvo[h][i]; }
    PG8_STAGEB(PG8_SB(0, 0), cB); PG8_STAGEB(PG8_SB(0, 1), cB + hstepB); PG8_STAGEA(PG8_SA(0, 0), 0, false, 0); PG8_STAGEA(PG8_SA(0, 1), 1, false, 0);
    if (wr == 1) PG8_BAR;
    PG8_WAIT_V(2); PG8_BAR;
    PG8_STAGEB(PG8_SB(1, 0), cB + kstep); PG8_STAGEA(PG8_SA(1, 0), 0, false, kstep); PG8_STAGEB(PG8_SB(1, 1), cB + hstepB + kstep);
    PG8_WAIT_V(6); PG8_BAR;
    for (;;) {
        const bool has_next = S.next(ui + 1, nxt);
        const char* nB = has_next ? (const char*)g.Bt + (size_t)nxt.brow0 * g.ldb * 2 : cB;
        nA = has_next ? gA + (size_t)nxt.arow0 * g.lda * 2 : cA;
        if constexpr (GATHER) { if (has_next) a_offsets(nxt, nvo); }
        for (int t = 0; t < nt; t += 2) {
            const bool last = (t == nt - 2);
            const size_t k1 = (size_t)(t + 1) * kstep, k2 = last ? 0 : (size_t)(t + 2) * kstep, k3 = k2 + kstep;
            const char* b2 = last ? nB : cB + (size_t)(t + 2) * kstep; const char* b3 = b2 + kstep;
            PG8_LDB(B0, 0, 0); PG8_LDB(B1, 0, 1); PG8_SCHED; PG8_LDA(At, 0, 0); PG8_STAGEA(PG8_SA(1, 1), 1, false, k1);
            PG8_WAIT_V(8); PG8_WAIT_L(0); PG8_BAR; PG8_MMA(0, 0, At, B0); PG8_MMA(0, 1, At, B1); PG8_BAR; PG8_SCHED;
            PG8_LDA(At, 0, 1); PG8_STAGEB(PG8_SB(0, 0), b2); PG8_STAGEB(PG8_SB(0, 1), b2 + hstepB); PG8_STAGEA(PG8_SA(0, 0), 0, last, k2);
            PG8_WAIT_V(8); PG8_WAIT_L(0); PG8_BAR; PG8_MMA(1, 0, At, B0); PG8_MMA(1, 1, At, B1); PG8_BAR; PG8_SCHED;
            PG8_LDB(B0, 1, 0); PG8_LDB(B1, 1, 1); PG8_SCHED; PG8_LDA(At, 1, 0); PG8_STAGEA(PG8_SA(0, 1), 1, last, k2);
            PG8_WAIT_V(8); PG8_WAIT_L(0); PG8_BAR; PG8_MMA(0, 0, At, B0); PG8_MMA(0, 1, At, B1); PG8_BAR; PG8_SCHED;
            PG8_LDA(At, 1, 1); PG8_STAGEB(PG8_SB(1, 0), b3); PG8_STAGEB(PG8_SB(1, 1), b3 + hstepB); PG8_STAGEA(PG8_SA(1, 0), 0, last, k3);
            PG8_WAIT_V(8); PG8_WAIT_L(0); PG8_BAR; PG8_MMA(1, 0, At, B0); PG8_MMA(1, 1, At, B1); PG8_BAR; PG8_SCHED;
        }
        if (wr == 0) PG8_BAR;
        { int l2 = threadIdx.x; asm volatile("" : "+v"(l2)); E(acc, cur, wr, wc, l2 & 15, (l2 >> 4) & 3); }
        if (!has_next) break;
#pragma unroll
        for (int a = 0; a < 2; ++a)
#pragma unroll
            for (int b = 0; b < 2; ++b)
#pragma unroll
                for (int m = 0; m < 4; ++m)
#pragma unroll
                    for (int n = 0; n < 2; ++n) acc[a][b][m][n] = (f32x4){0.f, 0.f, 0.f, 0.f};
        cur = nxt; cB = nB; cA = nA; ++ui;
        if constexpr (GATHER) {
#pragma unroll
            for (int h = 0; h < 2; ++h)
#pragma unroll
                for (int i = 0; i < 2; ++i) cvo[h][i] = nvo[h][i]; }
        if (wr == 1) PG8_BAR;
    }
    PG8_WAIT_V(0);
    PG8_BAR;
#undef PG8_SA
#undef PG8_SB
#undef PG8_GLDS
#undef PG8_STAGEA
#undef PG8_STAGEB
#undef PG8_LDA
#undef PG8_LDB
#undef PG8_MMA
#undef PG8_WAIT_V
#undef PG8_WAIT_L
#undef PG8_BAR
#undef PG8_SCHED
}
}

struct Args {
    const float* in[28]; float* out; unsigned char* ws; int ph_lo, ph_hi, nobar, pad;
};
enum In { I_X = 0, I_C, I_CTX, I_CCTX, I_ADAW, I_ADAB, I_NMIXG, I_NFFNG, I_EVWIN, I_EVLB, I_EVONORM, I_EVSGUG, I_EVWS, I_EVBS, I_EVWOUT,
          I_ODWIN, I_ODQG, I_ODWUQ, I_ODKVG, I_ODWUKV, I_ODWOUT, I_MR1W, I_MR1B, I_MR2W, I_MR2B, I_MGU, I_MDN, I_FING };
struct Frame {
    LAS unsigned char* lds;
    const __attribute__((address_space(4))) Args* ka;
    float* out;
    int tid, lane, wave, vcu, G;
    unsigned char* ws;
};
__device__ __forceinline__ const float* mod_ptr(const Frame& F, int layer, int mrow, int which) { return (const float*)(F.ws + WS_MOD) + ((size_t)(layer * 17 + mrow) * 6 + which) * DM; }
__device__ __forceinline__ int row_b(int row) { return row / PB; }
__device__ __forceinline__ const float* input_row(const Frame& F, int row) {
    const int b = row / PB, pos = row - b * PB;
    return pos < CTXL ? F.ka->in[I_CTX] + ((size_t)b * CTXL + pos) * DM : F.ka->in[I_X] + ((size_t)b * SEQ + (pos - CTXL)) * DM;
}

template <bool XONLY> struct TileSched {
    int nM, nN, nwg, G, c;
    __device__ __forceinline__ void init(int nN_, int G_, int c_) { nM = XONLY ? NXTILE : NTILE; nN = nN_; nwg = nM * nN; G = G_; c = c_; }
    __device__ __forceinline__ bool next(int i, pg8::Unit& u) const {
        const long L = (long)i * G + c; if (L >= nwg) return false;
        int wgid = (int)L; { const int q = nwg / 8, r = nwg % 8, xcd = wgid % 8, off = wgid / 8; wgid = (xcd < r ? xcd * (q + 1) : r * (q + 1) + (xcd - r) * q) + off; }
        const int nig = 8 * nN, gid = wgid / nig, fm = gid * 8, gsz = (nM - fm) < 8 ? (nM - fm) : 8;
        int pm = fm + ((wgid % nig) % gsz); const int pn = (wgid % nig) / gsz;
        if (XONLY) pm = (pm >> 3) * 9 + 1 + (pm & 7);
        u.pm = pm; u.pn = pn; u.ex = 0; u.arow0 = pm * 256; u.brow0 = pn * 256; return true;
    }
};
struct MoeSched {
    const int* blke; int nwg, G, c, brows;
    __device__ __forceinline__ void init(const int* blke_, int nblk, int G_, int c_) { blke = blke_; nwg = nblk * 4; G = G_; c = c_; brows = 1024; }
    __device__ __forceinline__ bool next(int i, pg8::Unit& u) const {
        const long L = (long)i * G + c; if (L >= nwg) return false;
        int wgid = (int)L; { const int q = nwg / 8, r = nwg % 8, xcd = wgid % 8, off = wgid / 8; wgid = (xcd < r ? xcd * (q + 1) : r * (q + 1) + (xcd - r) * q) + off; }
        const int blk = wgid >> 2, pn = wgid & 3; const int e = __builtin_amdgcn_readfirstlane(blke[blk]);
        u.pm = blk; u.pn = pn; u.ex = e; u.arow0 = blk * 256; u.brow0 = e * brows + pn * 256; return true;
    }
};

struct EpiStoreBf16 {
    static constexpr bool PERM = true;
    bf16_t* O; int ldc;
    __device__ __forceinline__ void operator()(const f32x4 (&acc)[2][2][4][2], const pg8::Unit& u, int wr, int wc, int fr, int fq) const {
        const int row0 = u.arow0 + wr * 64 + fr, col0 = u.pn * 256 + wc * 32 + 8 * fq;
#pragma unroll
        for (int ai = 0; ai < 2; ++ai)
#pragma unroll
            for (int m = 0; m < 4; ++m) { bf16_t* rowp = O + (size_t)(row0 + ai * 128 + m * 16) * ldc + col0;
#pragma unroll
                for (int bj = 0; bj < 2; ++bj) { const f32x4 v0 = acc[ai][bj][m][0], v1 = acc[ai][bj][m][1];
                    u32x4 w; w.x = cvtpk(v0[0], v0[1]); w.y = cvtpk(v0[2], v0[3]); w.z = cvtpk(v1[0], v1[1]); w.w = cvtpk(v1[2], v1[3]);
                    *(u32x4*)(rowp + bj * 128) = w; } }
    }
};
struct EpiStoreStats {
    static constexpr bool PERM = true;
    bf16_t* O; int ldc; float* stats;
    __device__ __forceinline__ void operator()(const f32x4 (&acc)[2][2][4][2], const pg8::Unit& u, int wr, int wc, int fr, int fq) const {
        const int row0 = u.arow0 + wr * 64 + fr, col0 = u.pn * 256 + wc * 32 + 8 * fq;
#pragma unroll
        for (int ai = 0; ai < 2; ++ai)
#pragma unroll
            for (int m = 0; m < 4; ++m) { const int row = row0 + ai * 128 + m * 16; bf16_t* rowp = O + (size_t)row * ldc + col0;
#pragma unroll
                for (int bj = 0; bj < 2; ++bj) { const f32x4 v0 = acc[ai][bj][m][0], v1 = acc[ai][bj][m][1];
                    u32x4 w; w.x = cvtpk(v0[0], v0[1]); w.y = cvtpk(v0[2], v0[3]); w.z = cvtpk(v1[0], v1[1]); w.w = cvtpk(v1[2], v1[3]);
                    *(u32x4*)(rowp + bj * 128) = w;
                    float s = (v0[0] * v0[0] + v0[1] * v0[1]) + (v0[2] * v0[2] + v0[3] * v0[3]) + (v1[0] * v1[0] + v1[1] * v1[1]) + (v1[2] * v1[2] + v1[3] * v1[3]);
                    s += __shfl_xor(s, 16); s += __shfl_xor(s, 32);
                    if (fq == 0) stats[(size_t)row * 24 + u.pn * 8 + bj * 4 + wc] = s; } }
    }
};
struct EpiResidual {
    static constexpr bool PERM = false;
    const Frame* F; float* dst; int layer; bool from_input;
    __device__ __forceinline__ void operator()(const f32x4 (&acc)[2][2][4][2], const pg8::Unit& u, int wr, int wc, int fr, int fq) const {
        const int b = u.pm / 9, isctx = (u.pm % 9) == 0, mrow = isctx ? 16 : b;
        const float* gate = mod_ptr(*F, layer, mrow, 2);
        const int col0 = u.pn * 256 + wc * 32 + 4 * fq;
        f32x4 gv[2][2];
#pragma unroll
        for (int bj = 0; bj < 2; ++bj)
#pragma unroll
            for (int n = 0; n < 2; ++n) gv[bj][n] = *(const f32x4*)(gate + col0 + bj * 128 + n * 16);
#pragma unroll
        for (int ai = 0; ai < 2; ++ai)
#pragma unroll
            for (int m = 0; m < 4; ++m) { const int row = u.arow0 + ai * 128 + wr * 64 + m * 16 + fr;
                const float* bp = from_input ? input_row(*F, row) : dst + (size_t)row * DM; float* dp = dst + (size_t)row * DM;
#pragma unroll
                for (int bj = 0; bj < 2; ++bj)
#pragma unroll
                    for (int n = 0; n < 2; ++n) { const int c = col0 + bj * 128 + n * 16; const f32x4 bs = *(const f32x4*)(bp + c);
                        *(f32x4*)(dp + c) = bs + gv[bj][n] * acc[ai][bj][m][n]; } }
    }
};
struct EpiSwiglu {
    static constexpr bool PERM = true;
    bf16_t* O;
    __device__ __forceinline__ void operator()(const f32x4 (&acc)[2][2][4][2], const pg8::Unit& u, int wr, int wc, int fr, int fq) const {
        const int row0 = u.arow0 + wr * 64 + fr, col0 = u.pn * 128 + wc * 32 + 8 * fq;
#pragma unroll
        for (int ai = 0; ai < 2; ++ai)
#pragma unroll
            for (int m = 0; m < 4; ++m) { bf16_t* rowp = O + (size_t)(row0 + ai * 128 + m * 16) * MFF + col0;
                float h[8];
#pragma unroll
                for (int n = 0; n < 2; ++n)
#pragma unroll
                    for (int j = 0; j < 4; ++j) h[n * 4 + j] = siluf_(acc[ai][0][m][n][j]) * acc[ai][1][m][n][j];
                u32x4 w; w.x = cvtpk(h[0], h[1]); w.y = cvtpk(h[2], h[3]); w.z = cvtpk(h[4], h[5]); w.w = cvtpk(h[6], h[7]);
                *(u32x4*)rowp = w; }
    }
};
struct EpiScatter {
    static constexpr bool PERM = true;
    bf16_t* O; const int* perm;
    __device__ __forceinline__ void operator()(const f32x4 (&acc)[2][2][4][2], const pg8::Unit& u, int wr, int wc, int fr, int fq) const {
        const int row0 = u.arow0 + wr * 64 + fr, col0 = u.pn * 256 + wc * 32 + 8 * fq;
#pragma unroll
        for (int ai = 0; ai < 2; ++ai)
#pragma unroll
            for (int m = 0; m < 4; ++m) { const int a = perm[row0 + ai * 128 + m * 16];
                if (a >= 0) { bf16_t* rowp = O + (size_t)a * DM + col0;
#pragma unroll
                    for (int bj = 0; bj < 2; ++bj) { const f32x4 v0 = acc[ai][bj][m][0], v1 = acc[ai][bj][m][1];
                        u32x4 w; w.x = cvtpk(v0[0], v0[1]); w.y = cvtpk(v0[2], v0[3]); w.z = cvtpk(v1[0], v1[1]); w.w = cvtpk(v1[2], v1[3]);
                        *(u32x4*)(rowp + bj * 128) = w; } } }
    }
};
struct EpiQ {
    static constexpr bool PERM = false;
    bf16_t* O; const float* stats;
    __device__ __forceinline__ void operator()(const f32x4 (&acc)[2][2][4][2], const pg8::Unit& u, int wr, int wc, int fr, int fq) const {
        float invf[4]; int fq2 = fq; asm volatile("" : "+v"(fq2));
#pragma unroll
        for (int j = 0; j < 4; ++j) invf[j] = __expf(-(float)(4 * fq2 + j) * (2.0f / 32.0f) * 9.210340371976184f);
#pragma unroll
        for (int ai = 0; ai < 2; ++ai)
#pragma unroll
            for (int m = 0; m < 4; ++m) { const int row = u.arow0 + ai * 128 + wr * 64 + m * 16 + fr;
                const float* st = stats + (size_t)row * 24; float ss = 0.f;
#pragma unroll
                for (int q = 0; q < 3; ++q) { const f32x4 s4 = *(const f32x4*)(st + 4 * q); ss += (s4[0] + s4[1]) + (s4[2] + s4[3]); }
                const float sc = __builtin_amdgcn_rsqf(ss * (1.0f / QRANK) + RMS_EPS) * ATT_C2;
                const int t = (row % PB) - CTXL; const float gr = (float)(t >> 6), gc = (float)(t & 63);
#pragma unroll
                for (int bj = 0; bj < 2; ++bj) { const int cg = u.pn * 256 + bj * 128 + wc * 32; const int within = cg % 192;
                    f32x4 v0 = acc[ai][bj][m][0] * sc, v1 = acc[ai][bj][m][1] * sc;
                    if (within >= 128) { const float p = (within == 128) ? gr : gc;
#pragma unroll
                        for (int j = 0; j < 4; ++j) { const float ang = p * invf[j]; const float cs = __cosf(ang), sn = __sinf(ang);
                            const float x1 = v0[j], x2 = v1[j]; v0[j] = x1 * cs - x2 * sn; v1[j] = x1 * sn + x2 * cs; } }
                    bf16_t* rowp = O + (size_t)row * NQ + cg + 4 * fq;
                    u32x2 w0; w0.x = cvtpk(v0[0], v0[1]); w0.y = cvtpk(v0[2], v0[3]); *(u32x2*)rowp = w0;
                    u32x2 w1; w1.x = cvtpk(v1[0], v1[1]); w1.y = cvtpk(v1[2], v1[3]); *(u32x2*)(rowp + 16) = w1; } }
    }
};
struct EpiKV {
    static constexpr bool PERM = true;
    bf16_t* KBp; bf16_t* VBp; const float* stats;
    __device__ __forceinline__ void operator()(const f32x4 (&acc)[2][2][4][2], const pg8::Unit& u, int wr, int wc, int fr, int fq) const {
        const int h = u.pn, c0 = wc * 32 + 8 * fq;
#pragma unroll
        for (int ai = 0; ai < 2; ++ai)
#pragma unroll
            for (int m = 0; m < 4; ++m) { const int row = u.arow0 + ai * 128 + wr * 64 + m * 16 + fr;
                const float* st = stats + (size_t)row * 24 + 12; const f32x4 s0 = *(const f32x4*)st, s1 = *(const f32x4*)(st + 4);
                const float ss = ((s0[0] + s0[1]) + (s0[2] + s0[3])) + ((s1[0] + s1[1]) + (s1[2] + s1[3]));
                const float sc = __builtin_amdgcn_rsqf(ss * (1.0f / KVRANK) + RMS_EPS);
#pragma unroll
                for (int bj = 0; bj < 2; ++bj) { const f32x4 v0 = acc[ai][bj][m][0] * sc, v1 = acc[ai][bj][m][1] * sc;
                    u32x4 w; w.x = cvtpk(v0[0], v0[1]); w.y = cvtpk(v0[2], v0[3]); w.z = cvtpk(v1[0], v1[1]); w.w = cvtpk(v1[2], v1[3]);
                    bf16_t* p = bj == 0 ? KBp + (size_t)row * NQ + h * 192 + c0 : VBp + (size_t)row * DM + h * 128 + c0;
                    *(u32x4*)p = w; } }
    }
};

__device__ __forceinline__ void tr_item(const float* W, int K, int N, bf16_t* WT, bool gu, const float* kscale, LAS float* scr, int item, int lane) {
    const int nblk = N / 32, kb = item / nblk, nb = item % nblk, k0 = 64 * kb, n0 = 32 * nb;
#pragma unroll 8
    for (int i = 0; i < 32; ++i) { const int kk = 2 * i + (lane >> 5); float w = W[(size_t)(k0 + kk) * N + n0 + (lane & 31)]; if (kscale) w *= kscale[k0 + kk]; scr[kk * 33 + (lane & 31)] = w; }
    LDS_WAIT(); asm volatile("" ::: "memory");
    int d0 = n0;
    if (gu) { const int i0 = n0 & 511; d0 = 256 * (i0 >> 7) + (n0 >= 512 ? 128 : 0) + (i0 & 127); }
    const int c = lane & 7;
#pragma unroll
    for (int j = 0; j < 4; ++j) { const int n = (lane >> 3) + 8 * j; const LAS float* s = scr + (8 * c) * 33 + n;
        u32x4 o; o.x = pk2(s[0 * 33], s[1 * 33]); o.y = pk2(s[2 * 33], s[3 * 33]); o.z = pk2(s[4 * 33], s[5 * 33]); o.w = pk2(s[6 * 33], s[7 * 33]);
        *(u32x4*)(WT + (size_t)(d0 + n) * K + k0 + 8 * c) = o; }
    LDS_WAIT(); asm volatile("" ::: "memory");
}
__device__ __forceinline__ void p0_prologue(Frame& F) {

    LAS float* S = (LAS float*)F.lds;
    for (int idx = F.tid; idx < 17 * DM; idx += 512) { const int r = idx >> 10, k = idx & 1023; const float cv = r < 16 ? F.ka->in[I_C][r * DM + k] : F.ka->in[I_CCTX][k]; S[k * 20 + r] = siluf_(cv); }
    __syncthreads();
    const int gw = F.vcu * 8 + F.wave, NGW = F.G * 8;
    float* part = (float*)(F.ws + WS_PART);
    for (int it = gw; it < 2 * 8 * 96; it += NGW) {
        const int l = it / 768, rem = it % 768, kc = rem / 96, slab = rem % 96, n0 = slab * 64;
        const float* w = F.ka->in[I_ADAW] + ((size_t)l * DM + kc * 128) * 6144 + n0 + F.lane;
        float acc[17];
#pragma unroll
        for (int r = 0; r < 17; ++r) acc[r] = 0.f;
#pragma unroll 4
        for (int kk = 0; kk < 128; ++kk) {
            const float wv = w[(size_t)kk * 6144];
            const LAS float* s = S + (kc * 128 + kk) * 20;
            const f32x4 s0 = *(const LAS f32x4*)s, s1 = *(const LAS f32x4*)(s + 4), s2 = *(const LAS f32x4*)(s + 8), s3 = *(const LAS f32x4*)(s + 12); const float s4 = s[16];
            acc[0] += s0[0] * wv; acc[1] += s0[1] * wv; acc[2] += s0[2] * wv; acc[3] += s0[3] * wv;
            acc[4] += s1[0] * wv; acc[5] += s1[1] * wv; acc[6] += s1[2] * wv; acc[7] += s1[3] * wv;
            acc[8] += s2[0] * wv; acc[9] += s2[1] * wv; acc[10] += s2[2] * wv; acc[11] += s2[3] * wv;
            acc[12] += s3[0] * wv; acc[13] += s3[1] * wv; acc[14] += s3[2] * wv; acc[15] += s3[3] * wv; acc[16] += s4 * wv;
        }
#pragma unroll
        for (int r = 0; r < 17; ++r) part[((size_t)(l * 8 + kc) * 17 + r) * 6144 + n0 + F.lane] = acc[r];
    }
    __syncthreads();
    LAS float* scr = (LAS float*)(F.lds + F.wave * 8448);
    constexpr int I_A = 16 * 112, I_B = 16 * 32, I_C2 = 16 * 22, I_D = 6 * 48, I_E = 4 * 64, I_F = 16 * 32, I_GU = 16 * 32, I_DN = 8 * 32;
    constexpr int NITEMS = I_A + I_B + I_C2 + I_D + I_E + I_F + 64 * I_GU + 64 * I_DN;
    for (int it = gw; it < NITEMS; it += NGW) {
        int r = it;
        if (r < I_A) { tr_item(F.ka->in[I_EVWIN], DM, EVIN, (bf16_t*)(F.ws + WS_WIN0), false, nullptr, scr, r, F.lane); continue; } r -= I_A;
        if (r < I_B) { tr_item(F.ka->in[I_EVWOUT], DM, DM, (bf16_t*)(F.ws + WS_WOUT0), false, nullptr, scr, r, F.lane); continue; } r -= I_B;
        if (r < I_C2) { tr_item(F.ka->in[I_ODWIN], DM, CIN, (bf16_t*)(F.ws + WS_WIN1), false, nullptr, scr, r, F.lane); continue; } r -= I_C2;
        if (r < I_D) { tr_item(F.ka->in[I_ODWUQ], QRANK, NQ, (bf16_t*)(F.ws + WS_WUQ), false, F.ka->in[I_ODQG], scr, r, F.lane); continue; } r -= I_D;
        if (r < I_E) { tr_item(F.ka->in[I_ODWUKV], KVRANK, NKV, (bf16_t*)(F.ws + WS_WUKV), false, F.ka->in[I_ODKVG], scr, r, F.lane); continue; } r -= I_E;
        if (r < I_F) { tr_item(F.ka->in[I_ODWOUT], DM, DM, (bf16_t*)(F.ws + WS_WOUT1), false, nullptr, scr, r, F.lane); continue; } r -= I_F;
        if (r < 64 * I_GU) { const int e = r / I_GU; tr_item(F.ka->in[I_MGU] + (size_t)e * DM * 1024, DM, 1024, (bf16_t*)(F.ws + WS_WGU) + (size_t)e * 1024 * DM, true, nullptr, scr, r % I_GU, F.lane); continue; } r -= 64 * I_GU;
        { const int e = r / I_DN; tr_item(F.ka->in[I_MDN] + (size_t)e * MFF * DM, MFF, DM, (bf16_t*)(F.ws + WS_WDN) + (size_t)e * DM * MFF, false, nullptr, scr, r % I_DN, F.lane); }
    }
}
__device__ __forceinline__ void p0b_mod(Frame& F) {
    const float* part = (const float*)(F.ws + WS_PART); float* mod = (float*)(F.ws + WS_MOD);
    const int gt = F.vcu * 512 + F.tid, NGT = F.G * 512;
    for (int idx = gt; idx < 2 * 17 * 6144; idx += NGT) {
        const int l = idx / (17 * 6144), rem = idx % (17 * 6144), r = rem / 6144, n = rem % 6144;
        float s = F.ka->in[I_ADAB][l * 6144 + n];
#pragma unroll
        for (int kc = 0; kc < 8; ++kc) s += part[((size_t)(l * 8 + kc) * 17 + r) * 6144 + n];
        mod[idx] = s;
    }
}

__device__ __forceinline__ void load_row4(const float* p, int lane, f32x4 (&v)[4]) {
#pragma unroll
    for (int j = 0; j < 4; ++j) v[j] = *(const f32x4*)(p + 4 * lane + 256 * j);
}
__device__ __forceinline__ float sumsq4(const f32x4 (&v)[4]) {
    float s = 0.f;
#pragma unroll
    for (int j = 0; j < 4; ++j) s += (v[j][0] * v[j][0] + v[j][1] * v[j][1]) + (v[j][2] * v[j][2] + v[j][3] * v[j][3]);
    return wave_sum(s);
}
__device__ __forceinline__ void norm_mod4(f32x4 (&v)[4], const float* g, const float* shift, const float* scale, int lane) {
    const float rstd = __builtin_amdgcn_rsqf(sumsq4(v) * (1.0f / DM) + RMS_EPS);
#pragma unroll
    for (int j = 0; j < 4; ++j) { const int c = 4 * lane + 256 * j; const f32x4 gg = *(const f32x4*)(g + c), sh = *(const f32x4*)(shift + c), sc = *(const f32x4*)(scale + c);
        v[j] = v[j] * rstd * gg * (sc + 1.0f) + sh; }
}
__device__ __forceinline__ void store_row_bf16(bf16_t* p, int lane, const f32x4 (&v)[4]) {
#pragma unroll
    for (int j = 0; j < 4; ++j) { u32x2 w; w.x = cvtpk(v[j][0], v[j][1]); w.y = cvtpk(v[j][2], v[j][3]); *(u32x2*)(p + 4 * lane + 256 * j) = w; }
}
__device__ __forceinline__ void moe_combine4(Frame& F, int row, int layer, int mrow, f32x4 (&v)[4]) {
    const bf16_t* ys = (const bf16_t*)(F.ws + WS_YS) + (size_t)(2 * row) * DM; const float* aw = (const float*)(F.ws + WS_ROUTE + RT_AW);
    const float w0 = aw[2 * row], w1 = aw[2 * row + 1]; const float* gate = mod_ptr(F, layer, mrow, 5);
#pragma unroll
    for (int j = 0; j < 4; ++j) { const int c = 4 * F.lane + 256 * j; const u32x2 y0 = *(const u32x2*)(ys + c), y1 = *(const u32x2*)(ys + DM + c); const f32x4 gg = *(const f32x4*)(gate + c);
        f32x4 y; y[0] = w0 * bflo(y0.x) + w1 * bflo(y1.x); y[1] = w0 * bfhi(y0.x) + w1 * bfhi(y1.x); y[2] = w0 * bflo(y0.y) + w1 * bflo(y1.y); y[3] = w0 * bfhi(y0.y) + w1 * bfhi(y1.y);
        v[j] = v[j] + gg * y; }
}
__device__ __forceinline__ void p1_norm_input(Frame& F) {
    const int gw = F.vcu * 8 + F.wave, NGW = F.G * 8; bf16_t* hx = (bf16_t*)(F.ws + WS_HX);
    for (int row = gw; row < R; row += NGW) {
        const int b = row / PB, pos = row - b * PB, mrow = pos < CTXL ? 16 : b;
        f32x4 v[4]; load_row4(input_row(F, row), F.lane, v);
        norm_mod4(v, F.ka->in[I_NMIXG], mod_ptr(F, 0, mrow, 0), mod_ptr(F, 0, mrow, 1), F.lane);
        store_row_bf16(hx + (size_t)row * DM, F.lane, v);
    }
}
__device__ __forceinline__ void p8_combine_norm(Frame& F) {
    const int gw = F.vcu * 8 + F.wave, NGW = F.G * 8; bf16_t* hx = (bf16_t*)(F.ws + WS_HX); float* xs = (float*)(F.ws + WS_XS);
    for (int row = gw; row < R; row += NGW) {
        const int b = row / PB, pos = row - b * PB, mrow = pos < CTXL ? 16 : b;
        f32x4 v[4]; load_row4(xs + (size_t)row * DM, F.lane, v);
        moe_combine4(F, row, 0, mrow, v);
#pragma unroll
        for (int j = 0; j < 4; ++j) *(f32x4*)(xs + (size_t)row * DM + 4 * F.lane + 256 * j) = v[j];
        norm_mod4(v, F.ka->in[I_NMIXG] + DM, mod_ptr(F, 1, mrow, 0), mod_ptr(F, 1, mrow, 1), F.lane);
        store_row_bf16(hx + (size_t)row * DM, F.lane, v);
    }
}
__device__ __forceinline__ void p16_final(Frame& F) {
    const int gw = F.vcu * 8 + F.wave, NGW = F.G * 8; const float* xs = (const float*)(F.ws + WS_XS);
    for (int row = gw; row < R; row += NGW) {
        const int b = row / PB, pos = row - b * PB; if (pos < CTXL) continue;
        f32x4 v[4];
        if (DBG_MODE >= 10) {
            const bf16_t* hx = (const bf16_t*)(F.ws + WS_HX) + (size_t)row * DM; const bf16_t* px = (const bf16_t*)(F.ws + WS_PX0) + (size_t)row * EVIN; const bf16_t* mx = (const bf16_t*)(F.ws + WS_MIX) + (size_t)row * DM;
#pragma unroll
            for (int j = 0; j < 4; ++j)
#pragma unroll
                for (int e = 0; e < 4; ++e) { const int c = 4 * F.lane + 256 * j + e;
                    v[j][e] = DBG_MODE == 10 ? bf2f(hx[c]) : DBG_MODE == 11 ? bf2f(px[c]) + bf2f(px[1024 + c]) + bf2f(px[2048 + c]) + bf2f(px[3072 + (c & 511)]) : bf2f(mx[c]); }
        } else load_row4(DBG_MODE == 1 ? input_row(F, row) : xs + (size_t)row * DM, F.lane, v);
        if (DBG_MODE == 0) moe_combine4(F, row, 1, b, v);
        const float rstd = __builtin_amdgcn_rsqf(sumsq4(v) * (1.0f / DM) + RMS_EPS);
        float* o = F.out + ((size_t)b * SEQ + (pos - CTXL)) * DM;
#pragma unroll
        for (int j = 0; j < 4; ++j) { const int c = 4 * F.lane + 256 * j; const f32x4 gg = *(const f32x4*)(F.ka->in[I_FING] + c); *(f32x4*)(o + c) = v[j] * rstd * gg; }
    }
}

template <bool XONLY>
__device__ __forceinline__ void p5_norm_route(Frame& F, int layer) {

    LAS float* W1L = (LAS float*)F.lds; LAS float* W2L = W1L + 4096;
    volatile LAS int* lcnt = (volatile LAS int*)(F.lds + LDSCTL_OFF + 64);
    const float* wr1 = F.ka->in[I_MR1W] + (size_t)layer * DM * 4; const float* wr2 = F.ka->in[I_MR2W] + (size_t)layer * 4 * DM * 8;
    for (int k = F.tid; k < DM; k += 512) { const int l = (k & 255) >> 2, j = k >> 8, e = k & 3; *(LAS f32x4*)(W1L + ((j * 4 + e) * 64 + l) * 4) = *(const f32x4*)(wr1 + k * 4); }
    for (int idx = F.tid; idx < 4 * DM * 2; idx += 512) { const int half = idx & 1, k = (idx >> 1) & 1023, g = idx >> 11; const int l = (k & 255) >> 2, j = k >> 8, e = k & 3;
        *(LAS f32x4*)(W2L + ((((g * 16 + j * 4 + e) * 2 + half) * 64) + l) * 4) = *(const f32x4*)(wr2 + ((size_t)g * DM + k) * 8 + half * 4); }
    if (F.tid < 32) lcnt[F.tid] = 0;
    __syncthreads();
    const int gw = F.vcu * 8 + F.wave, NGW = F.G * 8; bf16_t* hx = (bf16_t*)(F.ws + WS_HX); const float* xs = (const float*)(F.ws + WS_XS);
    int* ae = (int*)(F.ws + WS_ROUTE + RT_AE); int* ap = (int*)(F.ws + WS_ROUTE + RT_AP); float* aw = (float*)(F.ws + WS_ROUTE + RT_AW);
    const float* b1 = F.ka->in[I_MR1B] + layer * 4; const float* b2 = F.ka->in[I_MR2B] + layer * 32;
    for (int row = gw; row < R; row += NGW) {
        const int b = row / PB, pos = row - b * PB; if (XONLY && pos < CTXL) continue;
        const int mrow = pos < CTXL ? 16 : b;
        f32x4 v[4]; load_row4(xs + (size_t)row * DM, F.lane, v);
        norm_mod4(v, F.ka->in[I_NFFNG] + layer * DM, mod_ptr(F, layer, mrow, 3), mod_ptr(F, layer, mrow, 4), F.lane);
        store_row_bf16(hx + (size_t)row * DM, F.lane, v);
        f32x4 l1 = {0.f, 0.f, 0.f, 0.f};
#pragma unroll
        for (int j = 0; j < 4; ++j)
#pragma unroll
            for (int e = 0; e < 4; ++e) l1 += *(const LAS f32x4*)(W1L + ((j * 4 + e) * 64 + F.lane) * 4) * v[j][e];
        float g0 = wave_sum(l1[0]) + b1[0], g1 = wave_sum(l1[1]) + b1[1], g2 = wave_sum(l1[2]) + b1[2], g3 = wave_sum(l1[3]) + b1[3];
        int grp = 0; float gm = g0;
        if (g1 > gm) { gm = g1; grp = 1; } if (g2 > gm) { gm = g2; grp = 2; } if (g3 > gm) { gm = g3; grp = 3; }
        grp = __builtin_amdgcn_readfirstlane(grp);
        const float pg = 1.0f / (__expf(g0 - gm) + __expf(g1 - gm) + __expf(g2 - gm) + __expf(g3 - gm));
        f32x4 la = {0.f, 0.f, 0.f, 0.f}, lb = {0.f, 0.f, 0.f, 0.f};
        const LAS float* w2 = W2L + grp * 16 * 2 * 64 * 4;
#pragma unroll
        for (int j = 0; j < 4; ++j)
#pragma unroll
            for (int e = 0; e < 4; ++e) { const LAS float* p = w2 + (((j * 4 + e) * 2) * 64 + F.lane) * 4; la += *(const LAS f32x4*)p * v[j][e]; lb += *(const LAS f32x4*)(p + 256) * v[j][e]; }
        float lg[8];
#pragma unroll
        for (int q = 0; q < 4; ++q) { lg[q] = wave_sum(la[q]) + b2[grp * 8 + q]; lg[4 + q] = wave_sum(lb[q]) + b2[grp * 8 + 4 + q]; }
        int e0 = 0; float m0 = lg[0];
#pragma unroll
        for (int q = 1; q < 8; ++q) if (lg[q] > m0) { m0 = lg[q]; e0 = q; }
        int e1 = -1; float m1 = -3.0e38f;
#pragma unroll
        for (int q = 0; q < 8; ++q) if (q != e0 && lg[q] > m1) { m1 = lg[q]; e1 = q; }
        const float pb = __expf(m1 - m0), inv = pg / (1.0f + pb);
        if (F.lane < 2) {
            const int ex = grp * 8 + (F.lane == 0 ? e0 : e1);
            const int lp = __hip_atomic_fetch_add((LAS int*)lcnt + ex, 1, __ATOMIC_RELAXED, __HIP_MEMORY_SCOPE_WORKGROUP);
            const int a = 2 * row + F.lane; ae[a] = ex; ap[a] = lp; aw[a] = F.lane == 0 ? inv : inv * pb;
        }
    }
    __syncthreads();
    if (F.tid < 32) ((int*)(F.ws + WS_ROUTE + RT_CNTB))[F.vcu * 32 + F.tid] = lcnt[F.tid];
}
template <bool XONLY>
__device__ __forceinline__ void p5b_perm(Frame& F) {
    LAS int* seg = (LAS int*)F.lds;
    LAS int* mypre = seg + 512;
    LAS int* tot = mypre + 32;
    LAS int* base = tot + 32;
    LAS int* pst = base + 32;
    const int* cntb = (const int*)(F.ws + WS_ROUTE + RT_CNTB);
    { const int e = F.tid & 31, sg = F.tid >> 5; int s = 0, pre = 0;
      for (int i = 0; i < 16; ++i) { const int B = sg * 16 + i; const int c = cntb[B * 32 + e]; if (B < F.vcu) pre += c; s += c; }
      seg[sg * 32 + e] = s; if (sg == (F.vcu >> 4)) mypre[e] = pre; }
    __syncthreads();
    if (F.tid < 32) { int t = 0, bs = 0; for (int sg = 0; sg < 16; ++sg) { const int s = seg[sg * 32 + F.tid]; if (sg < (F.vcu >> 4)) bs += s; t += s; } tot[F.tid] = t; base[F.tid] = bs + mypre[F.tid]; }
    __syncthreads();
    if (F.tid == 0) { int ps = 0; for (int e = 0; e < 32; ++e) { pst[e] = ps; ps += ((tot[e] + 255) >> 8) << 8; } pst[32] = ps; }
    __syncthreads();
    const int gw = F.vcu * 8 + F.wave, NGW = F.G * 8;
    const int* ae = (const int*)(F.ws + WS_ROUTE + RT_AE); const int* ap = (const int*)(F.ws + WS_ROUTE + RT_AP); int* perm = (int*)(F.ws + WS_ROUTE + RT_PERM);
    for (int row = gw; row < R; row += NGW) {
        const int b = row / PB, pos = row - b * PB; if (XONLY && pos < CTXL) continue;
        if (F.lane < 2) { const int a = 2 * row + F.lane; const int e = ae[a]; perm[pst[e] + base[e] + ap[a]] = a; }
    }
    if (F.vcu < 32) { const int e = F.vcu; for (int s = pst[e] + tot[e] + F.tid; s < pst[e + 1]; s += 512) perm[s] = -1; }
    if (F.vcu == 0) { int* blke = (int*)(F.ws + WS_ROUTE + RT_BLKE);
        if (F.tid < 32) { const int e = F.tid; for (int blk = pst[e] >> 8; blk < (pst[e + 1] >> 8); ++blk) blke[blk] = e; }
        if (F.tid == 0) *(int*)(F.ws + WS_ROUTE + RT_NBLK) = pst[32] >> 8; }
}

__device__ __forceinline__ bf16x8 lds_frag256(const LAS unsigned char* base, int row, int chunk) { return *(const LAS bf16x8*)(base + row * 256 + ((chunk ^ (row & 7)) << 4)); }
__device__ __forceinline__ bf16x8 lds_frag128(const LAS unsigned char* base, int row, int chunk) { return *(const LAS bf16x8*)(base + row * 128 + ((chunk ^ (row & 7)) << 4)); }
#define MFMA16(a, b, c) __builtin_amdgcn_mfma_f32_16x16x32_bf16((a), (b), (c), 0, 0, 0)

__device__ __forceinline__ void gla_item(Frame& F, int item) {
    const int b = item >> 4, h = (item >> 2) & 3, dir = (item >> 1) & 1, vh = item & 1;
    LAS unsigned char* QD = F.lds; LAS unsigned char* KD = F.lds + 16384; LAS unsigned char* KT = F.lds + 32768; LAS unsigned char* VT = F.lds + 49152;
    LAS unsigned char* PS = F.lds + 57344; LAS unsigned char* ST = F.lds + 65536; LAS float* LF = (LAS float*)(F.lds + 81920); LAS float* SEGT = (LAS float*)(F.lds + 114688); LAS float* DEC = (LAS float*)(F.lds + 116736);
    const int tid = F.tid, lane = F.lane, wave = F.wave, fr = lane & 15, fq = lane >> 4;
    const int t0 = tid >> 4, c = tid & 15, tv = tid >> 3, cv = tid & 7;
    const bf16_t* px = (const bf16_t*)(F.ws + WS_PX0);
    bf16_t* og = (bf16_t*)(F.ws + WS_OG) + (size_t)dir * R * 512;
    float lbv[8], oml[8];
    { const float* lg = F.ka->in[I_EVLB] + h * 128 + 8 * c;
#pragma unroll
      for (int e = 0; e < 8; ++e) { lbv[e] = 1.0f / (1.0f + __expf(lg[512 + e] - lg[e])); oml[e] = 1.0f - lbv[e]; } }
    { u32x4 z = {0u, 0u, 0u, 0u}; *(LAS u32x4*)(ST + tid * 32) = z; *(LAS u32x4*)(ST + tid * 32 + 16) = z; }
    f32x4 S[4];
#pragma unroll
    for (int i = 0; i < 4; ++i) S[i] = (f32x4){0.f, 0.f, 0.f, 0.f};
    u32x4 rq[2], rf[2], rv;
    auto chunk_p0 = [&](int j) { return dir == 0 ? 64 * j : (j < 4 ? 192 - 64 * j : PB - 64 * (j - 3)); };
    auto row_of = [&](int p0, int tau) { return b * PB + (dir == 0 ? p0 + tau : p0 + 63 - tau); };
    auto load_chunk = [&](int j) {
        const int p0 = chunk_p0(j);
#pragma unroll
        for (int i = 0; i < 2; ++i) { const bf16_t* rp = px + (size_t)row_of(p0, t0 + 32 * i) * EVIN + h * 128 + 8 * c; rq[i] = *(const u32x4*)rp; rf[i] = *(const u32x4*)(rp + 512 * (1 + dir)); }
        rv = *(const u32x4*)(px + (size_t)row_of(p0, tv) * EVIN + 1536 + h * 128 + vh * 64 + 8 * cv);
    };
    load_chunk(0);
    __syncthreads();
    const int ti = wave & 3, sp = wave >> 2, ki = wave;
    for (int j = 0; j < 36; ++j) {
        const int p0 = chunk_p0(j);
        float qv[2][8], kv[2][8];
#pragma unroll
        for (int i = 0; i < 2; ++i) { const int tau = t0 + 32 * i; float lf[8];
#pragma unroll
            for (int e = 0; e < 4; ++e) { const unsigned wq = rq[i][e], wf = rf[i][e];
                qv[i][2 * e] = bflo(wq); qv[i][2 * e + 1] = bfhi(wq);
                const float s0 = sigmoidf_(bflo(wf)), s1 = sigmoidf_(bfhi(wf));
                const float f0 = lbv[2 * e] + oml[2 * e] * s0, f1 = lbv[2 * e + 1] + oml[2 * e + 1] * s1;
                kv[i][2 * e] = 1.0f - f0; kv[i][2 * e + 1] = 1.0f - f1; lf[2 * e] = __logf(f0); lf[2 * e + 1] = __logf(f1); }
            *(LAS f32x4*)(LF + tau * 128 + 8 * c) = (f32x4){lf[0], lf[1], lf[2], lf[3]}; *(LAS f32x4*)(LF + tau * 128 + 8 * c + 4) = (f32x4){lf[4], lf[5], lf[6], lf[7]}; }
        __syncthreads();
        { const int k = tid & 127, sg = tid >> 7; float run = 0.f;
#pragma unroll
          for (int i = 0; i < 16; ++i) { const int idx = (16 * sg + i) * 128 + k; run += LF[idx]; LF[idx] = run; }
          SEGT[sg * 128 + k] = run; }
        __syncthreads();
        { float seg[4][8];
#pragma unroll
          for (int s = 0; s < 4; ++s) { const f32x4 a0 = *(const LAS f32x4*)(SEGT + s * 128 + 8 * c), a1 = *(const LAS f32x4*)(SEGT + s * 128 + 8 * c + 4);
#pragma unroll
              for (int e = 0; e < 4; ++e) { seg[s][e] = a0[e]; seg[s][4 + e] = a1[e]; } }
#pragma unroll
          for (int i = 0; i < 2; ++i) { const int tau = t0 + 32 * i, sgt = tau >> 4;
              const f32x4 c0 = *(const LAS f32x4*)(LF + tau * 128 + 8 * c), c1 = *(const LAS f32x4*)(LF + tau * 128 + 8 * c + 4);
              float qd[8], kd[8], kt[8];
#pragma unroll
              for (int e = 0; e < 8; ++e) { float off = 0.f, bl = 0.f;
#pragma unroll
                  for (int s = 0; s < 4; ++s) { bl += seg[s][e]; if (s < sgt) off += seg[s][e]; }
                  const float bb = (e < 4 ? c0[e] : c1[e - 4]) + off;
                  qd[e] = qv[i][e] * __expf(bb); kd[e] = kv[i][e] * __expf(-bb); kt[e] = kv[i][e] * __expf(bl - bb); }
              u32x4 w; w.x = cvtpk(qd[0], qd[1]); w.y = cvtpk(qd[2], qd[3]); w.z = cvtpk(qd[4], qd[5]); w.w = cvtpk(qd[6], qd[7]);
              *(LAS u32x4*)(QD + tau * 256 + ((c ^ (tau & 7)) << 4)) = w;
              w.x = cvtpk(kd[0], kd[1]); w.y = cvtpk(kd[2], kd[3]); w.z = cvtpk(kd[4], kd[5]); w.w = cvtpk(kd[6], kd[7]);
              *(LAS u32x4*)(KD + tau * 256 + ((c ^ (tau & 7)) << 4)) = w;
#pragma unroll
              for (int e = 0; e < 8; ++e) *(LAS unsigned short*)(KT + (8 * c + e) * 128 + ((2 * tau) ^ (e << 4))) = (unsigned short)f2bf(kt[e]); }
#pragma unroll
          for (int e = 0; e < 4; ++e) { const unsigned wv = rv[e];
              *(LAS unsigned short*)(VT + (8 * cv + 2 * e) * 128 + ((2 * tv) ^ ((2 * e) << 4))) = (unsigned short)(wv & 0xffffu);
              *(LAS unsigned short*)(VT + (8 * cv + 2 * e + 1) * 128 + ((2 * tv) ^ ((2 * e + 1) << 4))) = (unsigned short)(wv >> 16); }
          if (tid < 128) DEC[tid] = __expf(SEGT[tid] + SEGT[128 + tid] + SEGT[256 + tid] + SEGT[384 + tid]); }
        __syncthreads();
        if (j + 1 < 36) load_chunk(j + 1);
        bf16x8 bq[4];
#pragma unroll
        for (int ks = 0; ks < 4; ++ks) bq[ks] = lds_frag256(QD, 16 * ti + fr, ks * 4 + fq);
        f32x4 oacc[2];
#pragma unroll
        for (int u = 0; u < 2; ++u) { const int si = 2 * sp + u; f32x4 a = {0.f, 0.f, 0.f, 0.f};
#pragma unroll
            for (int ks = 0; ks < 4; ++ks) a = MFMA16(lds_frag256(KD, 16 * si + fr, ks * 4 + fq), bq[ks], a);
            const int tt = 16 * ti + fr, s0 = 16 * si + 4 * fq;
            u32x2 w; w.x = cvtpk(s0 <= tt ? a[0] : 0.f, s0 + 1 <= tt ? a[1] : 0.f); w.y = cvtpk(s0 + 2 <= tt ? a[2] : 0.f, s0 + 3 <= tt ? a[3] : 0.f);
            *(LAS u32x2*)(PS + tt * 128 + ((2 * s0) ^ ((tt & 7) << 4))) = w;
            const int vi = 2 * sp + u; f32x4 o = {0.f, 0.f, 0.f, 0.f};
#pragma unroll
            for (int ks = 0; ks < 4; ++ks) o = MFMA16(lds_frag256(ST, 16 * vi + fr, ks * 4 + fq), bq[ks], o);
            oacc[u] = o; }
        { const f32x4 dk = *(const LAS f32x4*)(DEC + 16 * ki + 4 * fq);
          bf16x8 ak[2];
#pragma unroll
          for (int ks = 0; ks < 2; ++ks) ak[ks] = lds_frag128(KT, 16 * ki + fr, ks * 4 + fq);
#pragma unroll
          for (int vi = 0; vi < 4; ++vi) { f32x4 s = S[vi] * dk;
#pragma unroll
              for (int ks = 0; ks < 2; ++ks) s = MFMA16(ak[ks], lds_frag128(VT, 16 * vi + fr, ks * 4 + fq), s);
              S[vi] = s; } }
        __syncthreads();
        { bf16x8 bp[2];
#pragma unroll
          for (int ks = 0; ks < 2; ++ks) bp[ks] = lds_frag128(PS, 16 * ti + fr, ks * 4 + fq);
          const int orow = row_of(p0, 16 * ti + fr);
#pragma unroll
          for (int u = 0; u < 2; ++u) { const int vi = 2 * sp + u; f32x4 o = oacc[u];
#pragma unroll
              for (int ks = 0; ks < 2; ++ks) o = MFMA16(lds_frag128(VT, 16 * vi + fr, ks * 4 + fq), bp[ks], o);
              u32x2 w; w.x = cvtpk(o[0], o[1]); w.y = cvtpk(o[2], o[3]);
              *(u32x2*)(og + (size_t)orow * 512 + h * 128 + vh * 64 + 16 * vi + 4 * fq) = w; }
#pragma unroll
          for (int vi = 0; vi < 4; ++vi) { const int v = 16 * vi + fr, k0 = 16 * ki + 4 * fq; u32x2 w; w.x = cvtpk(S[vi][0], S[vi][1]); w.y = cvtpk(S[vi][2], S[vi][3]);
              *(LAS u32x2*)(ST + v * 256 + ((2 * k0) ^ ((v & 7) << 4))) = w; } }
    }
    __syncthreads();
}

__device__ __forceinline__ void sgu_item(Frame& F, int ci) {
    LAS unsigned char* VNT = F.lds; LAS unsigned char* WS = F.lds + 32768;
    const int tid = F.tid, lane = F.lane, wave = F.wave, fr = lane & 15, fq = lane >> 4;
    const int r0 = ci * 128, row = tid >> 2, q = tid & 3;
    const bf16_t* px = (const bf16_t*)(F.ws + WS_PX0); bf16_t* mix = (bf16_t*)(F.ws + WS_MIX);
    const bf16_t* vrow = px + (size_t)(r0 + row) * EVIN + 3072;
    float sum = 0.f, sq = 0.f;
#pragma unroll 4
    for (int i = 0; i < 16; ++i) { const u32x4 w = *(const u32x4*)(vrow + 128 * q + 8 * i);
#pragma unroll
        for (int e = 0; e < 4; ++e) { const float a = geluf_(bflo(w[e])), bb = geluf_(bfhi(w[e])); sum += a + bb; sq += a * a + bb * bb; } }
    sum += __shfl_xor(sum, 1); sum += __shfl_xor(sum, 2); sq += __shfl_xor(sq, 1); sq += __shfl_xor(sq, 2);
    const float mean = sum * (1.0f / 512.0f), rstd = __builtin_amdgcn_rsqf(fmaxf(sq * (1.0f / 512.0f) - mean * mean, 0.f) + RMS_EPS);
    for (int g = 0; g < 4; ++g) {
        const float* gain = F.ka->in[I_EVSGUG] + 128 * g + 32 * q;
#pragma unroll
        for (int i = 0; i < 4; ++i) { const u32x4 w = *(const u32x4*)(vrow + 128 * g + 32 * q + 8 * i);
#pragma unroll
            for (int e = 0; e < 4; ++e) { const int cl = 32 * q + 8 * i + 2 * e;
                const float a = (geluf_(bflo(w[e])) - mean) * rstd * gain[8 * i + 2 * e], bb = (geluf_(bfhi(w[e])) - mean) * rstd * gain[8 * i + 2 * e + 1];
                *(LAS unsigned short*)(VNT + cl * 256 + ((2 * row) ^ ((cl & 7) << 4))) = (unsigned short)f2bf(a);
                *(LAS unsigned short*)(VNT + (cl + 1) * 256 + ((2 * row) ^ (((cl + 1) & 7) << 4))) = (unsigned short)f2bf(bb); } }
        const float* wsg = F.ka->in[I_EVWS] + (size_t)g * 128 * 128;
#pragma unroll
        for (int it = 0; it < 4; ++it) { const int idx = tid + 512 * it, t = idx >> 4, ch = idx & 15; const f32x4 a = *(const f32x4*)(wsg + t * 128 + 8 * ch), bb = *(const f32x4*)(wsg + t * 128 + 8 * ch + 4);
            u32x4 w; w.x = cvtpk(a[0], a[1]); w.y = cvtpk(a[2], a[3]); w.z = cvtpk(bb[0], bb[1]); w.w = cvtpk(bb[2], bb[3]);
            *(LAS u32x4*)(WS + t * 256 + ((ch ^ (t & 7)) << 4)) = w; }
        __syncthreads();
        bf16x8 av[4];
#pragma unroll
        for (int ks = 0; ks < 4; ++ks) av[ks] = lds_frag256(VNT, 16 * wave + fr, ks * 4 + fq);
#pragma unroll 2
        for (int tt = 0; tt < 8; ++tt) { f32x4 a = {0.f, 0.f, 0.f, 0.f};
#pragma unroll
            for (int ks = 0; ks < 4; ++ks) a = MFMA16(av[ks], lds_frag256(WS, 16 * tt + fr, ks * 4 + fq), a);
            const int t = 16 * tt + fr, c0 = 128 * g + 16 * wave + 4 * fq; const float bs = F.ka->in[I_EVBS][g * 128 + t];
            const u32x2 uw = *(const u32x2*)(px + (size_t)(r0 + t) * EVIN + 2560 + c0);
            u32x2 w; w.x = cvtpk(geluf_(bflo(uw.x)) * (a[0] + bs), geluf_(bfhi(uw.x)) * (a[1] + bs)); w.y = cvtpk(geluf_(bflo(uw.y)) * (a[2] + bs), geluf_(bfhi(uw.y)) * (a[3] + bs));
            *(u32x2*)(mix + (size_t)(r0 + t) * DM + 512 + c0) = w; }
        __syncthreads();
    }
}
__device__ __forceinline__ void p3_mixers(Frame& F) {
    for (int it = F.vcu; it < 256; it += F.G) gla_item(F, it);
    for (int ci = F.vcu; ci < R / 128; ci += F.G) sgu_item(F, ci);
}
__device__ __forceinline__ void p3b_hgrn_out(Frame& F) {
    const int gw = F.vcu * 8 + F.wave, NGW = F.G * 8; const bf16_t* og = (const bf16_t*)(F.ws + WS_OG); const bf16_t* px = (const bf16_t*)(F.ws + WS_PX0); bf16_t* mix = (bf16_t*)(F.ws + WS_MIX);
    const int c0 = 8 * F.lane; float gn[8];
#pragma unroll
    for (int e = 0; e < 8; ++e) gn[e] = F.ka->in[I_EVONORM][(c0 & 127) + e];
    for (int row = gw; row < R; row += NGW) {
        const u32x4 a = *(const u32x4*)(og + (size_t)row * 512 + c0), bb = *(const u32x4*)(og + (size_t)(R + row) * 512 + c0), gg = *(const u32x4*)(px + (size_t)row * EVIN + 2048 + c0);
        float o[8]; float ss = 0.f;
#pragma unroll
        for (int e = 0; e < 4; ++e) { o[2 * e] = bflo(a[e]) + bflo(bb[e]); o[2 * e + 1] = bfhi(a[e]) + bfhi(bb[e]); ss += o[2 * e] * o[2 * e] + o[2 * e + 1] * o[2 * e + 1]; }
        ss += __shfl_xor(ss, 1); ss += __shfl_xor(ss, 2); ss += __shfl_xor(ss, 4); ss += __shfl_xor(ss, 8);
        const float rstd = __builtin_amdgcn_rsqf(ss * (1.0f / 128.0f) + RMS_EPS);
        u32x4 w;
#pragma unroll
        for (int e = 0; e < 4; ++e) w[e] = cvtpk(o[2 * e] * rstd * gn[2 * e] * siluf_(bflo(gg[e])), o[2 * e + 1] * rstd * gn[2 * e + 1] * siluf_(bfhi(gg[e])));
        *(u32x4*)(mix + (size_t)row * DM + c0) = w;
    }
}

__device__ __forceinline__ void p10_kr(Frame& F) {
    const int gw = F.vcu * 8 + F.wave, NGW = F.G * 8; const bf16_t* px1 = (const bf16_t*)(F.ws + WS_PX1); bf16_t* kb = (bf16_t*)(F.ws + WS_KB);
    const int d = F.lane, i16 = d & 15; const float invf = __expf(-(float)i16 * (2.0f / 32.0f) * 9.210340371976184f);
    for (int row = gw; row < R; row += NGW) {
        const int pos = row % PB; float x = bf2f(px1[(size_t)row * CINP + 640 + d]);
        const float xo = __shfl_xor(x, 16);
        if (pos >= CTXL) { const int t = pos - CTXL; const float p = (d < 32) ? (float)(t >> 6) : (float)(t & 63); const float ang = p * invf, cs = __cosf(ang), sn = __sinf(ang);
            x = (d & 16) ? (xo * sn + x * cs) : (x * cs - xo * sn); }
        const unsigned short hb = (unsigned short)f2bf(x);
#pragma unroll
        for (int h = 0; h < 8; ++h) kb[(size_t)row * NQ + h * 192 + 128 + d] = hb;
    }
}

namespace att {
constexpr int KVBLK = 64, SHM_V = 64 * 128 * 2, SHM_K = 64 * 192 * 2;
constexpr float THR = 8.0f * 1.4426950408889634f;
#define KSWZ192(row, colB) ((row) * 384 + ((colB) ^ (((row) & 7) << 4)))
__device__ __forceinline__ int crow(int r, int hi) { return (r & 3) + 8 * (r >> 2) + 4 * hi; }
__device__ __forceinline__ void partialSM(f32x16& p0, f32x16& p1, float& m_reg, float& mn, float& alpha) {
    float pmax = p0[0];
#pragma unroll
    for (int r = 1; r < 16; ++r) pmax = fmaxf(pmax, p0[r]);
#pragma unroll
    for (int r = 0; r < 16; ++r) pmax = fmaxf(pmax, p1[r]);
    { auto rr = __builtin_amdgcn_permlane32_swap(__float_as_uint(pmax), __float_as_uint(pmax), false, false); pmax = fmaxf(__uint_as_float(rr[0]), __uint_as_float(rr[1])); }
    if (__builtin_expect(__all(pmax - m_reg <= THR), 1)) { mn = m_reg; alpha = 1.f; }
    else { mn = fmaxf(m_reg, pmax); alpha = __builtin_amdgcn_exp2f(m_reg - mn); m_reg = mn; }
#pragma unroll
    for (int r = 0; r < 16; ++r) p0[r] = p0[r] - mn;
#pragma unroll
    for (int r = 0; r < 16; ++r) p1[r] = p1[r] - mn;
#pragma unroll
    for (int r = 0; r < 16; ++r) p0[r] = __builtin_amdgcn_exp2f(p0[r]);
}
__device__ __forceinline__ void finishSM(f32x16& p0, f32x16& p1, float alpha, float& l_reg, bf16x8& pa0, bf16x8& pa1, bf16x8& pa2, bf16x8& pa3) {
#pragma unroll
    for (int r = 0; r < 16; ++r) p1[r] = __builtin_amdgcn_exp2f(p1[r]);
    float ps = 0;
#pragma unroll
    for (int r = 0; r < 16; ++r) ps += p0[r];
#pragma unroll
    for (int r = 0; r < 16; ++r) ps += p1[r];
    { auto rr = __builtin_amdgcn_permlane32_swap(__float_as_uint(ps), __float_as_uint(ps), false, false); ps = __uint_as_float(rr[0]) + __uint_as_float(rr[1]); }
    l_reg = l_reg * alpha + ps;
#define PK4(P, BASE, OUT) do { unsigned a0 = cvtpk(P[BASE + 0], P[BASE + 1]), a1 = cvtpk(P[BASE + 2], P[BASE + 3]);   \
    unsigned b0 = cvtpk(P[BASE + 4], P[BASE + 5]), b1 = cvtpk(P[BASE + 6], P[BASE + 7]);                              \
    auto r0 = __builtin_amdgcn_permlane32_swap(a0, b0, false, false); auto r1 = __builtin_amdgcn_permlane32_swap(a1, b1, false, false); \
    u32x4 w = {r0[0], r1[0], r0[1], r1[1]}; OUT = *reinterpret_cast<bf16x8*>(&w); } while (0)
    PK4(p0, 0, pa0); PK4(p0, 8, pa1); PK4(p1, 0, pa2); PK4(p1, 8, pa3);
#undef PK4
}
__device__ __forceinline__ void qkt(f32x16& p0, f32x16& p1, const LAS unsigned char* const (&kb)[4], const int boff, const bf16x8* qr) {
    p0 = f32x16{}; p1 = f32x16{};
#pragma unroll
    for (int m = 0; m < 3; ++m) {
#pragma unroll
        for (int r = 0; r < 4; ++r) { const int d0 = 4 * m + r;
            const bf16x8 b0 = *(const LAS bf16x8*)(kb[r] + boff + m * 128);
            const bf16x8 b1 = *(const LAS bf16x8*)(kb[r] + boff + m * 128 + 12288);
            p0 = __builtin_amdgcn_mfma_f32_32x32x16_bf16(b0, qr[d0], p0, 0, 0, 0);
            p1 = __builtin_amdgcn_mfma_f32_32x32x16_bf16(b1, qr[d0], p1, 0, 0, 0); }
        SBAR(); }
}
__device__ __forceinline__ int v_st(int k, int c) { const int kk = (k & ~0xC) | ((k & 4) << 1) | ((k & 8) >> 1); return ((kk >> 3) * 4 + (c >> 5)) * 512 + ((kk & 7) * 32 + (c & 31)) * 2; }
__device__ __forceinline__ int v_rd_base(int lane) { return ((lane & 3) << 3) | (((lane >> 2) & 3) << 6) | (((lane >> 4) & 1) << 5) | (((lane >> 5) & 1) << 8); }
constexpr int v_rd_off(int d0, int ks, int half) { return d0 * 512 + ks * 4096 + half * 2048; }
template <int OFF> __device__ __forceinline__ s16x4 tr_read(int vb) { s16x4 r; asm volatile("ds_read_b64_tr_b16 %0, %1 offset:%2" : "=&v"(r) : "v"(vb), "i"(OFF) : "memory"); return r; }
template <int D0> __device__ __forceinline__ void pv_one(f32x16& od, int vb, bf16x8 pa0, bf16x8 pa1, bf16x8 pa2, bf16x8 pa3) {
    const s16x4 l0 = tr_read<v_rd_off(D0, 0, 0)>(vb), h0 = tr_read<v_rd_off(D0, 0, 1)>(vb), l1 = tr_read<v_rd_off(D0, 1, 0)>(vb), h1 = tr_read<v_rd_off(D0, 1, 1)>(vb);
    const s16x4 l2 = tr_read<v_rd_off(D0, 2, 0)>(vb), h2 = tr_read<v_rd_off(D0, 2, 1)>(vb), l3 = tr_read<v_rd_off(D0, 3, 0)>(vb), h3 = tr_read<v_rd_off(D0, 3, 1)>(vb);
    asm volatile("s_waitcnt lgkmcnt(0)" ::: "memory"); SBAR();
#define PK(L, H) (bf16x8){L[0], L[1], L[2], L[3], H[0], H[1], H[2], H[3]}
    od = __builtin_amdgcn_mfma_f32_32x32x16_bf16(pa0, PK(l0, h0), od, 0, 0, 0);
    od = __builtin_amdgcn_mfma_f32_32x32x16_bf16(pa1, PK(l1, h1), od, 0, 0, 0);
    od = __builtin_amdgcn_mfma_f32_32x32x16_bf16(pa2, PK(l2, h2), od, 0, 0, 0);
    od = __builtin_amdgcn_mfma_f32_32x32x16_bf16(pa3, PK(l3, h3), od, 0, 0, 0);
#undef PK
}
__device__ __forceinline__ void pv_d0(f32x16* o, int vb, bf16x8 pa0, bf16x8 pa1, bf16x8 pa2, bf16x8 pa3) {
    pv_one<0>(o[0], vb, pa0, pa1, pa2, pa3); pv_one<1>(o[1], vb, pa0, pa1, pa2, pa3); pv_one<2>(o[2], vb, pa0, pa1, pa2, pa3); pv_one<3>(o[3], vb, pa0, pa1, pa2, pa3);
}
__device__ __forceinline__ void attn_unit(const int tid, const bf16_t* __restrict__ Qb, const bf16_t* __restrict__ Kh, const bf16_t* __restrict__ Vh, bf16_t* __restrict__ Ob, LAS unsigned char* lds) {
    const int wid = __builtin_amdgcn_readfirstlane(tid >> 6), lane = tid & 63, r32 = lane & 31, hi = lane >> 5;
    LAS unsigned char* V_lds = lds; LAS unsigned char* K_lds = lds + 2 * SHM_V;
    LAS float* ws = (LAS float*)(lds + 2 * SHM_V + 2 * SHM_K) + wid * 64; LAS float* li_l = ws; LAS float* al_l = ws + 32;
    float m_reg = -1e30f, l_reg = 0; f32x16 o[4] = {}; bf16x8 qr[12];
    const bf16_t* Qw = Qb + (size_t)(wid * 32 + r32) * NQ + hi * 8;
#pragma unroll
    for (int d0 = 0; d0 < 12; ++d0) qr[d0] = *(const bf16x8*)(Qw + d0 * 16);
    const int sr = tid >> 4, sc = (tid & 15) * 8, vst0 = v_st(sr, sc), vst1 = v_st(32 + sr, sc);
    unsigned kgo[3], klo[3];
#pragma unroll
    for (int i = 0; i < 3; ++i) { const int id = tid + 512 * i, kr_ = id / 24, kc_ = (id % 24) * 8; kgo[i] = (unsigned)(kr_ * NQ + kc_) * 2u; klo[i] = (unsigned)KSWZ192(kr_, kc_ * 2); }
    const unsigned vgo = (unsigned)(sr * DM + sc) * 2u;
    const int vb0 = (int)(uintptr_t)V_lds + v_rd_base(lane);
    const LAS unsigned char* kb[4];
#pragma unroll
    for (int r = 0; r < 4; ++r) kb[r] = K_lds + r32 * 384 + ((r * 32 + hi * 16) ^ ((r32 & 7) << 4));
    bf16x8 vs0, vs1, ks[3];
#define SLOAD(k0) do { const char* vt_ = (const char*)Vh + (size_t)(k0) * DM * 2; const char* kt_ = (const char*)Kh + (size_t)(k0) * NQ * 2; \
    vs0 = *(const bf16x8*)(vt_ + vgo); vs1 = *(const bf16x8*)(vt_ + 32 * DM * 2 + vgo); \
    _Pragma("unroll") for (int i_ = 0; i_ < 3; ++i_) ks[i_] = *(const bf16x8*)(kt_ + kgo[i_]); } while (0)
#define SWRITE(b) do { *(LAS bf16x8*)(V_lds + (b) * SHM_V + vst0) = vs0; *(LAS bf16x8*)(V_lds + (b) * SHM_V + vst1) = vs1; \
    _Pragma("unroll") for (int i_ = 0; i_ < 3; ++i_) *(LAS bf16x8*)(K_lds + (b) * SHM_K + klo[i_]) = ks[i_]; } while (0)
    const LAS float* al_hi = al_l + 4 * hi;
#define RESC(a) do { if (__any((a) < 1.f)) { if (hi == 0) al_l[r32] = (a); asm volatile("s_waitcnt lgkmcnt(0)" ::: "memory"); \
    _Pragma("unroll") for (int d_ = 0; d_ < 4; ++d_) _Pragma("unroll") for (int r_ = 0; r_ < 16; ++r_) o[d_][r_] *= al_hi[crow(r_, 0)]; } } while (0)
    f32x16 p0, p1; float mn, al; bf16x8 pa0, pa1, pa2, pa3; constexpr int NT = PB / KVBLK;
    SLOAD(0); SWRITE(0); __syncthreads();
    for (int j = 0; j < NT; j += 2) {
        SLOAD((j + 1) * KVBLK); SBAR();
        qkt(p0, p1, kb, 0, qr); partialSM(p0, p1, m_reg, mn, al); RESC(al);
        finishSM(p0, p1, al, l_reg, pa0, pa1, pa2, pa3); SBAR();
        pv_d0(o, vb0, pa0, pa1, pa2, pa3);
        SWRITE(1); __syncthreads();
        if (j + 2 < NT) SLOAD((j + 2) * KVBLK); SBAR();
        qkt(p0, p1, kb, SHM_K, qr); partialSM(p0, p1, m_reg, mn, al); RESC(al);
        finishSM(p0, p1, al, l_reg, pa0, pa1, pa2, pa3); SBAR();
        pv_d0(o, vb0 + SHM_V, pa0, pa1, pa2, pa3);
        if (j + 2 < NT) SWRITE(0);
        __syncthreads();
    }
    if (hi == 0) li_l[r32] = l_reg; asm volatile("s_waitcnt lgkmcnt(0)" ::: "memory");
    __syncthreads();
    int lane2 = threadIdx.x & 63; asm volatile("" : "+v"(lane2));
    const int hi2 = lane2 >> 5, r322 = lane2 & 31;
    LAS bf16_t* stg = (LAS bf16_t*)(lds + wid * 8192);
    LAS bf16_t* stg_l = stg + 4 * hi2 * 128 + r322; const LAS float* li_hi = li_l + 4 * hi2;
#pragma unroll
    for (int r = 0; r < 16; ++r) { const float rl = __builtin_amdgcn_rcpf(li_hi[crow(r, 0)]);
#pragma unroll
        for (int d0 = 0; d0 < 4; ++d0) stg_l[crow(r, 0) * 128 + d0 * 32] = (bf16_t)f2bf(o[d0][r] * rl); }
    asm volatile("s_waitcnt lgkmcnt(0)" ::: "memory");
    bf16_t* Ow = Ob + (size_t)(wid * 32 + (lane2 >> 4)) * DM + (lane2 & 15) * 8; const LAS bf16_t* stg_r = stg + (lane2 >> 4) * 128 + (lane2 & 15) * 8;
#pragma unroll
    for (int i = 0; i < 8; ++i) { const u32x4 v = *(const LAS u32x4*)(stg_r + i * 4 * 128); *(u32x4*)(Ow + (size_t)(i * 4) * DM) = v; }
    __syncthreads();
#undef SLOAD
#undef SWRITE
#undef RESC
}
}
__device__ __forceinline__ void p11_attention(Frame& F) {
    const bf16_t* Q = (const bf16_t*)(F.ws + WS_Q); const bf16_t* K = (const bf16_t*)(F.ws + WS_KB); const bf16_t* V = (const bf16_t*)(F.ws + WS_VB); bf16_t* O = (bf16_t*)(F.ws + WS_MIX);
    for (int i = 0; i < 4; ++i) {
        const int bh = (F.vcu >> 3) + 32 * i, qb = F.vcu & 7, b = bh >> 3, h = bh & 7;
        const size_t qrow = (size_t)b * PB + CTXL + qb * 256, krow = (size_t)b * PB;
        att::attn_unit(F.tid, Q + qrow * NQ + h * 192, K + krow * NQ + h * 192, V + krow * DM + h * 128, O + qrow * DM + h * 128, F.lds);
    }
}

__device__ __forceinline__ void ka_launder(Frame& F) { asm volatile("" : "+s"(F.ka)); int t = threadIdx.x; asm volatile("" : "+v"(t)); F.tid = t; F.lane = t & 63; F.wave = __builtin_amdgcn_readfirstlane(t >> 6); }
#ifndef DBG_MODE
#define DBG_MODE 0
#endif
constexpr int NPH = 21;
__device__ __forceinline__ void moe_gemms(Frame& F, int layer, int which) {
    const int nblk = __builtin_amdgcn_readfirstlane(*(const int*)(F.ws + WS_ROUTE + RT_NBLK));
    MoeSched S; S.init((const int*)(F.ws + WS_ROUTE + RT_BLKE), nblk, F.G, (int)blockIdx.x);
    const int* perm = (const int*)(F.ws + WS_ROUTE + RT_PERM);
    if (which == 0) {
        pg8::Gemm g{(const bf16_t*)(F.ws + WS_HX), (const bf16_t*)(F.ws + WS_WGU) + (size_t)layer * 32 * 1024 * DM, DM, DM, DM, perm};
        EpiSwiglu E{(bf16_t*)(F.ws + WS_ACT)};
        pg8::gemm_phase<EpiSwiglu, MoeSched, true>(F.lds, g, S, E);
    } else {
        pg8::Gemm g{(const bf16_t*)(F.ws + WS_ACT), (const bf16_t*)(F.ws + WS_WDN) + (size_t)layer * 32 * DM * MFF, MFF, MFF, MFF, nullptr};
        EpiScatter E{(bf16_t*)(F.ws + WS_YS), perm};
        pg8::gemm_phase<EpiScatter, MoeSched, false>(F.lds, g, S, E);
    }
}
__global__ void __launch_bounds__(512, 2) mega_fwd(Args args) {
    extern __shared__ __attribute__((aligned(16))) unsigned char lds_raw[];
    Frame F;
    F.lds = (LAS unsigned char*)lds_raw;
    F.tid = threadIdx.x; F.lane = F.tid & 63; F.wave = __builtin_amdgcn_readfirstlane(F.tid >> 6);
    F.G = gridDim.x; { const int bx = blockIdx.x; F.vcu = (F.G % 8 == 0) ? (bx % 8) * (F.G / 8) + bx / 8 : bx; }
    F.ws = args.ws; F.out = args.out;
    F.ka = (const __attribute__((address_space(4))) Args*)__builtin_amdgcn_kernarg_segment_ptr();
    for (int u = F.tid; u < (LDS_BYTES - LDSCTL_OFF) / 4; u += 512) ((LAS unsigned*)(F.lds + LDSCTL_OFF))[u] = 0u;
    __syncthreads();
    volatile LAS unsigned* MISC = (volatile LAS unsigned*)(F.lds + MISC_OFF);
    unsigned* ctl = (unsigned*)(F.ws + WS_CTL);
    XcdBarrier bar; bar.bar = ctl + CW_BAR; bar.x = 0; bar.st = nullptr;
    if (!args.nobar) bar = xcd_barrier_post(ctl + CW_BAR, MISC + 8);
    const int lo = args.ph_lo, hi = args.ph_hi;
#define IN(k) (lo <= (k) && (k) < hi)
#define SEAM(k) do { if (IN(k) && IN((k) + 1)) xcd_barrier(bar); } while (0)
    constexpr int LAST = DBG_MODE == 0 ? 20 : DBG_MODE == 1 ? -1 : DBG_MODE == 2 ? 6 : DBG_MODE == 3 ? 11 : DBG_MODE == 4 ? 15 : DBG_MODE == 10 ? 2 : DBG_MODE == 11 ? 3 : 5;
#ifndef PHMASK
#define PHMASK 0x1fffff
#endif
#define RUN(k) (ka_launder(F), IN(k) && (k) <= LAST && ((PHMASK >> (k)) & 1))

    if (RUN(0)) p0_prologue(F);
    SEAM(0);
    if (RUN(1)) p0b_mod(F);
    SEAM(1);
    if (RUN(2)) p1_norm_input(F);
    SEAM(2);
    if (RUN(3)) { pg8::Gemm g{(const bf16_t*)(F.ws + WS_HX), (const bf16_t*)(F.ws + WS_WIN0), DM, DM, DM, nullptr}; TileSched<false> S; S.init(EVIN / 256, F.G, (int)blockIdx.x);
        EpiStoreBf16 E{(bf16_t*)(F.ws + WS_PX0), EVIN}; pg8::gemm_phase<EpiStoreBf16, TileSched<false>, false>(F.lds, g, S, E); }
    SEAM(3);
    if (RUN(4)) p3_mixers(F);
    SEAM(4);
    if (RUN(5)) p3b_hgrn_out(F);
    SEAM(5);
    if (RUN(6)) { pg8::Gemm g{(const bf16_t*)(F.ws + WS_MIX), (const bf16_t*)(F.ws + WS_WOUT0), DM, DM, DM, nullptr}; TileSched<false> S; S.init(DM / 256, F.G, (int)blockIdx.x);
        EpiResidual E{&F, (float*)(F.ws + WS_XS), 0, true}; pg8::gemm_phase<EpiResidual, TileSched<false>, false>(F.lds, g, S, E); }
    SEAM(6);
    if (RUN(7)) p5_norm_route<false>(F, 0);
    SEAM(7);
    if (RUN(8)) p5b_perm<false>(F);
    SEAM(8);
    if (RUN(9)) moe_gemms(F, 0, 0);
    SEAM(9);
    if (RUN(10)) moe_gemms(F, 0, 1);
    SEAM(10);
    if (RUN(11)) p8_combine_norm(F);
    SEAM(11);
    if (RUN(12)) { pg8::Gemm g{(const bf16_t*)(F.ws + WS_HX), (const bf16_t*)(F.ws + WS_WIN1), DM, DM, DM, nullptr}; TileSched<false> S; S.init(CINP / 256, F.G, (int)blockIdx.x);
        EpiStoreStats E{(bf16_t*)(F.ws + WS_PX1), CINP, (float*)(F.ws + WS_STATS)}; pg8::gemm_phase<EpiStoreStats, TileSched<false>, false>(F.lds, g, S, E); }
    SEAM(12);
    if (RUN(13)) {
        { pg8::Gemm g{(const bf16_t*)(F.ws + WS_PX1), (const bf16_t*)(F.ws + WS_WUQ), CINP, QRANK, QRANK, nullptr}; TileSched<true> S; S.init(NQ / 256, F.G, (int)blockIdx.x);
          EpiQ E{(bf16_t*)(F.ws + WS_Q), (const float*)(F.ws + WS_STATS)}; pg8::gemm_phase<EpiQ, TileSched<true>, false>(F.lds, g, S, E); }
        { pg8::Gemm g{(const bf16_t*)(F.ws + WS_PX1) + QRANK, (const bf16_t*)(F.ws + WS_WUKV), CINP, KVRANK, KVRANK, nullptr}; TileSched<false> S; S.init(NKV / 256, F.G, (int)blockIdx.x);
          EpiKV E{(bf16_t*)(F.ws + WS_KB), (bf16_t*)(F.ws + WS_VB), (const float*)(F.ws + WS_STATS)}; pg8::gemm_phase<EpiKV, TileSched<false>, false>(F.lds, g, S, E); }
        ka_launder(F);
        p10_kr(F);
    }
    SEAM(13);
    if (RUN(14)) p11_attention(F);
    SEAM(14);
    if (RUN(15)) { pg8::Gemm g{(const bf16_t*)(F.ws + WS_MIX), (const bf16_t*)(F.ws + WS_WOUT1), DM, DM, DM, nullptr}; TileSched<true> S; S.init(DM / 256, F.G, (int)blockIdx.x);
        EpiResidual E{&F, (float*)(F.ws + WS_XS), 1, false}; pg8::gemm_phase<EpiResidual, TileSched<true>, false>(F.lds, g, S, E); }
    SEAM(15);
    if (RUN(16)) p5_norm_route<true>(F, 1);
    SEAM(16);
    if (RUN(17)) p5b_perm<true>(F);
    SEAM(17);
    if (RUN(18)) moe_gemms(F, 1, 0);
    SEAM(18);
    if (RUN(19)) moe_gemms(F, 1, 1);
    SEAM(19);
    ka_launder(F);
    if (IN(20) && ((PHMASK >> 20) & 1)) p16_final(F);
#undef IN
#undef SEAM
#undef RUN
}

#ifndef MK_N_LAUNCHES
#define MK_N_LAUNCHES 1
#endif
extern "C" void kernel_launch(void* const* d_in, const int* in_sizes, int n_in, void* d_out, int out_size, void* d_ws, size_t ws_size, hipStream_t stream) {
    static int grid = 0;
    if (grid == 0) {
        if (n_in != 28 || out_size != NB * SEQ * DM || ws_size < WS_END) { fprintf(stderr, "kernel_launch: unexpected shapes (n_in %d out %d ws %zu)\n", n_in, out_size, ws_size); grid = -1; return; }
        int dev = 0, cus = 0, per_cu = 0;
        if (hipGetDevice(&dev) != hipSuccess || hipDeviceGetAttribute(&cus, hipDeviceAttributeMultiprocessorCount, dev) != hipSuccess) { grid = -1; return; }
        if (hipFuncSetAttribute((const void*)mega_fwd, hipFuncAttributeMaxDynamicSharedMemorySize, LDS_BYTES) != hipSuccess) { fprintf(stderr, "kernel_launch: hipFuncSetAttribute failed\n"); grid = -1; return; }
        if (hipOccupancyMaxActiveBlocksPerMultiprocessor(&per_cu, (const void*)mega_fwd, 512, LDS_BYTES) != hipSuccess || per_cu < 1) { fprintf(stderr, "kernel_launch: occupancy query says %d blocks/CU\n", per_cu); per_cu = 1; }
        (void)hipGetLastError();
        grid = cus;
    }
    if (grid < 0) return;
    (void)hipMemsetAsync((char*)d_ws + WS_CTL, 0, CTL_ZERO_BYTES, stream);
    Args a{};
    for (int i = 0; i < 28; ++i) a.in[i] = (const float*)d_in[i];
    a.out = (float*)d_out; a.ws = (unsigned char*)d_ws;
    if (MK_N_LAUNCHES == 1) {
        a.ph_lo = 0; a.ph_hi = NPH; a.nobar = 0;
        void* kargs[] = {&a};
        hipError_t e = hipLaunchCooperativeKernel((const void*)mega_fwd, dim3(grid), dim3(512), kargs, LDS_BYTES, stream);
        if (e != hipSuccess) { (void)hipGetLastError(); fprintf(stderr, "kernel_launch: cooperative launch failed (%s), plain launch instead\n", hipGetErrorString(e)); hipLaunchKernelGGL(mega_fwd, dim3(grid), dim3(512), LDS_BYTES, stream, a); }
    } else {
        for (int p = 0; p < NPH; ++p) { a.ph_lo = p; a.ph_hi = p + 1; a.nobar = 1; hipLaunchKernelGGL(mega_fwd, dim3(grid), dim3(512), LDS_BYTES, stream, a); }
    }
}
```

```cpp
#include <hip/hip_runtime.h>
#include <cstdio>
#include <cstdint>
#define MK_N_LAUNCHES 1
#define DBG_MODE 0
#define REPMASK 0x0

#define LAS __attribute__((address_space(3)))
#define GAS __attribute__((address_space(1)))
typedef unsigned short bf16_t;
typedef short bf16x8 __attribute__((ext_vector_type(8)));
typedef short s16x4 __attribute__((ext_vector_type(4)));
typedef float f32x2 __attribute__((ext_vector_type(2)));
typedef float f32x4 __attribute__((ext_vector_type(4)));
typedef float f32x16 __attribute__((ext_vector_type(16)));
typedef unsigned u32x2 __attribute__((ext_vector_type(2)));
typedef unsigned u32x4 __attribute__((ext_vector_type(4)));

constexpr int DM = 1024, NB = 16, SEQ = 2048, CTXL = 256, PB = SEQ + CTXL  , R = NB * PB  ;
constexpr int NTILE = R / 256  , NXTILE = NB * SEQ / 256  ;
constexpr int EVIN = 3584;
constexpr int CIN = 704, CINP = 768, QRANK = 384, KVRANK = 256, NQ = 1536, NKV = 2048;
constexpr int NEXP = 32, MFF = 512;
constexpr int MAXSLOT = 81920;
constexpr float RMS_EPS = 1e-6f;
constexpr float ATT_C2 = 0.07216878364870322f * 1.4426950408889634f;

constexpr size_t MiB = 1u << 20;
constexpr size_t WS_CTL = 0, CTL_ZERO_BYTES = 1 * MiB;
constexpr size_t WS_MOD = 1 * MiB;
constexpr size_t WS_PART = 2 * MiB;
constexpr size_t WS_STATS = 9 * MiB;
constexpr size_t WS_ROUTE = 13 * MiB;
constexpr size_t WS_WIN0 = 16 * MiB, WS_WOUT0 = 23 * MiB, WS_WIN1 = 25 * MiB, WS_WUQ = 27 * MiB, WS_WUKV = 29 * MiB, WS_WOUT1 = 30 * MiB;
constexpr size_t WS_WGU = 32 * MiB;
constexpr size_t WS_WDN = 160 * MiB;
constexpr size_t WS_XS = 224 * MiB;
constexpr size_t WS_HX = 368 * MiB;
constexpr size_t WS_MIX = 440 * MiB;
constexpr size_t WS_RA = 512 * MiB;
constexpr size_t WS_PX0 = WS_RA, WS_Q = WS_RA, WS_KB = WS_RA + 108 * MiB, WS_ACT = WS_RA;
constexpr size_t WS_RB = 764 * MiB;
constexpr size_t WS_YS = WS_RB, WS_PX1 = WS_RB, WS_VB = WS_RB + 54 * MiB, WS_OG = WS_RB;
constexpr size_t WS_END = 908 * MiB;
constexpr size_t RT_AE = 0, RT_AP = 512 * 1024, RT_AW = 1024 * 1024, RT_PERM = 1536 * 1024, RT_CNTB = 2048 * 1024, RT_BLKE = 2048 * 1024 + 64 * 1024, RT_NBLK = RT_BLKE + 4096;
constexpr int CW_BAR = 4096;

constexpr int RING_BYTES = 131072;
constexpr int LDSCTL_OFF = 147456, MISC_OFF = LDSCTL_OFF + 320;
constexpr int LDS_BYTES = 149504;

#define LDS_WAIT() asm volatile("s_waitcnt lgkmcnt(0)" ::: "memory")
#define VM_WAIT() asm volatile("s_waitcnt vmcnt(0)" ::: "memory")
#define SBAR() __builtin_amdgcn_sched_barrier(0)
__device__ __forceinline__ unsigned f2bf(float f) { unsigned u = __builtin_bit_cast(unsigned, f); return (u + 0x7fffu + ((u >> 16) & 1u)) >> 16; }
__device__ __forceinline__ unsigned pk2(float lo, float hi) { return f2bf(lo) | (f2bf(hi) << 16); }
typedef __bf16 bf16x2_t __attribute__((ext_vector_type(2)));
__device__ __forceinline__ unsigned cvtpk(float lo, float hi) { f32x2 v = {lo, hi}; bf16x2_t b = __builtin_convertvector(v, bf16x2_t); return __builtin_bit_cast(unsigned, b); }
__device__ __forceinline__ float bf2f(unsigned short h) { return __builtin_bit_cast(float, (unsigned)h << 16); }
__device__ __forceinline__ float bflo(unsigned w) { return __builtin_bit_cast(float, w << 16); }
__device__ __forceinline__ float bfhi(unsigned w) { return __builtin_bit_cast(float, w & 0xffff0000u); }
__device__ __forceinline__ float wave_sum(float v) {
#pragma unroll
    for (int o = 1; o < 64; o <<= 1) v += __shfl_xor(v, o);
    return v;
}
constexpr float LOG2E = 1.4426950408889634f, LN2 = 0.6931471805599453f;
__device__ __forceinline__ float ex2(float x) { return __builtin_amdgcn_exp2f(x); }
__device__ __forceinline__ float lg2(float x) { return __builtin_amdgcn_logf(x); }
__device__ __forceinline__ float sigmoidf_(float x) { return __builtin_amdgcn_rcpf(1.0f + ex2(-LOG2E * x)); }
__device__ __forceinline__ float siluf_(float x) { return x * __builtin_amdgcn_rcpf(1.0f + ex2(-LOG2E * x)); }
__device__ __forceinline__ float geluf_(float x) { const float z = (-1.5957691216057308f * LOG2E) * (x + 0.044715f * x * x * x); return x * __builtin_amdgcn_rcpf(1.0f + ex2(z)); }

#define XB_TMO      128
#define XB_XCNT(j)  (256  + 64 * (j))
#define XB_XSUB(j)  (1280 + 64 * (j))
#define XB_XGEN(j)  (2304 + 64 * (j))
#define XB_TOP      3328
#define XB_TOPGEN   3392
#define XCD_BAR_WORDS 3456
#define XB_SPIN_CAP (1u << 22)
__device__ __forceinline__ unsigned xb_ld(unsigned* p)              { return __hip_atomic_load(p, __ATOMIC_RELAXED, __HIP_MEMORY_SCOPE_AGENT); }
__device__ __forceinline__ unsigned xb_add(unsigned* p, unsigned v) { return __hip_atomic_fetch_add(p, v, __ATOMIC_RELAXED, __HIP_MEMORY_SCOPE_AGENT); }
__device__ __forceinline__ unsigned xb_xcc_id() { return (unsigned)__builtin_amdgcn_s_getreg((3 << 11) | 20) & 0xFu; }
#define XB_SPIN(cond, bar) do { unsigned _sp = 0; while (cond) { __builtin_amdgcn_s_sleep(1); \
    if ((++_sp & 255u) == 0u) { if (xb_ld(&(bar)[XB_TMO])) break; if (_sp > XB_SPIN_CAP) { atomicAdd(&(bar)[XB_TMO], 1u); break; } } } } while (0)
struct XcdBarrier { unsigned* bar; unsigned x; volatile LAS unsigned* st; };
__device__ __forceinline__ XcdBarrier xcd_barrier_post(unsigned* bar, volatile LAS unsigned* st) {
    XcdBarrier b; b.bar = bar; b.x = xb_xcc_id(); b.st = st;
    if (threadIdx.x == 0) (void)xb_add(&bar[XB_XCNT(b.x)], 1u);
    return b;
}
__device__ __forceinline__ void xcd_barrier_complete(unsigned* bar, unsigned x, unsigned& nloc, unsigned& nx) {
    const unsigned G = gridDim.x * gridDim.y * gridDim.z;
    unsigned sum, cnt, mine, sp = 0u;
    for (;;) {
        sum = 0u; cnt = 0u; mine = 0u;
#pragma unroll
        for (unsigned j = 0; j < 16; ++j) { const unsigned c = xb_ld(&bar[XB_XCNT(j)]); sum += c; cnt += (c > 0u) ? 1u : 0u; mine = (j == x) ? c : mine; }
        if (sum == G) break;
        __builtin_amdgcn_s_sleep(1);
        if ((++sp & 255u) == 0u) { if (xb_ld(&bar[XB_TMO])) break; if (sp > XB_SPIN_CAP) { atomicAdd(&bar[XB_TMO], 1u); break; } }
    }
    nloc = mine > 0u ? mine : 1u; nx = cnt > 0u ? cnt : 1u;
}
__device__ __forceinline__ void xcd_barrier(const XcdBarrier& b) {
    asm volatile("s_waitcnt vmcnt(0)" ::: "memory");
    __syncthreads();
    if (threadIdx.x == 0) {
        unsigned* bar = b.bar;
        __builtin_amdgcn_s_waitcnt(0);
        unsigned nloc = b.st[0], nx = b.st[1];
        if (nloc == 0u) { xcd_barrier_complete(bar, b.x, nloc, nx); b.st[0] = nloc; b.st[1] = nx; }
        const unsigned old = xb_add(&bar[XB_XSUB(b.x)], 1u);
        const unsigned gen = old / nloc;
        if (old + 1u == (gen + 1u) * nloc) {
            __builtin_amdgcn_fence(__ATOMIC_RELEASE, "agent");
            asm volatile("s_waitcnt vmcnt(0)" ::: "memory");
            const unsigned og = xb_add(&bar[XB_TOP], 1u);
            const unsigned tg = og / nx;
            if (og + 1u == (tg + 1u) * nx) xb_add(&bar[XB_TOPGEN], 1u);
            else XB_SPIN(xb_ld(&bar[XB_TOPGEN]) == tg, bar);
            __builtin_amdgcn_fence(__ATOMIC_ACQUIRE, "agent");
            xb_add(&bar[XB_XGEN(b.x)], 1u);
            asm volatile("s_waitcnt vmcnt(0)" ::: "memory");
        } else {
            XB_SPIN(xb_ld(&bar[XB_XGEN(b.x)]) == gen, bar);
            __builtin_amdgcn_fence(__ATOMIC_ACQUIRE, "agent");
            asm volatile("s_waitcnt vmcnt(0)" ::: "memory");
        }
    }
    __syncthreads();
}

namespace pg8 {
constexpr int BM = 256, BK = 64, HALF = 128, HTB = HALF * BK * 2, STAGE_BYTES = 8 * HTB, NXCD = 8, WGM = 8;
__host__ __device__ __forceinline__ int lds_byte(int r, int c) { const int st = (r >> 4) * 2 + (c >> 5), rr = r & 15, cc = c & 31, ob = rr * 64 + cc * 2; return st * 1024 + (ob ^ (((ob >> 9) & 1) << 5)); }
__host__ __device__ __forceinline__ void stage_rc(int b, int& Rr, int& C) { const int st = b / 1024, sb = b % 1024, swz = sb ^ (((sb >> 9) & 1) << 5); Rr = (st >> 1) * 16 + swz / 64; C = (st & 1) * 32 + (swz % 64) / 2; }
__host__ __device__ __forceinline__ int perm32(int rho) { const int n = rho >> 4, i = rho & 15; return 8 * (i >> 2) + 4 * n + (i & 3); }

struct Unit { int arow0, brow0, pm, pn, ex; };
struct Gemm { const bf16_t* A; const bf16_t* Bt; int lda, ldb, K; const int* rowidx; };

template <class Epi, class Sched, bool GATHER>
__device__ __forceinline__ void gemm_phase(LAS unsigned char* lds, const Gemm g, const Sched& S, const Epi& E) {
    int tidl = threadIdx.x; asm volatile("" : "+v"(tidl));
    const int tid = tidl, wid = __builtin_amdgcn_readfirstlane(tid >> 6), lane = tid & 63, wr = wid >> 2, wc = wid & 3, fr = lane & 15, fq = lane >> 4;
    const int K = g.K, nt = K / BK;
    int sR[2], sC[2]; unsigned voffB[2], voffA[2];
#pragma unroll
    for (int i = 0; i < 2; ++i) { stage_rc(tid * 16 + i * 8192, sR[i], sC[i]); const int Rb = Epi::PERM ? ((sR[i] & ~31) + perm32(sR[i] & 31)) : sR[i];
        voffB[i] = (unsigned)(Rb * g.ldb + sC[i]) * 2u; voffA[i] = (unsigned)(sR[i] * g.lda + sC[i]) * 2u; }
    const size_t kstep = (size_t)(BK * 2);
    const size_t hstepB = (size_t)HALF * g.ldb * 2, hstepA = (size_t)HALF * g.lda * 2;
    const unsigned ldsw = (unsigned)wid * 1024u;
    const int aoff = lds_byte(wr * 64 + fr, fq * 8), boff = lds_byte(wc * 32 + fr, fq * 8);
#define PG8_SA(b, h) (((b) * 2 + (h)) * HTB)
#define PG8_SB(b, h) ((4 + (b) * 2 + (h)) * HTB)
#define PG8_GLDS(src, bufoff, i) __builtin_amdgcn_global_load_lds((const unsigned*)(src), (LAS unsigned*)(lds + (bufoff) + ldsw + (i) * 8192), 16, 0, 0)
#define PG8_STAGEB(bufoff, gbase) do { _Pragma("unroll") for (int _i = 0; _i < 2; ++_i) PG8_GLDS((const char*)(gbase) + voffB[_i], bufoff, _i); } while (0)
#define PG8_STAGEA(bufoff, h, isnext, kb) do { \
        if constexpr (GATHER) { _Pragma("unroll") for (int _i = 0; _i < 2; ++_i) PG8_GLDS(gA + (kb) + ((isnext) ? nvo[h][_i] : cvo[h][_i]), bufoff, _i); } \
        else { const char* _b = ((isnext) ? nA : cA) + (h) * hstepA + (kb); _Pragma("unroll") for (int _i = 0; _i < 2; ++_i) PG8_GLDS(_b + voffA[_i], bufoff, _i); } } while (0)
#define PG8_LDA(dst, b, h) do { _Pragma("unroll") for (int m = 0; m < 4; ++m) _Pragma("unroll") for (int k = 0; k < 2; ++k) dst[m][k] = *(const LAS bf16x8*)(lds + PG8_SA(b, h) + aoff + m * 2048 + k * 1024); } while (0)
#define PG8_LDB(dst, b, h) do { _Pragma("unroll") for (int n = 0; n < 2; ++n) _Pragma("unroll") for (int k = 0; k < 2; ++k) dst[n][k] = *(const LAS bf16x8*)(lds + PG8_SB(b, h) + boff + n * 2048 + k * 1024); } while (0)
#define PG8_MMA(ai, bj, At, Bt) do { __builtin_amdgcn_s_setprio(1); _Pragma("unroll") for (int m = 0; m < 4; ++m) _Pragma("unroll") for (int n = 0; n < 2; ++n) _Pragma("unroll") for (int k = 0; k < 2; ++k) \
        acc[ai][bj][m][n] = __builtin_amdgcn_mfma_f32_16x16x32_bf16(Bt[n][k], At[m][k], acc[ai][bj][m][n], 0, 0, 0); __builtin_amdgcn_s_setprio(0); } while (0)
#define PG8_WAIT_V(n) asm volatile("s_waitcnt vmcnt(" #n ")" ::: "memory")
#define PG8_WAIT_L(n) asm volatile("s_waitcnt lgkmcnt(" #n ")" ::: "memory")
#define PG8_BAR __builtin_amdgcn_s_barrier()
#define PG8_SCHED __builtin_amdgcn_sched_barrier(0)
    unsigned cvo[2][2], nvo[2][2];
    auto a_offsets = [&](const Unit& u, unsigned (&vo)[2][2]) {
#pragma unroll
        for (int h = 0; h < 2; ++h)
#pragma unroll
            for (int i = 0; i < 2; ++i) { const int a = g.rowidx[u.arow0 + h * HALF + sR[i]]; const int row = a < 0 ? 0 : (a >> 1); vo[h][i] = (unsigned)((size_t)row * g.lda + sC[i]) * 2u; }
    };
    Unit cur, nxt; int ui = 0;
    if (!S.next(0, cur)) return;
    f32x4 acc[2][2][4][2];
#pragma unroll
    for (int a = 0; a < 2; ++a)
#pragma unroll
        for (int b = 0; b < 2; ++b)
#pragma unroll
            for (int m = 0; m < 4; ++m)
#pragma unroll
                for (int n = 0; n < 2; ++n) acc[a][b][m][n] = (f32x4){0.f, 0.f, 0.f, 0.f};
    bf16x8 At[4][2], B0[2][2], B1[2][2];
    const char* gA = (const char*)g.A;
    const char* cA = gA + (size_t)cur.arow0 * g.lda * 2; const char* nA = cA;
    const char* cB = (const char*)g.Bt + (size_t)cur.brow0 * g.ldb * 2;
    if constexpr (GATHER) { a_offsets(cur, cvo);
#pragma unroll
        for (int h = 0; h < 2; ++h)
#pragma unroll
            for (int i = 0; i < 2; ++i) nvo[h][i] = cvo[h][i]; }
    PG8_STAGEB(PG8_SB(0, 0), cB); PG8_STAGEB(PG8_SB(0, 1), cB + hstepB); PG8_STAGEA(PG8_SA(0, 0), 0, false, 0); PG8_STAGEA(PG8_SA(0, 1), 1, false, 0);
    if (wr == 1) PG8_BAR;
    PG8_WAIT_V(2); PG8_BAR;
    PG8_STAGEB(PG8_SB(1, 0), cB + kstep); PG8_STAGEA(PG8_SA(1, 0), 0, false, kstep); PG8_STAGEB(PG8_SB(1, 1), cB + hstepB + kstep);
    PG8_WAIT_V(6); PG8_BAR;
    for (;;) {
        const bool has_next = S.next(ui + 1, nxt);
        const char* nB = has_next ? (const char*)g.Bt + (size_t)nxt.brow0 * g.ldb * 2 : cB;
        nA = has_next ? gA + (size_t)nxt.arow0 * g.lda * 2 : cA;
        if constexpr (GATHER) { if (has_next) a_offsets(nxt, nvo); }
        for (int t = 0; t < nt; t += 2) {
            const bool last = (t == nt - 2);
            const size_t k1 = (size_t)(t + 1) * kstep, k2 = last ? 0 : (size_t)(t + 2) * kstep, k3 = k2 + kstep;
            const char* b2 = last ? nB : cB + (size_t)(t + 2) * kstep; const char* b3 = b2 + kstep;
            PG8_LDB(B0, 0, 0); PG8_LDB(B1, 0, 1); PG8_SCHED; PG8_LDA(At, 0, 0); PG8_STAGEA(PG8_SA(1, 1), 1, false, k1);
            PG8_WAIT_V(8); PG8_WAIT_L(0); PG8_BAR; PG8_MMA(0, 0, At, B0); PG8_MMA(0, 1, At, B1); PG8_BAR; PG8_SCHED;
            PG8_LDA(At, 0, 1); PG8_STAGEB(PG8_SB(0, 0), b2); PG8_STAGEB(PG8_SB(0, 1), b2 + hstepB); PG8_STAGEA(PG8_SA(0, 0), 0, last, k2);
            PG8_WAIT_V(8); PG8_WAIT_L(0); PG8_BAR; PG8_MMA(1, 0, At, B0); PG8_MMA(1, 1, At, B1); PG8_BAR; PG8_SCHED;
            PG8_LDB(B0, 1, 0); PG8_LDB(B1, 1, 1); PG8_SCHED; PG8_LDA(At, 1, 0); PG8_STAGEA(PG8_SA(0, 1), 1, last, k2);
            PG8_WAIT_V(8); PG8_WAIT_L(0); PG8_BAR; PG8_MMA(0, 0, At, B0); PG8_MMA(0, 1, At, B1); PG8_BAR; PG8_SCHED;
            PG8_LDA(At, 1, 1); PG8_STAGEB(PG8_SB(1, 0), b3); PG8_STAGEB(PG8_SB(1, 1), b3 + hstepB); PG8_STAGEA(PG8_SA(1, 0), 0, last, k3);
            PG8_WAIT_V(8); PG8_WAIT_L(0); PG8_BAR; PG8_MMA(1, 0, At, B0); PG8_MMA(1, 1, At, B1); PG8_BAR; PG8_SCHED;
        }
        if (wr == 0) PG8_BAR;
        { int l2 = threadIdx.x; asm volatile("" : "+v"(l2)); E(acc, cur, wr, wc, l2 & 15, (l2 >> 4) & 3); }
        if (!has_next) break;
#pragma unroll
        for (int a = 0; a < 2; ++a)
#pragma unroll
            for (int b = 0; b < 2; ++b)
#pragma unroll
                for (int m = 0; m < 4; ++m)
#pragma unroll
                    for (int n = 0; n < 2; ++n) acc[a][b][m][n] = (f32x4){0.f, 0.f, 0.f, 0.f};
        cur = nxt; cB = nB; cA = nA; ++ui;
        if constexpr (GATHER) {
#pragma unroll
            for (int h = 0; h < 2; ++h)
#pragma unroll
                for (int i = 0; i < 2; ++i) cvo[h][i] = nvo[h][i]; }
        if (wr == 1) PG8_BAR;
    }
    PG8_WAIT_V(0);
    PG8_BAR;
#undef PG8_SA
#undef PG8_SB
#undef PG8_GLDS
#undef PG8_STAGEA
#undef PG8_STAGEB
#undef PG8_LDA
#undef PG8_LDB
#undef PG8_MMA
#undef PG8_WAIT_V
#undef PG8_WAIT_L
#undef PG8_BAR
#undef PG8_SCHED
}
}

struct Args {
    const float* in[28]; float* out; unsigned char* ws; int ph_lo, ph_hi, nobar, pad;
};
enum In { I_X = 0, I_C, I_CTX, I_CCTX, I_ADAW, I_ADAB, I_NMIXG, I_NFFNG, I_EVWIN, I_EVLB, I_EVONORM, I_EVSGUG, I_EVWS, I_EVBS, I_EVWOUT,
          I_ODWIN, I_ODQG, I_ODWUQ, I_ODKVG, I_ODWUKV, I_ODWOUT, I_MR1W, I_MR1B, I_MR2W, I_MR2B, I_MGU, I_MDN, I_FING };
struct Frame {
    LAS unsigned char* lds;
    const __attribute__((address_space(4))) Args* ka;
    float* out;
    int tid, lane, wave, vcu, G;
    unsigned char* ws;
};
__device__ __forceinline__ const float* mod_ptr(const Frame& F, int layer, int mrow, int which) { return (const float*)(F.ws + WS_MOD) + ((size_t)(layer * 17 + mrow) * 6 + which) * DM; }
__device__ __forceinline__ int row_b(int row) { return row / PB; }
__device__ __forceinline__ const float* input_row(const Frame& F, int row) {
    const int b = row / PB, pos = row - b * PB;
    return pos < CTXL ? F.ka->in[I_CTX] + ((size_t)b * CTXL + pos) * DM : F.ka->in[I_X] + ((size_t)b * SEQ + (pos - CTXL)) * DM;
}

template <bool XONLY> struct TileSched {
    int nM, nN, nwg, G, c;
    __device__ __forceinline__ void init(int nN_, int G_, int c_) { nM = XONLY ? NXTILE : NTILE; nN = nN_; nwg = nM * nN; G = G_; c = c_; }
    __device__ __forceinline__ bool next(int i, pg8::Unit& u) const {
        const long L = (long)i * G + c; if (L >= nwg) return false;
        int wgid = (int)L; { const int q = nwg / 8, r = nwg % 8, xcd = wgid % 8, off = wgid / 8; wgid = (xcd < r ? xcd * (q + 1) : r * (q + 1) + (xcd - r) * q) + off; }
        const int nig = 8 * nN, gid = wgid / nig, fm = gid * 8, gsz = (nM - fm) < 8 ? (nM - fm) : 8;
        int pm = fm + ((wgid % nig) % gsz); const int pn = (wgid % nig) / gsz;
        if (XONLY) pm = (pm >> 3) * 9 + 1 + (pm & 7);
        u.pm = pm; u.pn = pn; u.ex = 0; u.arow0 = pm * 256; u.brow0 = pn * 256; return true;
    }
};
struct MoeSched {
    const int* blke; int nwg, G, c, brows;
    __device__ __forceinline__ void init(const int* blke_, int nblk, int G_, int c_) { blke = blke_; nwg = nblk * 4; G = G_; c = c_; brows = 1024; }
    __device__ __forceinline__ bool next(int i, pg8::Unit& u) const {
        const long L = (long)i * G + c; if (L >= nwg) return false;
        int wgid = (int)L; { const int q = nwg / 8, r = nwg % 8, xcd = wgid % 8, off = wgid / 8; wgid = (xcd < r ? xcd * (q + 1) : r * (q + 1) + (xcd - r) * q) + off; }
        const int blk = wgid >> 2, pn = wgid & 3; const int e = __builtin_amdgcn_readfirstlane(blke[blk]);
        u.pm = blk; u.pn = pn; u.ex = e; u.arow0 = blk * 256; u.brow0 = e * brows + pn * 256; return true;
    }
};

struct EpiStoreBf16 {
    static constexpr bool PERM = true;
    bf16_t* O; int ldc;
    __device__ __forceinline__ void operator()(const f32x4 (&acc)[2][2][4][2], const pg8::Unit& u, int wr, int wc, int fr, int fq) const {
        const int row0 = u.arow0 + wr * 64 + fr, col0 = u.pn * 256 + wc * 32 + 8 * fq;
#pragma unroll
        for (int ai = 0; ai < 2; ++ai)
#pragma unroll
            for (int m = 0; m < 4; ++m) { bf16_t* rowp = O + (size_t)(row0 + ai * 128 + m * 16) * ldc + col0;
#pragma unroll
                for (int bj = 0; bj < 2; ++bj) { const f32x4 v0 = acc[ai][bj][m][0], v1 = acc[ai][bj][m][1];
                    u32x4 w; w.x = cvtpk(v0[0], v0[1]); w.y = cvtpk(v0[2], v0[3]); w.z = cvtpk(v1[0], v1[1]); w.w = cvtpk(v1[2], v1[3]);
                    *(u32x4*)(rowp + bj * 128) = w; } }
    }
};
struct EpiStoreStats {
    static constexpr bool PERM = true;
    bf16_t* O; int ldc; float* stats;
    __device__ __forceinline__ void operator()(const f32x4 (&acc)[2][2][4][2], const pg8::Unit& u, int wr, int wc, int fr, int fq) const {
        const int row0 = u.arow0 + wr * 64 + fr, col0 = u.pn * 256 + wc * 32 + 8 * fq;
#pragma unroll
        for (int ai = 0; ai < 2; ++ai)
#pragma unroll
            for (int m = 0; m < 4; ++m) { const int row = row0 + ai * 128 + m * 16; bf16_t* rowp = O + (size_t)row * ldc + col0;
#pragma unroll
                for (int bj = 0; bj < 2; ++bj) { const f32x4 v0 = acc[ai][bj][m][0], v1 = acc[ai][bj][m][1];
                    u32x4 w; w.x = cvtpk(v0[0], v0[1]); w.y = cvtpk(v0[2], v0[3]); w.z = cvtpk(v1[0], v1[1]); w.w = cvtpk(v1[2], v1[3]);
                    *(u32x4*)(rowp + bj * 128) = w;
                    float s = (v0[0] * v0[0] + v0[1] * v0[1]) + (v0[2] * v0[2] + v0[3] * v0[3]) + (v1[0] * v1[0] + v1[1] * v1[1]) + (v1[2] * v1[2] + v1[3] * v1[3]);
                    s += __shfl_xor(s, 16); s += __shfl_xor(s, 32);
                    if (fq == 0) stats[(size_t)row * 24 + u.pn * 8 + bj * 4 + wc] = s; } }
    }
};
struct EpiResidual {
    static constexpr bool PERM = false;
    const Frame* F; float* dst; int layer; bool from_input;
    __device__ __forceinline__ void operator()(const f32x4 (&acc)[2][2][4][2], const pg8::Unit& u, int wr, int wc, int fr, int fq) const {
        const int b = u.pm / 9, isctx = (u.pm % 9) == 0, mrow = isctx ? 16 : b;
        const float* gate = mod_ptr(*F, layer, mrow, 2);
        const int col0 = u.pn * 256 + wc * 32 + 4 * fq;
        f32x4 gv[2][2];
#pragma unroll
        for (int bj = 0; bj < 2; ++bj)
#pragma unroll
            for (int n = 0; n < 2; ++n) gv[bj][n] = *(const f32x4*)(gate + col0 + bj * 128 + n * 16);
#pragma unroll
        for (int ai = 0; ai < 2; ++ai)
#pragma unroll
            for (int m = 0; m < 4; ++m) { const int row = u.arow0 + ai * 128 + wr * 64 + m * 16 + fr;
                const float* bp = from_input ? input_row(*F, row) : dst + (size_t)row * DM; float* dp = dst + (size_t)row * DM;
#pragma unroll
                for (int bj = 0; bj < 2; ++bj)
#pragma unroll
                    for (int n = 0; n < 2; ++n) { const int c = col0 + bj * 128 + n * 16; const f32x4 bs = *(const f32x4*)(bp + c);
                        *(f32x4*)(dp + c) = bs + gv[bj][n] * acc[ai][bj][m][n]; } }
    }
};
struct EpiSwiglu {
    static constexpr bool PERM = true;
    bf16_t* O;
    __device__ __forceinline__ void operator()(const f32x4 (&acc)[2][2][4][2], const pg8::Unit& u, int wr, int wc, int fr, int fq) const {
        const int row0 = u.arow0 + wr * 64 + fr, col0 = u.pn * 128 + wc * 32 + 8 * fq;
#pragma unroll
        for (int ai = 0; ai < 2; ++ai)
#pragma unroll
            for (int m = 0; m < 4; ++m) { bf16_t* rowp = O + (size_t)(row0 + ai * 128 + m * 16) * MFF + col0;
                float h[8];
#pragma unroll
                for (int n = 0; n < 2; ++n)
#pragma unroll
                    for (int j = 0; j < 4; ++j) h[n * 4 + j] = siluf_(acc[ai][0][m][n][j]) * acc[ai][1][m][n][j];
                u32x4 w; w.x = cvtpk(h[0], h[1]); w.y = cvtpk(h[2], h[3]); w.z = cvtpk(h[4], h[5]); w.w = cvtpk(h[6], h[7]);
                *(u32x4*)rowp = w; }
    }
};
struct EpiScatter {
    static constexpr bool PERM = true;
    bf16_t* O; const int* perm;
    __device__ __forceinline__ void operator()(const f32x4 (&acc)[2][2][4][2], const pg8::Unit& u, int wr, int wc, int fr, int fq) const {
        const int row0 = u.arow0 + wr * 64 + fr, col0 = u.pn * 256 + wc * 32 + 8 * fq;
#pragma unroll
        for (int ai = 0; ai < 2; ++ai)
#pragma unroll
            for (int m = 0; m < 4; ++m) { const int a = perm[row0 + ai * 128 + m * 16];
                if (a >= 0) { bf16_t* rowp = O + (size_t)a * DM + col0;
#pragma unroll
                    for (int bj = 0; bj < 2; ++bj) { const f32x4 v0 = acc[ai][bj][m][0], v1 = acc[ai][bj][m][1];
                        u32x4 w; w.x = cvtpk(v0[0], v0[1]); w.y = cvtpk(v0[2], v0[3]); w.z = cvtpk(v1[0], v1[1]); w.w = cvtpk(v1[2], v1[3]);
                        *(u32x4*)(rowp + bj * 128) = w; } } }
    }
};
struct EpiQ {
    static constexpr bool PERM = false;
    bf16_t* O; const float* stats;
    __device__ __forceinline__ void operator()(const f32x4 (&acc)[2][2][4][2], const pg8::Unit& u, int wr, int wc, int fr, int fq) const {
        float invf[4]; int fq2 = fq; asm volatile("" : "+v"(fq2));
#pragma unroll
        for (int j = 0; j < 4; ++j) invf[j] = __expf(-(float)(4 * fq2 + j) * (2.0f / 32.0f) * 9.210340371976184f);
#pragma unroll
        for (int ai = 0; ai < 2; ++ai)
#pragma unroll
            for (int m = 0; m < 4; ++m) { const int row = u.arow0 + ai * 128 + wr * 64 + m * 16 + fr;
                const float* st = stats + (size_t)row * 24; float ss = 0.f;
#pragma unroll
                for (int q = 0; q < 3; ++q) { const f32x4 s4 = *(const f32x4*)(st + 4 * q); ss += (s4[0] + s4[1]) + (s4[2] + s4[3]); }
                const float sc = __builtin_amdgcn_rsqf(ss * (1.0f / QRANK) + RMS_EPS) * ATT_C2;
                const int t = (row % PB) - CTXL; const float gr = (float)(t >> 6), gc = (float)(t & 63);
#pragma unroll
                for (int bj = 0; bj < 2; ++bj) { const int cg = u.pn * 256 + bj * 128 + wc * 32; const int within = cg % 192;
                    f32x4 v0 = acc[ai][bj][m][0] * sc, v1 = acc[ai][bj][m][1] * sc;
                    if (within >= 128) { const float p = (within == 128) ? gr : gc;
#pragma unroll
                        for (int j = 0; j < 4; ++j) { const float ang = p * invf[j]; const float cs = __cosf(ang), sn = __sinf(ang);
                            const float x1 = v0[j], x2 = v1[j]; v0[j] = x1 * cs - x2 * sn; v1[j] = x1 * sn + x2 * cs; } }
                    bf16_t* rowp = O + (size_t)row * NQ + cg + 4 * fq;
                    u32x2 w0; w0.x = cvtpk(v0[0], v0[1]); w0.y = cvtpk(v0[2], v0[3]); *(u32x2*)rowp = w0;
                    u32x2 w1; w1.x = cvtpk(v1[0], v1[1]); w1.y = cvtpk(v1[2], v1[3]); *(u32x2*)(rowp + 16) = w1; } }
    }
};
struct EpiKV {
    static constexpr bool PERM = true;
    bf16_t* KBp; bf16_t* VBp; const float* stats;
    __device__ __forceinline__ void operator()(const f32x4 (&acc)[2][2][4][2], const pg8::Unit& u, int wr, int wc, int fr, int fq) const {
        const int h = u.pn, c0 = wc * 32 + 8 * fq;
#pragma unroll
        for (int ai = 0; ai < 2; ++ai)
#pragma unroll
            for (int m = 0; m < 4; ++m) { const int row = u.arow0 + ai * 128 + wr * 64 + m * 16 + fr;
                const float* st = stats + (size_t)row * 24 + 12; const f32x4 s0 = *(const f32x4*)st, s1 = *(const f32x4*)(st + 4);
                const float ss = ((s0[0] + s0[1]) + (s0[2] + s0[3])) + ((s1[0] + s1[1]) + (s1[2] + s1[3]));
                const float sc = __builtin_amdgcn_rsqf(ss * (1.0f / KVRANK) + RMS_EPS);
#pragma unroll
                for (int bj = 0; bj < 2; ++bj) { const f32x4 v0 = acc[ai][bj][m][0] * sc, v1 = acc[ai][bj][m][1] * sc;
                    u32x4 w; w.x = cvtpk(v0[0], v0[1]); w.y = cvtpk(v0[2], v0[3]); w.z = cvtpk(v1[0], v1[1]); w.w = cvtpk(v1[2], v1[3]);
                    bf16_t* p = bj == 0 ? KBp + (size_t)row * NQ + h * 192 + c0 : VBp + (size_t)row * DM + h * 128 + c0;
                    *(u32x4*)p = w; } }
    }
};

__device__ __forceinline__ void tr_item(const float* W, int K, int N, bf16_t* WT, bool gu, const float* kscale, LAS float* scr, int item, int lane) {
    const int nblk = N / 32, kb = item / nblk, nb = item % nblk, k0 = 64 * kb, n0 = 32 * nb;
#pragma unroll 8
    for (int i = 0; i < 32; ++i) { const int kk = 2 * i + (lane >> 5); float w = W[(size_t)(k0 + kk) * N + n0 + (lane & 31)]; if (kscale) w *= kscale[k0 + kk]; scr[kk * 33 + (lane & 31)] = w; }
    LDS_WAIT(); asm volatile("" ::: "memory");
    int d0 = n0;
    if (gu) { const int i0 = n0 & 511; d0 = 256 * (i0 >> 7) + (n0 >= 512 ? 128 : 0) + (i0 & 127); }
    const int c = lane & 7;
#pragma unroll
    for (int j = 0; j < 4; ++j) { const int n = (lane >> 3) + 8 * j; const LAS float* s = scr + (8 * c) * 33 + n;
        u32x4 o; o.x = pk2(s[0 * 33], s[1 * 33]); o.y = pk2(s[2 * 33], s[3 * 33]); o.z = pk2(s[4 * 33], s[5 * 33]); o.w = pk2(s[6 * 33], s[7 * 33]);
        *(u32x4*)(WT + (size_t)(d0 + n) * K + k0 + 8 * c) = o; }
    LDS_WAIT(); asm volatile("" ::: "memory");
}
__device__ __forceinline__ void p0_prologue(Frame& F) {
    __syncthreads();

    LAS float* S = (LAS float*)F.lds;
    for (int idx = F.tid; idx < 17 * DM; idx += 512) { const int r = idx >> 10, k = idx & 1023; const float cv = r < 16 ? F.ka->in[I_C][r * DM + k] : F.ka->in[I_CCTX][k]; S[k * 20 + r] = siluf_(cv); }
    __syncthreads();
    const int gw = F.vcu * 8 + F.wave, NGW = F.G * 8;
    float* part = (float*)(F.ws + WS_PART);
    for (int it = gw; it < 2 * 8 * 96; it += NGW) {
        const int l = it / 768, rem = it % 768, kc = rem / 96, slab = rem % 96, n0 = slab * 64;
        const float* w = F.ka->in[I_ADAW] + ((size_t)l * DM + kc * 128) * 6144 + n0 + F.lane;
        float acc[17];
#pragma unroll
        for (int r = 0; r < 17; ++r) acc[r] = 0.f;
#pragma unroll 4
        for (int kk = 0; kk < 128; ++kk) {
            const float wv = w[(size_t)kk * 6144];
            const LAS float* s = S + (kc * 128 + kk) * 20;
            const f32x4 s0 = *(const LAS f32x4*)s, s1 = *(const LAS f32x4*)(s + 4), s2 = *(const LAS f32x4*)(s + 8), s3 = *(const LAS f32x4*)(s + 12); const float s4 = s[16];
            acc[0] += s0[0] * wv; acc[1] += s0[1] * wv; acc[2] += s0[2] * wv; acc[3] += s0[3] * wv;
            acc[4] += s1[0] * wv; acc[5] += s1[1] * wv; acc[6] += s1[2] * wv; acc[7] += s1[3] * wv;
            acc[8] += s2[0] * wv; acc[9] += s2[1] * wv; acc[10] += s2[2] * wv; acc[11] += s2[3] * wv;
            acc[12] += s3[0] * wv; acc[13] += s3[1] * wv; acc[14] += s3[2] * wv; acc[15] += s3[3] * wv; acc[16] += s4 * wv;
        }
#pragma unroll
        for (int r = 0; r < 17; ++r) part[((size_t)(l * 8 + kc) * 17 + r) * 6144 + n0 + F.lane] = acc[r];
    }
    __syncthreads();
    LAS float* scr = (LAS float*)(F.lds + F.wave * 8448);
    constexpr int I_A = 16 * 112, I_B = 16 * 32, I_C2 = 16 * 22, I_D = 6 * 48, I_E = 4 * 64, I_F = 16 * 32, I_GU = 16 * 32, I_DN = 8 * 32;
    constexpr int NITEMS = I_A + I_B + I_C2 + I_D + I_E + I_F + 64 * I_GU + 64 * I_DN;
    for (int it = gw; it < NITEMS; it += NGW) {
        int r = it;
        if (r < I_A) { tr_item(F.ka->in[I_EVWIN], DM, EVIN, (bf16_t*)(F.ws + WS_WIN0), false, nullptr, scr, r, F.lane); continue; } r -= I_A;
        if (r < I_B) { tr_item(F.ka->in[I_EVWOUT], DM, DM, (bf16_t*)(F.ws + WS_WOUT0), false, nullptr, scr, r, F.lane); continue; } r -= I_B;
        if (r < I_C2) { tr_item(F.ka->in[I_ODWIN], DM, CIN, (bf16_t*)(F.ws + WS_WIN1), false, nullptr, scr, r, F.lane); continue; } r -= I_C2;
        if (r < I_D) { tr_item(F.ka->in[I_ODWUQ], QRANK, NQ, (bf16_t*)(F.ws + WS_WUQ), false, F.ka->in[I_ODQG], scr, r, F.lane); continue; } r -= I_D;
        if (r < I_E) { tr_item(F.ka->in[I_ODWUKV], KVRANK, NKV, (bf16_t*)(F.ws + WS_WUKV), false, F.ka->in[I_ODKVG], scr, r, F.lane); continue; } r -= I_E;
        if (r < I_F) { tr_item(F.ka->in[I_ODWOUT], DM, DM, (bf16_t*)(F.ws + WS_WOUT1), false, nullptr, scr, r, F.lane); continue; } r -= I_F;
        if (r < 64 * I_GU) { const int e = r / I_GU; tr_item(F.ka->in[I_MGU] + (size_t)e * DM * 1024, DM, 1024, (bf16_t*)(F.ws + WS_WGU) + (size_t)e * 1024 * DM, true, nullptr, scr, r % I_GU, F.lane); continue; } r -= 64 * I_GU;
        { const int e = r / I_DN; tr_item(F.ka->in[I_MDN] + (size_t)e * MFF * DM, MFF, DM, (bf16_t*)(F.ws + WS_WDN) + (size_t)e * DM * MFF, false, nullptr, scr, r % I_DN, F.lane); }
    }
}
__device__ __forceinline__ void p0b_mod(Frame& F) {
    const float* part = (const float*)(F.ws + WS_PART); float* mod = (float*)(F.ws + WS_MOD);
    const int gt = F.vcu * 512 + F.tid, NGT = F.G * 512;
    for (int idx = gt; idx < 2 * 17 * 6144; idx += NGT) {
        const int l = idx / (17 * 6144), rem = idx % (17 * 6144), r = rem / 6144, n = rem % 6144;
        float s = F.ka->in[I_ADAB][l * 6144 + n];
#pragma unroll
        for (int kc = 0; kc < 8; ++kc) s += part[((size_t)(l * 8 + kc) * 17 + r) * 6144 + n];
        mod[idx] = s;
    }
}

__device__ __forceinline__ void load_row4(const float* p, int lane, f32x4 (&v)[4]) {
#pragma unroll
    for (int j = 0; j < 4; ++j) v[j] = *(const f32x4*)(p + 4 * lane + 256 * j);
}
__device__ __forceinline__ float sumsq4(const f32x4 (&v)[4]) {
    float s = 0.f;
#pragma unroll
    for (int j = 0; j < 4; ++j) s += (v[j][0] * v[j][0] + v[j][1] * v[j][1]) + (v[j][2] * v[j][2] + v[j][3] * v[j][3]);
    return wave_sum(s);
}
__device__ __forceinline__ void norm_mod4(f32x4 (&v)[4], const float* g, const float* shift, const float* scale, int lane) {
    const float rstd = __builtin_amdgcn_rsqf(sumsq4(v) * (1.0f / DM) + RMS_EPS);
#pragma unroll
    for (int j = 0; j < 4; ++j) { const int c = 4 * lane + 256 * j; const f32x4 gg = *(const f32x4*)(g + c), sh = *(const f32x4*)(shift + c), sc = *(const f32x4*)(scale + c);
        v[j] = v[j] * rstd * gg * (sc + 1.0f) + sh; }
}
__device__ __forceinline__ void store_row_bf16(bf16_t* p, int lane, const f32x4 (&v)[4]) {
#pragma unroll
    for (int j = 0; j < 4; ++j) { u32x2 w; w.x = cvtpk(v[j][0], v[j][1]); w.y = cvtpk(v[j][2], v[j][3]); *(u32x2*)(p + 4 * lane + 256 * j) = w; }
}
__device__ __forceinline__ void moe_combine4(Frame& F, int row, int layer, int mrow, f32x4 (&v)[4]) {
    const bf16_t* ys = (const bf16_t*)(F.ws + WS_YS) + (size_t)(2 * row) * DM; const float* aw = (const float*)(F.ws + WS_ROUTE + RT_AW);
    const float w0 = aw[2 * row], w1 = aw[2 * row + 1]; const float* gate = mod_ptr(F, layer, mrow, 5);
#pragma unroll
    for (int j = 0; j < 4; ++j) { const int c = 4 * F.lane + 256 * j; const u32x2 y0 = *(const u32x2*)(ys + c), y1 = *(const u32x2*)(ys + DM + c); const f32x4 gg = *(const f32x4*)(gate + c);
        f32x4 y; y[0] = w0 * bflo(y0.x) + w1 * bflo(y1.x); y[1] = w0 * bfhi(y0.x) + w1 * bfhi(y1.x); y[2] = w0 * bflo(y0.y) + w1 * bflo(y1.y); y[3] = w0 * bfhi(y0.y) + w1 * bfhi(y1.y);
        v[j] = v[j] + gg * y; }
}
__device__ __forceinline__ void p1_norm_input(Frame& F) {
    const int gw = F.vcu * 8 + F.wave, NGW = F.G * 8; bf16_t* hx = (bf16_t*)(F.ws + WS_HX);
    for (int row = gw; row < R; row += NGW) {
        const int b = row / PB, pos = row - b * PB, mrow = pos < CTXL ? 16 : b;
        f32x4 v[4]; load_row4(input_row(F, row), F.lane, v);
        norm_mod4(v, F.ka->in[I_NMIXG], mod_ptr(F, 0, mrow, 0), mod_ptr(F, 0, mrow, 1), F.lane);
        store_row_bf16(hx + (size_t)row * DM, F.lane, v);
    }
}
__device__ __forceinline__ void p8_combine_norm(Frame& F) {
    const int gw = F.vcu * 8 + F.wave, NGW = F.G * 8; bf16_t* hx = (bf16_t*)(F.ws + WS_HX); float* xs = (float*)(F.ws + WS_XS);
    for (int row = gw; row < R; row += NGW) {
        const int b = row / PB, pos = row - b * PB, mrow = pos < CTXL ? 16 : b;
        f32x4 v[4]; load_row4(xs + (size_t)row * DM, F.lane, v);
        moe_combine4(F, row, 0, mrow, v);
#pragma unroll
        for (int j = 0; j < 4; ++j) *(f32x4*)(xs + (size_t)row * DM + 4 * F.lane + 256 * j) = v[j];
        norm_mod4(v, F.ka->in[I_NMIXG] + DM, mod_ptr(F, 1, mrow, 0), mod_ptr(F, 1, mrow, 1), F.lane);
        store_row_bf16(hx + (size_t)row * DM, F.lane, v);
    }
}
__device__ __forceinline__ void p16_final(Frame& F) {
    const int gw = F.vcu * 8 + F.wave, NGW = F.G * 8; const float* xs = (const float*)(F.ws + WS_XS);
    for (int row = gw; row < R; row += NGW) {
        const int b = row / PB, pos = row - b * PB; if (pos < CTXL) continue;
        f32x4 v[4];
        if (DBG_MODE >= 10) {
            const bf16_t* hx = (const bf16_t*)(F.ws + WS_HX) + (size_t)row * DM; const bf16_t* px = (const bf16_t*)(F.ws + WS_PX0) + (size_t)row * EVIN; const bf16_t* mx = (const bf16_t*)(F.ws + WS_MIX) + (size_t)row * DM;
#pragma unroll
            for (int j = 0; j < 4; ++j)
#pragma unroll
                for (int e = 0; e < 4; ++e) { const int c = 4 * F.lane + 256 * j + e;
                    v[j][e] = DBG_MODE == 10 ? bf2f(hx[c]) : DBG_MODE == 11 ? bf2f(px[c]) + bf2f(px[1024 + c]) + bf2f(px[2048 + c]) + bf2f(px[3072 + (c & 511)]) : bf2f(mx[c]); }
        } else load_row4(DBG_MODE == 1 ? input_row(F, row) : xs + (size_t)row * DM, F.lane, v);
        if (DBG_MODE == 0) moe_combine4(F, row, 1, b, v);
        const float rstd = __builtin_amdgcn_rsqf(sumsq4(v) * (1.0f / DM) + RMS_EPS);
        float* o = F.out + ((size_t)b * SEQ + (pos - CTXL)) * DM;
#pragma unroll
        for (int j = 0; j < 4; ++j) { const int c = 4 * F.lane + 256 * j; const f32x4 gg = *(const f32x4*)(F.ka->in[I_FING] + c); *(f32x4*)(o + c) = v[j] * rstd * gg; }
    }
}

template <bool XONLY>
__device__ __forceinline__ void p5_norm_route(Frame& F, int layer) {

    LAS float* W1L = (LAS float*)F.lds; LAS float* W2L = W1L + 4096;
    volatile LAS int* lcnt = (volatile LAS int*)(F.lds + LDSCTL_OFF + 64);
    const float* wr1 = F.ka->in[I_MR1W] + (size_t)layer * DM * 4; const float* wr2 = F.ka->in[I_MR2W] + (size_t)layer * 4 * DM * 8;
    for (int k = F.tid; k < DM; k += 512) { const int l = (k & 255) >> 2, j = k >> 8, e = k & 3; *(LAS f32x4*)(W1L + ((j * 4 + e) * 64 + l) * 4) = *(const f32x4*)(wr1 + k * 4); }
    for (int idx = F.tid; idx < 4 * DM * 2; idx += 512) { const int half = idx & 1, k = (idx >> 1) & 1023, g = idx >> 11; const int l = (k & 255) >> 2, j = k >> 8, e = k & 3;
        *(LAS f32x4*)(W2L + ((((g * 16 + j * 4 + e) * 2 + half) * 64) + l) * 4) = *(const f32x4*)(wr2 + ((size_t)g * DM + k) * 8 + half * 4); }
    if (F.tid < 32) lcnt[F.tid] = 0;
    __syncthreads();
    const int gw = F.vcu * 8 + F.wave, NGW = F.G * 8; bf16_t* hx = (bf16_t*)(F.ws + WS_HX); const float* xs = (const float*)(F.ws + WS_XS);
    int* ae = (int*)(F.ws + WS_ROUTE + RT_AE); int* ap = (int*)(F.ws + WS_ROUTE + RT_AP); float* aw = (float*)(F.ws + WS_ROUTE + RT_AW);
    const float* b1 = F.ka->in[I_MR1B] + layer * 4; const float* b2 = F.ka->in[I_MR2B] + layer * 32;
    for (int row = gw; row < R; row += NGW) {
        const int b = row / PB, pos = row - b * PB; if (XONLY && pos < CTXL) continue;
        const int mrow = pos < CTXL ? 16 : b;
        f32x4 v[4]; load_row4(xs + (size_t)row * DM, F.lane, v);
        norm_mod4(v, F.ka->in[I_NFFNG] + layer * DM, mod_ptr(F, layer, mrow, 3), mod_ptr(F, layer, mrow, 4), F.lane);
        store_row_bf16(hx + (size_t)row * DM, F.lane, v);
        f32x4 l1 = {0.f, 0.f, 0.f, 0.f};
#pragma unroll
        for (int j = 0; j < 4; ++j)
#pragma unroll
            for (int e = 0; e < 4; ++e) l1 += *(const LAS f32x4*)(W1L + ((j * 4 + e) * 64 + F.lane) * 4) * v[j][e];
        float g0 = wave_sum(l1[0]) + b1[0], g1 = wave_sum(l1[1]) + b1[1], g2 = wave_sum(l1[2]) + b1[2], g3 = wave_sum(l1[3]) + b1[3];
        int grp = 0; float gm = g0;
        if (g1 > gm) { gm = g1; grp = 1; } if (g2 > gm) { gm = g2; grp = 2; } if (g3 > gm) { gm = g3; grp = 3; }
        grp = __builtin_amdgcn_readfirstlane(grp);
        const float pg = 1.0f / (__expf(g0 - gm) + __expf(g1 - gm) + __expf(g2 - gm) + __expf(g3 - gm));
        f32x4 la = {0.f, 0.f, 0.f, 0.f}, lb = {0.f, 0.f, 0.f, 0.f};
        const LAS float* w2 = W2L + grp * 16 * 2 * 64 * 4;
#pragma unroll
        for (int j = 0; j < 4; ++j)
#pragma unroll
            for (int e = 0; e < 4; ++e) { const LAS float* p = w2 + (((j * 4 + e) * 2) * 64 + F.lane) * 4; la += *(const LAS f32x4*)p * v[j][e]; lb += *(const LAS f32x4*)(p + 256) * v[j][e]; }
        float lg[8];
#pragma unroll
        for (int q = 0; q < 4; ++q) { lg[q] = wave_sum(la[q]) + b2[grp * 8 + q]; lg[4 + q] = wave_sum(lb[q]) + b2[grp * 8 + 4 + q]; }
        int e0 = 0; float m0 = lg[0];
#pragma unroll
        for (int q = 1; q < 8; ++q) if (lg[q] > m0) { m0 = lg[q]; e0 = q; }
        int e1 = -1; float m1 = -3.0e38f;
#pragma unroll
        for (int q = 0; q < 8; ++q) if (q != e0 && lg[q] > m1) { m1 = lg[q]; e1 = q; }
        const float pb = __expf(m1 - m0), inv = pg / (1.0f + pb);
        if (F.lane < 2) {
            const int ex = grp * 8 + (F.lane == 0 ? e0 : e1);
            const int lp = __hip_atomic_fetch_add((LAS int*)lcnt + ex, 1, __ATOMIC_RELAXED, __HIP_MEMORY_SCOPE_WORKGROUP);
            const int a = 2 * row + F.lane; ae[a] = ex; ap[a] = lp; aw[a] = F.lane == 0 ? inv : inv * pb;
        }
    }
    __syncthreads();
    if (F.tid < 32) ((int*)(F.ws + WS_ROUTE + RT_CNTB))[F.vcu * 32 + F.tid] = lcnt[F.tid];
}
template <bool XONLY>
__device__ __forceinline__ void p5b_perm(Frame& F) {
    LAS int* seg = (LAS int*)F.lds;
    LAS int* mypre = seg + 512;
    LAS int* tot = mypre + 32;
    LAS int* base = tot + 32;
    LAS int* pst = base + 32;
    const int* cntb = (const int*)(F.ws + WS_ROUTE + RT_CNTB);
    { const int e = F.tid & 31, sg = F.tid >> 5; int s = 0, pre = 0;
      for (int i = 0; i < 16; ++i) { const int B = sg * 16 + i; const int c = cntb[B * 32 + e]; if (B < F.vcu) pre += c; s += c; }
      seg[sg * 32 + e] = s; if (sg == (F.vcu >> 4)) mypre[e] = pre; }
    __syncthreads();
    if (F.tid < 32) { int t = 0, bs = 0; for (int sg = 0; sg < 16; ++sg) { const int s = seg[sg * 32 + F.tid]; if (sg < (F.vcu >> 4)) bs += s; t += s; } tot[F.tid] = t; base[F.tid] = bs + mypre[F.tid]; }
    __syncthreads();
    if (F.tid == 0) { int ps = 0; for (int e = 0; e < 32; ++e) { pst[e] = ps; ps += ((tot[e] + 255) >> 8) << 8; } pst[32] = ps; }
    __syncthreads();
    const int gw = F.vcu * 8 + F.wave, NGW = F.G * 8;
    const int* ae = (const int*)(F.ws + WS_ROUTE + RT_AE); const int* ap = (const int*)(F.ws + WS_ROUTE + RT_AP); int* perm = (int*)(F.ws + WS_ROUTE + RT_PERM);
    for (int row = gw; row < R; row += NGW) {
        const int b = row / PB, pos = row - b * PB; if (XONLY && pos < CTXL) continue;
        if (F.lane < 2) { const int a = 2 * row + F.lane; const int e = ae[a]; perm[pst[e] + base[e] + ap[a]] = a; }
    }
    if (F.vcu < 32) { const int e = F.vcu; for (int s = pst[e] + tot[e] + F.tid; s < pst[e + 1]; s += 512) perm[s] = -1; }
    if (F.vcu == 0) { int* blke = (int*)(F.ws + WS_ROUTE + RT_BLKE);
        if (F.tid < 32) { const int e = F.tid; for (int blk = pst[e] >> 8; blk < (pst[e + 1] >> 8); ++blk) blke[blk] = e; }
        if (F.tid == 0) *(int*)(F.ws + WS_ROUTE + RT_NBLK) = pst[32] >> 8; }
}

__device__ __forceinline__ bf16x8 lds_frag256(const LAS unsigned char* base, int row, int chunk) { return *(const LAS bf16x8*)(base + row * 256 + ((chunk ^ (row & 7)) << 4)); }
__device__ __forceinline__ bf16x8 lds_frag128(const LAS unsigned char* base, int row, int chunk) { return *(const LAS bf16x8*)(base + row * 128 + ((chunk ^ (row & 7)) << 4)); }
#define MFMA16(a, b, c) __builtin_amdgcn_mfma_f32_16x16x32_bf16((a), (b), (c), 0, 0, 0)

typedef short v4i16_t __attribute__((ext_vector_type(4)));
__device__ __forceinline__ int trswz256(int r, int cb) { return r * 256 + (cb ^ (((r & 3) | ((r >> 1) & 4)) << 5)); }
__device__ __forceinline__ int trswz128(int r, int cb) { return r * 128 + (cb ^ ((((r >> 1) & 1) | ((r >> 2) & 2)) << 5)); }
template <int ROWB> __device__ __forceinline__ bf16x8 lds_trfrag(const LAS unsigned char* tile, int s0, int c0, int lane) {
    const int i = lane & 15, r0 = s0 + (i >> 2), r1 = r0 + 4, cb = (c0 + 4 * (i & 3)) * 2;
    const int a0 = ROWB == 256 ? trswz256(r0, cb) : trswz128(r0, cb), a1 = ROWB == 256 ? trswz256(r1, cb) : trswz128(r1, cb);
    const v4i16_t lo = __builtin_amdgcn_ds_read_tr16_b64_v4i16((LAS v4i16_t*)(tile + a0)), hi = __builtin_amdgcn_ds_read_tr16_b64_v4i16((LAS v4i16_t*)(tile + a1));
    return (bf16x8){lo[0], lo[1], lo[2], lo[3], hi[0], hi[1], hi[2], hi[3]};
}
__device__ __forceinline__ void gla_item(Frame& F, int item) {
    const int b = item >> 4, h = (item >> 2) & 3, dir = (item >> 1) & 1, vh = item & 1;
    LAS unsigned char* QD = F.lds; LAS unsigned char* KD = F.lds + 16384; LAS unsigned char* KT = F.lds + 32768  ; LAS unsigned char* VR = F.lds + 49152  ;
    LAS unsigned char* PS = F.lds + 57344; LAS unsigned char* ST = F.lds + 65536; LAS float* LF = (LAS float*)(F.lds + 81920); LAS float* SEGT = (LAS float*)(F.lds + 114688); LAS float* DEC = (LAS float*)(F.lds + 116736);
    const int tid = F.tid, lane = F.lane, wave = F.wave, fr = lane & 15, fq = lane >> 4;
    const int t0 = tid >> 4, c = tid & 15, tv = tid >> 3, cv = tid & 7;
    const bf16_t* px = (const bf16_t*)(F.ws + WS_PX0);
    bf16_t* og = (bf16_t*)(F.ws + WS_OG) + (size_t)dir * R * 512;
    float lbv[8], oml[8];
    { const float* lg = F.ka->in[I_EVLB] + h * 128 + 8 * c;
#pragma unroll
      for (int e = 0; e < 8; ++e) { lbv[e] = 1.0f / (1.0f + __expf(lg[512 + e] - lg[e])); oml[e] = 1.0f - lbv[e]; } }
    { u32x4 z = {0u, 0u, 0u, 0u}; *(LAS u32x4*)(ST + tid * 32) = z; *(LAS u32x4*)(ST + tid * 32 + 16) = z; }
    f32x4 S[4];
#pragma unroll
    for (int i = 0; i < 4; ++i) S[i] = (f32x4){0.f, 0.f, 0.f, 0.f};
    auto chunk_p0 = [&](int j) { return dir == 0 ? 64 * j : (j < 4 ? 192 - 64 * j : PB - 64 * (j - 3)); };
    auto row_of = [&](int p0, int tau) { return b * PB + (dir == 0 ? p0 + tau : p0 + 63 - tau); };
    u32x4 rqA[2], rfA[2], rvA, rqB[2], rfB[2], rvB;
#define GLA_LOAD(j, RQ, RF, RV) do { const int p0_ = chunk_p0(j); \
        _Pragma("unroll") for (int i_ = 0; i_ < 2; ++i_) { const bf16_t* rp_ = px + (size_t)row_of(p0_, t0 + 32 * i_) * EVIN + h * 128 + 8 * c; RQ[i_] = *(const u32x4*)rp_; RF[i_] = *(const u32x4*)(rp_ + 512 * (1 + dir)); } \
        RV = *(const u32x4*)(px + (size_t)row_of(p0_, tv) * EVIN + 1536 + h * 128 + vh * 64 + 8 * cv); } while (0)
    GLA_LOAD(0, rqA, rfA, rvA); GLA_LOAD(1, rqB, rfB, rvB);
    __syncthreads();
    const int ti = wave & 3, sp = wave >> 2, ki = wave;
#define GLA_STEP(j, RQ, RF, RV) do { \
        const int p0 = chunk_p0(j); float qv[2][8], kv[2][8]; const u32x4 vraw = RV; \
        _Pragma("unroll") for (int i = 0; i < 2; ++i) { const int tau = t0 + 32 * i; float lf[8]; \
            _Pragma("unroll") for (int e = 0; e < 4; ++e) { const unsigned wq = RQ[i][e], wf = RF[i][e]; \
                qv[i][2 * e] = bflo(wq); qv[i][2 * e + 1] = bfhi(wq); \
                const float s0_ = sigmoidf_(bflo(wf)), s1_ = sigmoidf_(bfhi(wf)); \
                const float f0 = lbv[2 * e] + oml[2 * e] * s0_, f1 = lbv[2 * e + 1] + oml[2 * e + 1] * s1_; \
                kv[i][2 * e] = 1.0f - f0; kv[i][2 * e + 1] = 1.0f - f1; lf[2 * e] = lg2(f0); lf[2 * e + 1] = lg2(f1); } \
            *(LAS f32x4*)(LF + tau * 128 + 8 * c) = (f32x4){lf[0], lf[1], lf[2], lf[3]}; *(LAS f32x4*)(LF + tau * 128 + 8 * c + 4) = (f32x4){lf[4], lf[5], lf[6], lf[7]}; } \
        if ((j) + 2 < 36) GLA_LOAD((j) + 2, RQ, RF, RV); \
        __syncthreads(); \
        { const int k = tid & 127, sg = tid >> 7; float run = 0.f; \
          _Pragma("unroll") for (int i = 0; i < 16; ++i) { const int idx = (16 * sg + i) * 128 + k; run += LF[idx]; LF[idx] = run; } \
          SEGT[sg * 128 + k] = run; } \
        __syncthreads(); \
        { float seg[4][8]; float ebl[8]; \
          _Pragma("unroll") for (int s = 0; s < 4; ++s) { const f32x4 a0 = *(const LAS f32x4*)(SEGT + s * 128 + 8 * c), a1 = *(const LAS f32x4*)(SEGT + s * 128 + 8 * c + 4); \
              _Pragma("unroll") for (int e = 0; e < 4; ++e) { seg[s][e] = a0[e]; seg[s][4 + e] = a1[e]; } } \
          float offr[2][8]; const bool odd = (t0 >> 4) != 0; \
          _Pragma("unroll") for (int e = 0; e < 8; ++e) { ebl[e] = ex2((seg[0][e] + seg[1][e]) + (seg[2][e] + seg[3][e])); offr[0][e] = odd ? seg[0][e] : 0.f; offr[1][e] = (seg[0][e] + seg[1][e]) + (odd ? seg[2][e] : 0.f); } \
          _Pragma("unroll") for (int i = 0; i < 2; ++i) { const int tau = t0 + 32 * i; \
              const f32x4 c0 = *(const LAS f32x4*)(LF + tau * 128 + 8 * c), c1 = *(const LAS f32x4*)(LF + tau * 128 + 8 * c + 4); \
              float qd[8], kd[8], kt[8]; \
              _Pragma("unroll") for (int e = 0; e < 8; ++e) { \
                  const float bb = (e < 4 ? c0[e] : c1[e - 4]) + offr[i][e]; const float eb = ex2(bb); \
                  qd[e] = qv[i][e] * eb; kd[e] = kv[i][e] * __builtin_amdgcn_rcpf(eb); kt[e] = kd[e] * ebl[e]; } \
              u32x4 w; w.x = cvtpk(qd[0], qd[1]); w.y = cvtpk(qd[2], qd[3]); w.z = cvtpk(qd[4], qd[5]); w.w = cvtpk(qd[6], qd[7]); \
              *(LAS u32x4*)(QD + tau * 256 + ((c ^ (tau & 7)) << 4)) = w; \
              w.x = cvtpk(kd[0], kd[1]); w.y = cvtpk(kd[2], kd[3]); w.z = cvtpk(kd[4], kd[5]); w.w = cvtpk(kd[6], kd[7]); \
              *(LAS u32x4*)(KD + tau * 256 + ((c ^ (tau & 7)) << 4)) = w; \
              w.x = cvtpk(kt[0], kt[1]); w.y = cvtpk(kt[2], kt[3]); w.z = cvtpk(kt[4], kt[5]); w.w = cvtpk(kt[6], kt[7]); \
              *(LAS u32x4*)(KT + trswz256(tau, 16 * c)) = w; } \
          *(LAS u32x4*)(VR + trswz128(tv, 16 * cv)) = vraw; \
          if (tid < 128) DEC[tid] = ex2((SEGT[tid] + SEGT[128 + tid]) + (SEGT[256 + tid] + SEGT[384 + tid])); } \
        __syncthreads(); \
        bf16x8 bq[4]; \
        _Pragma("unroll") for (int ks = 0; ks < 4; ++ks) bq[ks] = lds_frag256(QD, 16 * ti + fr, ks * 4 + fq); \
        f32x4 oacc[2]; \
        _Pragma("unroll") for (int u = 0; u < 2; ++u) { const int si = 2 * sp + u; f32x4 a = {0.f, 0.f, 0.f, 0.f}; \
            _Pragma("unroll") for (int ks = 0; ks < 4; ++ks) a = MFMA16(lds_frag256(KD, 16 * si + fr, ks * 4 + fq), bq[ks], a); \
            const int tt = 16 * ti + fr, s0 = 16 * si + 4 * fq; \
            u32x2 w; w.x = cvtpk(s0 <= tt ? a[0] : 0.f, s0 + 1 <= tt ? a[1] : 0.f); w.y = cvtpk(s0 + 2 <= tt ? a[2] : 0.f, s0 + 3 <= tt ? a[3] : 0.f); \
            *(LAS u32x2*)(PS + tt * 128 + ((2 * s0) ^ ((tt & 7) << 4))) = w; \
            const int vi = 2 * sp + u; f32x4 o = {0.f, 0.f, 0.f, 0.f}; \
            _Pragma("unroll") for (int ks = 0; ks < 4; ++ks) o = MFMA16(lds_frag256(ST, 16 * vi + fr, ks * 4 + fq), bq[ks], o); \
            oacc[u] = o; } \
        bf16x8 vfr[4][2]; \
        _Pragma("unroll") for (int vi = 0; vi < 4; ++vi) _Pragma("unroll") for (int ks = 0; ks < 2; ++ks) vfr[vi][ks] = lds_trfrag<128>(VR, 32 * ks + 8 * fq, 16 * vi, lane); \
        { const f32x4 dk = *(const LAS f32x4*)(DEC + 16 * ki + 4 * fq); \
          bf16x8 ak[2]; \
          _Pragma("unroll") for (int ks = 0; ks < 2; ++ks) ak[ks] = lds_trfrag<256>(KT, 32 * ks + 8 * fq, 16 * ki, lane); \
          _Pragma("unroll") for (int vi = 0; vi < 4; ++vi) { f32x4 s = S[vi] * dk; \
              _Pragma("unroll") for (int ks = 0; ks < 2; ++ks) s = MFMA16(ak[ks], vfr[vi][ks], s); \
              S[vi] = s; } } \
        __syncthreads(); \
        { bf16x8 bp[2]; \
          _Pragma("unroll") for (int ks = 0; ks < 2; ++ks) bp[ks] = lds_frag128(PS, 16 * ti + fr, ks * 4 + fq); \
          const int orow = row_of(p0, 16 * ti + fr); \
          _Pragma("unroll") for (int u = 0; u < 2; ++u) { const int vi = 2 * sp + u; f32x4 o = oacc[u]; \
              _Pragma("unroll") for (int ks = 0; ks < 2; ++ks) o = MFMA16(sp == 0 ? vfr[u][ks] : vfr[2 + u][ks], bp[ks], o); \
              u32x2 w; w.x = cvtpk(o[0], o[1]); w.y = cvtpk(o[2], o[3]); \
              *(u32x2*)(og + (size_t)orow * 512 + h * 128 + vh * 64 + 16 * vi + 4 * fq) = w; } \
          _Pragma("unroll") for (int vi = 0; vi < 4; ++vi) { const int v = 16 * vi + fr, k0 = 16 * ki + 4 * fq; u32x2 w; w.x = cvtpk(S[vi][0], S[vi][1]); w.y = cvtpk(S[vi][2], S[vi][3]); \
              *(LAS u32x2*)(ST + v * 256 + ((2 * k0) ^ ((v & 7) << 4))) = w; } } \
    } while (0)
    for (int j = 0; j < 36; j += 2) { GLA_STEP(j, rqA, rfA, rvA); GLA_STEP(j + 1, rqB, rfB, rvB); }
    __syncthreads();
#undef GLA_LOAD
#undef GLA_STEP
}

__device__ __forceinline__ void sgu_item(Frame& F, int ci) {
    LAS unsigned char* VNT = F.lds; LAS unsigned char* WS = F.lds + 32768;
    const int tid = F.tid, lane = F.lane, wave = F.wave, fr = lane & 15, fq = lane >> 4;
    const int r0 = ci * 128, row = tid >> 2, q = tid & 3;
    const bf16_t* px = (const bf16_t*)(F.ws + WS_PX0); bf16_t* mix = (bf16_t*)(F.ws + WS_MIX);
    const bf16_t* vrow = px + (size_t)(r0 + row) * EVIN + 3072;
    float sum = 0.f, sq = 0.f;
#pragma unroll 4
    for (int i = 0; i < 16; ++i) { const u32x4 w = *(const u32x4*)(vrow + 128 * q + 8 * i);
#pragma unroll
        for (int e = 0; e < 4; ++e) { const float a = geluf_(bflo(w[e])), bb = geluf_(bfhi(w[e])); sum += a + bb; sq += a * a + bb * bb; } }
    sum += __shfl_xor(sum, 1); sum += __shfl_xor(sum, 2); sq += __shfl_xor(sq, 1); sq += __shfl_xor(sq, 2);
    const float mean = sum * (1.0f / 512.0f), rstd = __builtin_amdgcn_rsqf(fmaxf(sq * (1.0f / 512.0f) - mean * mean, 0.f) + RMS_EPS);
    for (int g = 0; g < 4; ++g) {
        const float* gain = F.ka->in[I_EVSGUG] + 128 * g + 32 * q;
#pragma unroll
        for (int i = 0; i < 4; ++i) { const u32x4 w = *(const u32x4*)(vrow + 128 * g + 32 * q + 8 * i);
#pragma unroll
            for (int e = 0; e < 4; ++e) { const int cl = 32 * q + 8 * i + 2 * e;
                const float a = (geluf_(bflo(w[e])) - mean) * rstd * gain[8 * i + 2 * e], bb = (geluf_(bfhi(w[e])) - mean) * rstd * gain[8 * i + 2 * e + 1];
                *(LAS unsigned short*)(VNT + cl * 256 + ((2 * row) ^ ((cl & 7) << 4))) = (unsigned short)f2bf(a);
                *(LAS unsigned short*)(VNT + (cl + 1) * 256 + ((2 * row) ^ (((cl + 1) & 7) << 4))) = (unsigned short)f2bf(bb); } }
        const float* wsg = F.ka->in[I_EVWS] + (size_t)g * 128 * 128;
#pragma unroll
        for (int it = 0; it < 4; ++it) { const int idx = tid + 512 * it, t = idx >> 4, ch = idx & 15; const f32x4 a = *(const f32x4*)(wsg + t * 128 + 8 * ch), bb = *(const f32x4*)(wsg + t * 128 + 8 * ch + 4);
            u32x4 w; w.x = cvtpk(a[0], a[1]); w.y = cvtpk(a[2], a[3]); w.z = cvtpk(bb[0], bb[1]); w.w = cvtpk(bb[2], bb[3]);
            *(LAS u32x4*)(WS + t * 256 + ((ch ^ (t & 7)) << 4)) = w; }
        __syncthreads();
        bf16x8 av[4];
#pragma unroll
        for (int ks = 0; ks < 4; ++ks) av[ks] = lds_frag256(VNT, 16 * wave + fr, ks * 4 + fq);
#pragma unroll 2
        for (int tt = 0; tt < 8; ++tt) { f32x4 a = {0.f, 0.f, 0.f, 0.f};
#pragma unroll
            for (int ks = 0; ks < 4; ++ks) a = MFMA16(av[ks], lds_frag256(WS, 16 * tt + fr, ks * 4 + fq), a);
            const int t = 16 * tt + fr, c0 = 128 * g + 16 * wave + 4 * fq; const float bs = F.ka->in[I_EVBS][g * 128 + t];
            const u32x2 uw = *(const u32x2*)(px + (size_t)(r0 + t) * EVIN + 2560 + c0);
            u32x2 w; w.x = cvtpk(geluf_(bflo(uw.x)) * (a[0] + bs), geluf_(bfhi(uw.x)) * (a[1] + bs)); w.y = cvtpk(geluf_(bflo(uw.y)) * (a[2] + bs), geluf_(bfhi(uw.y)) * (a[3] + bs));
            *(u32x2*)(mix + (size_t)(r0 + t) * DM + 512 + c0) = w; }
        __syncthreads();
    }
}
__device__ __forceinline__ void p3_mixers(Frame& F) {
    for (int rep_ = 0; rep_ < 1 + ((REPMASK >> 21) & 1); ++rep_)
    for (int it = F.vcu; it < 256; it += F.G) gla_item(F, it);
    { int t = threadIdx.x; asm volatile("" : "+v"(t)); F.tid = t; F.lane = t & 63; F.wave = __builtin_amdgcn_readfirstlane(t >> 6); }
    for (int rep_ = 0; rep_ < 1 + ((REPMASK >> 22) & 1); ++rep_)
    for (int ci = F.vcu; ci < R / 128; ci += F.G) sgu_item(F, ci);
}
__device__ __forceinline__ void p3b_hgrn_out(Frame& F) {
    const int gw = F.vcu * 8 + F.wave, NGW = F.G * 8; const bf16_t* og = (const bf16_t*)(F.ws + WS_OG); const bf16_t* px = (const bf16_t*)(F.ws + WS_PX0); bf16_t* mix = (bf16_t*)(F.ws + WS_MIX);
    const int c0 = 8 * F.lane; float gn[8];
#pragma unroll
    for (int e = 0; e < 8; ++e) gn[e] = F.ka->in[I_EVONORM][(c0 & 127) + e];
    for (int row = gw; row < R; row += NGW) {
        const u32x4 a = *(const u32x4*)(og + (size_t)row * 512 + c0), bb = *(const u32x4*)(og + (size_t)(R + row) * 512 + c0), gg = *(const u32x4*)(px + (size_t)row * EVIN + 2048 + c0);
        float o[8]; float ss = 0.f;
#pragma unroll
        for (int e = 0; e < 4; ++e) { o[2 * e] = bflo(a[e]) + bflo(bb[e]); o[2 * e + 1] = bfhi(a[e]) + bfhi(bb[e]); ss += o[2 * e] * o[2 * e] + o[2 * e + 1] * o[2 * e + 1]; }
        ss += __shfl_xor(ss, 1); ss += __shfl_xor(ss, 2); ss += __shfl_xor(ss, 4); ss += __shfl_xor(ss, 8);
        const float rstd = __builtin_amdgcn_rsqf(ss * (1.0f / 128.0f) + RMS_EPS);
        u32x4 w;
#pragma unroll
        for (int e = 0; e < 4; ++e) w[e] = cvtpk(o[2 * e] * rstd * gn[2 * e] * siluf_(bflo(gg[e])), o[2 * e + 1] * rstd * gn[2 * e + 1] * siluf_(bfhi(gg[e])));
        *(u32x4*)(mix + (size_t)row * DM + c0) = w;
    }
}

__device__ __forceinline__ void p10_kr(Frame& F) {
    const int gw = F.vcu * 8 + F.wave, NGW = F.G * 8; const bf16_t* px1 = (const bf16_t*)(F.ws + WS_PX1); bf16_t* kb = (bf16_t*)(F.ws + WS_KB);
    const int d = F.lane, i16 = d & 15; const float invf = __expf(-(float)i16 * (2.0f / 32.0f) * 9.210340371976184f);
    for (int row = gw; row < R; row += NGW) {
        const int pos = row % PB; float x = bf2f(px1[(size_t)row * CINP + 640 + d]);
        const float xo = __shfl_xor(x, 16);
        if (pos >= CTXL) { const int t = pos - CTXL; const float p = (d < 32) ? (float)(t >> 6) : (float)(t & 63); const float ang = p * invf, cs = __cosf(ang), sn = __sinf(ang);
            x = (d & 16) ? (xo * sn + x * cs) : (x * cs - xo * sn); }
        const unsigned short hb = (unsigned short)f2bf(x);
#pragma unroll
        for (int h = 0; h < 8; ++h) kb[(size_t)row * NQ + h * 192 + 128 + d] = hb;
    }
}

namespace att {
constexpr int KVBLK = 64, SHM_V = 64 * 128 * 2, SHM_K = 64 * 192 * 2;
constexpr float THR = 8.0f * 1.4426950408889634f;
#define KSWZ192(row, colB) ((row) * 384 + ((colB) ^ (((row) & 7) << 4)))
__device__ __forceinline__ int crow(int r, int hi) { return (r & 3) + 8 * (r >> 2) + 4 * hi; }
__device__ __forceinline__ void partialSM(f32x16& p0, f32x16& p1, float& m_reg, float& mn, float& alpha) {
    float pmax = p0[0];
#pragma unroll
    for (int r = 1; r < 16; ++r) pmax = fmaxf(pmax, p0[r]);
#pragma unroll
    for (int r = 0; r < 16; ++r) pmax = fmaxf(pmax, p1[r]);
    { auto rr = __builtin_amdgcn_permlane32_swap(__float_as_uint(pmax), __float_as_uint(pmax), false, false); pmax = fmaxf(__uint_as_float(rr[0]), __uint_as_float(rr[1])); }
    if (__builtin_expect(__all(pmax - m_reg <= THR), 1)) { mn = m_reg; alpha = 1.f; }
    else { mn = fmaxf(m_reg, pmax); alpha = __builtin_amdgcn_exp2f(m_reg - mn); m_reg = mn; }
#pragma unroll
    for (int r = 0; r < 16; ++r) p0[r] = p0[r] - mn;
#pragma unroll
    for (int r = 0; r < 16; ++r) p1[r] = p1[r] - mn;
#pragma unroll
    for (int r = 0; r < 16; ++r) p0[r] = __builtin_amdgcn_exp2f(p0[r]);
}
__device__ __forceinline__ void finishSM(f32x16& p0, f32x16& p1, float alpha, float& l_reg, bf16x8& pa0, bf16x8& pa1, bf16x8& pa2, bf16x8& pa3) {
#pragma unroll
    for (int r = 0; r < 16; ++r) p1[r] = __builtin_amdgcn_exp2f(p1[r]);
    float ps = 0;
#pragma unroll
    for (int r = 0; r < 16; ++r) ps += p0[r];
#pragma unroll
    for (int r = 0; r < 16; ++r) ps += p1[r];
    { auto rr = __builtin_amdgcn_permlane32_swap(__float_as_uint(ps), __float_as_uint(ps), false, false); ps = __uint_as_float(rr[0]) + __uint_as_float(rr[1]); }
    l_reg = l_reg * alpha + ps;
#define PK4(P, BASE, OUT) do { unsigned a0 = cvtpk(P[BASE + 0], P[BASE + 1]), a1 = cvtpk(P[BASE + 2], P[BASE + 3]);   \
    unsigned b0 = cvtpk(P[BASE + 4], P[BASE + 5]), b1 = cvtpk(P[BASE + 6], P[BASE + 7]);                              \
    auto r0 = __builtin_amdgcn_permlane32_swap(a0, b0, false, false); auto r1 = __builtin_amdgcn_permlane32_swap(a1, b1, false, false); \
    u32x4 w = {r0[0], r1[0], r0[1], r1[1]}; OUT = *reinterpret_cast<bf16x8*>(&w); } while (0)
    PK4(p0, 0, pa0); PK4(p0, 8, pa1); PK4(p1, 0, pa2); PK4(p1, 8, pa3);
#undef PK4
}
__device__ __forceinline__ void qkt(f32x16& p0, f32x16& p1, const LAS unsigned char* const (&kb)[4], const int boff, const bf16x8* qr) {
    p0 = f32x16{}; p1 = f32x16{};
#pragma unroll
    for (int m = 0; m < 3; ++m) {
#pragma unroll
        for (int r = 0; r < 4; ++r) { const int d0 = 4 * m + r;
            const bf16x8 b0 = *(const LAS bf16x8*)(kb[r] + boff + m * 128);
            const bf16x8 b1 = *(const LAS bf16x8*)(kb[r] + boff + m * 128 + 12288);
            p0 = __builtin_amdgcn_mfma_f32_32x32x16_bf16(b0, qr[d0], p0, 0, 0, 0);
            p1 = __builtin_amdgcn_mfma_f32_32x32x16_bf16(b1, qr[d0], p1, 0, 0, 0); }
        SBAR(); }
}
__device__ __forceinline__ int v_st(int k, int c) { const int kk = (k & ~0xC) | ((k & 4) << 1) | ((k & 8) >> 1); return ((kk >> 3) * 4 + (c >> 5)) * 512 + ((kk & 7) * 32 + (c & 31)) * 2; }
__device__ __forceinline__ int v_rd_base(int lane) { return ((lane & 3) << 3) | (((lane >> 2) & 3) << 6) | (((lane >> 4) & 1) << 5) | (((lane >> 5) & 1) << 8); }
constexpr int v_rd_off(int d0, int ks, int half) { return d0 * 512 + ks * 4096 + half * 2048; }
template <int OFF> __device__ __forceinline__ s16x4 tr_read(int vb) { s16x4 r; asm volatile("ds_read_b64_tr_b16 %0, %1 offset:%2" : "=&v"(r) : "v"(vb), "i"(OFF) : "memory"); return r; }
template <int D0> __device__ __forceinline__ void pv_one(f32x16& od, int vb, bf16x8 pa0, bf16x8 pa1, bf16x8 pa2, bf16x8 pa3) {
    const s16x4 l0 = tr_read<v_rd_off(D0, 0, 0)>(vb), h0 = tr_read<v_rd_off(D0, 0, 1)>(vb), l1 = tr_read<v_rd_off(D0, 1, 0)>(vb), h1 = tr_read<v_rd_off(D0, 1, 1)>(vb);
    const s16x4 l2 = tr_read<v_rd_off(D0, 2, 0)>(vb), h2 = tr_read<v_rd_off(D0, 2, 1)>(vb), l3 = tr_read<v_rd_off(D0, 3, 0)>(vb), h3 = tr_read<v_rd_off(D0, 3, 1)>(vb);
    asm volatile("s_waitcnt lgkmcnt(0)" ::: "memory"); SBAR();
#define PK(L, H) (bf16x8){L[0], L[1], L[2], L[3], H[0], H[1], H[2], H[3]}
    od = __builtin_amdgcn_mfma_f32_32x32x16_bf16(pa0, PK(l0, h0), od, 0, 0, 0);
    od = __builtin_amdgcn_mfma_f32_32x32x16_bf16(pa1, PK(l1, h1), od, 0, 0, 0);
    od = __builtin_amdgcn_mfma_f32_32x32x16_bf16(pa2, PK(l2, h2), od, 0, 0, 0);
    od = __builtin_amdgcn_mfma_f32_32x32x16_bf16(pa3, PK(l3, h3), od, 0, 0, 0);
#undef PK
}
__device__ __forceinline__ void pv_d0(f32x16* o, int vb, bf16x8 pa0, bf16x8 pa1, bf16x8 pa2, bf16x8 pa3) {
    pv_one<0>(o[0], vb, pa0, pa1, pa2, pa3); pv_one<1>(o[1], vb, pa0, pa1, pa2, pa3); pv_one<2>(o[2], vb, pa0, pa1, pa2, pa3); pv_one<3>(o[3], vb, pa0, pa1, pa2, pa3);
}
__device__ __forceinline__ void attn_unit(const int tid, const bf16_t* __restrict__ Qb, const bf16_t* __restrict__ Kh, const bf16_t* __restrict__ Vh, bf16_t* __restrict__ Ob, LAS unsigned char* lds) {
    const int wid = __builtin_amdgcn_readfirstlane(tid >> 6), lane = tid & 63, r32 = lane & 31, hi = lane >> 5;
    LAS unsigned char* V_lds = lds; LAS unsigned char* K_lds = lds + 2 * SHM_V;
    LAS float* ws = (LAS float*)(lds + 2 * SHM_V + 2 * SHM_K) + wid * 64; LAS float* li_l = ws; LAS float* al_l = ws + 32;
    float m_reg = -1e30f, l_reg = 0; f32x16 o[4] = {}; bf16x8 qr[12];
    const bf16_t* Qw = Qb + (size_t)(wid * 32 + r32) * NQ + hi * 8;
#pragma unroll
    for (int d0 = 0; d0 < 12; ++d0) qr[d0] = *(const bf16x8*)(Qw + d0 * 16);
    const int sr = tid >> 4, sc = (tid & 15) * 8, vst0 = v_st(sr, sc), vst1 = v_st(32 + sr, sc);
    unsigned kgo[3], klo[3];
#pragma unroll
    for (int i = 0; i < 3; ++i) { const int id = tid + 512 * i, kr_ = id / 24, kc_ = (id % 24) * 8; kgo[i] = (unsigned)(kr_ * NQ + kc_) * 2u; klo[i] = (unsigned)KSWZ192(kr_, kc_ * 2); }
    const unsigned vgo = (unsigned)(sr * DM + sc) * 2u;
    const int vb0 = (int)(uintptr_t)V_lds + v_rd_base(lane);
    const LAS unsigned char* kb[4];
#pragma unroll
    for (int r = 0; r < 4; ++r) kb[r] = K_lds + r32 * 384 + ((r * 32 + hi * 16) ^ ((r32 & 7) << 4));
    bf16x8 vs0, vs1, ks[3];
#define SLOAD(k0) do { const char* vt_ = (const char*)Vh + (size_t)(k0) * DM * 2; const char* kt_ = (const char*)Kh + (size_t)(k0) * NQ * 2; \
    vs0 = *(const bf16x8*)(vt_ + vgo); vs1 = *(const bf16x8*)(vt_ + 32 * DM * 2 + vgo); \
    _Pragma("unroll") for (int i_ = 0; i_ < 3; ++i_) ks[i_] = *(const bf16x8*)(kt_ + kgo[i_]); } while (0)
#define SWRITE(b) do { *(LAS bf16x8*)(V_lds + (b) * SHM_V + vst0) = vs0; *(LAS bf16x8*)(V_lds + (b) * SHM_V + vst1) = vs1; \
    _Pragma("unroll") for (int i_ = 0; i_ < 3; ++i_) *(LAS bf16x8*)(K_lds + (b) * SHM_K + klo[i_]) = ks[i_]; } while (0)
    const LAS float* al_hi = al_l + 4 * hi;
#define RESC(a) do { if (__any((a) < 1.f)) { if (hi == 0) al_l[r32] = (a); asm volatile("s_waitcnt lgkmcnt(0)" ::: "memory"); \
    _Pragma("unroll") for (int d_ = 0; d_ < 4; ++d_) _Pragma("unroll") for (int r_ = 0; r_ < 16; ++r_) o[d_][r_] *= al_hi[crow(r_, 0)]; } } while (0)
    f32x16 p0, p1; float mn, al; bf16x8 pa0, pa1, pa2, pa3; constexpr int NT = PB / KVBLK;
    SLOAD(0); SWRITE(0); __syncthreads();
    for (int j = 0; j < NT; j += 2) {
        SLOAD((j + 1) * KVBLK); SBAR();
        qkt(p0, p1, kb, 0, qr); partialSM(p0, p1, m_reg, mn, al); RESC(al);
        finishSM(p0, p1, al, l_reg, pa0, pa1, pa2, pa3); SBAR();
        pv_d0(o, vb0, pa0, pa1, pa2, pa3);
        SWRITE(1); __syncthreads();
        if (j + 2 < NT) SLOAD((j + 2) * KVBLK); SBAR();
        qkt(p0, p1, kb, SHM_K, qr); partialSM(p0, p1, m_reg, mn, al); RESC(al);
        finishSM(p0, p1, al, l_reg, pa0, pa1, pa2, pa3); SBAR();
        pv_d0(o, vb0 + SHM_V, pa0, pa1, pa2, pa3);
        if (j + 2 < NT) SWRITE(0);
        __syncthreads();
    }
    if (hi == 0) li_l[r32] = l_reg; asm volatile("s_waitcnt lgkmcnt(0)" ::: "memory");
    __syncthreads();
    int lane2 = threadIdx.x & 63; asm volatile("" : "+v"(lane2));
    const int hi2 = lane2 >> 5, r322 = lane2 & 31;
    LAS bf16_t* stg = (LAS bf16_t*)(lds + wid * 8192);
    LAS bf16_t* stg_l = stg + 4 * hi2 * 128 + r322; const LAS float* li_hi = li_l + 4 * hi2;
#pragma unroll
    for (int r = 0; r < 16; ++r) { const float rl = __builtin_amdgcn_rcpf(li_hi[crow(r, 0)]);
#pragma unroll
        for (int d0 = 0; d0 < 4; ++d0) stg_l[crow(r, 0) * 128 + d0 * 32] = (bf16_t)f2bf(o[d0][r] * rl); }
    asm volatile("s_waitcnt lgkmcnt(0)" ::: "memory");
    bf16_t* Ow = Ob + (size_t)(wid * 32 + (lane2 >> 4)) * DM + (lane2 & 15) * 8; const LAS bf16_t* stg_r = stg + (lane2 >> 4) * 128 + (lane2 & 15) * 8;
#pragma unroll
    for (int i = 0; i < 8; ++i) { const u32x4 v = *(const LAS u32x4*)(stg_r + i * 4 * 128); *(u32x4*)(Ow + (size_t)(i * 4) * DM) = v; }
    __syncthreads();
#undef SLOAD
#undef SWRITE
#undef RESC
}
}
__device__ __forceinline__ void p11_attention(Frame& F) {
    const bf16_t* Q = (const bf16_t*)(F.ws + WS_Q); const bf16_t* K = (const bf16_t*)(F.ws + WS_KB); const bf16_t* V = (const bf16_t*)(F.ws + WS_VB); bf16_t* O = (bf16_t*)(F.ws + WS_MIX);
    for (int i = 0; i < 4; ++i) {
        const int bh = (F.vcu >> 3) + 32 * i, qb = F.vcu & 7, b = bh >> 3, h = bh & 7;
        const size_t qrow = (size_t)b * PB + CTXL + qb * 256, krow = (size_t)b * PB;
        att::attn_unit(F.tid, Q + qrow * NQ + h * 192, K + krow * NQ + h * 192, V + krow * DM + h * 128, O + qrow * DM + h * 128, F.lds);
    }
}

__device__ __forceinline__ void ka_launder(Frame& F) { asm volatile("" : "+s"(F.ka)); int t = threadIdx.x; asm volatile("" : "+v"(t)); F.tid = t; F.lane = t & 63; F.wave = __builtin_amdgcn_readfirstlane(t >> 6); }
#ifndef DBG_MODE
#define DBG_MODE 0
#endif
constexpr int NPH = 21;
__device__ __forceinline__ void moe_gemms(Frame& F, int layer, int which) {
    const int nblk = __builtin_amdgcn_readfirstlane(*(const int*)(F.ws + WS_ROUTE + RT_NBLK));
    MoeSched S; S.init((const int*)(F.ws + WS_ROUTE + RT_BLKE), nblk, F.G, (int)blockIdx.x);
    const int* perm = (const int*)(F.ws + WS_ROUTE + RT_PERM);
    if (which == 0) {
        pg8::Gemm g{(const bf16_t*)(F.ws + WS_HX), (const bf16_t*)(F.ws + WS_WGU) + (size_t)layer * 32 * 1024 * DM, DM, DM, DM, perm};
        EpiSwiglu E{(bf16_t*)(F.ws + WS_ACT)};
        pg8::gemm_phase<EpiSwiglu, MoeSched, true>(F.lds, g, S, E);
    } else {
        pg8::Gemm g{(const bf16_t*)(F.ws + WS_ACT), (const bf16_t*)(F.ws + WS_WDN) + (size_t)layer * 32 * DM * MFF, MFF, MFF, MFF, nullptr};
        EpiScatter E{(bf16_t*)(F.ws + WS_YS), perm};
        pg8::gemm_phase<EpiScatter, MoeSched, false>(F.lds, g, S, E);
    }
}
__global__ void __launch_bounds__(512, 2) mega_fwd(Args args) {
    extern __shared__ __attribute__((aligned(16))) unsigned char lds_raw[];
    Frame F;
    F.lds = (LAS unsigned char*)lds_raw;
    F.tid = threadIdx.x; F.lane = F.tid & 63; F.wave = __builtin_amdgcn_readfirstlane(F.tid >> 6);
    F.G = gridDim.x; { const int bx = blockIdx.x; F.vcu = (F.G % 8 == 0) ? (bx % 8) * (F.G / 8) + bx / 8 : bx; }
    F.ws = args.ws; F.out = args.out;
    F.ka = (const __attribute__((address_space(4))) Args*)__builtin_amdgcn_kernarg_segment_ptr();
    for (int u = F.tid; u < (LDS_BYTES - LDSCTL_OFF) / 4; u += 512) ((LAS unsigned*)(F.lds + LDSCTL_OFF))[u] = 0u;
    __syncthreads();
    volatile LAS unsigned* MISC = (volatile LAS unsigned*)(F.lds + MISC_OFF);
    unsigned* ctl = (unsigned*)(F.ws + WS_CTL);
    XcdBarrier bar; bar.bar = ctl + CW_BAR; bar.x = 0; bar.st = nullptr;
    if (!args.nobar) bar = xcd_barrier_post(ctl + CW_BAR, MISC + 8);
    const int lo = args.ph_lo, hi = args.ph_hi;
#define IN(k) (lo <= (k) && (k) < hi)
#define SEAM(k) do { if (IN(k) && IN((k) + 1)) xcd_barrier(bar); } while (0)
    constexpr int LAST = DBG_MODE == 0 ? 20 : DBG_MODE == 1 ? -1 : DBG_MODE == 2 ? 6 : DBG_MODE == 3 ? 11 : DBG_MODE == 4 ? 15 : DBG_MODE == 10 ? 2 : DBG_MODE == 11 ? 3 : 5;
#ifndef PHMASK
#define PHMASK 0x1fffff
#endif
#define RUN(k) (ka_launder(F), IN(k) && (k) <= LAST && ((PHMASK >> (k)) & 1))

    if (RUN(0)) for (int rep_ = 0; rep_ < 1 + ((REPMASK >> 0) & 1); ++rep_) p0_prologue(F);
    SEAM(0);
    if (RUN(1)) for (int rep_ = 0; rep_ < 1 + ((REPMASK >> 1) & 1); ++rep_) p0b_mod(F);
    SEAM(1);
    if (RUN(2)) for (int rep_ = 0; rep_ < 1 + ((REPMASK >> 2) & 1); ++rep_) p1_norm_input(F);
    SEAM(2);
    if (RUN(3)) for (int rep_ = 0; rep_ < 1 + ((REPMASK >> 3) & 1); ++rep_) { pg8::Gemm g{(const bf16_t*)(F.ws + WS_HX), (const bf16_t*)(F.ws + WS_WIN0), DM, DM, DM, nullptr}; TileSched<false> S; S.init(EVIN / 256, F.G, (int)blockIdx.x);
        EpiStoreBf16 E{(bf16_t*)(F.ws + WS_PX0), EVIN}; pg8::gemm_phase<EpiStoreBf16, TileSched<false>, false>(F.lds, g, S, E); }
    SEAM(3);
    if (RUN(4)) for (int rep_ = 0; rep_ < 1 + ((REPMASK >> 4) & 1); ++rep_) p3_mixers(F);
    SEAM(4);
    if (RUN(5)) for (int rep_ = 0; rep_ < 1 + ((REPMASK >> 5) & 1); ++rep_) p3b_hgrn_out(F);
    SEAM(5);
    if (RUN(6)) for (int rep_ = 0; rep_ < 1 + ((REPMASK >> 6) & 1); ++rep_) { pg8::Gemm g{(const bf16_t*)(F.ws + WS_MIX), (const bf16_t*)(F.ws + WS_WOUT0), DM, DM, DM, nullptr}; TileSched<false> S; S.init(DM / 256, F.G, (int)blockIdx.x);
        EpiResidual E{&F, (float*)(F.ws + WS_XS), 0, true}; pg8::gemm_phase<EpiResidual, TileSched<false>, false>(F.lds, g, S, E); }
    SEAM(6);
    if (RUN(7)) for (int rep_ = 0; rep_ < 1 + ((REPMASK >> 7) & 1); ++rep_) p5_norm_route<false>(F, 0);
    SEAM(7);
    if (RUN(8)) for (int rep_ = 0; rep_ < 1 + ((REPMASK >> 8) & 1); ++rep_) p5b_perm<false>(F);
    SEAM(8);
    if (RUN(9)) for (int rep_ = 0; rep_ < 1 + ((REPMASK >> 9) & 1); ++rep_) moe_gemms(F, 0, 0);
    SEAM(9);
    if (RUN(10)) for (int rep_ = 0; rep_ < 1 + ((REPMASK >> 10) & 1); ++rep_) moe_gemms(F, 0, 1);
    SEAM(10);
    if (RUN(11)) for (int rep_ = 0; rep_ < 1 + ((REPMASK >> 11) & 1); ++rep_) p8_combine_norm(F);
    SEAM(11);
    if (RUN(12)) for (int rep_ = 0; rep_ < 1 + ((REPMASK >> 12) & 1); ++rep_) { pg8::Gemm g{(const bf16_t*)(F.ws + WS_HX), (const bf16_t*)(F.ws + WS_WIN1), DM, DM, DM, nullptr}; TileSched<false> S; S.init(CINP / 256, F.G, (int)blockIdx.x);
        EpiStoreStats E{(bf16_t*)(F.ws + WS_PX1), CINP, (float*)(F.ws + WS_STATS)}; pg8::gemm_phase<EpiStoreStats, TileSched<false>, false>(F.lds, g, S, E); }
    SEAM(12);
    if (RUN(13)) for (int rep_ = 0; rep_ < 1 + ((REPMASK >> 13) & 1); ++rep_) {
        { pg8::Gemm g{(const bf16_t*)(F.ws + WS_PX1), (const bf16_t*)(F.ws + WS_WUQ), CINP, QRANK, QRANK, nullptr}; TileSched<true> S; S.init(NQ / 256, F.G, (int)blockIdx.x);
          EpiQ E{(bf16_t*)(F.ws + WS_Q), (const float*)(F.ws + WS_STATS)}; pg8::gemm_phase<EpiQ, TileSched<true>, false>(F.lds, g, S, E); }
        { pg8::Gemm g{(const bf16_t*)(F.ws + WS_PX1) + QRANK, (const bf16_t*)(F.ws + WS_WUKV), CINP, KVRANK, KVRANK, nullptr}; TileSched<false> S; S.init(NKV / 256, F.G, (int)blockIdx.x);
          EpiKV E{(bf16_t*)(F.ws + WS_KB), (bf16_t*)(F.ws + WS_VB), (const float*)(F.ws + WS_STATS)}; pg8::gemm_phase<EpiKV, TileSched<false>, false>(F.lds, g, S, E); }
        ka_launder(F);
        p10_kr(F);
    }
    SEAM(13);
    if (RUN(14)) for (int rep_ = 0; rep_ < 1 + ((REPMASK >> 14) & 1); ++rep_) p11_attention(F);
    SEAM(14);
    if (RUN(15)) for (int rep_ = 0; rep_ < 1 + ((REPMASK >> 15) & 1); ++rep_) { pg8::Gemm g{(const bf16_t*)(F.ws + WS_MIX), (const bf16_t*)(F.ws + WS_WOUT1), DM, DM, DM, nullptr}; TileSched<true> S; S.init(DM / 256, F.G, (int)blockIdx.x);
        EpiResidual E{&F, (float*)(F.ws + WS_XS), 1, false}; pg8::gemm_phase<EpiResidual, TileSched<true>, false>(F.lds, g, S, E); }
    SEAM(15);
    if (RUN(16)) for (int rep_ = 0; rep_ < 1 + ((REPMASK >> 16) & 1); ++rep_) p5_norm_route<true>(F, 1);
    SEAM(16);
    if (RUN(17)) for (int rep_ = 0; rep_ < 1 + ((REPMASK >> 17) & 1); ++rep_) p5b_perm<true>(F);
    SEAM(17);
    if (RUN(18)) for (int rep_ = 0; rep_ < 1 + ((REPMASK >> 18) & 1); ++rep_) moe_gemms(F, 1, 0);
    SEAM(18);
    if (RUN(19)) for (int rep_ = 0; rep_ < 1 + ((REPMASK >> 19) & 1); ++rep_) moe_gemms(F, 1, 1);
    SEAM(19);
    ka_launder(F);
    if (IN(20) && ((PHMASK >> 20) & 1)) p16_final(F);
#undef IN
#undef SEAM
#undef RUN
}

#ifndef MK_N_LAUNCHES
#define MK_N_LAUNCHES 1
#endif
extern "C" void kernel_launch(void* const* d_in, const int* in_sizes, int n_in, void* d_out, int out_size, void* d_ws, size_t ws_size, hipStream_t stream) {
    static int grid = 0;
    if (grid == 0) {
        if (n_in != 28 || out_size != NB * SEQ * DM || ws_size < WS_END) { fprintf(stderr, "kernel_launch: unexpected shapes (n_in %d out %d ws %zu)\n", n_in, out_size, ws_size); grid = -1; return; }
        int dev = 0, cus = 0, per_cu = 0;
        if (hipGetDevice(&dev) != hipSuccess || hipDeviceGetAttribute(&cus, hipDeviceAttributeMultiprocessorCount, dev) != hipSuccess) { grid = -1; return; }
        if (hipFuncSetAttribute((const void*)mega_fwd, hipFuncAttributeMaxDynamicSharedMemorySize, LDS_BYTES) != hipSuccess) { fprintf(stderr, "kernel_launch: hipFuncSetAttribute failed\n"); grid = -1; return; }
        if (hipOccupancyMaxActiveBlocksPerMultiprocessor(&per_cu, (const void*)mega_fwd, 512, LDS_BYTES) != hipSuccess || per_cu < 1) { fprintf(stderr, "kernel_launch: occupancy query says %d blocks/CU\n", per_cu); per_cu = 1; }
        (void)hipGetLastError();
        grid = cus;
    }
    if (grid < 0) return;
    (void)hipMemsetAsync((char*)d_ws + WS_CTL, 0, CTL_ZERO_BYTES, stream);
    Args a{};
    for (int i = 0; i < 28; ++i) a.in[i] = (const float*)d_in[i];
    a.out = (float*)d_out; a.ws = (unsigned char*)d_ws;
    if (MK_N_LAUNCHES == 1) {
        a.ph_lo = 0; a.ph_hi = NPH; a.nobar = 0;
        void* kargs[] = {&a};
        hipError_t e = hipLaunchCooperativeKernel((const void*)mega_fwd, dim3(grid), dim3(512), kargs, LDS_BYTES, stream);
        if (e != hipSuccess) { (void)hipGetLastError(); fprintf(stderr, "kernel_launch: cooperative launch failed (%s), plain launch instead\n", hipGetErrorString(e)); hipLaunchKernelGGL(mega_fwd, dim3(grid), dim3(512), LDS_BYTES, stream, a); }
    } else {
        for (int p = 0; p < NPH; ++p) { a.ph_lo = p; a.ph_hi = p + 1; a.nobar = 1; hipLaunchKernelGGL(mega_fwd, dim3(grid), dim3(512), LDS_BYTES, stream, a); }
    }
}
```

```cpp
#include <hip/hip_runtime.h>
#include <cstdio>
#include <cstdint>
#define MK_N_LAUNCHES 1
#define DBG_MODE 0
#define REPMASK 0x0

#define LAS __attribute__((address_space(3)))
#define GAS __attribute__((address_space(1)))
typedef unsigned short bf16_t;
typedef short bf16x8 __attribute__((ext_vector_type(8)));
typedef short s16x4 __attribute__((ext_vector_type(4)));
typedef float f32x2 __attribute__((ext_vector_type(2)));
typedef float f32x4 __attribute__((ext_vector_type(4)));
typedef float f32x16 __attribute__((ext_vector_type(16)));
typedef unsigned u32x2 __attribute__((ext_vector_type(2)));
typedef unsigned u32x4 __attribute__((ext_vector_type(4)));

constexpr int DM = 1024, NB = 16, SEQ = 2048, CTXL = 256, PB = SEQ + CTXL  , R = NB * PB  ;
constexpr int NTILE = R / 256  , NXTILE = NB * SEQ / 256  ;
constexpr int EVIN = 3584;
constexpr int CIN = 704, CINP = 768, QRANK = 384, KVRANK = 256, NQ = 1536, NKV = 2048;
constexpr int NEXP = 32, MFF = 512;
constexpr int MAXSLOT = 81920;
constexpr float RMS_EPS = 1e-6f;
constexpr float ATT_C2 = 0.07216878364870322f * 1.4426950408889634f;

constexpr size_t MiB = 1u << 20;
constexpr size_t WS_CTL = 0, CTL_ZERO_BYTES = 1 * MiB;
constexpr size_t WS_MOD = 1 * MiB;
constexpr size_t WS_PART = 2 * MiB;
constexpr size_t WS_STATS = 9 * MiB;
constexpr size_t WS_ROUTE = 13 * MiB;
constexpr size_t WS_WIN0 = 16 * MiB, WS_WOUT0 = 23 * MiB, WS_WIN1 = 25 * MiB, WS_WUQ = 27 * MiB, WS_WUKV = 29 * MiB, WS_WOUT1 = 30 * MiB;
constexpr size_t WS_WGU = 32 * MiB;
constexpr size_t WS_WDN = 160 * MiB;
constexpr size_t WS_XS = 224 * MiB;
constexpr size_t WS_HX = 368 * MiB;
constexpr size_t WS_MIX = 440 * MiB;
constexpr size_t WS_RA = 512 * MiB;
constexpr size_t WS_PX0 = WS_RA, WS_Q = WS_RA, WS_KB = WS_RA + 108 * MiB, WS_ACT = WS_RA;
constexpr size_t WS_RB = 764 * MiB;
constexpr size_t WS_YS = WS_RB, WS_PX1 = WS_RB, WS_VB = WS_RB + 54 * MiB, WS_OG = WS_RB;
constexpr size_t WS_END = 908 * MiB;
constexpr size_t RT_AE = 0, RT_AP = 512 * 1024, RT_AW = 1024 * 1024, RT_PERM = 1536 * 1024, RT_CNTB = 2048 * 1024, RT_BLKE = 2048 * 1024 + 64 * 1024, RT_NBLK = RT_BLKE + 4096;
constexpr int CW_BAR = 4096;

constexpr int RING_BYTES = 131072;
constexpr int LDSCTL_OFF = 147456, MISC_OFF = LDSCTL_OFF + 320;
constexpr int LDS_BYTES = 149504;

#define LDS_WAIT() asm volatile("s_waitcnt lgkmcnt(0)" ::: "memory")
#define VM_WAIT() asm volatile("s_waitcnt vmcnt(0)" ::: "memory")
#define SBAR() __builtin_amdgcn_sched_barrier(0)
__device__ __forceinline__ unsigned f2bf(float f) { unsigned u = __builtin_bit_cast(unsigned, f); return (u + 0x7fffu + ((u >> 16) & 1u)) >> 16; }
__device__ __forceinline__ unsigned pk2(float lo, float hi) { return f2bf(lo) | (f2bf(hi) << 16); }
typedef __bf16 bf16x2_t __attribute__((ext_vector_type(2)));
__device__ __forceinline__ unsigned cvtpk(float lo, float hi) { f32x2 v = {lo, hi}; bf16x2_t b = __builtin_convertvector(v, bf16x2_t); return __builtin_bit_cast(unsigned, b); }
__device__ __forceinline__ float bf2f(unsigned short h) { return __builtin_bit_cast(float, (unsigned)h << 16); }
__device__ __forceinline__ float bflo(unsigned w) { return __builtin_bit_cast(float, w << 16); }
__device__ __forceinline__ float bfhi(unsigned w) { return __builtin_bit_cast(float, w & 0xffff0000u); }
__device__ __forceinline__ float dpp_add(float v, const int ctrl) { return v; }
#define DPP_ADD(v, ctrl) ((v) + __builtin_bit_cast(float, __builtin_amdgcn_update_dpp(0, __builtin_bit_cast(int, (v)), (ctrl), 0xf, 0xf, true)))
__device__ __forceinline__ float wave_sum(float v) {
    v = DPP_ADD(v, 0xB1);
    v = DPP_ADD(v, 0x4E);
    v = DPP_ADD(v, 0x141);
    v = DPP_ADD(v, 0x140);
    const int iv = __builtin_bit_cast(int, v);
    return (__builtin_bit_cast(float, __builtin_amdgcn_readlane(iv, 0)) + __builtin_bit_cast(float, __builtin_amdgcn_readlane(iv, 16))) +
           (__builtin_bit_cast(float, __builtin_amdgcn_readlane(iv, 32)) + __builtin_bit_cast(float, __builtin_amdgcn_readlane(iv, 48)));
}
constexpr float LOG2E = 1.4426950408889634f, LN2 = 0.6931471805599453f;
__device__ __forceinline__ float ex2(float x) { return __builtin_amdgcn_exp2f(x); }
__device__ __forceinline__ float lg2(float x) { return __builtin_amdgcn_logf(x); }
__device__ __forceinline__ float sigmoidf_(float x) { return __builtin_amdgcn_rcpf(1.0f + ex2(-LOG2E * x)); }
__device__ __forceinline__ float siluf_(float x) { return x * __builtin_amdgcn_rcpf(1.0f + ex2(-LOG2E * x)); }
__device__ __forceinline__ float geluf_(float x) { const float z = (-1.5957691216057308f * LOG2E) * (x + 0.044715f * x * x * x); return x * __builtin_amdgcn_rcpf(1.0f + ex2(z)); }

#define XB_TMO      128
#define XB_XCNT(j)  (256  + 64 * (j))
#define XB_XSUB(j)  (1280 + 64 * (j))
#define XB_XGEN(j)  (2304 + 64 * (j))
#define XB_TOP      3328
#define XB_TOPGEN   3392
#define XCD_BAR_WORDS 3456
#define XB_SPIN_CAP (1u << 22)
__device__ __forceinline__ unsigned xb_ld(unsigned* p)              { return __hip_atomic_load(p, __ATOMIC_RELAXED, __HIP_MEMORY_SCOPE_AGENT); }
__device__ __forceinline__ unsigned xb_add(unsigned* p, unsigned v) { return __hip_atomic_fetch_add(p, v, __ATOMIC_RELAXED, __HIP_MEMORY_SCOPE_AGENT); }
__device__ __forceinline__ unsigned xb_xcc_id() { return (unsigned)__builtin_amdgcn_s_getreg((3 << 11) | 20) & 0xFu; }
#define XB_SPIN(cond, bar) do { unsigned _sp = 0; while (cond) { __builtin_amdgcn_s_sleep(1); \
    if ((++_sp & 255u) == 0u) { if (xb_ld(&(bar)[XB_TMO])) break; if (_sp > XB_SPIN_CAP) { atomicAdd(&(bar)[XB_TMO], 1u); break; } } } } while (0)
struct XcdBarrier { unsigned* bar; unsigned x; volatile LAS unsigned* st; };
__device__ __forceinline__ XcdBarrier xcd_barrier_post(unsigned* bar, volatile LAS unsigned* st) {
    XcdBarrier b; b.bar = bar; b.x = xb_xcc_id(); b.st = st;
    if (threadIdx.x == 0) (void)xb_add(&bar[XB_XCNT(b.x)], 1u);
    return b;
}
__device__ __forceinline__ void xcd_barrier_complete(unsigned* bar, unsigned x, unsigned& nloc, unsigned& nx) {
    const unsigned G = gridDim.x * gridDim.y * gridDim.z;
    unsigned sum, cnt, mine, sp = 0u;
    for (;;) {
        sum = 0u; cnt = 0u; mine = 0u;
#pragma unroll
        for (unsigned j = 0; j < 16; ++j) { const unsigned c = xb_ld(&bar[XB_XCNT(j)]); sum += c; cnt += (c > 0u) ? 1u : 0u; mine = (j == x) ? c : mine; }
        if (sum == G) break;
        __builtin_amdgcn_s_sleep(1);
        if ((++sp & 255u) == 0u) { if (xb_ld(&bar[XB_TMO])) break; if (sp > XB_SPIN_CAP) { atomicAdd(&bar[XB_TMO], 1u); break; } }
    }
    nloc = mine > 0u ? mine : 1u; nx = cnt > 0u ? cnt : 1u;
}
__device__ __forceinline__ void xcd_barrier(const XcdBarrier& b) {
    asm volatile("s_waitcnt vmcnt(0)" ::: "memory");
    __syncthreads();
    if (threadIdx.x == 0) {
        unsigned* bar = b.bar;
        __builtin_amdgcn_s_waitcnt(0);
        unsigned nloc = b.st[0], nx = b.st[1];
        if (nloc == 0u) { xcd_barrier_complete(bar, b.x, nloc, nx); b.st[0] = nloc; b.st[1] = nx; }
        const unsigned old = xb_add(&bar[XB_XSUB(b.x)], 1u);
        const unsigned gen = old / nloc;
        if (old + 1u == (gen + 1u) * nloc) {
            __builtin_amdgcn_fence(__ATOMIC_RELEASE, "agent");
            asm volatile("s_waitcnt vmcnt(0)" ::: "memory");
            const unsigned og = xb_add(&bar[XB_TOP], 1u);
            const unsigned tg = og / nx;
            if (og + 1u == (tg + 1u) * nx) xb_add(&bar[XB_TOPGEN], 1u);
            else XB_SPIN(xb_ld(&bar[XB_TOPGEN]) == tg, bar);
            __builtin_amdgcn_fence(__ATOMIC_ACQUIRE, "agent");
            xb_add(&bar[XB_XGEN(b.x)], 1u);
            asm volatile("s_waitcnt vmcnt(0)" ::: "memory");
        } else {
            XB_SPIN(xb_ld(&bar[XB_XGEN(b.x)]) == gen, bar);
            __builtin_amdgcn_fence(__ATOMIC_ACQUIRE, "agent");
            asm volatile("s_waitcnt vmcnt(0)" ::: "memory");
        }
    }
    __syncthreads();
}

namespace pg8 {
constexpr int BM = 256, BK = 64, HALF = 128, HTB = HALF * BK * 2, STAGE_BYTES = 8 * HTB, NXCD = 8, WGM = 8;
__host__ __device__ __forceinline__ int lds_byte(int r, int c) { const int st = (r >> 4) * 2 + (c >> 5), rr = r & 15, cc = c & 31, ob = rr * 64 + cc * 2; return st * 1024 + (ob ^ (((ob >> 9) & 1) << 5)); }
__host__ __device__ __forceinline__ void stage_rc(int b, int& Rr, int& C) { const int st = b / 1024, sb = b % 1024, swz = sb ^ (((sb >> 9) & 1) << 5); Rr = (st >> 1) * 16 + swz / 64; C = (st & 1) * 32 + (swz % 64) / 2; }
__host__ __device__ __forceinline__ int perm32(int rho) { const int n = rho >> 4, i = rho & 15; return 8 * (i >> 2) + 4 * n + (i & 3); }

struct Unit { int arow0, brow0, pm, pn, ex; };
struct Gemm { const bf16_t* A; const bf16_t* Bt; int lda, ldb, K; const int* rowidx; };

template <class Epi, class Sched, bool GATHER>
__device__ __forceinline__ void gemm_phase(LAS unsigned char* lds, const Gemm g, const Sched& S, const Epi& E) {
    int tidl = threadIdx.x; asm volatile("" : "+v"(tidl));
    const int tid = tidl, wid = __builtin_amdgcn_readfirstlane(tid >> 6), lane = tid & 63, wr = wid >> 2, wc = wid & 3, fr = lane & 15, fq = lane >> 4;
    const int K = g.K, nt = K / BK;
    int sR[2], sC[2]; unsigned voffB[2], voffA[2];
#pragma unroll
    for (int i = 0; i < 2; ++i) { stage_rc(tid * 16 + i * 8192, sR[i], sC[i]); const int Rb = Epi::PERM ? ((sR[i] & ~31) + perm32(sR[i] & 31)) : sR[i];
        voffB[i] = (unsigned)(Rb * g.ldb + sC[i]) * 2u; voffA[i] = (unsigned)(sR[i] * g.lda + sC[i]) * 2u; }
    const size_t kstep = (size_t)(BK * 2);
    const size_t hstepB = (size_t)HALF * g.ldb * 2, hstepA = (size_t)HALF * g.lda * 2;
    const unsigned ldsw = (unsigned)wid * 1024u;
    const int aoff = lds_byte(wr * 64 + fr, fq * 8), boff = lds_byte(wc * 32 + fr, fq * 8);
#define PG8_SA(b, h) (((b) * 2 + (h)) * HTB)
#define PG8_SB(b, h) ((4 + (b) * 2 + (h)) * HTB)
#define PG8_GLDS(src, bufoff, i) __builtin_amdgcn_global_load_lds((const unsigned*)(src), (LAS unsigned*)(lds + (bufoff) + ldsw + (i) * 8192), 16, 0, 0)
#define PG8_STAGEB(bufoff, gbase) do { _Pragma("unroll") for (int _i = 0; _i < 2; ++_i) PG8_GLDS((const char*)(gbase) + voffB[_i], bufoff, _i); } while (0)
#define PG8_STAGEA(bufoff, h, isnext, kb) do { \
        if constexpr (GATHER) { _Pragma("unroll") for (int _i = 0; _i < 2; ++_i) PG8_GLDS(gA + (kb) + ((isnext) ? nvo[h][_i] : cvo[h][_i]), bufoff, _i); } \
        else { const char* _b = ((isnext) ? nA : cA) + (h) * hstepA + (kb); _Pragma("unroll") for (int _i = 0; _i < 2; ++_i) PG8_GLDS(_b + voffA[_i], bufoff, _i); } } while (0)
#define PG8_LDA(dst, b, h) do { _Pragma("unroll") for (int m = 0; m < 4; ++m) _Pragma("unroll") for (int k = 0; k < 2; ++k) dst[m][k] = *(const LAS bf16x8*)(lds + PG8_SA(b, h) + aoff + m * 2048 + k * 1024); } while (0)
#define PG8_LDB(dst, b, h) do { _Pragma("unroll") for (int n = 0; n < 2; ++n) _Pragma("unroll") for (int k = 0; k < 2; ++k) dst[n][k] = *(const LAS bf16x8*)(lds + PG8_SB(b, h) + boff + n * 2048 + k * 1024); } while (0)
#define PG8_MMA(ai, bj, At, Bt) do { __builtin_amdgcn_s_setprio(1); _Pragma("unroll") for (int m = 0; m < 4; ++m) _Pragma("unroll") for (int n = 0; n < 2; ++n) _Pragma("unroll") for (int k = 0; k < 2; ++k) \
        acc[ai][bj][m][n] = __builtin_amdgcn_mfma_f32_16x16x32_bf16(Bt[n][k], At[m][k], acc[ai][bj][m][n], 0, 0, 0); __builtin_amdgcn_s_setprio(0); } while (0)
#define PG8_WAIT_V(n) asm volatile("s_waitcnt vmcnt(" #n ")" ::: "memory")
#define PG8_WAIT_L(n) asm volatile("s_waitcnt lgkmcnt(" #n ")" ::: "memory")
#define PG8_BAR __builtin_amdgcn_s_barrier()
#define PG8_SCHED __builtin_amdgcn_sched_barrier(0)
    unsigned cvo[2][2], nvo[2][2];
    auto a_offsets = [&](const Unit& u, unsigned (&vo)[2][2]) {
#pragma unroll
        for (int h = 0; h < 2; ++h)
#pragma unroll
            for (int i = 0; i < 2; ++i) { const int a = g.rowidx[u.arow0 + h * HALF + sR[i]]; const int row = a < 0 ? 0 : (a >> 1); vo[h][i] = (unsigned)((size_t)row * g.lda + sC[i]) * 2u; }
    };
    Unit cur, nxt; int ui = 0;
    if (!S.next(0, cur)) return;
    f32x4 acc[2][2][4][2];
#pragma unroll
    for (int a = 0; a < 2; ++a)
#pragma unroll
        for (int b = 0; b < 2; ++b)
#pragma unroll
            for (int m = 0; m < 4; ++m)
#pragma unroll
                for (int n = 0; n < 2; ++n) acc[a][b][m][n] = (f32x4){0.f, 0.f, 0.f, 0.f};
    bf16x8 At[4][2], B0[2][2], B1[2][2];
    const char* gA = (const char*)g.A;
    const char* cA = gA + (size_t)cur.arow0 * g.lda * 2; const char* nA = cA;
    const char* cB = (const char*)g.Bt + (size_t)cur.brow0 * g.ldb * 2;
    if constexpr (GATHER) { a_offsets(cur, cvo);
#pragma unroll
        for (int h = 0; h < 2; ++h)
#pragma unroll
            for (int i = 0; i < 2; ++i) nvo[h][i] = cvo[h][i]; }
    PG8_STAGEB(PG8_SB(0, 0), cB); PG8_STAGEB(PG8_SB(0, 1), cB + hstepB); PG8_STAGEA(PG8_SA(0, 0), 0, false, 0); PG8_STAGEA(PG8_SA(0, 1), 1, false, 0);
    if (wr == 1) PG8_BAR;
    PG8_WAIT_V(2); PG8_BAR;
    PG8_STAGEB(PG8_SB(1, 0), cB + kstep); PG8_STAGEA(PG8_SA(1, 0), 0, false, kstep); PG8_STAGEB(PG8_SB(1, 1), cB + hstepB + kstep);
    PG8_WAIT_V(6); PG8_BAR;
    for (;;) {
        const bool has_next = S.next(ui + 1, nxt);
        const char* nB = has_next ? (const char*)g.Bt + (size_t)nxt.brow0 * g.ldb * 2 : cB;
        nA = has_next ? gA + (size_t)nxt.arow0 * g.lda * 2 : cA;
        if constexpr (GATHER) { if (has_next) a_offsets(nxt, nvo); }
        for (int t = 0; t < nt; t += 2) {
            const bool last = (t == nt - 2);
            const size_t k1 = (size_t)(t + 1) * kstep, k2 = last ? 0 : (size_t)(t + 2) * kstep, k3 = k2 + kstep;
            const char* b2 = last ? nB : cB + (size_t)(t + 2) * kstep; const char* b3 = b2 + kstep;
            PG8_LDB(B0, 0, 0); PG8_LDB(B1, 0, 1); PG8_SCHED; PG8_LDA(At, 0, 0); PG8_STAGEA(PG8_SA(1, 1), 1, false, k1);
            PG8_WAIT_V(8); PG8_WAIT_L(0); PG8_BAR; PG8_MMA(0, 0, At, B0); PG8_MMA(0, 1, At, B1); PG8_BAR; PG8_SCHED;
            PG8_LDA(At, 0, 1); PG8_STAGEB(PG8_SB(0, 0), b2); PG8_STAGEB(PG8_SB(0, 1), b2 + hstepB); PG8_STAGEA(PG8_SA(0, 0), 0, last, k2);
            PG8_WAIT_V(8); PG8_WAIT_L(0); PG8_BAR; PG8_MMA(1, 0, At, B0); PG8_MMA(1, 1, At, B1); PG8_BAR; PG8_SCHED;
            PG8_LDB(B0, 1, 0); PG8_LDB(B1, 1, 1); PG8_SCHED; PG8_LDA(At, 1, 0); PG8_STAGEA(PG8_SA(0, 1), 1, last, k2);
            PG8_WAIT_V(8); PG8_WAIT_L(0); PG8_BAR; PG8_MMA(0, 0, At, B0); PG8_MMA(0, 1, At, B1); PG8_BAR; PG8_SCHED;
            PG8_LDA(At, 1, 1); PG8_STAGEB(PG8_SB(1, 0), b3); PG8_STAGEB(PG8_SB(1, 1), b3 + hstepB); PG8_STAGEA(PG8_SA(1, 0), 0, last, k3);
            PG8_WAIT_V(8); PG8_WAIT_L(0); PG8_BAR; PG8_MMA(1, 0, At, B0); PG8_MMA(1, 1, At, B1); PG8_BAR; PG8_SCHED;
        }
        if (wr == 0) PG8_BAR;
        { int l2 = threadIdx.x; asm volatile("" : "+v"(l2)); E(acc, cur, wr, wc, l2 & 15, (l2 >> 4) & 3); }
        if (!has_next) break;
#pragma unroll
        for (int a = 0; a < 2; ++a)
#pragma unroll
            for (int b = 0; b < 2; ++b)
#pragma unroll
                for (int m = 0; m < 4; ++m)
#pragma unroll
                    for (int n = 0; n < 2; ++n) acc[a][b][m][n] = (f32x4){0.f, 0.f, 0.f, 0.f};
        cur = nxt; cB = nB; cA = nA; ++ui;
        if constexpr (GATHER) {
#pragma unroll
            for (int h = 0; h < 2; ++h)
#pragma unroll
                for (int i = 0; i < 2; ++i) cvo[h][i] = nvo[h][i]; }
        if (wr == 1) PG8_BAR;
    }
    PG8_WAIT_V(0);
    PG8_BAR;
#undef PG8_SA
#undef PG8_SB
#undef PG8_GLDS
#undef PG8_STAGEA
#undef PG8_STAGEB
#undef PG8_LDA
#undef PG8_LDB
#undef PG8_MMA
#undef PG8_WAIT_V
#undef PG8_WAIT_L
#undef PG8_BAR
#undef PG8_SCHED
}
}

struct Args {
    const float* in[28]; float* out; unsigned char* ws; int ph_lo, ph_hi, nobar, pad;
};
enum In { I_X = 0, I_C, I_CTX, I_CCTX, I_ADAW, I_ADAB, I_NMIXG, I_NFFNG, I_EVWIN, I_EVLB, I_EVONORM, I_EVSGUG, I_EVWS, I_EVBS, I_EVWOUT,
          I_ODWIN, I_ODQG, I_ODWUQ, I_ODKVG, I_ODWUKV, I_ODWOUT, I_MR1W, I_MR1B, I_MR2W, I_MR2B, I_MGU, I_MDN, I_FING };
struct Frame {
    LAS unsigned char* lds;
    const __attribute__((address_space(4))) Args* ka;
    float* out;
    int tid, lane, wave, vcu, G;
    unsigned char* ws;
};
__device__ __forceinline__ const float* mod_ptr(const Frame& F, int layer, int mrow, int which) { return (const float*)(F.ws + WS_MOD) + ((size_t)(layer * 17 + mrow) * 6 + which) * DM; }
__device__ __forceinline__ int row_b(int row) { return row / PB; }
__device__ __forceinline__ const float* input_row(const Frame& F, int row) {
    const int b = row / PB, pos = row - b * PB;
    return pos < CTXL ? F.ka->in[I_CTX] + ((size_t)b * CTXL + pos) * DM : F.ka->in[I_X] + ((size_t)b * SEQ + (pos - CTXL)) * DM;
}

template <bool XONLY> struct TileSched {
    int nM, nN, nwg, G, c;
    __device__ __forceinline__ void init(int nN_, int G_, int c_) { nM = XONLY ? NXTILE : NTILE; nN = nN_; nwg = nM * nN; G = G_; c = c_; }
    __device__ __forceinline__ bool next(int i, pg8::Unit& u) const {
        const long L = (long)i * G + c; if (L >= nwg) return false;
        int wgid = (int)L; { const int q = nwg / 8, r = nwg % 8, xcd = wgid % 8, off = wgid / 8; wgid = (xcd < r ? xcd * (q + 1) : r * (q + 1) + (xcd - r) * q) + off; }
        const int nig = 8 * nN, gid = wgid / nig, fm = gid * 8, gsz = (nM - fm) < 8 ? (nM - fm) : 8;
        int pm = fm + ((wgid % nig) % gsz); const int pn = (wgid % nig) / gsz;
        if (XONLY) pm = (pm >> 3) * 9 + 1 + (pm & 7);
        u.pm = pm; u.pn = pn; u.ex = 0; u.arow0 = pm * 256; u.brow0 = pn * 256; return true;
    }
};
struct MoeSched {
    const int* blke; int nwg, G, c, brows;
    __device__ __forceinline__ void init(const int* blke_, int nblk, int G_, int c_) { blke = blke_; nwg = nblk * 4; G = G_; c = c_; brows = 1024; }
    __device__ __forceinline__ bool next(int i, pg8::Unit& u) const {
        const long L = (long)i * G + c; if (L >= nwg) return false;
        int wgid = (int)L; { const int q = nwg / 8, r = nwg % 8, xcd = wgid % 8, off = wgid / 8; wgid = (xcd < r ? xcd * (q + 1) : r * (q + 1) + (xcd - r) * q) + off; }
        const int blk = wgid >> 2, pn = wgid & 3; const int e = __builtin_amdgcn_readfirstlane(blke[blk]);
        u.pm = blk; u.pn = pn; u.ex = e; u.arow0 = blk * 256; u.brow0 = e * brows + pn * 256; return true;
    }
};

struct EpiStoreBf16 {
    static constexpr bool PERM = true;
    bf16_t* O; int ldc;
    __device__ __forceinline__ void operator()(const f32x4 (&acc)[2][2][4][2], const pg8::Unit& u, int wr, int wc, int fr, int fq) const {
        const int row0 = u.arow0 + wr * 64 + fr, col0 = u.pn * 256 + wc * 32 + 8 * fq;
#pragma unroll
        for (int ai = 0; ai < 2; ++ai)
#pragma unroll
            for (int m = 0; m < 4; ++m) { bf16_t* rowp = O + (size_t)(row0 + ai * 128 + m * 16) * ldc + col0;
#pragma unroll
                for (int bj = 0; bj < 2; ++bj) { const f32x4 v0 = acc[ai][bj][m][0], v1 = acc[ai][bj][m][1];
                    u32x4 w; w.x = cvtpk(v0[0], v0[1]); w.y = cvtpk(v0[2], v0[3]); w.z = cvtpk(v1[0], v1[1]); w.w = cvtpk(v1[2], v1[3]);
                    *(u32x4*)(rowp + bj * 128) = w; } }
    }
};
struct EpiStoreStats {
    static constexpr bool PERM = true;
    bf16_t* O; int ldc; float* stats;
    __device__ __forceinline__ void operator()(const f32x4 (&acc)[2][2][4][2], const pg8::Unit& u, int wr, int wc, int fr, int fq) const {
        const int row0 = u.arow0 + wr * 64 + fr, col0 = u.pn * 256 + wc * 32 + 8 * fq;
#pragma unroll
        for (int ai = 0; ai < 2; ++ai)
#pragma unroll
            for (int m = 0; m < 4; ++m) { const int row = row0 + ai * 128 + m * 16; bf16_t* rowp = O + (size_t)row * ldc + col0;
#pragma unroll
                for (int bj = 0; bj < 2; ++bj) { const f32x4 v0 = acc[ai][bj][m][0], v1 = acc[ai][bj][m][1];
                    u32x4 w; w.x = cvtpk(v0[0], v0[1]); w.y = cvtpk(v0[2], v0[3]); w.z = cvtpk(v1[0], v1[1]); w.w = cvtpk(v1[2], v1[3]);
                    *(u32x4*)(rowp + bj * 128) = w;
                    float s = (v0[0] * v0[0] + v0[1] * v0[1]) + (v0[2] * v0[2] + v0[3] * v0[3]) + (v1[0] * v1[0] + v1[1] * v1[1]) + (v1[2] * v1[2] + v1[3] * v1[3]);
                    s += __shfl_xor(s, 16); s += __shfl_xor(s, 32);
                    if (fq == 0) stats[(size_t)row * 24 + u.pn * 8 + bj * 4 + wc] = s; } }
    }
};
struct EpiResidual {
    static constexpr bool PERM = false;
    const Frame* F; float* dst; int layer; bool from_input;
    __device__ __forceinline__ void operator()(const f32x4 (&acc)[2][2][4][2], const pg8::Unit& u, int wr, int wc, int fr, int fq) const {
        const int b = u.pm / 9, isctx = (u.pm % 9) == 0, mrow = isctx ? 16 : b;
        const float* gate = mod_ptr(*F, layer, mrow, 2);
        const int col0 = u.pn * 256 + wc * 32 + 4 * fq;
        f32x4 gv[2][2];
#pragma unroll
        for (int bj = 0; bj < 2; ++bj)
#pragma unroll
            for (int n = 0; n < 2; ++n) gv[bj][n] = *(const f32x4*)(gate + col0 + bj * 128 + n * 16);
#pragma unroll
        for (int ai = 0; ai < 2; ++ai)
#pragma unroll
            for (int m = 0; m < 4; ++m) { const int row = u.arow0 + ai * 128 + wr * 64 + m * 16 + fr;
                const float* bp = from_input ? input_row(*F, row) : dst + (size_t)row * DM; float* dp = dst + (size_t)row * DM;
#pragma unroll
                for (int bj = 0; bj < 2; ++bj)
#pragma unroll
                    for (int n = 0; n < 2; ++n) { const int c = col0 + bj * 128 + n * 16; const f32x4 bs = *(const f32x4*)(bp + c);
                        *(f32x4*)(dp + c) = bs + gv[bj][n] * acc[ai][bj][m][n]; } }
    }
};
struct EpiSwiglu {
    static constexpr bool PERM = true;
    bf16_t* O;
    __device__ __forceinline__ void operator()(const f32x4 (&acc)[2][2][4][2], const pg8::Unit& u, int wr, int wc, int fr, int fq) const {
        const int row0 = u.arow0 + wr * 64 + fr, col0 = u.pn * 128 + wc * 32 + 8 * fq;
#pragma unroll
        for (int ai = 0; ai < 2; ++ai)
#pragma unroll
            for (int m = 0; m < 4; ++m) { bf16_t* rowp = O + (size_t)(row0 + ai * 128 + m * 16) * MFF + col0;
                float h[8];
#pragma unroll
                for (int n = 0; n < 2; ++n)
#pragma unroll
                    for (int j = 0; j < 4; ++j) h[n * 4 + j] = siluf_(acc[ai][0][m][n][j]) * acc[ai][1][m][n][j];
                u32x4 w; w.x = cvtpk(h[0], h[1]); w.y = cvtpk(h[2], h[3]); w.z = cvtpk(h[4], h[5]); w.w = cvtpk(h[6], h[7]);
                *(u32x4*)rowp = w; }
    }
};
struct EpiScatter {
    static constexpr bool PERM = true;
    bf16_t* O; const int* perm;
    __device__ __forceinline__ void operator()(const f32x4 (&acc)[2][2][4][2], const pg8::Unit& u, int wr, int wc, int fr, int fq) const {
        const int row0 = u.arow0 + wr * 64 + fr, col0 = u.pn * 256 + wc * 32 + 8 * fq;
#pragma unroll
        for (int ai = 0; ai < 2; ++ai)
#pragma unroll
            for (int m = 0; m < 4; ++m) { const int a = perm[row0 + ai * 128 + m * 16];
                if (a >= 0) { bf16_t* rowp = O + (size_t)a * DM + col0;
#pragma unroll
                    for (int bj = 0; bj < 2; ++bj) { const f32x4 v0 = acc[ai][bj][m][0], v1 = acc[ai][bj][m][1];
                        u32x4 w; w.x = cvtpk(v0[0], v0[1]); w.y = cvtpk(v0[2], v0[3]); w.z = cvtpk(v1[0], v1[1]); w.w = cvtpk(v1[2], v1[3]);
                        *(u32x4*)(rowp + bj * 128) = w; } } }
    }
};
struct EpiQ {
    static constexpr bool PERM = false;
    bf16_t* O; const float* stats;
    __device__ __forceinline__ void operator()(const f32x4 (&acc)[2][2][4][2], const pg8::Unit& u, int wr, int wc, int fr, int fq) const {
        float invf[4]; int fq2 = fq; asm volatile("" : "+v"(fq2));
#pragma unroll
        for (int j = 0; j < 4; ++j) invf[j] = __expf(-(float)(4 * fq2 + j) * (2.0f / 32.0f) * 9.210340371976184f);
#pragma unroll
        for (int ai = 0; ai < 2; ++ai)
#pragma unroll
            for (int m = 0; m < 4; ++m) { const int row = u.arow0 + ai * 128 + wr * 64 + m * 16 + fr;
                const float* st = stats + (size_t)row * 24; float ss = 0.f;
#pragma unroll
                for (int q = 0; q < 3; ++q) { const f32x4 s4 = *(const f32x4*)(st + 4 * q); ss += (s4[0] + s4[1]) + (s4[2] + s4[3]); }
                const float sc = __builtin_amdgcn_rsqf(ss * (1.0f / QRANK) + RMS_EPS) * ATT_C2;
                const int t = (row % PB) - CTXL; const float gr = (float)(t >> 6), gc = (float)(t & 63);
#pragma unroll
                for (int bj = 0; bj < 2; ++bj) { const int cg = u.pn * 256 + bj * 128 + wc * 32; const int within = cg % 192;
                    f32x4 v0 = acc[ai][bj][m][0] * sc, v1 = acc[ai][bj][m][1] * sc;
                    if (within >= 128) { const float p = (within == 128) ? gr : gc;
#pragma unroll
                        for (int j = 0; j < 4; ++j) { const float ang = p * invf[j]; const float cs = __cosf(ang), sn = __sinf(ang);
                            const float x1 = v0[j], x2 = v1[j]; v0[j] = x1 * cs - x2 * sn; v1[j] = x1 * sn + x2 * cs; } }
                    bf16_t* rowp = O + (size_t)row * NQ + cg + 4 * fq;
                    u32x2 w0; w0.x = cvtpk(v0[0], v0[1]); w0.y = cvtpk(v0[2], v0[3]); *(u32x2*)rowp = w0;
                    u32x2 w1; w1.x = cvtpk(v1[0], v1[1]); w1.y = cvtpk(v1[2], v1[3]); *(u32x2*)(rowp + 16) = w1; } }
    }
};
struct EpiKV {
    static constexpr bool PERM = true;
    bf16_t* KBp; bf16_t* VBp; const float* stats;
    __device__ __forceinline__ void operator()(const f32x4 (&acc)[2][2][4][2], const pg8::Unit& u, int wr, int wc, int fr, int fq) const {
        const int h = u.pn, c0 = wc * 32 + 8 * fq;
#pragma unroll
        for (int ai = 0; ai < 2; ++ai)
#pragma unroll
            for (int m = 0; m < 4; ++m) { const int row = u.arow0 + ai * 128 + wr * 64 + m * 16 + fr;
                const float* st = stats + (size_t)row * 24 + 12; const f32x4 s0 = *(const f32x4*)st, s1 = *(const f32x4*)(st + 4);
                const float ss = ((s0[0] + s0[1]) + (s0[2] + s0[3])) + ((s1[0] + s1[1]) + (s1[2] + s1[3]));
                const float sc = __builtin_amdgcn_rsqf(ss * (1.0f / KVRANK) + RMS_EPS);
#pragma unroll
                for (int bj = 0; bj < 2; ++bj) { const f32x4 v0 = acc[ai][bj][m][0] * sc, v1 = acc[ai][bj][m][1] * sc;
                    u32x4 w; w.x = cvtpk(v0[0], v0[1]); w.y = cvtpk(v0[2], v0[3]); w.z = cvtpk(v1[0], v1[1]); w.w = cvtpk(v1[2], v1[3]);
                    bf16_t* p = bj == 0 ? KBp + (size_t)row * NQ + h * 192 + c0 : VBp + (size_t)row * DM + h * 128 + c0;
                    *(u32x4*)p = w; } }
    }
};

__device__ __forceinline__ void tr_item(const float* W, int K, int N, bf16_t* WT, bool gu, const float* kscale, LAS float* scr, int item, int lane) {
    const int nblk = N / 64, kb = item / nblk, nb = item % nblk, k0 = 64 * kb, n0 = 64 * nb;
    f32x4 v[16];
#pragma unroll
    for (int i = 0; i < 16; ++i) v[i] = *(const f32x4*)(W + (size_t)(k0 + 4 * i + (lane >> 4)) * N + n0 + 4 * (lane & 15));
#pragma unroll
    for (int i = 0; i < 16; ++i) { const int kk = 4 * i + (lane >> 4); f32x4 w = v[i]; if (kscale) w = w * kscale[k0 + kk]; LAS float* p = scr + kk * 65 + 4 * (lane & 15); p[0] = w[0]; p[1] = w[1]; p[2] = w[2]; p[3] = w[3]; }
    LDS_WAIT(); asm volatile("" ::: "memory");
    int d0 = n0;
    if (gu) { const int i0 = n0 & 511; d0 = 256 * (i0 >> 7) + (n0 >= 512 ? 128 : 0) + (i0 & 127); }
    const int c = lane & 7;
#pragma unroll
    for (int j = 0; j < 8; ++j) { const int n = (lane >> 3) + 8 * j; const LAS float* sp = scr + (8 * c) * 65 + n;
        u32x4 o; o.x = pk2(sp[0 * 65], sp[1 * 65]); o.y = pk2(sp[2 * 65], sp[3 * 65]); o.z = pk2(sp[4 * 65], sp[5 * 65]); o.w = pk2(sp[6 * 65], sp[7 * 65]);
        *(u32x4*)(WT + (size_t)(d0 + n) * K + k0 + 8 * c) = o; }
    LDS_WAIT(); asm volatile("" ::: "memory");
}
__device__ __forceinline__ void p0_prologue(Frame& F) {
    __syncthreads();

    LAS float* S = (LAS float*)F.lds;
    for (int idx = F.tid; idx < 17 * DM; idx += 512) { const int r = idx >> 10, k = idx & 1023; const float cv = r < 16 ? F.ka->in[I_C][r * DM + k] : F.ka->in[I_CCTX][k]; S[k * 20 + r] = siluf_(cv); }
    __syncthreads();
    const int gw = F.vcu * 8 + F.wave, NGW = F.G * 8;
    float* part = (float*)(F.ws + WS_PART);
    for (int it = gw; it < 2 * 8 * 96; it += NGW) {
        const int l = it / 768, rem = it % 768, kc = rem / 96, slab = rem % 96, n0 = slab * 64;
        const float* w = F.ka->in[I_ADAW] + ((size_t)l * DM + kc * 128) * 6144 + n0 + F.lane;
        float acc[17];
#pragma unroll
        for (int r = 0; r < 17; ++r) acc[r] = 0.f;
#pragma unroll 4
        for (int kk = 0; kk < 128; ++kk) {
            const float wv = w[(size_t)kk * 6144];
            const LAS float* s = S + (kc * 128 + kk) * 20;
            const f32x4 s0 = *(const LAS f32x4*)s, s1 = *(const LAS f32x4*)(s + 4), s2 = *(const LAS f32x4*)(s + 8), s3 = *(const LAS f32x4*)(s + 12); const float s4 = s[16];
            acc[0] += s0[0] * wv; acc[1] += s0[1] * wv; acc[2] += s0[2] * wv; acc[3] += s0[3] * wv;
            acc[4] += s1[0] * wv; acc[5] += s1[1] * wv; acc[6] += s1[2] * wv; acc[7] += s1[3] * wv;
            acc[8] += s2[0] * wv; acc[9] += s2[1] * wv; acc[10] += s2[2] * wv; acc[11] += s2[3] * wv;
            acc[12] += s3[0] * wv; acc[13] += s3[1] * wv; acc[14] += s3[2] * wv; acc[15] += s3[3] * wv; acc[16] += s4 * wv;
        }
#pragma unroll
        for (int r = 0; r < 17; ++r) part[((size_t)(l * 8 + kc) * 17 + r) * 6144 + n0 + F.lane] = acc[r];
    }
    __syncthreads();
    LAS float* scr = (LAS float*)(F.lds + F.wave * 16640);
    constexpr int I_A = 16 * 56, I_B = 16 * 16, I_C2 = 16 * 11, I_D = 6 * 24, I_E = 4 * 32, I_F = 16 * 16, I_GU = 16 * 16, I_DN = 8 * 16;
    constexpr int NITEMS = I_A + I_B + I_C2 + I_D + I_E + I_F + 64 * I_GU + 64 * I_DN;
    for (int it = gw; it < NITEMS; it += NGW) {
        int r = it;
        if (r < I_A) { tr_item(F.ka->in[I_EVWIN], DM, EVIN, (bf16_t*)(F.ws + WS_WIN0), false, nullptr, scr, r, F.lane); continue; } r -= I_A;
        if (r < I_B) { tr_item(F.ka->in[I_EVWOUT], DM, DM, (bf16_t*)(F.ws + WS_WOUT0), false, nullptr, scr, r, F.lane); continue; } r -= I_B;
        if (r < I_C2) { tr_item(F.ka->in[I_ODWIN], DM, CIN, (bf16_t*)(F.ws + WS_WIN1), false, nullptr, scr, r, F.lane); continue; } r -= I_C2;
        if (r < I_D) { tr_item(F.ka->in[I_ODWUQ], QRANK, NQ, (bf16_t*)(F.ws + WS_WUQ), false, F.ka->in[I_ODQG], scr, r, F.lane); continue; } r -= I_D;
        if (r < I_E) { tr_item(F.ka->in[I_ODWUKV], KVRANK, NKV, (bf16_t*)(F.ws + WS_WUKV), false, F.ka->in[I_ODKVG], scr, r, F.lane); continue; } r -= I_E;
        if (r < I_F) { tr_item(F.ka->in[I_ODWOUT], DM, DM, (bf16_t*)(F.ws + WS_WOUT1), false, nullptr, scr, r, F.lane); continue; } r -= I_F;
        if (r < 64 * I_GU) { const int e = r / I_GU; tr_item(F.ka->in[I_MGU] + (size_t)e * DM * 1024, DM, 1024, (bf16_t*)(F.ws + WS_WGU) + (size_t)e * 1024 * DM, true, nullptr, scr, r % I_GU, F.lane); continue; } r -= 64 * I_GU;
        { const int e = r / I_DN; tr_item(F.ka->in[I_MDN] + (size_t)e * MFF * DM, MFF, DM, (bf16_t*)(F.ws + WS_WDN) + (size_t)e * DM * MFF, false, nullptr, scr, r % I_DN, F.lane); }
    }
}
__device__ __forceinline__ void p0b_mod(Frame& F) {
    const float* part = (const float*)(F.ws + WS_PART); float* mod = (float*)(F.ws + WS_MOD);
    const int gt = F.vcu * 512 + F.tid, NGT = F.G * 512;
    for (int idx = gt; idx < 2 * 17 * 6144; idx += NGT) {
        const int l = idx / (17 * 6144), rem = idx % (17 * 6144), r = rem / 6144, n = rem % 6144;
        float s = F.ka->in[I_ADAB][l * 6144 + n];
#pragma unroll
        for (int kc = 0; kc < 8; ++kc) s += part[((size_t)(l * 8 + kc) * 17 + r) * 6144 + n];
        mod[idx] = s;
    }
}

__device__ __forceinline__ void load_row4(const float* p, int lane, f32x4 (&v)[4]) {
#pragma unroll
    for (int j = 0; j < 4; ++j) v[j] = *(const f32x4*)(p + 4 * lane + 256 * j);
}
__device__ __forceinline__ float sumsq4(const f32x4 (&v)[4]) {
    float s = 0.f;
#pragma unroll
    for (int j = 0; j < 4; ++j) s += (v[j][0] * v[j][0] + v[j][1] * v[j][1]) + (v[j][2] * v[j][2] + v[j][3] * v[j][3]);
    return wave_sum(s);
}
__device__ __forceinline__ void norm_mod4(f32x4 (&v)[4], const float* g, const float* shift, const float* scale, int lane) {
    const float rstd = __builtin_amdgcn_rsqf(sumsq4(v) * (1.0f / DM) + RMS_EPS);
#pragma unroll
    for (int j = 0; j < 4; ++j) { const int c = 4 * lane + 256 * j; const f32x4 gg = *(const f32x4*)(g + c), sh = *(const f32x4*)(shift + c), sc = *(const f32x4*)(scale + c);
        v[j] = v[j] * rstd * gg * (sc + 1.0f) + sh; }
}
__device__ __forceinline__ void store_row_bf16(bf16_t* p, int lane, const f32x4 (&v)[4]) {
#pragma unroll
    for (int j = 0; j < 4; ++j) { u32x2 w; w.x = cvtpk(v[j][0], v[j][1]); w.y = cvtpk(v[j][2], v[j][3]); *(u32x2*)(p + 4 * lane + 256 * j) = w; }
}
__device__ __forceinline__ void moe_combine4(Frame& F, int row, int layer, int mrow, f32x4 (&v)[4]) {
    const bf16_t* ys = (const bf16_t*)(F.ws + WS_YS) + (size_t)(2 * row) * DM; const float* aw = (const float*)(F.ws + WS_ROUTE + RT_AW);
    const float w0 = aw[2 * row], w1 = aw[2 * row + 1]; const float* gate = mod_ptr(F, layer, mrow, 5);
#pragma unroll
    for (int j = 0; j < 4; ++j) { const int c = 4 * F.lane + 256 * j; const u32x2 y0 = *(const u32x2*)(ys + c), y1 = *(const u32x2*)(ys + DM + c); const f32x4 gg = *(const f32x4*)(gate + c);
        f32x4 y; y[0] = w0 * bflo(y0.x) + w1 * bflo(y1.x); y[1] = w0 * bfhi(y0.x) + w1 * bfhi(y1.x); y[2] = w0 * bflo(y0.y) + w1 * bflo(y1.y); y[3] = w0 * bfhi(y0.y) + w1 * bfhi(y1.y);
        v[j] = v[j] + gg * y; }
}
__device__ __forceinline__ void p1_norm_input(Frame& F) {
    const int gw = F.vcu * 8 + F.wave, NGW = F.G * 8; bf16_t* hx = (bf16_t*)(F.ws + WS_HX);
    for (int row = gw; row < R; row += NGW) {
        const int b = row / PB, pos = row - b * PB, mrow = pos < CTXL ? 16 : b;
        f32x4 v[4]; load_row4(input_row(F, row), F.lane, v);
        norm_mod4(v, F.ka->in[I_NMIXG], mod_ptr(F, 0, mrow, 0), mod_ptr(F, 0, mrow, 1), F.lane);
        store_row_bf16(hx + (size_t)row * DM, F.lane, v);
    }
}
__device__ __forceinline__ void p8_combine_norm(Frame& F) {
    const int gw = F.vcu * 8 + F.wave, NGW = F.G * 8; bf16_t* hx = (bf16_t*)(F.ws + WS_HX); float* xs = (float*)(F.ws + WS_XS);
    for (int row = gw; row < R; row += NGW) {
        const int b = row / PB, pos = row - b * PB, mrow = pos < CTXL ? 16 : b;
        f32x4 v[4]; load_row4(xs + (size_t)row * DM, F.lane, v);
        moe_combine4(F, row, 0, mrow, v);
#pragma unroll
        for (int j = 0; j < 4; ++j) *(f32x4*)(xs + (size_t)row * DM + 4 * F.lane + 256 * j) = v[j];
        norm_mod4(v, F.ka->in[I_NMIXG] + DM, mod_ptr(F, 1, mrow, 0), mod_ptr(F, 1, mrow, 1), F.lane);
        store_row_bf16(hx + (size_t)row * DM, F.lane, v);
    }
}
__device__ __forceinline__ void p16_final(Frame& F) {
    const int gw = F.vcu * 8 + F.wave, NGW = F.G * 8; const float* xs = (const float*)(F.ws + WS_XS);
    for (int row = gw; row < R; row += NGW) {
        const int b = row / PB, pos = row - b * PB; if (pos < CTXL) continue;
        f32x4 v[4];
        if (DBG_MODE >= 10) {
            const bf16_t* hx = (const bf16_t*)(F.ws + WS_HX) + (size_t)row * DM; const bf16_t* px = (const bf16_t*)(F.ws + WS_PX0) + (size_t)row * EVIN; const bf16_t* mx = (const bf16_t*)(F.ws + WS_MIX) + (size_t)row * DM;
#pragma unroll
            for (int j = 0; j < 4; ++j)
#pragma unroll
                for (int e = 0; e < 4; ++e) { const int c = 4 * F.lane + 256 * j + e;
                    v[j][e] = DBG_MODE == 10 ? bf2f(hx[c]) : DBG_MODE == 11 ? bf2f(px[c]) + bf2f(px[1024 + c]) + bf2f(px[2048 + c]) + bf2f(px[3072 + (c & 511)]) : bf2f(mx[c]); }
        } else load_row4(DBG_MODE == 1 ? input_row(F, row) : xs + (size_t)row * DM, F.lane, v);
        if (DBG_MODE == 0) moe_combine4(F, row, 1, b, v);
        const float rstd = __builtin_amdgcn_rsqf(sumsq4(v) * (1.0f / DM) + RMS_EPS);
        float* o = F.out + ((size_t)b * SEQ + (pos - CTXL)) * DM;
#pragma unroll
        for (int j = 0; j < 4; ++j) { const int c = 4 * F.lane + 256 * j; const f32x4 gg = *(const f32x4*)(F.ka->in[I_FING] + c); *(f32x4*)(o + c) = v[j] * rstd * gg; }
    }
}

template <bool XONLY>
__device__ __forceinline__ void p5_norm_route(Frame& F, int layer) {

    LAS float* W1L = (LAS float*)F.lds; LAS float* W2L = W1L + 4096;
    volatile LAS int* lcnt = (volatile LAS int*)(F.lds + LDSCTL_OFF + 64);
    const float* wr1 = F.ka->in[I_MR1W] + (size_t)layer * DM * 4; const float* wr2 = F.ka->in[I_MR2W] + (size_t)layer * 4 * DM * 8;
    for (int k = F.tid; k < DM; k += 512) { const int l = (k & 255) >> 2, j = k >> 8, e = k & 3; *(LAS f32x4*)(W1L + ((j * 4 + e) * 64 + l) * 4) = *(const f32x4*)(wr1 + k * 4); }
    for (int idx = F.tid; idx < 4 * DM * 2; idx += 512) { const int half = idx & 1, k = (idx >> 1) & 1023, g = idx >> 11; const int l = (k & 255) >> 2, j = k >> 8, e = k & 3;
        *(LAS f32x4*)(W2L + ((((g * 16 + j * 4 + e) * 2 + half) * 64) + l) * 4) = *(const f32x4*)(wr2 + ((size_t)g * DM + k) * 8 + half * 4); }
    if (F.tid < 32) lcnt[F.tid] = 0;
    __syncthreads();
    const int gw = F.vcu * 8 + F.wave, NGW = F.G * 8; bf16_t* hx = (bf16_t*)(F.ws + WS_HX); const float* xs = (const float*)(F.ws + WS_XS);
    int* ae = (int*)(F.ws + WS_ROUTE + RT_AE); int* ap = (int*)(F.ws + WS_ROUTE + RT_AP); float* aw = (float*)(F.ws + WS_ROUTE + RT_AW);
    const float* b1 = F.ka->in[I_MR1B] + layer * 4; const float* b2 = F.ka->in[I_MR2B] + layer * 32;
    for (int row = gw; row < R; row += NGW) {
        const int b = row / PB, pos = row - b * PB; if (XONLY && pos < CTXL) continue;
        const int mrow = pos < CTXL ? 16 : b;
        f32x4 v[4]; load_row4(xs + (size_t)row * DM, F.lane, v);
        norm_mod4(v, F.ka->in[I_NFFNG] + layer * DM, mod_ptr(F, layer, mrow, 3), mod_ptr(F, layer, mrow, 4), F.lane);
        store_row_bf16(hx + (size_t)row * DM, F.lane, v);
        f32x4 l1 = {0.f, 0.f, 0.f, 0.f};
#pragma unroll
        for (int j = 0; j < 4; ++j)
#pragma unroll
            for (int e = 0; e < 4; ++e) l1 += *(const LAS f32x4*)(W1L + ((j * 4 + e) * 64 + F.lane) * 4) * v[j][e];
        float g0 = wave_sum(l1[0]) + b1[0], g1 = wave_sum(l1[1]) + b1[1], g2 = wave_sum(l1[2]) + b1[2], g3 = wave_sum(l1[3]) + b1[3];
        int grp = 0; float gm = g0;
        if (g1 > gm) { gm = g1; grp = 1; } if (g2 > gm) { gm = g2; grp = 2; } if (g3 > gm) { gm = g3; grp = 3; }
        grp = __builtin_amdgcn_readfirstlane(grp);
        const float pg = 1.0f / (__expf(g0 - gm) + __expf(g1 - gm) + __expf(g2 - gm) + __expf(g3 - gm));
        f32x4 la = {0.f, 0.f, 0.f, 0.f}, lb = {0.f, 0.f, 0.f, 0.f};
        const LAS float* w2 = W2L + grp * 16 * 2 * 64 * 4;
#pragma unroll
        for (int j = 0; j < 4; ++j)
#pragma unroll
            for (int e = 0; e < 4; ++e) { const LAS float* p = w2 + (((j * 4 + e) * 2) * 64 + F.lane) * 4; la += *(const LAS f32x4*)p * v[j][e]; lb += *(const LAS f32x4*)(p + 256) * v[j][e]; }
        float lg[8];
#pragma unroll
        for (int q = 0; q < 4; ++q) { lg[q] = wave_sum(la[q]) + b2[grp * 8 + q]; lg[4 + q] = wave_sum(lb[q]) + b2[grp * 8 + 4 + q]; }
        int e0 = 0; float m0 = lg[0];
#pragma unroll
        for (int q = 1; q < 8; ++q) if (lg[q] > m0) { m0 = lg[q]; e0 = q; }
        int e1 = -1; float m1 = -3.0e38f;
#pragma unroll
        for (int q = 0; q < 8; ++q) if (q != e0 && lg[q] > m1) { m1 = lg[q]; e1 = q; }
        const float pb = __expf(m1 - m0), inv = pg / (1.0f + pb);
        if (F.lane < 2) {
            const int ex = grp * 8 + (F.lane == 0 ? e0 : e1);
            const int lp = __hip_atomic_fetch_add((LAS int*)lcnt + ex, 1, __ATOMIC_RELAXED, __HIP_MEMORY_SCOPE_WORKGROUP);
            const int a = 2 * row + F.lane; ae[a] = ex; ap[a] = lp; aw[a] = F.lane == 0 ? inv : inv * pb;
        }
    }
    __syncthreads();
    if (F.tid < 32) ((int*)(F.ws + WS_ROUTE + RT_CNTB))[F.vcu * 32 + F.tid] = lcnt[F.tid];
}
template <bool XONLY>
__device__ __forceinline__ void p5b_perm(Frame& F) {
    LAS int* seg = (LAS int*)F.lds;
    LAS int* mypre = seg + 512;
    LAS int* tot = mypre + 32;
    LAS int* base = tot + 32;
    LAS int* pst = base + 32;
    const int* cntb = (const int*)(F.ws + WS_ROUTE + RT_CNTB);
    { const int e = F.tid & 31, sg = F.tid >> 5; int s = 0, pre = 0;
      for (int i = 0; i < 16; ++i) { const int B = sg * 16 + i; const int c = cntb[B * 32 + e]; if (B < F.vcu) pre += c; s += c; }
      seg[sg * 32 + e] = s; if (sg == (F.vcu >> 4)) mypre[e] = pre; }
    __syncthreads();
    if (F.tid < 32) { int t = 0, bs = 0; for (int sg = 0; sg < 16; ++sg) { const int s = seg[sg * 32 + F.tid]; if (sg < (F.vcu >> 4)) bs += s; t += s; } tot[F.tid] = t; base[F.tid] = bs + mypre[F.tid]; }
    __syncthreads();
    if (F.tid == 0) { int ps = 0; for (int e = 0; e < 32; ++e) { pst[e] = ps; ps += ((tot[e] + 255) >> 8) << 8; } pst[32] = ps; }
    __syncthreads();
    const int gw = F.vcu * 8 + F.wave, NGW = F.G * 8;
    const int* ae = (const int*)(F.ws + WS_ROUTE + RT_AE); const int* ap = (const int*)(F.ws + WS_ROUTE + RT_AP); int* perm = (int*)(F.ws + WS_ROUTE + RT_PERM);
    for (int row = gw; row < R; row += NGW) {
        const int b = row / PB, pos = row - b * PB; if (XONLY && pos < CTXL) continue;
        if (F.lane < 2) { const int a = 2 * row + F.lane; const int e = ae[a]; perm[pst[e] + base[e] + ap[a]] = a; }
    }
    if (F.vcu < 32) { const int e = F.vcu; for (int s = pst[e] + tot[e] + F.tid; s < pst[e + 1]; s += 512) perm[s] = -1; }
    if (F.vcu == 0) { int* blke = (int*)(F.ws + WS_ROUTE + RT_BLKE);
        if (F.tid < 32) { const int e = F.tid; for (int blk = pst[e] >> 8; blk < (pst[e + 1] >> 8); ++blk) blke[blk] = e; }
        if (F.tid == 0) *(int*)(F.ws + WS_ROUTE + RT_NBLK) = pst[32] >> 8; }
}

__device__ __forceinline__ bf16x8 lds_frag256(const LAS unsigned char* base, int row, int chunk) { return *(const LAS bf16x8*)(base + row * 256 + ((chunk ^ (row & 7)) << 4)); }
__device__ __forceinline__ bf16x8 lds_frag128(const LAS unsigned char* base, int row, int chunk) { return *(const LAS bf16x8*)(base + row * 128 + ((chunk ^ (row & 7)) << 4)); }
#define MFMA16(a, b, c) __builtin_amdgcn_mfma_f32_16x16x32_bf16((a), (b), (c), 0, 0, 0)

typedef short v4i16_t __attribute__((ext_vector_type(4)));
__device__ __forceinline__ int trswz256(int r, int cb) { return r * 256 + (cb ^ (((r & 3) | ((r >> 1) & 4)) << 5)); }
__device__ __forceinline__ int trswz128(int r, int cb) { return r * 128 + (cb ^ ((((r >> 1) & 1) | ((r >> 2) & 2)) << 5)); }
template <int ROWB> __device__ __forceinline__ bf16x8 lds_trfrag(const LAS unsigned char* tile, int s0, int c0, int lane) {
    const int i = lane & 15, r0 = s0 + (i >> 2), r1 = r0 + 4, cb = (c0 + 4 * (i & 3)) * 2;
    const int a0 = ROWB == 256 ? trswz256(r0, cb) : trswz128(r0, cb), a1 = ROWB == 256 ? trswz256(r1, cb) : trswz128(r1, cb);
    const v4i16_t lo = __builtin_amdgcn_ds_read_tr16_b64_v4i16((LAS v4i16_t*)(tile + a0)), hi = __builtin_amdgcn_ds_read_tr16_b64_v4i16((LAS v4i16_t*)(tile + a1));
    return (bf16x8){lo[0], lo[1], lo[2], lo[3], hi[0], hi[1], hi[2], hi[3]};
}
__device__ __forceinline__ void gla_item(Frame& F, int item) {
    const int b = item >> 4, h = (item >> 2) & 3, dir = (item >> 1) & 1, vh = item & 1;
    LAS unsigned char* QD = F.lds; LAS unsigned char* KD = F.lds + 16384; LAS unsigned char* KT = F.lds + 32768  ; LAS unsigned char* VR = F.lds + 49152  ;
    LAS unsigned char* PS = F.lds + 57344; LAS unsigned char* ST = F.lds + 65536; LAS float* LF = (LAS float*)(F.lds + 81920); LAS float* SEGT = (LAS float*)(F.lds + 114688); LAS float* DEC = (LAS float*)(F.lds + 116736);
    const int tid = F.tid, lane = F.lane, wave = F.wave, fr = lane & 15, fq = lane >> 4;
    const int t0 = tid >> 4, c = tid & 15, tv = tid >> 3, cv = tid & 7;
    const bf16_t* px = (const bf16_t*)(F.ws + WS_PX0);
    bf16_t* og = (bf16_t*)(F.ws + WS_OG) + (size_t)dir * R * 512;
    float lbv[8], oml[8];
    { const float* lg = F.ka->in[I_EVLB] + h * 128 + 8 * c;
#pragma unroll
      for (int e = 0; e < 8; ++e) { lbv[e] = 1.0f / (1.0f + __expf(lg[512 + e] - lg[e])); oml[e] = 1.0f - lbv[e]; } }
    { u32x4 z = {0u, 0u, 0u, 0u}; *(LAS u32x4*)(ST + tid * 32) = z; *(LAS u32x4*)(ST + tid * 32 + 16) = z; }
    f32x4 S[4];
#pragma unroll
    for (int i = 0; i < 4; ++i) S[i] = (f32x4){0.f, 0.f, 0.f, 0.f};
    auto chunk_p0 = [&](int j) { return dir == 0 ? 64 * j : (j < 4 ? 192 - 64 * j : PB - 64 * (j - 3)); };
    auto row_of = [&](int p0, int tau) { return b * PB + (dir == 0 ? p0 + tau : p0 + 63 - tau); };
    u32x4 rqA[2], rfA[2], rvA, rqB[2], rfB[2], rvB;
#define GLA_LOAD(j, RQ, RF, RV) do { const int p0_ = chunk_p0(j); \
        _Pragma("unroll") for (int i_ = 0; i_ < 2; ++i_) { const bf16_t* rp_ = px + (size_t)row_of(p0_, t0 + 32 * i_) * EVIN + h * 128 + 8 * c; RQ[i_] = *(const u32x4*)rp_; RF[i_] = *(const u32x4*)(rp_ + 512 * (1 + dir)); } \
        RV = *(const u32x4*)(px + (size_t)row_of(p0_, tv) * EVIN + 1536 + h * 128 + vh * 64 + 8 * cv); } while (0)
    GLA_LOAD(0, rqA, rfA, rvA); GLA_LOAD(1, rqB, rfB, rvB);
    __syncthreads();
    const int ti = wave & 3, sp = wave >> 2, ki = wave;
#define GLA_STEP(j, RQ, RF, RV) do { \
        const int p0 = chunk_p0(j); float qv[2][8], kv[2][8]; const u32x4 vraw = RV; \
        _Pragma("unroll") for (int i = 0; i < 2; ++i) { const int tau = t0 + 32 * i; float lf[8]; \
            _Pragma("unroll") for (int e = 0; e < 4; ++e) { const unsigned wq = RQ[i][e], wf = RF[i][e]; \
                qv[i][2 * e] = bflo(wq); qv[i][2 * e + 1] = bfhi(wq); \
                const float s0_ = sigmoidf_(bflo(wf)), s1_ = sigmoidf_(bfhi(wf)); \
                const float f0 = lbv[2 * e] + oml[2 * e] * s0_, f1 = lbv[2 * e + 1] + oml[2 * e + 1] * s1_; \
                kv[i][2 * e] = 1.0f - f0; kv[i][2 * e + 1] = 1.0f - f1; lf[2 * e] = lg2(f0); lf[2 * e + 1] = lg2(f1); } \
            *(LAS f32x4*)(LF + tau * 128 + 8 * c) = (f32x4){lf[0], lf[1], lf[2], lf[3]}; *(LAS f32x4*)(LF + tau * 128 + 8 * c + 4) = (f32x4){lf[4], lf[5], lf[6], lf[7]}; } \
        if ((j) + 2 < 36) GLA_LOAD((j) + 2, RQ, RF, RV); \
        __syncthreads(); \
        { const int k = tid & 127, sg = tid >> 7; float run = 0.f; \
          _Pragma("unroll") for (int i = 0; i < 16; ++i) { const int idx = (16 * sg + i) * 128 + k; run += LF[idx]; LF[idx] = run; } \
          SEGT[sg * 128 + k] = run; } \
        __syncthreads(); \
        { float seg[4][8]; float ebl[8]; \
          _Pragma("unroll") for (int s = 0; s < 4; ++s) { const f32x4 a0 = *(const LAS f32x4*)(SEGT + s * 128 + 8 * c), a1 = *(const LAS f32x4*)(SEGT + s * 128 + 8 * c + 4); \
              _Pragma("unroll") for (int e = 0; e < 4; ++e) { seg[s][e] = a0[e]; seg[s][4 + e] = a1[e]; } } \
          float offr[2][8]; const bool odd = (t0 >> 4) != 0; \
          _Pragma("unroll") for (int e = 0; e < 8; ++e) { ebl[e] = ex2((seg[0][e] + seg[1][e]) + (seg[2][e] + seg[3][e])); offr[0][e] = odd ? seg[0][e] : 0.f; offr[1][e] = (seg[0][e] + seg[1][e]) + (odd ? seg[2][e] : 0.f); } \
          _Pragma("unroll") for (int i = 0; i < 2; ++i) { const int tau = t0 + 32 * i; \
              const f32x4 c0 = *(const LAS f32x4*)(LF + tau * 128 + 8 * c), c1 = *(const LAS f32x4*)(LF + tau * 128 + 8 * c + 4); \
              float qd[8], kd[8], kt[8]; \
              _Pragma("unroll") for (int e = 0; e < 8; ++e) { \
                  const float bb = (e < 4 ? c0[e] : c1[e - 4]) + offr[i][e]; const float eb = ex2(bb); \
                  qd[e] = qv[i][e] * eb; kd[e] = kv[i][e] * __builtin_amdgcn_rcpf(eb); kt[e] = kd[e] * ebl[e]; } \
              u32x4 w; w.x = cvtpk(qd[0], qd[1]); w.y = cvtpk(qd[2], qd[3]); w.z = cvtpk(qd[4], qd[5]); w.w = cvtpk(qd[6], qd[7]); \
              *(LAS u32x4*)(QD + tau * 256 + ((c ^ (tau & 7)) << 4)) = w; \
              w.x = cvtpk(kd[0], kd[1]); w.y = cvtpk(kd[2], kd[3]); w.z = cvtpk(kd[4], kd[5]); w.w = cvtpk(kd[6], kd[7]); \
              *(LAS u32x4*)(KD + tau * 256 + ((c ^ (tau & 7)) << 4)) = w; \
              w.x = cvtpk(kt[0], kt[1]); w.y = cvtpk(kt[2], kt[3]); w.z = cvtpk(kt[4], kt[5]); w.w = cvtpk(kt[6], kt[7]); \
              *(LAS u32x4*)(KT + trswz256(tau, 16 * c)) = w; } \
          *(LAS u32x4*)(VR + trswz128(tv, 16 * cv)) = vraw; \
          if (tid < 128) DEC[tid] = ex2((SEGT[tid] + SEGT[128 + tid]) + (SEGT[256 + tid] + SEGT[384 + tid])); } \
        __syncthreads(); \
        bf16x8 bq[4]; \
        _Pragma("unroll") for (int ks = 0; ks < 4; ++ks) bq[ks] = lds_frag256(QD, 16 * ti + fr, ks * 4 + fq); \
        f32x4 oacc[2]; \
        _Pragma("unroll") for (int u = 0; u < 2; ++u) { const int si = 2 * sp + u; f32x4 a = {0.f, 0.f, 0.f, 0.f}; \
            _Pragma("unroll") for (int ks = 0; ks < 4; ++ks) a = MFMA16(lds_frag256(KD, 16 * si + fr, ks * 4 + fq), bq[ks], a); \
            const int tt = 16 * ti + fr, s0 = 16 * si + 4 * fq; \
            u32x2 w; w.x = cvtpk(s0 <= tt ? a[0] : 0.f, s0 + 1 <= tt ? a[1] : 0.f); w.y = cvtpk(s0 + 2 <= tt ? a[2] : 0.f, s0 + 3 <= tt ? a[3] : 0.f); \
            *(LAS u32x2*)(PS + tt * 128 + ((2 * s0) ^ ((tt & 7) << 4))) = w; \
            const int vi = 2 * sp + u; f32x4 o = {0.f, 0.f, 0.f, 0.f}; \
            _Pragma("unroll") for (int ks = 0; ks < 4; ++ks) o = MFMA16(lds_frag256(ST, 16 * vi + fr, ks * 4 + fq), bq[ks], o); \
            oacc[u] = o; } \
        bf16x8 vfr[4][2]; \
        _Pragma("unroll") for (int vi = 0; vi < 4; ++vi) _Pragma("unroll") for (int ks = 0; ks < 2; ++ks) vfr[vi][ks] = lds_trfrag<128>(VR, 32 * ks + 8 * fq, 16 * vi, lane); \
        { const f32x4 dk = *(const LAS f32x4*)(DEC + 16 * ki + 4 * fq); \
          bf16x8 ak[2]; \
          _Pragma("unroll") for (int ks = 0; ks < 2; ++ks) ak[ks] = lds_trfrag<256>(KT, 32 * ks + 8 * fq, 16 * ki, lane); \
          _Pragma("unroll") for (int vi = 0; vi < 4; ++vi) { f32x4 s = S[vi] * dk; \
              _Pragma("unroll") for (int ks = 0; ks < 2; ++ks) s = MFMA16(ak[ks], vfr[vi][ks], s); \
              S[vi] = s; } } \
        __syncthreads(); \
        { bf16x8 bp[2]; \
          _Pragma("unroll") for (int ks = 0; ks < 2; ++ks) bp[ks] = lds_frag128(PS, 16 * ti + fr, ks * 4 + fq); \
          const int orow = row_of(p0, 16 * ti + fr); \
          _Pragma("unroll") for (int u = 0; u < 2; ++u) { const int vi = 2 * sp + u; f32x4 o = oacc[u]; \
              _Pragma("unroll") for (int ks = 0; ks < 2; ++ks) o = MFMA16(sp == 0 ? vfr[u][ks] : vfr[2 + u][ks], bp[ks], o); \
              u32x2 w; w.x = cvtpk(o[0], o[1]); w.y = cvtpk(o[2], o[3]); \
              *(u32x2*)(og + (size_t)orow * 512 + h * 128 + vh * 64 + 16 * vi + 4 * fq) = w; } \
          _Pragma("unroll") for (int vi = 0; vi < 4; ++vi) { const int v = 16 * vi + fr, k0 = 16 * ki + 4 * fq; u32x2 w; w.x = cvtpk(S[vi][0], S[vi][1]); w.y = cvtpk(S[vi][2], S[vi][3]); \
              *(LAS u32x2*)(ST + v * 256 + ((2 * k0) ^ ((v & 7) << 4))) = w; } } \
    } while (0)
    for (int j = 0; j < 36; j += 2) { GLA_STEP(j, rqA, rfA, rvA); GLA_STEP(j + 1, rqB, rfB, rvB); }
    __syncthreads();
#undef GLA_LOAD
#undef GLA_STEP
}

__device__ __forceinline__ void sgu_item(Frame& F, int ci) {
    LAS unsigned char* VNT = F.lds; LAS unsigned char* WS = F.lds + 32768;
    const int tid = F.tid, lane = F.lane, wave = F.wave, fr = lane & 15, fq = lane >> 4;
    const int r0 = ci * 128, row = tid >> 2, q = tid & 3;
    const bf16_t* px = (const bf16_t*)(F.ws + WS_PX0); bf16_t* mix = (bf16_t*)(F.ws + WS_MIX);
    const bf16_t* vrow = px + (size_t)(r0 + row) * EVIN + 3072;
    float sum = 0.f, sq = 0.f;
#pragma unroll 4
    for (int i = 0; i < 16; ++i) { const u32x4 w = *(const u32x4*)(vrow + 128 * q + 8 * i);
#pragma unroll
        for (int e = 0; e < 4; ++e) { const float a = geluf_(bflo(w[e])), bb = geluf_(bfhi(w[e])); sum += a + bb; sq += a * a + bb * bb; } }
    sum += __shfl_xor(sum, 1); sum += __shfl_xor(sum, 2); sq += __shfl_xor(sq, 1); sq += __shfl_xor(sq, 2);
    const float mean = sum * (1.0f / 512.0f), rstd = __builtin_amdgcn_rsqf(fmaxf(sq * (1.0f / 512.0f) - mean * mean, 0.f) + RMS_EPS);
    for (int g = 0; g < 4; ++g) {
        const float* gain = F.ka->in[I_EVSGUG] + 128 * g + 32 * q;
#pragma unroll
        for (int i = 0; i < 4; ++i) { const u32x4 w = *(const u32x4*)(vrow + 128 * g + 32 * q + 8 * i);
#pragma unroll
            for (int e = 0; e < 4; ++e) { const int cl = 32 * q + 8 * i + 2 * e;
                const float a = (geluf_(bflo(w[e])) - mean) * rstd * gain[8 * i + 2 * e], bb = (geluf_(bfhi(w[e])) - mean) * rstd * gain[8 * i + 2 * e + 1];
                *(LAS unsigned short*)(VNT + cl * 256 + ((2 * row) ^ ((cl & 7) << 4))) = (unsigned short)f2bf(a);
                *(LAS unsigned short*)(VNT + (cl + 1) * 256 + ((2 * row) ^ (((cl + 1) & 7) << 4))) = (unsigned short)f2bf(bb); } }
        const float* wsg = F.ka->in[I_EVWS] + (size_t)g * 128 * 128;
#pragma unroll
        for (int it = 0; it < 4; ++it) { const int idx = tid + 512 * it, t = idx >> 4, ch = idx & 15; const f32x4 a = *(const f32x4*)(wsg + t * 128 + 8 * ch), bb = *(const f32x4*)(wsg + t * 128 + 8 * ch + 4);
            u32x4 w; w.x = cvtpk(a[0], a[1]); w.y = cvtpk(a[2], a[3]); w.z = cvtpk(bb[0], bb[1]); w.w = cvtpk(bb[2], bb[3]);
            *(LAS u32x4*)(WS + t * 256 + ((ch ^ (t & 7)) << 4)) = w; }
        __syncthreads();
        bf16x8 av[4];
#pragma unroll
        for (int ks = 0; ks < 4; ++ks) av[ks] = lds_frag256(VNT, 16 * wave + fr, ks * 4 + fq);
#pragma unroll 2
        for (int tt = 0; tt < 8; ++tt) { f32x4 a = {0.f, 0.f, 0.f, 0.f};
#pragma unroll
            for (int ks = 0; ks < 4; ++ks) a = MFMA16(av[ks], lds_frag256(WS, 16 * tt + fr, ks * 4 + fq), a);
            const int t = 16 * tt + fr, c0 = 128 * g + 16 * wave + 4 * fq; const float bs = F.ka->in[I_EVBS][g * 128 + t];
            const u32x2 uw = *(const u32x2*)(px + (size_t)(r0 + t) * EVIN + 2560 + c0);
            u32x2 w; w.x = cvtpk(geluf_(bflo(uw.x)) * (a[0] + bs), geluf_(bfhi(uw.x)) * (a[1] + bs)); w.y = cvtpk(geluf_(bflo(uw.y)) * (a[2] + bs), geluf_(bfhi(uw.y)) * (a[3] + bs));
            *(u32x2*)(mix + (size_t)(r0 + t) * DM + 512 + c0) = w; }
        __syncthreads();
    }
}
__device__ __forceinline__ void p3_mixers(Frame& F) {
    for (int rep_ = 0; rep_ < 1 + ((REPMASK >> 21) & 1); ++rep_)
    for (int it = F.vcu; it < 256; it += F.G) gla_item(F, it);
    { int t = threadIdx.x; asm volatile("" : "+v"(t)); F.tid = t; F.lane = t & 63; F.wave = __builtin_amdgcn_readfirstlane(t >> 6); }
    for (int rep_ = 0; rep_ < 1 + ((REPMASK >> 22) & 1); ++rep_)
    for (int ci = F.vcu; ci < R / 128; ci += F.G) sgu_item(F, ci);
}
__device__ __forceinline__ void p3b_hgrn_out(Frame& F) {
    const int gw = F.vcu * 8 + F.wave, NGW = F.G * 8; const bf16_t* og = (const bf16_t*)(F.ws + WS_OG); const bf16_t* px = (const bf16_t*)(F.ws + WS_PX0); bf16_t* mix = (bf16_t*)(F.ws + WS_MIX);
    const int c0 = 8 * F.lane; float gn[8];
#pragma unroll
    for (int e = 0; e < 8; ++e) gn[e] = F.ka->in[I_EVONORM][(c0 & 127) + e];
    for (int row = gw; row < R; row += NGW) {
        const u32x4 a = *(const u32x4*)(og + (size_t)row * 512 + c0), bb = *(const u32x4*)(og + (size_t)(R + row) * 512 + c0), gg = *(const u32x4*)(px + (size_t)row * EVIN + 2048 + c0);
        float o[8]; float ss = 0.f;
#pragma unroll
        for (int e = 0; e < 4; ++e) { o[2 * e] = bflo(a[e]) + bflo(bb[e]); o[2 * e + 1] = bfhi(a[e]) + bfhi(bb[e]); ss += o[2 * e] * o[2 * e] + o[2 * e + 1] * o[2 * e + 1]; }
        ss += __shfl_xor(ss, 1); ss += __shfl_xor(ss, 2); ss += __shfl_xor(ss, 4); ss += __shfl_xor(ss, 8);
        const float rstd = __builtin_amdgcn_rsqf(ss * (1.0f / 128.0f) + RMS_EPS);
        u32x4 w;
#pragma unroll
        for (int e = 0; e < 4; ++e) w[e] = cvtpk(o[2 * e] * rstd * gn[2 * e] * siluf_(bflo(gg[e])), o[2 * e + 1] * rstd * gn[2 * e + 1] * siluf_(bfhi(gg[e])));
        *(u32x4*)(mix + (size_t)row * DM + c0) = w;
    }
}

__device__ __forceinline__ void p10_kr(Frame& F) {
    const int gw = F.vcu * 8 + F.wave, NGW = F.G * 8; const bf16_t* px1 = (const bf16_t*)(F.ws + WS_PX1); bf16_t* kb = (bf16_t*)(F.ws + WS_KB);
    const int d = F.lane, i16 = d & 15; const float invf = __expf(-(float)i16 * (2.0f / 32.0f) * 9.210340371976184f);
    for (int row = gw; row < R; row += NGW) {
        const int pos = row % PB; float x = bf2f(px1[(size_t)row * CINP + 640 + d]);
        const float xo = __shfl_xor(x, 16);
        if (pos >= CTXL) { const int t = pos - CTXL; const float p = (d < 32) ? (float)(t >> 6) : (float)(t & 63); const float ang = p * invf, cs = __cosf(ang), sn = __sinf(ang);
            x = (d & 16) ? (xo * sn + x * cs) : (x * cs - xo * sn); }
        const unsigned short hb = (unsigned short)f2bf(x);
#pragma unroll
        for (int h = 0; h < 8; ++h) kb[(size_t)row * NQ + h * 192 + 128 + d] = hb;
    }
}

namespace att {
constexpr int KVBLK = 64, SHM_V = 64 * 128 * 2, SHM_K = 64 * 192 * 2;
constexpr float THR = 8.0f * 1.4426950408889634f;
#define KSWZ192(row, colB) ((row) * 384 + ((colB) ^ (((row) & 7) << 4)))
__device__ __forceinline__ int crow(int r, int hi) { return (r & 3) + 8 * (r >> 2) + 4 * hi; }
__device__ __forceinline__ void partialSM(f32x16& p0, f32x16& p1, float& m_reg, float& mn, float& alpha) {
    float pmax = p0[0];
#pragma unroll
    for (int r = 1; r < 16; ++r) pmax = fmaxf(pmax, p0[r]);
#pragma unroll
    for (int r = 0; r < 16; ++r) pmax = fmaxf(pmax, p1[r]);
    { auto rr = __builtin_amdgcn_permlane32_swap(__float_as_uint(pmax), __float_as_uint(pmax), false, false); pmax = fmaxf(__uint_as_float(rr[0]), __uint_as_float(rr[1])); }
    if (__builtin_expect(__all(pmax - m_reg <= THR), 1)) { mn = m_reg; alpha = 1.f; }
    else { mn = fmaxf(m_reg, pmax); alpha = __builtin_amdgcn_exp2f(m_reg - mn); m_reg = mn; }
#pragma unroll
    for (int r = 0; r < 16; ++r) p0[r] = p0[r] - mn;
#pragma unroll
    for (int r = 0; r < 16; ++r) p1[r] = p1[r] - mn;
#pragma unroll
    for (int r = 0; r < 16; ++r) p0[r] = __builtin_amdgcn_exp2f(p0[r]);
}
__device__ __forceinline__ void finishSM(f32x16& p0, f32x16& p1, float alpha, float& l_reg, bf16x8& pa0, bf16x8& pa1, bf16x8& pa2, bf16x8& pa3) {
#pragma unroll
    for (int r = 0; r < 16; ++r) p1[r] = __builtin_amdgcn_exp2f(p1[r]);
    float ps = 0;
#pragma unroll
    for (int r = 0; r < 16; ++r) ps += p0[r];
#pragma unroll
    for (int r = 0; r < 16; ++r) ps += p1[r];
    { auto rr = __builtin_amdgcn_permlane32_swap(__float_as_uint(ps), __float_as_uint(ps), false, false); ps = __uint_as_float(rr[0]) + __uint_as_float(rr[1]); }
    l_reg = l_reg * alpha + ps;
#define PK4(P, BASE, OUT) do { unsigned a0 = cvtpk(P[BASE + 0], P[BASE + 1]), a1 = cvtpk(P[BASE + 2], P[BASE + 3]);   \
    unsigned b0 = cvtpk(P[BASE + 4], P[BASE + 5]), b1 = cvtpk(P[BASE + 6], P[BASE + 7]);                              \
    auto r0 = __builtin_amdgcn_permlane32_swap(a0, b0, false, false); auto r1 = __builtin_amdgcn_permlane32_swap(a1, b1, false, false); \
    u32x4 w = {r0[0], r1[0], r0[1], r1[1]}; OUT = *reinterpret_cast<bf16x8*>(&w); } while (0)
    PK4(p0, 0, pa0); PK4(p0, 8, pa1); PK4(p1, 0, pa2); PK4(p1, 8, pa3);
#undef PK4
}
__device__ __forceinline__ void qkt(f32x16& p0, f32x16& p1, const LAS unsigned char* const (&kb)[4], const int boff, const bf16x8* qr) {
    p0 = f32x16{}; p1 = f32x16{};
#pragma unroll
    for (int m = 0; m < 3; ++m) {
#pragma unroll
        for (int r = 0; r < 4; ++r) { const int d0 = 4 * m + r;
            const bf16x8 b0 = *(const LAS bf16x8*)(kb[r] + boff + m * 128);
            const bf16x8 b1 = *(const LAS bf16x8*)(kb[r] + boff + m * 128 + 12288);
            p0 = __builtin_amdgcn_mfma_f32_32x32x16_bf16(b0, qr[d0], p0, 0, 0, 0);
            p1 = __builtin_amdgcn_mfma_f32_32x32x16_bf16(b1, qr[d0], p1, 0, 0, 0); }
        SBAR(); }
}
__device__ __forceinline__ int v_st(int k, int c) { const int kk = (k & ~0xC) | ((k & 4) << 1) | ((k & 8) >> 1); return ((kk >> 3) * 4 + (c >> 5)) * 512 + ((kk & 7) * 32 + (c & 31)) * 2; }
__device__ __forceinline__ int v_rd_base(int lane) { return ((lane & 3) << 3) | (((lane >> 2) & 3) << 6) | (((lane >> 4) & 1) << 5) | (((lane >> 5) & 1) << 8); }
constexpr int v_rd_off(int d0, int ks, int half) { return d0 * 512 + ks * 4096 + half * 2048; }
template <int OFF> __device__ __forceinline__ s16x4 tr_read(int vb) { s16x4 r; asm volatile("ds_read_b64_tr_b16 %0, %1 offset:%2" : "=&v"(r) : "v"(vb), "i"(OFF) : "memory"); return r; }
template <int D0> __device__ __forceinline__ void pv_one(f32x16& od, int vb, bf16x8 pa0, bf16x8 pa1, bf16x8 pa2, bf16x8 pa3) {
    const s16x4 l0 = tr_read<v_rd_off(D0, 0, 0)>(vb), h0 = tr_read<v_rd_off(D0, 0, 1)>(vb), l1 = tr_read<v_rd_off(D0, 1, 0)>(vb), h1 = tr_read<v_rd_off(D0, 1, 1)>(vb);
    const s16x4 l2 = tr_read<v_rd_off(D0, 2, 0)>(vb), h2 = tr_read<v_rd_off(D0, 2, 1)>(vb), l3 = tr_read<v_rd_off(D0, 3, 0)>(vb), h3 = tr_read<v_rd_off(D0, 3, 1)>(vb);
    asm volatile("s_waitcnt lgkmcnt(0)" ::: "memory"); SBAR();
#define PK(L, H) (bf16x8){L[0], L[1], L[2], L[3], H[0], H[1], H[2], H[3]}
    od = __builtin_amdgcn_mfma_f32_32x32x16_bf16(pa0, PK(l0, h0), od, 0, 0, 0);
    od = __builtin_amdgcn_mfma_f32_32x32x16_bf16(pa1, PK(l1, h1), od, 0, 0, 0);
    od = __builtin_amdgcn_mfma_f32_32x32x16_bf16(pa2, PK(l2, h2), od, 0, 0, 0);
    od = __builtin_amdgcn_mfma_f32_32x32x16_bf16(pa3, PK(l3, h3), od, 0, 0, 0);
#undef PK
}
__device__ __forceinline__ void pv_d0(f32x16* o, int vb, bf16x8 pa0, bf16x8 pa1, bf16x8 pa2, bf16x8 pa3) {
    pv_one<0>(o[0], vb, pa0, pa1, pa2, pa3); pv_one<1>(o[1], vb, pa0, pa1, pa2, pa3); pv_one<2>(o[2], vb, pa0, pa1, pa2, pa3); pv_one<3>(o[3], vb, pa0, pa1, pa2, pa3);
}
__device__ __forceinline__ void attn_unit(const int tid, const bf16_t* __restrict__ Qb, const bf16_t* __restrict__ Kh, const bf16_t* __restrict__ Vh, bf16_t* __restrict__ Ob, LAS unsigned char* lds) {
    const int wid = __builtin_amdgcn_readfirstlane(tid >> 6), lane = tid & 63, r32 = lane & 31, hi = lane >> 5;
    LAS unsigned char* V_lds = lds; LAS unsigned char* K_lds = lds + 2 * SHM_V;
    LAS float* ws = (LAS float*)(lds + 2 * SHM_V + 2 * SHM_K) + wid * 64; LAS float* li_l = ws; LAS float* al_l = ws + 32;
    float m_reg = -1e30f, l_reg = 0; f32x16 o[4] = {}; bf16x8 qr[12];
    const bf16_t* Qw = Qb + (size_t)(wid * 32 + r32) * NQ + hi * 8;
#pragma unroll
    for (int d0 = 0; d0 < 12; ++d0) qr[d0] = *(const bf16x8*)(Qw + d0 * 16);
    const int sr = tid >> 4, sc = (tid & 15) * 8, vst0 = v_st(sr, sc), vst1 = v_st(32 + sr, sc);
    unsigned kgo[3], klo[3];
#pragma unroll
    for (int i = 0; i < 3; ++i) { const int id = tid + 512 * i, kr_ = id / 24, kc_ = (id % 24) * 8; kgo[i] = (unsigned)(kr_ * NQ + kc_) * 2u; klo[i] = (unsigned)KSWZ192(kr_, kc_ * 2); }
    const unsigned vgo = (unsigned)(sr * DM + sc) * 2u;
    const int vb0 = (int)(uintptr_t)V_lds + v_rd_base(lane);
    const LAS unsigned char* kb[4];
#pragma unroll
    for (int r = 0; r < 4; ++r) kb[r] = K_lds + r32 * 384 + ((r * 32 + hi * 16) ^ ((r32 & 7) << 4));
    bf16x8 vs0, vs1, ks[3];
#define SLOAD(k0) do { const char* vt_ = (const char*)Vh + (size_t)(k0) * DM * 2; const char* kt_ = (const char*)Kh + (size_t)(k0) * NQ * 2; \
    vs0 = *(const bf16x8*)(vt_ + vgo); vs1 = *(const bf16x8*)(vt_ + 32 * DM * 2 + vgo); \
    _Pragma("unroll") for (int i_ = 0; i_ < 3; ++i_) ks[i_] = *(const bf16x8*)(kt_ + kgo[i_]); } while (0)
#define SWRITE(b) do { *(LAS bf16x8*)(V_lds + (b) * SHM_V + vst0) = vs0; *(LAS bf16x8*)(V_lds + (b) * SHM_V + vst1) = vs1; \
    _Pragma("unroll") for (int i_ = 0; i_ < 3; ++i_) *(LAS bf16x8*)(K_lds + (b) * SHM_K + klo[i_]) = ks[i_]; } while (0)
    const LAS float* al_hi = al_l + 4 * hi;
#define RESC(a) do { if (__any((a) < 1.f)) { if (hi == 0) al_l[r32] = (a); asm volatile("s_waitcnt lgkmcnt(0)" ::: "memory"); \
    _Pragma("unroll") for (int d_ = 0; d_ < 4; ++d_) _Pragma("unroll") for (int r_ = 0; r_ < 16; ++r_) o[d_][r_] *= al_hi[crow(r_, 0)]; } } while (0)
    f32x16 p0, p1; float mn, al; bf16x8 pa0, pa1, pa2, pa3; constexpr int NT = PB / KVBLK;
    SLOAD(0); SWRITE(0); __syncthreads();
    for (int j = 0; j < NT; j += 2) {
        SLOAD((j + 1) * KVBLK); SBAR();
        qkt(p0, p1, kb, 0, qr); partialSM(p0, p1, m_reg, mn, al); RESC(al);
        finishSM(p0, p1, al, l_reg, pa0, pa1, pa2, pa3); SBAR();
        pv_d0(o, vb0, pa0, pa1, pa2, pa3);
        SWRITE(1); __syncthreads();
        if (j + 2 < NT) SLOAD((j + 2) * KVBLK); SBAR();
        qkt(p0, p1, kb, SHM_K, qr); partialSM(p0, p1, m_reg, mn, al); RESC(al);
        finishSM(p0, p1, al, l_reg, pa0, pa1, pa2, pa3); SBAR();
        pv_d0(o, vb0 + SHM_V, pa0, pa1, pa2, pa3);
        if (j + 2 < NT) SWRITE(0);
        __syncthreads();
    }
    if (hi == 0) li_l[r32] = l_reg; asm volatile("s_waitcnt lgkmcnt(0)" ::: "memory");
    __syncthreads();
    int lane2 = threadIdx.x & 63; asm volatile("" : "+v"(lane2));
    const int hi2 = lane2 >> 5, r322 = lane2 & 31;
    LAS bf16_t* stg = (LAS bf16_t*)(lds + wid * 8192);
    LAS bf16_t* stg_l = stg + 4 * hi2 * 128 + r322; const LAS float* li_hi = li_l + 4 * hi2;
#pragma unroll
    for (int r = 0; r < 16; ++r) { const float rl = __builtin_amdgcn_rcpf(li_hi[crow(r, 0)]);
#pragma unroll
        for (int d0 = 0; d0 < 4; ++d0) stg_l[crow(r, 0) * 128 + d0 * 32] = (bf16_t)f2bf(o[d0][r] * rl); }
    asm volatile("s_waitcnt lgkmcnt(0)" ::: "memory");
    bf16_t* Ow = Ob + (size_t)(wid * 32 + (lane2 >> 4)) * DM + (lane2 & 15) * 8; const LAS bf16_t* stg_r = stg + (lane2 >> 4) * 128 + (lane2 & 15) * 8;
#pragma unroll
    for (int i = 0; i < 8; ++i) { const u32x4 v = *(const LAS u32x4*)(stg_r + i * 4 * 128); *(u32x4*)(Ow + (size_t)(i * 4) * DM) = v; }
    __syncthreads();
#undef SLOAD
#undef SWRITE
#undef RESC
}
}
__device__ __forceinline__ void p11_attention(Frame& F) {
    const bf16_t* Q = (const bf16_t*)(F.ws + WS_Q); const bf16_t* K = (const bf16_t*)(F.ws + WS_KB); const bf16_t* V = (const bf16_t*)(F.ws + WS_VB); bf16_t* O = (bf16_t*)(F.ws + WS_MIX);
    for (int i = 0; i < 4; ++i) {
        const int bh = (F.vcu >> 3) + 32 * i, qb = F.vcu & 7, b = bh >> 3, h = bh & 7;
        const size_t qrow = (size_t)b * PB + CTXL + qb * 256, krow = (size_t)b * PB;
        att::attn_unit(F.tid, Q + qrow * NQ + h * 192, K + krow * NQ + h * 192, V + krow * DM + h * 128, O + qrow * DM + h * 128, F.lds);
    }
}

__device__ __forceinline__ void ka_launder(Frame& F) { asm volatile("" : "+s"(F.ka)); int t = threadIdx.x; asm volatile("" : "+v"(t)); F.tid = t; F.lane = t & 63; F.wave = __builtin_amdgcn_readfirstlane(t >> 6); }
#ifndef DBG_MODE
#define DBG_MODE 0
#endif
constexpr int NPH = 21;
__device__ __forceinline__ void moe_gemms(Frame& F, int layer, int which) {
    const int nblk = __builtin_amdgcn_readfirstlane(*(const int*)(F.ws + WS_ROUTE + RT_NBLK));
    MoeSched S; S.init((const int*)(F.ws + WS_ROUTE + RT_BLKE), nblk, F.G, (int)blockIdx.x);
    const int* perm = (const int*)(F.ws + WS_ROUTE + RT_PERM);
    if (which == 0) {
        pg8::Gemm g{(const bf16_t*)(F.ws + WS_HX), (const bf16_t*)(F.ws + WS_WGU) + (size_t)layer * 32 * 1024 * DM, DM, DM, DM, perm};
        EpiSwiglu E{(bf16_t*)(F.ws + WS_ACT)};
        pg8::gemm_phase<EpiSwiglu, MoeSched, true>(F.lds, g, S, E);
    } else {
        pg8::Gemm g{(const bf16_t*)(F.ws + WS_ACT), (const bf16_t*)(F.ws + WS_WDN) + (size_t)layer * 32 * DM * MFF, MFF, MFF, MFF, nullptr};
        EpiScatter E{(bf16_t*)(F.ws + WS_YS), perm};
        pg8::gemm_phase<EpiScatter, MoeSched, false>(F.lds, g, S, E);
    }
}
__global__ void __launch_bounds__(512, 2) mega_fwd(Args args) {
    extern __shared__ __attribute__((aligned(16))) unsigned char lds_raw[];
    Frame F;
    F.lds = (LAS unsigned char*)lds_raw;
    F.tid = threadIdx.x; F.lane = F.tid & 63; F.wave = __builtin_amdgcn_readfirstlane(F.tid >> 6);
    F.G = gridDim.x; { const int bx = blockIdx.x; F.vcu = (F.G % 8 == 0) ? (bx % 8) * (F.G / 8) + bx / 8 : bx; }
    F.ws = args.ws; F.out = args.out;
    F.ka = (const __attribute__((address_space(4))) Args*)__builtin_amdgcn_kernarg_segment_ptr();
    for (int u = F.tid; u < (LDS_BYTES - LDSCTL_OFF) / 4; u += 512) ((LAS unsigned*)(F.lds + LDSCTL_OFF))[u] = 0u;
    __syncthreads();
    volatile LAS unsigned* MISC = (volatile LAS unsigned*)(F.lds + MISC_OFF);
    unsigned* ctl = (unsigned*)(F.ws + WS_CTL);
    XcdBarrier bar; bar.bar = ctl + CW_BAR; bar.x = 0; bar.st = nullptr;
    if (!args.nobar) bar = xcd_barrier_post(ctl + CW_BAR, MISC + 8);
    const int lo = args.ph_lo, hi = args.ph_hi;
#define IN(k) (lo <= (k) && (k) < hi)
#define SEAM(k) do { if (IN(k) && IN((k) + 1)) xcd_barrier(bar); } while (0)
    constexpr int LAST = DBG_MODE == 0 ? 20 : DBG_MODE == 1 ? -1 : DBG_MODE == 2 ? 6 : DBG_MODE == 3 ? 11 : DBG_MODE == 4 ? 15 : DBG_MODE == 10 ? 2 : DBG_MODE == 11 ? 3 : 5;
#ifndef PHMASK
#define PHMASK 0x1fffff
#endif
#define RUN(k) (ka_launder(F), IN(k) && (k) <= LAST && ((PHMASK >> (k)) & 1))

    if (RUN(0)) for (int rep_ = 0; rep_ < 1 + ((REPMASK >> 0) & 1); ++rep_) p0_prologue(F);
    SEAM(0);
    if (RUN(1)) for (int rep_ = 0; rep_ < 1 + ((REPMASK >> 1) & 1); ++rep_) p0b_mod(F);
    SEAM(1);
    if (RUN(2)) for (int rep_ = 0; rep_ < 1 + ((REPMASK >> 2) & 1); ++rep_) p1_norm_input(F);
    SEAM(2);
    if (RUN(3)) for (int rep_ = 0; rep_ < 1 + ((REPMASK >> 3) & 1); ++rep_) { pg8::Gemm g{(const bf16_t*)(F.ws + WS_HX), (const bf16_t*)(F.ws + WS_WIN0), DM, DM, DM, nullptr}; TileSched<false> S; S.init(EVIN / 256, F.G, (int)blockIdx.x);
        EpiStoreBf16 E{(bf16_t*)(F.ws + WS_PX0), EVIN}; pg8::gemm_phase<EpiStoreBf16, TileSched<false>, false>(F.lds, g, S, E); }
    SEAM(3);
    if (RUN(4)) for (int rep_ = 0; rep_ < 1 + ((REPMASK >> 4) & 1); ++rep_) p3_mixers(F);
    SEAM(4);
    if (RUN(5)) for (int rep_ = 0; rep_ < 1 + ((REPMASK >> 5) & 1); ++rep_) p3b_hgrn_out(F);
    SEAM(5);
    if (RUN(6)) for (int rep_ = 0; rep_ < 1 + ((REPMASK >> 6) & 1); ++rep_) { pg8::Gemm g{(const bf16_t*)(F.ws + WS_MIX), (const bf16_t*)(F.ws + WS_WOUT0), DM, DM, DM, nullptr}; TileSched<false> S; S.init(DM / 256, F.G, (int)blockIdx.x);
        EpiResidual E{&F, (float*)(F.ws + WS_XS), 0, true}; pg8::gemm_phase<EpiResidual, TileSched<false>, false>(F.lds, g, S, E); }
    SEAM(6);
    if (RUN(7)) for (int rep_ = 0; rep_ < 1 + ((REPMASK >> 7) & 1); ++rep_) p5_norm_route<false>(F, 0);
    SEAM(7);
    if (RUN(8)) for (int rep_ = 0; rep_ < 1 + ((REPMASK >> 8) & 1); ++rep_) p5b_perm<false>(F);
    SEAM(8);
    if (RUN(9)) for (int rep_ = 0; rep_ < 1 + ((REPMASK >> 9) & 1); ++rep_) moe_gemms(F, 0, 0);
    SEAM(9);
    if (RUN(10)) for (int rep_ = 0; rep_ < 1 + ((REPMASK >> 10) & 1); ++rep_) moe_gemms(F, 0, 1);
    SEAM(10);
    if (RUN(11)) for (int rep_ = 0; rep_ < 1 + ((REPMASK >> 11) & 1); ++rep_) p8_combine_norm(F);
    SEAM(11);
    if (RUN(12)) for (int rep_ = 0; rep_ < 1 + ((REPMASK >> 12) & 1); ++rep_) { pg8::Gemm g{(const bf16_t*)(F.ws + WS_HX), (const bf16_t*)(F.ws + WS_WIN1), DM, DM, DM, nullptr}; TileSched<false> S; S.init(CINP / 256, F.G, (int)blockIdx.x);
        EpiStoreStats E{(bf16_t*)(F.ws + WS_PX1), CINP, (float*)(F.ws + WS_STATS)}; pg8::gemm_phase<EpiStoreStats, TileSched<false>, false>(F.lds, g, S, E); }
    SEAM(12);
    if (RUN(13)) for (int rep_ = 0; rep_ < 1 + ((REPMASK >> 13) & 1); ++rep_) {
        { pg8::Gemm g{(const bf16_t*)(F.ws + WS_PX1), (const bf16_t*)(F.ws + WS_WUQ), CINP, QRANK, QRANK, nullptr}; TileSched<true> S; S.init(NQ / 256, F.G, (int)blockIdx.x);
          EpiQ E{(bf16_t*)(F.ws + WS_Q), (const float*)(F.ws + WS_STATS)}; pg8::gemm_phase<EpiQ, TileSched<true>, false>(F.lds, g, S, E); }
        { pg8::Gemm g{(const bf16_t*)(F.ws + WS_PX1) + QRANK, (const bf16_t*)(F.ws + WS_WUKV), CINP, KVRANK, KVRANK, nullptr}; TileSched<false> S; S.init(NKV / 256, F.G, (int)blockIdx.x);
          EpiKV E{(bf16_t*)(F.ws + WS_KB), (bf16_t*)(F.ws + WS_VB), (const float*)(F.ws + WS_STATS)}; pg8::gemm_phase<EpiKV, TileSched<false>, false>(F.lds, g, S, E); }
        ka_launder(F);
        p10_kr(F);
    }
    SEAM(13);
    if (RUN(14)) for (int rep_ = 0; rep_ < 1 + ((REPMASK >> 14) & 1); ++rep_) p11_attention(F);
    SEAM(14);
    if (RUN(15)) for (int rep_ = 0; rep_ < 1 + ((REPMASK >> 15) & 1); ++rep_) { pg8::Gemm g{(const bf16_t*)(F.ws + WS_MIX), (const bf16_t*)(F.ws + WS_WOUT1), DM, DM, DM, nullptr}; TileSched<true> S; S.init(DM / 256, F.G, (int)blockIdx.x);
        EpiResidual E{&F, (float*)(F.ws + WS_XS), 1, false}; pg8::gemm_phase<EpiResidual, TileSched<true>, false>(F.lds, g, S, E); }
    SEAM(15);
    if (RUN(16)) for (int rep_ = 0; rep_ < 1 + ((REPMASK >> 16) & 1); ++rep_) p5_norm_route<true>(F, 1);
    SEAM(16);
    if (RUN(17)) for (int rep_ = 0; rep_ < 1 + ((REPMASK >> 17) & 1); ++rep_) p5b_perm<true>(F);
    SEAM(17);
    if (RUN(18)) for (int rep_ = 0; rep_ < 1 + ((REPMASK >> 18) & 1); ++rep_) moe_gemms(F, 1, 0);
    SEAM(18);
    if (RUN(19)) for (int rep_ = 0; rep_ < 1 + ((REPMASK >> 19) & 1); ++rep_) moe_gemms(F, 1, 1);
    SEAM(19);
    ka_launder(F);
    if (IN(20) && ((PHMASK >> 20) & 1)) p16_final(F);
#undef IN
#undef SEAM
#undef RUN
}

#ifndef MK_N_LAUNCHES
#define MK_N_LAUNCHES 1
#endif
extern "C" void kernel_launch(void* const* d_in, const int* in_sizes, int n_in, void* d_out, int out_size, void* d_ws, size_t ws_size, hipStream_t stream) {
    static int grid = 0;
    if (grid == 0) {
        if (n_in != 28 || out_size != NB * SEQ * DM || ws_size < WS_END) { fprintf(stderr, "kernel_launch: unexpected shapes (n_in %d out %d ws %zu)\n", n_in, out_size, ws_size); grid = -1; return; }
        int dev = 0, cus = 0, per_cu = 0;
        if (hipGetDevice(&dev) != hipSuccess || hipDeviceGetAttribute(&cus, hipDeviceAttributeMultiprocessorCount, dev) != hipSuccess) { grid = -1; return; }
        if (hipFuncSetAttribute((const void*)mega_fwd, hipFuncAttributeMaxDynamicSharedMemorySize, LDS_BYTES) != hipSuccess) { fprintf(stderr, "kernel_launch: hipFuncSetAttribute failed\n"); grid = -1; return; }
        if (hipOccupancyMaxActiveBlocksPerMultiprocessor(&per_cu, (const void*)mega_fwd, 512, LDS_BYTES) != hipSuccess || per_cu < 1) { fprintf(stderr, "kernel_launch: occupancy query says %d blocks/CU\n", per_cu); per_cu = 1; }
        (void)hipGetLastError();
        grid = cus;
    }
    if (grid < 0) return;
    (void)hipMemsetAsync((char*)d_ws + WS_CTL, 0, CTL_ZERO_BYTES, stream);
    Args a{};
    for (int i = 0; i < 28; ++i) a.in[i] = (const float*)d_in[i];
    a.out = (float*)d_out; a.ws = (unsigned char*)d_ws;
    if (MK_N_LAUNCHES == 1) {
        a.ph_lo = 0; a.ph_hi = NPH; a.nobar = 0;
        void* kargs[] = {&a};
        hipError_t e = hipLaunchCooperativeKernel((const void*)mega_fwd, dim3(grid), dim3(512), kargs, LDS_BYTES, stream);
        if (e != hipSuccess) { (void)hipGetLastError(); fprintf(stderr, "kernel_launch: cooperative launch failed (%s), plain launch instead\n", hipGetErrorString(e)); hipLaunchKernelGGL(mega_fwd, dim3(grid), dim3(512), LDS_BYTES, stream, a); }
    } else {
        for (int p = 0; p < NPH; ++p) { a.ph_lo = p; a.ph_hi = p + 1; a.nobar = 1; hipLaunchKernelGGL(mega_fwd, dim3(grid), dim3(512), LDS_BYTES, stream, a); }
    }
}
```

```cpp
#include <hip/hip_runtime.h>
#include <cstdio>
#include <cstdint>
#define MK_N_LAUNCHES 1
#define DBG_MODE 0
#define REPMASK 0x0

#define LAS __attribute__((address_space(3)))
#define GAS __attribute__((address_space(1)))
typedef unsigned short bf16_t;
typedef short bf16x8 __attribute__((ext_vector_type(8)));
typedef short s16x4 __attribute__((ext_vector_type(4)));
typedef float f32x2 __attribute__((ext_vector_type(2)));
typedef float f32x4 __attribute__((ext_vector_type(4)));
typedef float f32x16 __attribute__((ext_vector_type(16)));
typedef unsigned u32x2 __attribute__((ext_vector_type(2)));
typedef unsigned u32x4 __attribute__((ext_vector_type(4)));

constexpr int DM = 1024, NB = 16, SEQ = 2048, CTXL = 256, PB = SEQ + CTXL  , R = NB * PB  ;
constexpr int NTILE = R / 256  , NXTILE = NB * SEQ / 256  ;
constexpr int EVIN = 3584;
constexpr int CIN = 704, CINP = 768, QRANK = 384, KVRANK = 256, NQ = 1536, NKV = 2048;
constexpr int NEXP = 32, MFF = 512;
constexpr int MAXSLOT = 81920;
constexpr float RMS_EPS = 1e-6f;
constexpr float ATT_C2 = 0.07216878364870322f * 1.4426950408889634f;

constexpr size_t MiB = 1u << 20;
constexpr size_t WS_CTL = 0, CTL_ZERO_BYTES = 1 * MiB;
constexpr size_t WS_MOD = 1 * MiB;
constexpr size_t WS_PART = 2 * MiB;
constexpr size_t WS_STATS = 9 * MiB;
constexpr size_t WS_ROUTE = 13 * MiB;
constexpr size_t WS_WIN0 = 16 * MiB, WS_WOUT0 = 23 * MiB, WS_WIN1 = 25 * MiB, WS_WUQ = 27 * MiB, WS_WUKV = 29 * MiB, WS_WOUT1 = 30 * MiB;
constexpr size_t WS_WGU = 32 * MiB;
constexpr size_t WS_WDN = 160 * MiB;
constexpr size_t WS_XS = 224 * MiB;
constexpr size_t WS_HX = 368 * MiB;
constexpr size_t WS_MIX = 440 * MiB;
constexpr size_t WS_RA = 512 * MiB;
constexpr size_t WS_PX0 = WS_RA, WS_Q = WS_RA, WS_KB = WS_RA + 108 * MiB, WS_ACT = WS_RA;
constexpr size_t WS_RB = 764 * MiB;
constexpr size_t WS_YS = WS_RB, WS_PX1 = WS_RB, WS_VB = WS_RB + 54 * MiB, WS_OG = WS_RB;
constexpr size_t WS_END = 908 * MiB;
constexpr size_t RT_AE = 0, RT_AP = 512 * 1024, RT_AW = 1024 * 1024, RT_PERM = 1536 * 1024, RT_CNTB = 2048 * 1024, RT_BLKE = 2048 * 1024 + 64 * 1024, RT_NBLK = RT_BLKE + 4096;
constexpr int CW_BAR = 4096;

constexpr int RING_BYTES = 131072;
constexpr int LDSCTL_OFF = 147456, MISC_OFF = LDSCTL_OFF + 320;
constexpr int LDS_BYTES = 149504;

#define LDS_WAIT() asm volatile("s_waitcnt lgkmcnt(0)" ::: "memory")
#define VM_WAIT() asm volatile("s_waitcnt vmcnt(0)" ::: "memory")
#define SBAR() __builtin_amdgcn_sched_barrier(0)
__device__ __forceinline__ unsigned f2bf(float f) { unsigned u = __builtin_bit_cast(unsigned, f); return (u + 0x7fffu + ((u >> 16) & 1u)) >> 16; }
__device__ __forceinline__ unsigned pk2(float lo, float hi) { return f2bf(lo) | (f2bf(hi) << 16); }
typedef __bf16 bf16x2_t __attribute__((ext_vector_type(2)));
__device__ __forceinline__ unsigned cvtpk(float lo, float hi) { f32x2 v = {lo, hi}; bf16x2_t b = __builtin_convertvector(v, bf16x2_t); return __builtin_bit_cast(unsigned, b); }
__device__ __forceinline__ float bf2f(unsigned short h) { return __builtin_bit_cast(float, (unsigned)h << 16); }
__device__ __forceinline__ float bflo(unsigned w) { return __builtin_bit_cast(float, w << 16); }
__device__ __forceinline__ float bfhi(unsigned w) { return __builtin_bit_cast(float, w & 0xffff0000u); }
__device__ __forceinline__ float dpp_add(float v, const int ctrl) { return v; }
#define DPP_ADD(v, ctrl) ((v) + __builtin_bit_cast(float, __builtin_amdgcn_update_dpp(0, __builtin_bit_cast(int, (v)), (ctrl), 0xf, 0xf, true)))
__device__ __forceinline__ float wave_sum(float v) {
    v = DPP_ADD(v, 0xB1);
    v = DPP_ADD(v, 0x4E);
    v = DPP_ADD(v, 0x141);
    v = DPP_ADD(v, 0x140);
    const int iv = __builtin_bit_cast(int, v);
    return (__builtin_bit_cast(float, __builtin_amdgcn_readlane(iv, 0)) + __builtin_bit_cast(float, __builtin_amdgcn_readlane(iv, 16))) +
           (__builtin_bit_cast(float, __builtin_amdgcn_readlane(iv, 32)) + __builtin_bit_cast(float, __builtin_amdgcn_readlane(iv, 48)));
}
constexpr float LOG2E = 1.4426950408889634f, LN2 = 0.6931471805599453f;
__device__ __forceinline__ float ex2(float x) { return __builtin_amdgcn_exp2f(x); }
__device__ __forceinline__ float lg2(float x) { return __builtin_amdgcn_logf(x); }
__device__ __forceinline__ float sigmoidf_(float x) { return __builtin_amdgcn_rcpf(1.0f + ex2(-LOG2E * x)); }
__device__ __forceinline__ float siluf_(float x) { return x * __builtin_amdgcn_rcpf(1.0f + ex2(-LOG2E * x)); }
__device__ __forceinline__ float geluf_(float x) { const float z = (-1.5957691216057308f * LOG2E) * (x + 0.044715f * x * x * x); return x * __builtin_amdgcn_rcpf(1.0f + ex2(z)); }

#define XB_TMO      128
#define XB_XCNT(j)  (256  + 64 * (j))
#define XB_XSUB(j)  (1280 + 64 * (j))
#define XB_XGEN(j)  (2304 + 64 * (j))
#define XB_TOP      3328
#define XB_TOPGEN   3392
#define XCD_BAR_WORDS 3456
#define XB_SPIN_CAP (1u << 22)
__device__ __forceinline__ unsigned xb_ld(unsigned* p)              { return __hip_atomic_load(p, __ATOMIC_RELAXED, __HIP_MEMORY_SCOPE_AGENT); }
__device__ __forceinline__ unsigned xb_add(unsigned* p, unsigned v) { return __hip_atomic_fetch_add(p, v, __ATOMIC_RELAXED, __HIP_MEMORY_SCOPE_AGENT); }
__device__ __forceinline__ unsigned xb_xcc_id() { return (unsigned)__builtin_amdgcn_s_getreg((3 << 11) | 20) & 0xFu; }
#define XB_SPIN(cond, bar) do { unsigned _sp = 0; while (cond) { __builtin_amdgcn_s_sleep(1); \
    if ((++_sp & 255u) == 0u) { if (xb_ld(&(bar)[XB_TMO])) break; if (_sp > XB_SPIN_CAP) { atomicAdd(&(bar)[XB_TMO], 1u); break; } } } } while (0)
struct XcdBarrier { unsigned* bar; unsigned x; volatile LAS unsigned* st; };
__device__ __forceinline__ XcdBarrier xcd_barrier_post(unsigned* bar, volatile LAS unsigned* st) {
    XcdBarrier b; b.bar = bar; b.x = xb_xcc_id(); b.st = st;
    if (threadIdx.x == 0) (void)xb_add(&bar[XB_XCNT(b.x)], 1u);
    return b;
}
__device__ __forceinline__ void xcd_barrier_complete(unsigned* bar, unsigned x, unsigned& nloc, unsigned& nx) {
    const unsigned G = gridDim.x * gridDim.y * gridDim.z;
    unsigned sum, cnt, mine, sp = 0u;
    for (;;) {
        sum = 0u; cnt = 0u; mine = 0u;
#pragma unroll
        for (unsigned j = 0; j < 16; ++j) { const unsigned c = xb_ld(&bar[XB_XCNT(j)]); sum += c; cnt += (c > 0u) ? 1u : 0u; mine = (j == x) ? c : mine; }
        if (sum == G) break;
        __builtin_amdgcn_s_sleep(1);
        if ((++sp & 255u) == 0u) { if (xb_ld(&bar[XB_TMO])) break; if (sp > XB_SPIN_CAP) { atomicAdd(&bar[XB_TMO], 1u); break; } }
    }
    nloc = mine > 0u ? mine : 1u; nx = cnt > 0u ? cnt : 1u;
}
__device__ __forceinline__ void xcd_barrier(const XcdBarrier& b) {
    asm volatile("s_waitcnt vmcnt(0)" ::: "memory");
    __syncthreads();
    if (threadIdx.x == 0) {
        unsigned* bar = b.bar;
        __builtin_amdgcn_s_waitcnt(0);
        unsigned nloc = b.st[0], nx = b.st[1];
        if (nloc == 0u) { xcd_barrier_complete(bar, b.x, nloc, nx); b.st[0] = nloc; b.st[1] = nx; }
        const unsigned old = xb_add(&bar[XB_XSUB(b.x)], 1u);
        const unsigned gen = old / nloc;
        if (old + 1u == (gen + 1u) * nloc) {
            __builtin_amdgcn_fence(__ATOMIC_RELEASE, "agent");
            asm volatile("s_waitcnt vmcnt(0)" ::: "memory");
            const unsigned og = xb_add(&bar[XB_TOP], 1u);
            const unsigned tg = og / nx;
            if (og + 1u == (tg + 1u) * nx) xb_add(&bar[XB_TOPGEN], 1u);
            else XB_SPIN(xb_ld(&bar[XB_TOPGEN]) == tg, bar);
            __builtin_amdgcn_fence(__ATOMIC_ACQUIRE, "agent");
            xb_add(&bar[XB_XGEN(b.x)], 1u);
            asm volatile("s_waitcnt vmcnt(0)" ::: "memory");
        } else {
            XB_SPIN(xb_ld(&bar[XB_XGEN(b.x)]) == gen, bar);
            __builtin_amdgcn_fence(__ATOMIC_ACQUIRE, "agent");
            asm volatile("s_waitcnt vmcnt(0)" ::: "memory");
        }
    }
    __syncthreads();
}

namespace pg8 {
constexpr int BM = 256, BK = 64, HALF = 128, HTB = HALF * BK * 2, STAGE_BYTES = 8 * HTB, NXCD = 8, WGM = 8;
__host__ __device__ __forceinline__ int lds_byte(int r, int c) { const int st = (r >> 4) * 2 + (c >> 5), rr = r & 15, cc = c & 31, ob = rr * 64 + cc * 2; return st * 1024 + (ob ^ (((ob >> 9) & 1) << 5)); }
__host__ __device__ __forceinline__ void stage_rc(int b, int& Rr, int& C) { const int st = b / 1024, sb = b % 1024, swz = sb ^ (((sb >> 9) & 1) << 5); Rr = (st >> 1) * 16 + swz / 64; C = (st & 1) * 32 + (swz % 64) / 2; }
__host__ __device__ __forceinline__ int perm32(int rho) { const int n = rho >> 4, i = rho & 15; return 8 * (i >> 2) + 4 * n + (i & 3); }

struct Unit { int arow0, brow0, pm, pn, ex; };
struct Gemm { const bf16_t* A; const bf16_t* Bt; int lda, ldb, K; const int* rowidx; };

template <class Epi, class Sched, bool GATHER>
__device__ __forceinline__ void gemm_phase(LAS unsigned char* lds, const Gemm g, const Sched& S, const Epi& E) {
    int tidl = threadIdx.x; asm volatile("" : "+v"(tidl));
    const int tid = tidl, wid = __builtin_amdgcn_readfirstlane(tid >> 6), lane = tid & 63, wr = wid >> 2, wc = wid & 3, fr = lane & 15, fq = lane >> 4;
    const int K = g.K, nt = K / BK;
    int sR[2], sC[2]; unsigned voffB[2], voffA[2];
#pragma unroll
    for (int i = 0; i < 2; ++i) { stage_rc(tid * 16 + i * 8192, sR[i], sC[i]); const int Rb = Epi::PERM ? ((sR[i] & ~31) + perm32(sR[i] & 31)) : sR[i];
        voffB[i] = (unsigned)(Rb * g.ldb + sC[i]) * 2u; voffA[i] = (unsigned)(sR[i] * g.lda + sC[i]) * 2u; }
    const size_t kstep = (size_t)(BK * 2);
    const size_t hstepB = (size_t)HALF * g.ldb * 2, hstepA = (size_t)HALF * g.lda * 2;
    const unsigned ldsw = (unsigned)wid * 1024u;
    const int aoff = lds_byte(wr * 64 + fr, fq * 8), boff = lds_byte(wc * 32 + fr, fq * 8);
#define PG8_SA(b, h) (((b) * 2 + (h)) * HTB)
#define PG8_SB(b, h) ((4 + (b) * 2 + (h)) * HTB)
#define PG8_GLDS(src, bufoff, i) __builtin_amdgcn_global_load_lds((const unsigned*)(src), (LAS unsigned*)(lds + (bufoff) + ldsw + (i) * 8192), 16, 0, 0)
#define PG8_STAGEB(bufoff, gbase) do { _Pragma("unroll") for (int _i = 0; _i < 2; ++_i) PG8_GLDS((const char*)(gbase) + voffB[_i], bufoff, _i); } while (0)
#define PG8_STAGEA(bufoff, h, isnext, kb) do { \
        if constexpr (GATHER) { _Pragma("unroll") for (int _i = 0; _i < 2; ++_i) PG8_GLDS(gA + (kb) + ((isnext) ? nvo[h][_i] : cvo[h][_i]), bufoff, _i); } \
        else { const char* _b = ((isnext) ? nA : cA) + (h) * hstepA + (kb); _Pragma("unroll") for (int _i = 0; _i < 2; ++_i) PG8_GLDS(_b + voffA[_i], bufoff, _i); } } while (0)
#define PG8_LDA(dst, b, h) do { _Pragma("unroll") for (int m = 0; m < 4; ++m) _Pragma("unroll") for (int k = 0; k < 2; ++k) dst[m][k] = *(const LAS bf16x8*)(lds + PG8_SA(b, h) + aoff + m * 2048 + k * 1024); } while (0)
#define PG8_LDB(dst, b, h) do { _Pragma("unroll") for (int n = 0; n < 2; ++n) _Pragma("unroll") for (int k = 0; k < 2; ++k) dst[n][k] = *(const LAS bf16x8*)(lds + PG8_SB(b, h) + boff + n * 2048 + k * 1024); } while (0)
#define PG8_MMA(ai, bj, At, Bt) do { __builtin_amdgcn_s_setprio(1); _Pragma("unroll") for (int m = 0; m < 4; ++m) _Pragma("unroll") for (int n = 0; n < 2; ++n) _Pragma("unroll") for (int k = 0; k < 2; ++k) \
        acc[ai][bj][m][n] = __builtin_amdgcn_mfma_f32_16x16x32_bf16(Bt[n][k], At[m][k], acc[ai][bj][m][n], 0, 0, 0); __builtin_amdgcn_s_setprio(0); } while (0)
#define PG8_WAIT_V(n) asm volatile("s_waitcnt vmcnt(" #n ")" ::: "memory")
#define PG8_WAIT_L(n) asm volatile("s_waitcnt lgkmcnt(" #n ")" ::: "memory")
#define PG8_BAR __builtin_amdgcn_s_barrier()
#define PG8_SCHED __builtin_amdgcn_sched_barrier(0)
    unsigned cvo[2][2], nvo[2][2];
    auto a_offsets = [&](const Unit& u, unsigned (&vo)[2][2]) {
#pragma unroll
        for (int h = 0; h < 2; ++h)
#pragma unroll
            for (int i = 0; i < 2; ++i) { const int a = g.rowidx[u.arow0 + h * HALF + sR[i]]; const int row = a < 0 ? 0 : (a >> 1); vo[h][i] = (unsigned)((size_t)row * g.lda + sC[i]) * 2u; }
    };
    Unit cur, nxt; int ui = 0;
    if (!S.next(0, cur)) return;
    f32x4 acc[2][2][4][2];
#pragma unroll
    for (int a = 0; a < 2; ++a)
#pragma unroll
        for (int b = 0; b < 2; ++b)
#pragma unroll
            for (int m = 0; m < 4; ++m)
#pragma unroll
                for (int n = 0; n < 2; ++n) acc[a][b][m][n] = (f32x4){0.f, 0.f, 0.f, 0.f};
    bf16x8 At[4][2], B0[2][2], B1[2][2];
    const char* gA = (const char*)g.A;
    const char* cA = gA + (size_t)cur.arow0 * g.lda * 2; const char* nA = cA;
    const char* cB = (const char*)g.Bt + (size_t)cur.brow0 * g.ldb * 2;
    if constexpr (GATHER) { a_offsets(cur, cvo);
#pragma unroll
        for (int h = 0; h < 2; ++h)
#pragma unroll
            for (int i = 0; i < 2; ++i) nvo[h][i] = cvo[h][i]; }
    PG8_STAGEB(PG8_SB(0, 0), cB); PG8_STAGEB(PG8_SB(0, 1), cB + hstepB); PG8_STAGEA(PG8_SA(0, 0), 0, false, 0); PG8_STAGEA(PG8_SA(0, 1), 1, false, 0);
    if (wr == 1) PG8_BAR;
    PG8_WAIT_V(2); PG8_BAR;
    PG8_STAGEB(PG8_SB(1, 0), cB + kstep); PG8_STAGEA(PG8_SA(1, 0), 0, false, kstep); PG8_STAGEB(PG8_SB(1, 1), cB + hstepB + kstep);
    PG8_WAIT_V(6); PG8_BAR;
    for (;;) {
        const bool has_next = S.next(ui + 1, nxt);
        const char* nB = has_next ? (const char*)g.Bt + (size_t)nxt.brow0 * g.ldb * 2 : cB;
        nA = has_next ? gA + (size_t)nxt.arow0 * g.lda * 2 : cA;
        if constexpr (GATHER) { if (has_next) a_offsets(nxt, nvo); }
        for (int t = 0; t < nt; t += 2) {
            const bool last = (t == nt - 2);
            const size_t k1 = (size_t)(t + 1) * kstep, k2 = last ? 0 : (size_t)(t + 2) * kstep, k3 = k2 + kstep;
            const char* b2 = last ? nB : cB + (size_t)(t + 2) * kstep; const char* b3 = b2 + kstep;
            PG8_LDB(B0, 0, 0); PG8_LDB(B1, 0, 1); PG8_SCHED; PG8_LDA(At, 0, 0); PG8_STAGEA(PG8_SA(1, 1), 1, false, k1);
            PG8_WAIT_V(8); PG8_WAIT_L(0); PG8_BAR; PG8_MMA(0, 0, At, B0); PG8_MMA(0, 1, At, B1); PG8_BAR; PG8_SCHED;
            PG8_LDA(At, 0, 1); PG8_STAGEB(PG8_SB(0, 0), b2); PG8_STAGEB(PG8_SB(0, 1), b2 + hstepB); PG8_STAGEA(PG8_SA(0, 0), 0, last, k2);
            PG8_WAIT_V(8); PG8_WAIT_L(0); PG8_BAR; PG8_MMA(1, 0, At, B0); PG8_MMA(1, 1, At, B1); PG8_BAR; PG8_SCHED;
            PG8_LDB(B0, 1, 0); PG8_LDB(B1, 1, 1); PG8_SCHED; PG8_LDA(At, 1, 0); PG8_STAGEA(PG8_SA(0, 1), 1, last, k2);
            PG8_WAIT_V(8); PG8_WAIT_L(0); PG8_BAR; PG8_MMA(0, 0, At, B0); PG8_MMA(0, 1, At, B1); PG8_BAR; PG8_SCHED;
            PG8_LDA(At, 1, 1); PG8_STAGEB(PG8_SB(1, 0), b3); PG8_STAGEB(PG8_SB(1, 1), b3 + hstepB); PG8_STAGEA(PG8_SA(1, 0), 0, last, k3);
            PG8_WAIT_V(8); PG8_WAIT_L(0); PG8_BAR; PG8_MMA(1, 0, At, B0); PG8_MMA(1, 1, At, B1); PG8_BAR; PG8_SCHED;
        }
        if (wr == 0) PG8_BAR;
        { int l2 = threadIdx.x; asm volatile("" : "+v"(l2)); E(acc, cur, wr, wc, l2 & 15, (l2 >> 4) & 3); }
        if (!has_next) break;
#pragma unroll
        for (int a = 0; a < 2; ++a)
#pragma unroll
            for (int b = 0; b < 2; ++b)
#pragma unroll
                for (int m = 0; m < 4; ++m)
#pragma unroll
                    for (int n = 0; n < 2; ++n) acc[a][b][m][n] = (f32x4){0.f, 0.f, 0.f, 0.f};
        cur = nxt; cB = nB; cA = nA; ++ui;
        if constexpr (GATHER) {
#pragma unroll
            for (int h = 0; h < 2; ++h)
#pragma unroll
                for (int i = 0; i < 2; ++i) cvo[h][i] = nvo[h][i]; }
        if (wr == 1) PG8_BAR;
    }
    PG8_WAIT_V(0);
    PG8_BAR;
#undef PG8_SA
#undef PG8_SB
#undef PG8_GLDS
#undef PG8_STAGEA
#undef PG8_STAGEB
#undef PG8_LDA
#undef PG8_LDB
#undef PG8_MMA
#undef PG8_WAIT_V
#undef PG8_WAIT_L
#undef PG8_BAR
#undef PG8_SCHED
}
}

struct Args {
    const float* in[28]; float* out; unsigned char* ws; int ph_lo, ph_hi, nobar, pad;
};
enum In { I_X = 0, I_C, I_CTX, I_CCTX, I_ADAW, I_ADAB, I_NMIXG, I_NFFNG, I_EVWIN, I_EVLB, I_EVONORM, I_EVSGUG, I_EVWS, I_EVBS, I_EVWOUT,
          I_ODWIN, I_ODQG, I_ODWUQ, I_ODKVG, I_ODWUKV, I_ODWOUT, I_MR1W, I_MR1B, I_MR2W, I_MR2B, I_MGU, I_MDN, I_FING };
struct Frame {
    LAS unsigned char* lds;
    const __attribute__((address_space(4))) Args* ka;
    float* out;
    int tid, lane, wave, vcu, G;
    unsigned char* ws;
};
__device__ __forceinline__ const float* mod_ptr(const Frame& F, int layer, int mrow, int which) { return (const float*)(F.ws + WS_MOD) + ((size_t)(layer * 17 + mrow) * 6 + which) * DM; }
__device__ __forceinline__ int row_b(int row) { return row / PB; }
__device__ __forceinline__ const float* input_row(const Frame& F, int row) {
    const int b = row / PB, pos = row - b * PB;
    return pos < CTXL ? F.ka->in[I_CTX] + ((size_t)b * CTXL + pos) * DM : F.ka->in[I_X] + ((size_t)b * SEQ + (pos - CTXL)) * DM;
}

template <bool XONLY> struct TileSched {
    int nM, nN, nwg, G, c;
    __device__ __forceinline__ void init(int nN_, int G_, int c_) { nM = XONLY ? NXTILE : NTILE; nN = nN_; nwg = nM * nN; G = G_; c = c_; }
    __device__ __forceinline__ bool next(int i, pg8::Unit& u) const {
        const long L = (long)i * G + c; if (L >= nwg) return false;
        int wgid = (int)L; { const int q = nwg / 8, r = nwg % 8, xcd = wgid % 8, off = wgid / 8; wgid = (xcd < r ? xcd * (q + 1) : r * (q + 1) + (xcd - r) * q) + off; }
        const int nig = 8 * nN, gid = wgid / nig, fm = gid * 8, gsz = (nM - fm) < 8 ? (nM - fm) : 8;
        int pm = fm + ((wgid % nig) % gsz); const int pn = (wgid % nig) / gsz;
        if (XONLY) pm = (pm >> 3) * 9 + 1 + (pm & 7);
        u.pm = pm; u.pn = pn; u.ex = 0; u.arow0 = pm * 256; u.brow0 = pn * 256; return true;
    }
};
struct MoeSched {
    const int* blke; int nwg, G, c, brows;
    __device__ __forceinline__ void init(const int* blke_, int nblk, int G_, int c_) { blke = blke_; nwg = nblk * 4; G = G_; c = c_; brows = 1024; }
    __device__ __forceinline__ bool next(int i, pg8::Unit& u) const {
        const long L = (long)i * G + c; if (L >= nwg) return false;
        int wgid = (int)L; { const int q = nwg / 8, r = nwg % 8, xcd = wgid % 8, off = wgid / 8; wgid = (xcd < r ? xcd * (q + 1) : r * (q + 1) + (xcd - r) * q) + off; }
        const int blk = wgid >> 2, pn = wgid & 3; const int e = __builtin_amdgcn_readfirstlane(blke[blk]);
        u.pm = blk; u.pn = pn; u.ex = e; u.arow0 = blk * 256; u.brow0 = e * brows + pn * 256; return true;
    }
};

struct EpiStoreBf16 {
    static constexpr bool PERM = true;
    bf16_t* O; int ldc;
    __device__ __forceinline__ void operator()(const f32x4 (&acc)[2][2][4][2], const pg8::Unit& u, int wr, int wc, int fr, int fq) const {
        const int row0 = u.arow0 + wr * 64 + fr, col0 = u.pn * 256 + wc * 32 + 8 * fq;
#pragma unroll
        for (int ai = 0; ai < 2; ++ai)
#pragma unroll
            for (int m = 0; m < 4; ++m) { bf16_t* rowp = O + (size_t)(row0 + ai * 128 + m * 16) * ldc + col0;
#pragma unroll
                for (int bj = 0; bj < 2; ++bj) { const f32x4 v0 = acc[ai][bj][m][0], v1 = acc[ai][bj][m][1];
                    u32x4 w; w.x = cvtpk(v0[0], v0[1]); w.y = cvtpk(v0[2], v0[3]); w.z = cvtpk(v1[0], v1[1]); w.w = cvtpk(v1[2], v1[3]);
                    *(u32x4*)(rowp + bj * 128) = w; } }
    }
};
struct EpiStoreStats {
    static constexpr bool PERM = true;
    bf16_t* O; int ldc; float* stats;
    __device__ __forceinline__ void operator()(const f32x4 (&acc)[2][2][4][2], const pg8::Unit& u, int wr, int wc, int fr, int fq) const {
        const int row0 = u.arow0 + wr * 64 + fr, col0 = u.pn * 256 + wc * 32 + 8 * fq;
#pragma unroll
        for (int ai = 0; ai < 2; ++ai)
#pragma unroll
            for (int m = 0; m < 4; ++m) { const int row = row0 + ai * 128 + m * 16; bf16_t* rowp = O + (size_t)row * ldc + col0;
#pragma unroll
                for (int bj = 0; bj < 2; ++bj) { const f32x4 v0 = acc[ai][bj][m][0], v1 = acc[ai][bj][m][1];
                    u32x4 w; w.x = cvtpk(v0[0], v0[1]); w.y = cvtpk(v0[2], v0[3]); w.z = cvtpk(v1[0], v1[1]); w.w = cvtpk(v1[2], v1[3]);
                    *(u32x4*)(rowp + bj * 128) = w;
                    float s = (v0[0] * v0[0] + v0[1] * v0[1]) + (v0[2] * v0[2] + v0[3] * v0[3]) + (v1[0] * v1[0] + v1[1] * v1[1]) + (v1[2] * v1[2] + v1[3] * v1[3]);
                    s += __shfl_xor(s, 16); s += __shfl_xor(s, 32);
                    if (fq == 0) stats[(size_t)row * 24 + u.pn * 8 + bj * 4 + wc] = s; } }
    }
};
struct EpiResidual {
    static constexpr bool PERM = false;
    const Frame* F; float* dst; int layer; bool from_input;
    __device__ __forceinline__ void operator()(const f32x4 (&acc)[2][2][4][2], const pg8::Unit& u, int wr, int wc, int fr, int fq) const {
        const int b = u.pm / 9, isctx = (u.pm % 9) == 0, mrow = isctx ? 16 : b;
        const float* gate = mod_ptr(*F, layer, mrow, 2);
        const int col0 = u.pn * 256 + wc * 32 + 4 * fq;
        f32x4 gv[2][2];
#pragma unroll
        for (int bj = 0; bj < 2; ++bj)
#pragma unroll
            for (int n = 0; n < 2; ++n) gv[bj][n] = *(const f32x4*)(gate + col0 + bj * 128 + n * 16);
#pragma unroll
        for (int ai = 0; ai < 2; ++ai)
#pragma unroll
            for (int m = 0; m < 4; ++m) { const int row = u.arow0 + ai * 128 + wr * 64 + m * 16 + fr;
                const float* bp = from_input ? input_row(*F, row) : dst + (size_t)row * DM; float* dp = dst + (size_t)row * DM;
#pragma unroll
                for (int bj = 0; bj < 2; ++bj)
#pragma unroll
                    for (int n = 0; n < 2; ++n) { const int c = col0 + bj * 128 + n * 16; const f32x4 bs = *(const f32x4*)(bp + c);
                        *(f32x4*)(dp + c) = bs + gv[bj][n] * acc[ai][bj][m][n]; } }
    }
};
struct EpiSwiglu {
    static constexpr bool PERM = true;
    bf16_t* O;
    __device__ __forceinline__ void operator()(const f32x4 (&acc)[2][2][4][2], const pg8::Unit& u, int wr, int wc, int fr, int fq) const {
        const int row0 = u.arow0 + wr * 64 + fr, col0 = u.pn * 128 + wc * 32 + 8 * fq;
#pragma unroll
        for (int ai = 0; ai < 2; ++ai)
#pragma unroll
            for (int m = 0; m < 4; ++m) { bf16_t* rowp = O + (size_t)(row0 + ai * 128 + m * 16) * MFF + col0;
                float h[8];
#pragma unroll
                for (int n = 0; n < 2; ++n)
#pragma unroll
                    for (int j = 0; j < 4; ++j) h[n * 4 + j] = siluf_(acc[ai][0][m][n][j]) * acc[ai][1][m][n][j];
                u32x4 w; w.x = cvtpk(h[0], h[1]); w.y = cvtpk(h[2], h[3]); w.z = cvtpk(h[4], h[5]); w.w = cvtpk(h[6], h[7]);
                *(u32x4*)rowp = w; }
    }
};
struct EpiScatter {
    static constexpr bool PERM = true;
    bf16_t* O; const int* perm;
    __device__ __forceinline__ void operator()(const f32x4 (&acc)[2][2][4][2], const pg8::Unit& u, int wr, int wc, int fr, int fq) const {
        const int row0 = u.arow0 + wr * 64 + fr, col0 = u.pn * 256 + wc * 32 + 8 * fq;
#pragma unroll
        for (int ai = 0; ai < 2; ++ai)
#pragma unroll
            for (int m = 0; m < 4; ++m) { const int a = perm[row0 + ai * 128 + m * 16];
                if (a >= 0) { bf16_t* rowp = O + (size_t)a * DM + col0;
#pragma unroll
                    for (int bj = 0; bj < 2; ++bj) { const f32x4 v0 = acc[ai][bj][m][0], v1 = acc[ai][bj][m][1];
                        u32x4 w; w.x = cvtpk(v0[0], v0[1]); w.y = cvtpk(v0[2], v0[3]); w.z = cvtpk(v1[0], v1[1]); w.w = cvtpk(v1[2], v1[3]);
                        *(u32x4*)(rowp + bj * 128) = w; } } }
    }
};
struct EpiQ {
    static constexpr bool PERM = false;
    bf16_t* O; const float* stats;
    __device__ __forceinline__ void operator()(const f32x4 (&acc)[2][2][4][2], const pg8::Unit& u, int wr, int wc, int fr, int fq) const {
        float invf[4]; int fq2 = fq; asm volatile("" : "+v"(fq2));
#pragma unroll
        for (int j = 0; j < 4; ++j) invf[j] = __expf(-(float)(4 * fq2 + j) * (2.0f / 32.0f) * 9.210340371976184f);
#pragma unroll
        for (int ai = 0; ai < 2; ++ai)
#pragma unroll
            for (int m = 0; m < 4; ++m) { const int row = u.arow0 + ai * 128 + wr * 64 + m * 16 + fr;
                const float* st = stats + (size_t)row * 24; float ss = 0.f;
#pragma unroll
                for (int q = 0; q < 3; ++q) { const f32x4 s4 = *(const f32x4*)(st + 4 * q); ss += (s4[0] + s4[1]) + (s4[2] + s4[3]); }
                const float sc = __builtin_amdgcn_rsqf(ss * (1.0f / QRANK) + RMS_EPS) * ATT_C2;
                const int t = (row % PB) - CTXL; const float gr = (float)(t >> 6), gc = (float)(t & 63);
#pragma unroll
                for (int bj = 0; bj < 2; ++bj) { const int cg = u.pn * 256 + bj * 128 + wc * 32; const int within = cg % 192;
                    f32x4 v0 = acc[ai][bj][m][0] * sc, v1 = acc[ai][bj][m][1] * sc;
                    if (within >= 128) { const float p = (within == 128) ? gr : gc;
#pragma unroll
                        for (int j = 0; j < 4; ++j) { const float ang = p * invf[j]; const float cs = __cosf(ang), sn = __sinf(ang);
                            const float x1 = v0[j], x2 = v1[j]; v0[j] = x1 * cs - x2 * sn; v1[j] = x1 * sn + x2 * cs; } }
                    bf16_t* rowp = O + (size_t)row * NQ + cg + 4 * fq;
                    u32x2 w0; w0.x = cvtpk(v0[0], v0[1]); w0.y = cvtpk(v0[2], v0[3]); *(u32x2*)rowp = w0;
                    u32x2 w1; w1.x = cvtpk(v1[0], v1[1]); w1.y = cvtpk(v1[2], v1[3]); *(u32x2*)(rowp + 16) = w1; } }
    }
};
struct EpiKV {
    static constexpr bool PERM = true;
    bf16_t* KBp; bf16_t* VBp; const float* stats;
    __device__ __forceinline__ void operator()(const f32x4 (&acc)[2][2][4][2], const pg8::Unit& u, int wr, int wc, int fr, int fq) const {
        const int h = u.pn, c0 = wc * 32 + 8 * fq;
#pragma unroll
        for (int ai = 0; ai < 2; ++ai)
#pragma unroll
            for (int m = 0; m < 4; ++m) { const int row = u.arow0 + ai * 128 + wr * 64 + m * 16 + fr;
                const float* st = stats + (size_t)row * 24 + 12; const f32x4 s0 = *(const f32x4*)st, s1 = *(const f32x4*)(st + 4);
                const float ss = ((s0[0] + s0[1]) + (s0[2] + s0[3])) + ((s1[0] + s1[1]) + (s1[2] + s1[3]));
                const float sc = __builtin_amdgcn_rsqf(ss * (1.0f / KVRANK) + RMS_EPS);
#pragma unroll
                for (int bj = 0; bj < 2; ++bj) { const f32x4 v0 = acc[ai][bj][m][0] * sc, v1 = acc[ai][bj][m][1] * sc;
                    u32x4 w; w.x = cvtpk(v0[0], v0[1]); w.y = cvtpk(v0[2], v0[3]); w.z = cvtpk(v1[0], v1[1]); w.w = cvtpk(v1[2], v1[3]);
                    bf16_t* p = bj == 0 ? KBp + (size_t)row * NQ + h * 192 + c0 : VBp + (size_t)row * DM + h * 128 + c0;
                    *(u32x4*)p = w; } }
    }
};

__device__ __forceinline__ void tr_item(const float* W, int K, int N, bf16_t* WT, bool gu, const float* kscale, LAS float* scr, int item, int lane) {
    const int nblk = N / 64, kb = item / nblk, nb = item % nblk, k0 = 64 * kb, n0 = 64 * nb;
    f32x4 v[16];
#pragma unroll
    for (int i = 0; i < 16; ++i) v[i] = *(const f32x4*)(W + (size_t)(k0 + 4 * i + (lane >> 4)) * N + n0 + 4 * (lane & 15));
#pragma unroll
    for (int i = 0; i < 16; ++i) { const int kk = 4 * i + (lane >> 4); f32x4 w = v[i]; if (kscale) w = w * kscale[k0 + kk]; LAS float* p = scr + kk * 65 + 4 * (lane & 15); p[0] = w[0]; p[1] = w[1]; p[2] = w[2]; p[3] = w[3]; }
    LDS_WAIT(); asm volatile("" ::: "memory");
    int d0 = n0;
    if (gu) { const int i0 = n0 & 511; d0 = 256 * (i0 >> 7) + (n0 >= 512 ? 128 : 0) + (i0 & 127); }
    const int c = lane & 7;
#pragma unroll
    for (int j = 0; j < 8; ++j) { const int n = (lane >> 3) + 8 * j; const LAS float* sp = scr + (8 * c) * 65 + n;
        u32x4 o; o.x = pk2(sp[0 * 65], sp[1 * 65]); o.y = pk2(sp[2 * 65], sp[3 * 65]); o.z = pk2(sp[4 * 65], sp[5 * 65]); o.w = pk2(sp[6 * 65], sp[7 * 65]);
        *(u32x4*)(WT + (size_t)(d0 + n) * K + k0 + 8 * c) = o; }
    LDS_WAIT(); asm volatile("" ::: "memory");
}
__device__ __forceinline__ void p0_prologue(Frame& F) {
    __syncthreads();

    LAS float* S = (LAS float*)F.lds;
    for (int idx = F.tid; idx < 17 * DM; idx += 512) { const int r = idx >> 10, k = idx & 1023; const float cv = r < 16 ? F.ka->in[I_C][r * DM + k] : F.ka->in[I_CCTX][k]; S[k * 20 + r] = siluf_(cv); }
    __syncthreads();
    const int gw = F.vcu * 8 + F.wave, NGW = F.G * 8;
    float* part = (float*)(F.ws + WS_PART);
    for (int it = gw; it < 2 * 8 * 96; it += NGW) {
        const int l = it / 768, rem = it % 768, kc = rem / 96, slab = rem % 96, n0 = slab * 64;
        const float* w = F.ka->in[I_ADAW] + ((size_t)l * DM + kc * 128) * 6144 + n0 + F.lane;
        float acc[17];
#pragma unroll
        for (int r = 0; r < 17; ++r) acc[r] = 0.f;
#pragma unroll 4
        for (int kk = 0; kk < 128; ++kk) {
            const float wv = w[(size_t)kk * 6144];
            const LAS float* s = S + (kc * 128 + kk) * 20;
            const f32x4 s0 = *(const LAS f32x4*)s, s1 = *(const LAS f32x4*)(s + 4), s2 = *(const LAS f32x4*)(s + 8), s3 = *(const LAS f32x4*)(s + 12); const float s4 = s[16];
            acc[0] += s0[0] * wv; acc[1] += s0[1] * wv; acc[2] += s0[2] * wv; acc[3] += s0[3] * wv;
            acc[4] += s1[0] * wv; acc[5] += s1[1] * wv; acc[6] += s1[2] * wv; acc[7] += s1[3] * wv;
            acc[8] += s2[0] * wv; acc[9] += s2[1] * wv; acc[10] += s2[2] * wv; acc[11] += s2[3] * wv;
            acc[12] += s3[0] * wv; acc[13] += s3[1] * wv; acc[14] += s3[2] * wv; acc[15] += s3[3] * wv; acc[16] += s4 * wv;
        }
#pragma unroll
        for (int r = 0; r < 17; ++r) part[((size_t)(l * 8 + kc) * 17 + r) * 6144 + n0 + F.lane] = acc[r];
    }
    __syncthreads();
    LAS float* scr = (LAS float*)(F.lds + F.wave * 16640);
    constexpr int I_A = 16 * 56, I_B = 16 * 16, I_C2 = 16 * 11, I_D = 6 * 24, I_E = 4 * 32, I_F = 16 * 16, I_GU = 16 * 16, I_DN = 8 * 16;
    constexpr int NITEMS = I_A + I_B + I_C2 + I_D + I_E + I_F + 64 * I_GU + 64 * I_DN;
    for (int it = gw; it < NITEMS; it += NGW) {
        int r = it;
        if (r < I_A) { tr_item(F.ka->in[I_EVWIN], DM, EVIN, (bf16_t*)(F.ws + WS_WIN0), false, nullptr, scr, r, F.lane); continue; } r -= I_A;
        if (r < I_B) { tr_item(F.ka->in[I_EVWOUT], DM, DM, (bf16_t*)(F.ws + WS_WOUT0), false, nullptr, scr, r, F.lane); continue; } r -= I_B;
        if (r < I_C2) { tr_item(F.ka->in[I_ODWIN], DM, CIN, (bf16_t*)(F.ws + WS_WIN1), false, nullptr, scr, r, F.lane); continue; } r -= I_C2;
        if (r < I_D) { tr_item(F.ka->in[I_ODWUQ], QRANK, NQ, (bf16_t*)(F.ws + WS_WUQ), false, F.ka->in[I_ODQG], scr, r, F.lane); continue; } r -= I_D;
        if (r < I_E) { tr_item(F.ka->in[I_ODWUKV], KVRANK, NKV, (bf16_t*)(F.ws + WS_WUKV), false, F.ka->in[I_ODKVG], scr, r, F.lane); continue; } r -= I_E;
        if (r < I_F) { tr_item(F.ka->in[I_ODWOUT], DM, DM, (bf16_t*)(F.ws + WS_WOUT1), false, nullptr, scr, r, F.lane); continue; } r -= I_F;
        if (r < 64 * I_GU) { const int e = r / I_GU; tr_item(F.ka->in[I_MGU] + (size_t)e * DM * 1024, DM, 1024, (bf16_t*)(F.ws + WS_WGU) + (size_t)e * 1024 * DM, true, nullptr, scr, r % I_GU, F.lane); continue; } r -= 64 * I_GU;
        { const int e = r / I_DN; tr_item(F.ka->in[I_MDN] + (size_t)e * MFF * DM, MFF, DM, (bf16_t*)(F.ws + WS_WDN) + (size_t)e * DM * MFF, false, nullptr, scr, r % I_DN, F.lane); }
    }
}
__device__ __forceinline__ void p0b_mod(Frame& F) {
    const float* part = (const float*)(F.ws + WS_PART); float* mod = (float*)(F.ws + WS_MOD);
    const int gt = F.vcu * 512 + F.tid, NGT = F.G * 512;
    for (int idx = gt; idx < 2 * 17 * 6144; idx += NGT) {
        const int l = idx / (17 * 6144), rem = idx % (17 * 6144), r = rem / 6144, n = rem % 6144;
        float s = F.ka->in[I_ADAB][l * 6144 + n];
#pragma unroll
        for (int kc = 0; kc < 8; ++kc) s += part[((size_t)(l * 8 + kc) * 17 + r) * 6144 + n];
        mod[idx] = s;
    }
}

__device__ __forceinline__ void load_row4(const float* p, int lane, f32x4 (&v)[4]) {
#pragma unroll
    for (int j = 0; j < 4; ++j) v[j] = *(const f32x4*)(p + 4 * lane + 256 * j);
}
__device__ __forceinline__ float sumsq4(const f32x4 (&v)[4]) {
    float s = 0.f;
#pragma unroll
    for (int j = 0; j < 4; ++j) s += (v[j][0] * v[j][0] + v[j][1] * v[j][1]) + (v[j][2] * v[j][2] + v[j][3] * v[j][3]);
    return wave_sum(s);
}
__device__ __forceinline__ void norm_mod4(f32x4 (&v)[4], const float* g, const float* shift, const float* scale, int lane) {
    const float rstd = __builtin_amdgcn_rsqf(sumsq4(v) * (1.0f / DM) + RMS_EPS);
#pragma unroll
    for (int j = 0; j < 4; ++j) { const int c = 4 * lane + 256 * j; const f32x4 gg = *(const f32x4*)(g + c), sh = *(const f32x4*)(shift + c), sc = *(const f32x4*)(scale + c);
        v[j] = v[j] * rstd * gg * (sc + 1.0f) + sh; }
}
__device__ __forceinline__ void store_row_bf16(bf16_t* p, int lane, const f32x4 (&v)[4]) {
#pragma unroll
    for (int j = 0; j < 4; ++j) { u32x2 w; w.x = cvtpk(v[j][0], v[j][1]); w.y = cvtpk(v[j][2], v[j][3]); *(u32x2*)(p + 4 * lane + 256 * j) = w; }
}
__device__ __forceinline__ void moe_combine4(Frame& F, int row, int layer, int mrow, f32x4 (&v)[4]) {
    const bf16_t* ys = (const bf16_t*)(F.ws + WS_YS) + (size_t)(2 * row) * DM; const float* aw = (const float*)(F.ws + WS_ROUTE + RT_AW);
    const float w0 = aw[2 * row], w1 = aw[2 * row + 1]; const float* gate = mod_ptr(F, layer, mrow, 5);
#pragma unroll
    for (int j = 0; j < 4; ++j) { const int c = 4 * F.lane + 256 * j; const u32x2 y0 = *(const u32x2*)(ys + c), y1 = *(const u32x2*)(ys + DM + c); const f32x4 gg = *(const f32x4*)(gate + c);
        f32x4 y; y[0] = w0 * bflo(y0.x) + w1 * bflo(y1.x); y[1] = w0 * bfhi(y0.x) + w1 * bfhi(y1.x); y[2] = w0 * bflo(y0.y) + w1 * bflo(y1.y); y[3] = w0 * bfhi(y0.y) + w1 * bfhi(y1.y);
        v[j] = v[j] + gg * y; }
}
__device__ __forceinline__ void p1_norm_input(Frame& F) {
    const int gw = F.vcu * 8 + F.wave, NGW = F.G * 8; bf16_t* hx = (bf16_t*)(F.ws + WS_HX);
    for (int row = gw; row < R; row += NGW) {
        const int b = row / PB, pos = row - b * PB, mrow = pos < CTXL ? 16 : b;
        f32x4 v[4]; load_row4(input_row(F, row), F.lane, v);
        norm_mod4(v, F.ka->in[I_NMIXG], mod_ptr(F, 0, mrow, 0), mod_ptr(F, 0, mrow, 1), F.lane);
        store_row_bf16(hx + (size_t)row * DM, F.lane, v);
    }
}
__device__ __forceinline__ void p8_combine_norm(Frame& F) {
    const int gw = F.vcu * 8 + F.wave, NGW = F.G * 8; bf16_t* hx = (bf16_t*)(F.ws + WS_HX); float* xs = (float*)(F.ws + WS_XS);
    for (int row = gw; row < R; row += NGW) {
        const int b = row / PB, pos = row - b * PB, mrow = pos < CTXL ? 16 : b;
        f32x4 v[4]; load_row4(xs + (size_t)row * DM, F.lane, v);
        moe_combine4(F, row, 0, mrow, v);
#pragma unroll
        for (int j = 0; j < 4; ++j) *(f32x4*)(xs + (size_t)row * DM + 4 * F.lane + 256 * j) = v[j];
        norm_mod4(v, F.ka->in[I_NMIXG] + DM, mod_ptr(F, 1, mrow, 0), mod_ptr(F, 1, mrow, 1), F.lane);
        store_row_bf16(hx + (size_t)row * DM, F.lane, v);
    }
}
__device__ __forceinline__ void p16_final(Frame& F) {
    const int gw = F.vcu * 8 + F.wave, NGW = F.G * 8; const float* xs = (const float*)(F.ws + WS_XS);
    for (int row = gw; row < R; row += NGW) {
        const int b = row / PB, pos = row - b * PB; if (pos < CTXL) continue;
        f32x4 v[4];
        if (DBG_MODE >= 10) {
            const bf16_t* hx = (const bf16_t*)(F.ws + WS_HX) + (size_t)row * DM; const bf16_t* px = (const bf16_t*)(F.ws + WS_PX0) + (size_t)row * EVIN; const bf16_t* mx = (const bf16_t*)(F.ws + WS_MIX) + (size_t)row * DM;
#pragma unroll
            for (int j = 0; j < 4; ++j)
#pragma unroll
                for (int e = 0; e < 4; ++e) { const int c = 4 * F.lane + 256 * j + e;
                    v[j][e] = DBG_MODE == 10 ? bf2f(hx[c]) : DBG_MODE == 11 ? bf2f(px[c]) + bf2f(px[1024 + c]) + bf2f(px[2048 + c]) + bf2f(px[3072 + (c & 511)]) : bf2f(mx[c]); }
        } else load_row4(DBG_MODE == 1 ? input_row(F, row) : xs + (size_t)row * DM, F.lane, v);
        if (DBG_MODE == 0) moe_combine4(F, row, 1, b, v);
        const float rstd = __builtin_amdgcn_rsqf(sumsq4(v) * (1.0f / DM) + RMS_EPS);
        float* o = F.out + ((size_t)b * SEQ + (pos - CTXL)) * DM;
#pragma unroll
        for (int j = 0; j < 4; ++j) { const int c = 4 * F.lane + 256 * j; const f32x4 gg = *(const f32x4*)(F.ka->in[I_FING] + c); *(f32x4*)(o + c) = v[j] * rstd * gg; }
    }
}

template <bool XONLY>
__device__ __forceinline__ void p5_norm_route(Frame& F, int layer) {

    LAS float* W1L = (LAS float*)F.lds; LAS float* W2L = W1L + 4096;
    volatile LAS int* lcnt = (volatile LAS int*)(F.lds + LDSCTL_OFF + 64);
    const float* wr1 = F.ka->in[I_MR1W] + (size_t)layer * DM * 4; const float* wr2 = F.ka->in[I_MR2W] + (size_t)layer * 4 * DM * 8;
    for (int k = F.tid; k < DM; k += 512) { const int l = (k & 255) >> 2, j = k >> 8, e = k & 3; *(LAS f32x4*)(W1L + ((j * 4 + e) * 64 + l) * 4) = *(const f32x4*)(wr1 + k * 4); }
    for (int idx = F.tid; idx < 4 * DM * 2; idx += 512) { const int half = idx & 1, k = (idx >> 1) & 1023, g = idx >> 11; const int l = (k & 255) >> 2, j = k >> 8, e = k & 3;
        *(LAS f32x4*)(W2L + ((((g * 16 + j * 4 + e) * 2 + half) * 64) + l) * 4) = *(const f32x4*)(wr2 + ((size_t)g * DM + k) * 8 + half * 4); }
    if (F.tid < 32) lcnt[F.tid] = 0;
    __syncthreads();
    const int gw = F.vcu * 8 + F.wave, NGW = F.G * 8; bf16_t* hx = (bf16_t*)(F.ws + WS_HX); const float* xs = (const float*)(F.ws + WS_XS);
    int* ae = (int*)(F.ws + WS_ROUTE + RT_AE); int* ap = (int*)(F.ws + WS_ROUTE + RT_AP); float* aw = (float*)(F.ws + WS_ROUTE + RT_AW);
    const float* b1 = F.ka->in[I_MR1B] + layer * 4; const float* b2 = F.ka->in[I_MR2B] + layer * 32;
    for (int row = gw; row < R; row += NGW) {
        const int b = row / PB, pos = row - b * PB; if (XONLY && pos < CTXL) continue;
        const int mrow = pos < CTXL ? 16 : b;
        f32x4 v[4]; load_row4(xs + (size_t)row * DM, F.lane, v);
        norm_mod4(v, F.ka->in[I_NFFNG] + layer * DM, mod_ptr(F, layer, mrow, 3), mod_ptr(F, layer, mrow, 4), F.lane);
        store_row_bf16(hx + (size_t)row * DM, F.lane, v);
        f32x4 l1 = {0.f, 0.f, 0.f, 0.f};
#pragma unroll
        for (int j = 0; j < 4; ++j)
#pragma unroll
            for (int e = 0; e < 4; ++e) l1 += *(const LAS f32x4*)(W1L + ((j * 4 + e) * 64 + F.lane) * 4) * v[j][e];
        float g0 = wave_sum(l1[0]) + b1[0], g1 = wave_sum(l1[1]) + b1[1], g2 = wave_sum(l1[2]) + b1[2], g3 = wave_sum(l1[3]) + b1[3];
        int grp = 0; float gm = g0;
        if (g1 > gm) { gm = g1; grp = 1; } if (g2 > gm) { gm = g2; grp = 2; } if (g3 > gm) { gm = g3; grp = 3; }
        grp = __builtin_amdgcn_readfirstlane(grp);
        const float pg = 1.0f / (__expf(g0 - gm) + __expf(g1 - gm) + __expf(g2 - gm) + __expf(g3 - gm));
        f32x4 la = {0.f, 0.f, 0.f, 0.f}, lb = {0.f, 0.f, 0.f, 0.f};
        const LAS float* w2 = W2L + grp * 16 * 2 * 64 * 4;
#pragma unroll
        for (int j = 0; j < 4; ++j)
#pragma unroll
            for (int e = 0; e < 4; ++e) { const LAS float* p = w2 + (((j * 4 + e) * 2) * 64 + F.lane) * 4; la += *(const LAS f32x4*)p * v[j][e]; lb += *(const LAS f32x4*)(p + 256) * v[j][e]; }
        float lg[8];
#pragma unroll
        for (int q = 0; q < 4; ++q) { lg[q] = wave_sum(la[q]) + b2[grp * 8 + q]; lg[4 + q] = wave_sum(lb[q]) + b2[grp * 8 + 4 + q]; }
        int e0 = 0; float m0 = lg[0];
#pragma unroll
        for (int q = 1; q < 8; ++q) if (lg[q] > m0) { m0 = lg[q]; e0 = q; }
        int e1 = -1; float m1 = -3.0e38f;
#pragma unroll
        for (int q = 0; q < 8; ++q) if (q != e0 && lg[q] > m1) { m1 = lg[q]; e1 = q; }
        const float pb = __expf(m1 - m0), inv = pg / (1.0f + pb);
        if (F.lane < 2) {
            const int ex = grp * 8 + (F.lane == 0 ? e0 : e1);
            const int lp = __hip_atomic_fetch_add((LAS int*)lcnt + ex, 1, __ATOMIC_RELAXED, __HIP_MEMORY_SCOPE_WORKGROUP);
            const int a = 2 * row + F.lane; ae[a] = ex; ap[a] = lp; aw[a] = F.lane == 0 ? inv : inv * pb;
        }
    }
    __syncthreads();
    if (F.tid < 32) ((int*)(F.ws + WS_ROUTE + RT_CNTB))[F.vcu * 32 + F.tid] = lcnt[F.tid];
}
template <bool XONLY>
__device__ __forceinline__ void p5b_perm(Frame& F) {
    LAS int* seg = (LAS int*)F.lds;
    LAS int* mypre = seg + 512;
    LAS int* tot = mypre + 32;
    LAS int* base = tot + 32;
    LAS int* pst = base + 32;
    const int* cntb = (const int*)(F.ws + WS_ROUTE + RT_CNTB);
    { const int e = F.tid & 31, sg = F.tid >> 5; int s = 0, pre = 0;
      for (int i = 0; i < 16; ++i) { const int B = sg * 16 + i; const int c = cntb[B * 32 + e]; if (B < F.vcu) pre += c; s += c; }
      seg[sg * 32 + e] = s; if (sg == (F.vcu >> 4)) mypre[e] = pre; }
    __syncthreads();
    if (F.tid < 32) { int t = 0, bs = 0; for (int sg = 0; sg < 16; ++sg) { const int s = seg[sg * 32 + F.tid]; if (sg < (F.vcu >> 4)) bs += s; t += s; } tot[F.tid] = t; base[F.tid] = bs + mypre[F.tid]; }
    __syncthreads();
    if (F.tid == 0) { int ps = 0; for (int e = 0; e < 32; ++e) { pst[e] = ps; ps += ((tot[e] + 255) >> 8) << 8; } pst[32] = ps; }
    __syncthreads();
    const int gw = F.vcu * 8 + F.wave, NGW = F.G * 8;
    const int* ae = (const int*)(F.ws + WS_ROUTE + RT_AE); const int* ap = (const int*)(F.ws + WS_ROUTE + RT_AP); int* perm = (int*)(F.ws + WS_ROUTE + RT_PERM);
    for (int row = gw; row < R; row += NGW) {
        const int b = row / PB, pos = row - b * PB; if (XONLY && pos < CTXL) continue;
        if (F.lane < 2) { const int a = 2 * row + F.lane; const int e = ae[a]; perm[pst[e] + base[e] + ap[a]] = a; }
    }
    if (F.vcu < 32) { const int e = F.vcu; for (int s = pst[e] + tot[e] + F.tid; s < pst[e + 1]; s += 512) perm[s] = -1; }
    if (F.vcu == 0) { int* blke = (int*)(F.ws + WS_ROUTE + RT_BLKE);
        if (F.tid < 32) { const int e = F.tid; for (int blk = pst[e] >> 8; blk < (pst[e + 1] >> 8); ++blk) blke[blk] = e; }
        if (F.tid == 0) *(int*)(F.ws + WS_ROUTE + RT_NBLK) = pst[32] >> 8; }
}

__device__ __forceinline__ bf16x8 lds_frag256(const LAS unsigned char* base, int row, int chunk) { return *(const LAS bf16x8*)(base + row * 256 + ((chunk ^ (row & 7)) << 4)); }
__device__ __forceinline__ bf16x8 lds_frag128(const LAS unsigned char* base, int row, int chunk) { return *(const LAS bf16x8*)(base + row * 128 + ((chunk ^ (row & 7)) << 4)); }
#define MFMA16(a, b, c) __builtin_amdgcn_mfma_f32_16x16x32_bf16((a), (b), (c), 0, 0, 0)

typedef short v4i16_t __attribute__((ext_vector_type(4)));
__device__ __forceinline__ int trswz256(int r, int cb) { return r * 256 + (cb ^ (((r & 3) | ((r >> 1) & 4)) << 5)); }
__device__ __forceinline__ int trswz128(int r, int cb) { return r * 128 + (cb ^ ((((r >> 1) & 1) | ((r >> 2) & 2)) << 5)); }
template <int ROWB> __device__ __forceinline__ bf16x8 lds_trfrag(const LAS unsigned char* tile, int s0, int c0, int lane) {
    const int i = lane & 15, r0 = s0 + (i >> 2), r1 = r0 + 4, cb = (c0 + 4 * (i & 3)) * 2;
    const int a0 = ROWB == 256 ? trswz256(r0, cb) : trswz128(r0, cb), a1 = ROWB == 256 ? trswz256(r1, cb) : trswz128(r1, cb);
    const v4i16_t lo = __builtin_amdgcn_ds_read_tr16_b64_v4i16((LAS v4i16_t*)(tile + a0)), hi = __builtin_amdgcn_ds_read_tr16_b64_v4i16((LAS v4i16_t*)(tile + a1));
    return (bf16x8){lo[0], lo[1], lo[2], lo[3], hi[0], hi[1], hi[2], hi[3]};
}
__device__ __forceinline__ void gla_item(Frame& F, int item) {
    const int b = item >> 4, h = (item >> 2) & 3, dir = (item >> 1) & 1, vh = item & 1;
    LAS unsigned char* QD = F.lds; LAS unsigned char* KD = F.lds + 16384; LAS unsigned char* KT = F.lds + 32768  ; LAS unsigned char* VR = F.lds + 49152  ;
    LAS unsigned char* PS = F.lds + 57344; LAS unsigned char* ST = F.lds + 65536; LAS float* LF = (LAS float*)(F.lds + 81920); LAS float* SEGT = (LAS float*)(F.lds + 114688); LAS float* DEC = (LAS float*)(F.lds + 116736);
    const int tid = F.tid, lane = F.lane, wave = F.wave, fr = lane & 15, fq = lane >> 4;
    const int t0 = tid >> 4, c = tid & 15, tv = tid >> 3, cv = tid & 7;
    const bf16_t* px = (const bf16_t*)(F.ws + WS_PX0);
    bf16_t* og = (bf16_t*)(F.ws + WS_OG) + (size_t)dir * R * 512;
    float lbv[8], oml[8];
    { const float* lg = F.ka->in[I_EVLB] + h * 128 + 8 * c;
#pragma unroll
      for (int e = 0; e < 8; ++e) { lbv[e] = 1.0f / (1.0f + __expf(lg[512 + e] - lg[e])); oml[e] = 1.0f - lbv[e]; } }
    { u32x4 z = {0u, 0u, 0u, 0u}; *(LAS u32x4*)(ST + tid * 32) = z; *(LAS u32x4*)(ST + tid * 32 + 16) = z; }
    f32x4 S[4];
#pragma unroll
    for (int i = 0; i < 4; ++i) S[i] = (f32x4){0.f, 0.f, 0.f, 0.f};
    auto chunk_p0 = [&](int j) { return dir == 0 ? 64 * j : (j < 4 ? 192 - 64 * j : PB - 64 * (j - 3)); };
    auto row_of = [&](int p0, int tau) { return b * PB + (dir == 0 ? p0 + tau : p0 + 63 - tau); };
    u32x4 rqA[2], rfA[2], rvA, rqB[2], rfB[2], rvB;
#define GLA_LOAD(j, RQ, RF, RV) do { const int p0_ = chunk_p0(j); \
        _Pragma("unroll") for (int i_ = 0; i_ < 2; ++i_) { const bf16_t* rp_ = px + (size_t)row_of(p0_, t0 + 32 * i_) * EVIN + h * 128 + 8 * c; RQ[i_] = *(const u32x4*)rp_; RF[i_] = *(const u32x4*)(rp_ + 512 * (1 + dir)); } \
        RV = *(const u32x4*)(px + (size_t)row_of(p0_, tv) * EVIN + 1536 + h * 128 + vh * 64 + 8 * cv); } while (0)
    GLA_LOAD(0, rqA, rfA, rvA); GLA_LOAD(1, rqB, rfB, rvB);
    __syncthreads();
    const int ti = wave & 3, sp = wave >> 2, ki = wave;
#define GLA_STEP(j, RQ, RF, RV) do { \
        const int p0 = chunk_p0(j); float qv[2][8], kv[2][8]; const u32x4 vraw = RV; \
        _Pragma("unroll") for (int i = 0; i < 2; ++i) { const int tau = t0 + 32 * i; float lf[8]; \
            _Pragma("unroll") for (int e = 0; e < 4; ++e) { const unsigned wq = RQ[i][e], wf = RF[i][e]; \
                qv[i][2 * e] = bflo(wq); qv[i][2 * e + 1] = bfhi(wq); \
                const float s0_ = sigmoidf_(bflo(wf)), s1_ = sigmoidf_(bfhi(wf)); \
                const float f0 = lbv[2 * e] + oml[2 * e] * s0_, f1 = lbv[2 * e + 1] + oml[2 * e + 1] * s1_; \
                kv[i][2 * e] = 1.0f - f0; kv[i][2 * e + 1] = 1.0f - f1; lf[2 * e] = lg2(f0); lf[2 * e + 1] = lg2(f1); } \
            *(LAS f32x4*)(LF + tau * 128 + 8 * c) = (f32x4){lf[0], lf[1], lf[2], lf[3]}; *(LAS f32x4*)(LF + tau * 128 + 8 * c + 4) = (f32x4){lf[4], lf[5], lf[6], lf[7]}; } \
        if ((j) + 2 < 36) GLA_LOAD((j) + 2, RQ, RF, RV); \
        __syncthreads(); \
        { const int k = tid & 127, sg = tid >> 7; float run = 0.f; \
          _Pragma("unroll") for (int i = 0; i < 16; ++i) { const int idx = (16 * sg + i) * 128 + k; run += LF[idx]; LF[idx] = run; } \
          SEGT[sg * 128 + k] = run; } \
        __syncthreads(); \
        { float seg[4][8]; float ebl[8]; \
          _Pragma("unroll") for (int s = 0; s < 4; ++s) { const f32x4 a0 = *(const LAS f32x4*)(SEGT + s * 128 + 8 * c), a1 = *(const LAS f32x4*)(SEGT + s * 128 + 8 * c + 4); \
              _Pragma("unroll") for (int e = 0; e < 4; ++e) { seg[s][e] = a0[e]; seg[s][4 + e] = a1[e]; } } \
          float offr[2][8]; const bool odd = (t0 >> 4) != 0; \
          _Pragma("unroll") for (int e = 0; e < 8; ++e) { ebl[e] = ex2((seg[0][e] + seg[1][e]) + (seg[2][e] + seg[3][e])); offr[0][e] = odd ? seg[0][e] : 0.f; offr[1][e] = (seg[0][e] + seg[1][e]) + (odd ? seg[2][e] : 0.f); } \
          _Pragma("unroll") for (int i = 0; i < 2; ++i) { const int tau = t0 + 32 * i; \
              const f32x4 c0 = *(const LAS f32x4*)(LF + tau * 128 + 8 * c), c1 = *(const LAS f32x4*)(LF + tau * 128 + 8 * c + 4); \
              float qd[8], kd[8], kt[8]; \
              _Pragma("unroll") for (int e = 0; e < 8; ++e) { \
                  const float bb = (e < 4 ? c0[e] : c1[e - 4]) + offr[i][e]; const float eb = ex2(bb); \
                  qd[e] = qv[i][e] * eb; kd[e] = kv[i][e] * __builtin_amdgcn_rcpf(eb); kt[e] = kd[e] * ebl[e]; } \
              u32x4 w; w.x = cvtpk(qd[0], qd[1]); w.y = cvtpk(qd[2], qd[3]); w.z = cvtpk(qd[4], qd[5]); w.w = cvtpk(qd[6], qd[7]); \
              *(LAS u32x4*)(QD + tau * 256 + ((c ^ (tau & 7)) << 4)) = w; \
              w.x = cvtpk(kd[0], kd[1]); w.y = cvtpk(kd[2], kd[3]); w.z = cvtpk(kd[4], kd[5]); w.w = cvtpk(kd[6], kd[7]); \
              *(LAS u32x4*)(KD + tau * 256 + ((c ^ (tau & 7)) << 4)) = w; \
              w.x = cvtpk(kt[0], kt[1]); w.y = cvtpk(kt[2], kt[3]); w.z = cvtpk(kt[4], kt[5]); w.w = cvtpk(kt[6], kt[7]); \
              *(LAS u32x4*)(KT + trswz256(tau, 16 * c)) = w; } \
          *(LAS u32x4*)(VR + trswz128(tv, 16 * cv)) = vraw; \
          if (tid < 128) DEC[tid] = ex2((SEGT[tid] + SEGT[128 + tid]) + (SEGT[256 + tid] + SEGT[384 + tid])); } \
        __syncthreads(); \
        bf16x8 bq[4]; \
        _Pragma("unroll") for (int ks = 0; ks < 4; ++ks) bq[ks] = lds_frag256(QD, 16 * ti + fr, ks * 4 + fq); \
        f32x4 oacc[2]; \
        _Pragma("unroll") for (int u = 0; u < 2; ++u) { const int si = 2 * sp + u; f32x4 a = {0.f, 0.f, 0.f, 0.f}; \
            _Pragma("unroll") for (int ks = 0; ks < 4; ++ks) a = MFMA16(lds_frag256(KD, 16 * si + fr, ks * 4 + fq), bq[ks], a); \
            const int tt = 16 * ti + fr, s0 = 16 * si + 4 * fq; \
            u32x2 w; w.x = cvtpk(s0 <= tt ? a[0] : 0.f, s0 + 1 <= tt ? a[1] : 0.f); w.y = cvtpk(s0 + 2 <= tt ? a[2] : 0.f, s0 + 3 <= tt ? a[3] : 0.f); \
            *(LAS u32x2*)(PS + tt * 128 + ((2 * s0) ^ ((tt & 7) << 4))) = w; \
            const int vi = 2 * sp + u; f32x4 o = {0.f, 0.f, 0.f, 0.f}; \
            _Pragma("unroll") for (int ks = 0; ks < 4; ++ks) o = MFMA16(lds_frag256(ST, 16 * vi + fr, ks * 4 + fq), bq[ks], o); \
            oacc[u] = o; } \
        bf16x8 vfr[4][2]; \
        _Pragma("unroll") for (int vi = 0; vi < 4; ++vi) _Pragma("unroll") for (int ks = 0; ks < 2; ++ks) vfr[vi][ks] = lds_trfrag<128>(VR, 32 * ks + 8 * fq, 16 * vi, lane); \
        { const f32x4 dk = *(const LAS f32x4*)(DEC + 16 * ki + 4 * fq); \
          bf16x8 ak[2]; \
          _Pragma("unroll") for (int ks = 0; ks < 2; ++ks) ak[ks] = lds_trfrag<256>(KT, 32 * ks + 8 * fq, 16 * ki, lane); \
          _Pragma("unroll") for (int vi = 0; vi < 4; ++vi) { f32x4 s = S[vi] * dk; \
              _Pragma("unroll") for (int ks = 0; ks < 2; ++ks) s = MFMA16(ak[ks], vfr[vi][ks], s); \
              S[vi] = s; } } \
        __syncthreads(); \
        { bf16x8 bp[2]; \
          _Pragma("unroll") for (int ks = 0; ks < 2; ++ks) bp[ks] = lds_frag128(PS, 16 * ti + fr, ks * 4 + fq); \
          const int orow = row_of(p0, 16 * ti + fr); \
          _Pragma("unroll") for (int u = 0; u < 2; ++u) { const int vi = 2 * sp + u; f32x4 o = oacc[u]; \
              _Pragma("unroll") for (int ks = 0; ks < 2; ++ks) o = MFMA16(sp == 0 ? vfr[u][ks] : vfr[2 + u][ks], bp[ks], o); \
              u32x2 w; w.x = cvtpk(o[0], o[1]); w.y = cvtpk(o[2], o[3]); \
              *(u32x2*)(og + (size_t)orow * 512 + h * 128 + vh * 64 + 16 * vi + 4 * fq) = w; } \
          _Pragma("unroll") for (int vi = 0; vi < 4; ++vi) { const int v = 16 * vi + fr, k0 = 16 * ki + 4 * fq; u32x2 w; w.x = cvtpk(S[vi][0], S[vi][1]); w.y = cvtpk(S[vi][2], S[vi][3]); \
              *(LAS u32x2*)(ST + v * 256 + ((2 * k0) ^ ((v & 7) << 4))) = w; } } \
    } while (0)
    for (int j = 0; j < 36; j += 2) { GLA_STEP(j, rqA, rfA, rvA); GLA_STEP(j + 1, rqB, rfB, rvB); }
    __syncthreads();
#undef GLA_LOAD
#undef GLA_STEP
}

__device__ __forceinline__ void sgu_item(Frame& F, int ci) {
    LAS unsigned char* VNT = F.lds; LAS unsigned char* WS = F.lds + 32768;
    const int tid = F.tid, lane = F.lane, wave = F.wave, fr = lane & 15, fq = lane >> 4;
    const int r0 = ci * 128, row = tid >> 2, q = tid & 3;
    const bf16_t* px = (const bf16_t*)(F.ws + WS_PX0); bf16_t* mix = (bf16_t*)(F.ws + WS_MIX);
    const bf16_t* vrow = px + (size_t)(r0 + row) * EVIN + 3072;
    float sum = 0.f, sq = 0.f;
#pragma unroll 4
    for (int i = 0; i < 16; ++i) { const u32x4 w = *(const u32x4*)(vrow + 128 * q + 8 * i);
#pragma unroll
        for (int e = 0; e < 4; ++e) { const float a = geluf_(bflo(w[e])), bb = geluf_(bfhi(w[e])); sum += a + bb; sq += a * a + bb * bb; } }
    sum += __shfl_xor(sum, 1); sum += __shfl_xor(sum, 2); sq += __shfl_xor(sq, 1); sq += __shfl_xor(sq, 2);
    const float mean = sum * (1.0f / 512.0f), rstd = __builtin_amdgcn_rsqf(fmaxf(sq * (1.0f / 512.0f) - mean * mean, 0.f) + RMS_EPS);
    for (int g = 0; g < 4; ++g) {
        const float* gain = F.ka->in[I_EVSGUG] + 128 * g + 32 * q;
#pragma unroll
        for (int i = 0; i < 4; ++i) { const u32x4 w = *(const u32x4*)(vrow + 128 * g + 32 * q + 8 * i);
#pragma unroll
            for (int e = 0; e < 4; ++e) { const int cl = 32 * q + 8 * i + 2 * e;
                const float a = (geluf_(bflo(w[e])) - mean) * rstd * gain[8 * i + 2 * e], bb = (geluf_(bfhi(w[e])) - mean) * rstd * gain[8 * i + 2 * e + 1];
                *(LAS unsigned short*)(VNT + cl * 256 + ((2 * row) ^ ((cl & 7) << 4))) = (unsigned short)f2bf(a);
                *(LAS unsigned short*)(VNT + (cl + 1) * 256 + ((2 * row) ^ (((cl + 1) & 7) << 4))) = (unsigned short)f2bf(bb); } }
        const float* wsg = F.ka->in[I_EVWS] + (size_t)g * 128 * 128;
#pragma unroll
        for (int it = 0; it < 4; ++it) { const int idx = tid + 512 * it, t = idx >> 4, ch = idx & 15; const f32x4 a = *(const f32x4*)(wsg + t * 128 + 8 * ch), bb = *(const f32x4*)(wsg + t * 128 + 8 * ch + 4);
            u32x4 w; w.x = cvtpk(a[0], a[1]); w.y = cvtpk(a[2], a[3]); w.z = cvtpk(bb[0], bb[1]); w.w = cvtpk(bb[2], bb[3]);
            *(LAS u32x4*)(WS + t * 256 + ((ch ^ (t & 7)) << 4)) = w; }
        __syncthreads();
        bf16x8 av[4];
#pragma unroll
        for (int ks = 0; ks < 4; ++ks) av[ks] = lds_frag256(VNT, 16 * wave + fr, ks * 4 + fq);
#pragma unroll 2
        for (int tt = 0; tt < 8; ++tt) { f32x4 a = {0.f, 0.f, 0.f, 0.f};
#pragma unroll
            for (int ks = 0; ks < 4; ++ks) a = MFMA16(av[ks], lds_frag256(WS, 16 * tt + fr, ks * 4 + fq), a);
            const int t = 16 * tt + fr, c0 = 128 * g + 16 * wave + 4 * fq; const float bs = F.ka->in[I_EVBS][g * 128 + t];
            const u32x2 uw = *(const u32x2*)(px + (size_t)(r0 + t) * EVIN + 2560 + c0);
            u32x2 w; w.x = cvtpk(geluf_(bflo(uw.x)) * (a[0] + bs), geluf_(bfhi(uw.x)) * (a[1] + bs)); w.y = cvtpk(geluf_(bflo(uw.y)) * (a[2] + bs), geluf_(bfhi(uw.y)) * (a[3] + bs));
            *(u32x2*)(mix + (size_t)(r0 + t) * DM + 512 + c0) = w; }
        __syncthreads();
    }
}
__device__ __forceinline__ void p3_mixers(Frame& F) {
    for (int rep_ = 0; rep_ < 1 + ((REPMASK >> 21) & 1); ++rep_)
    for (int it = F.vcu; it < 256; it += F.G) gla_item(F, it);
    { int t = threadIdx.x; asm volatile("" : "+v"(t)); F.tid = t; F.lane = t & 63; F.wave = __builtin_amdgcn_readfirstlane(t >> 6); }
    for (int rep_ = 0; rep_ < 1 + ((REPMASK >> 22) & 1); ++rep_)
    for (int ci = F.vcu; ci < R / 128; ci += F.G) sgu_item(F, ci);
}
__device__ __forceinline__ void p3b_hgrn_out(Frame& F) {
    const int gw = F.vcu * 8 + F.wave, NGW = F.G * 8; const bf16_t* og = (const bf16_t*)(F.ws + WS_OG); const bf16_t* px = (const bf16_t*)(F.ws + WS_PX0); bf16_t* mix = (bf16_t*)(F.ws + WS_MIX);
    const int c0 = 8 * F.lane; float gn[8];
#pragma unroll
    for (int e = 0; e < 8; ++e) gn[e] = F.ka->in[I_EVONORM][(c0 & 127) + e];
    for (int row = gw; row < R; row += NGW) {
        const u32x4 a = *(const u32x4*)(og + (size_t)row * 512 + c0), bb = *(const u32x4*)(og + (size_t)(R + row) * 512 + c0), gg = *(const u32x4*)(px + (size_t)row * EVIN + 2048 + c0);
        float o[8]; float ss = 0.f;
#pragma unroll
        for (int e = 0; e < 4; ++e) { o[2 * e] = bflo(a[e]) + bflo(bb[e]); o[2 * e + 1] = bfhi(a[e]) + bfhi(bb[e]); ss += o[2 * e] * o[2 * e] + o[2 * e + 1] * o[2 * e + 1]; }
        ss += __shfl_xor(ss, 1); ss += __shfl_xor(ss, 2); ss += __shfl_xor(ss, 4); ss += __shfl_xor(ss, 8);
        const float rstd = __builtin_amdgcn_rsqf(ss * (1.0f / 128.0f) + RMS_EPS);
        u32x4 w;
#pragma unroll
        for (int e = 0; e < 4; ++e) w[e] = cvtpk(o[2 * e] * rstd * gn[2 * e] * siluf_(bflo(gg[e])), o[2 * e + 1] * rstd * gn[2 * e + 1] * siluf_(bfhi(gg[e])));
        *(u32x4*)(mix + (size_t)row * DM + c0) = w;
    }
}

__device__ __forceinline__ void p10_kr(Frame& F) {
    const int gw = F.vcu * 8 + F.wave, NGW = F.G * 8; const bf16_t* px1 = (const bf16_t*)(F.ws + WS_PX1); bf16_t* kb = (bf16_t*)(F.ws + WS_KB);
    const int d = F.lane, i16 = d & 15; const float invf = __expf(-(float)i16 * (2.0f / 32.0f) * 9.210340371976184f);
    for (int row = gw; row < R; row += NGW) {
        const int pos = row % PB; float x = bf2f(px1[(size_t)row * CINP + 640 + d]);
        const float xo = __shfl_xor(x, 16);
        if (pos >= CTXL) { const int t = pos - CTXL; const float p = (d < 32) ? (float)(t >> 6) : (float)(t & 63); const float ang = p * invf, cs = __cosf(ang), sn = __sinf(ang);
            x = (d & 16) ? (xo * sn + x * cs) : (x * cs - xo * sn); }
        const unsigned short hb = (unsigned short)f2bf(x);
#pragma unroll
        for (int h = 0; h < 8; ++h) kb[(size_t)row * NQ + h * 192 + 128 + d] = hb;
    }
}

namespace att {
constexpr int KVBLK = 64, SHM_V = 64 * 128 * 2, SHM_K = 64 * 192 * 2;
constexpr float THR = 8.0f * 1.4426950408889634f;
#define KSWZ192(row, colB) ((row) * 384 + ((colB) ^ (((row) & 7) << 4)))
__device__ __forceinline__ int crow(int r, int hi) { return (r & 3) + 8 * (r >> 2) + 4 * hi; }
__device__ __forceinline__ void partialSM(f32x16& p0, f32x16& p1, float& m_reg, float& mn, float& alpha) {
    float pmax = p0[0];
#pragma unroll
    for (int r = 1; r < 16; ++r) pmax = fmaxf(pmax, p0[r]);
#pragma unroll
    for (int r = 0; r < 16; ++r) pmax = fmaxf(pmax, p1[r]);
    { auto rr = __builtin_amdgcn_permlane32_swap(__float_as_uint(pmax), __float_as_uint(pmax), false, false); pmax = fmaxf(__uint_as_float(rr[0]), __uint_as_float(rr[1])); }
    if (__builtin_expect(__all(pmax - m_reg <= THR), 1)) { mn = m_reg; alpha = 1.f; }
    else { mn = fmaxf(m_reg, pmax); alpha = __builtin_amdgcn_exp2f(m_reg - mn); m_reg = mn; }
#pragma unroll
    for (int r = 0; r < 16; ++r) p0[r] = p0[r] - mn;
#pragma unroll
    for (int r = 0; r < 16; ++r) p1[r] = p1[r] - mn;
#pragma unroll
    for (int r = 0; r < 16; ++r) p0[r] = __builtin_amdgcn_exp2f(p0[r]);
}
__device__ __forceinline__ void finishSM(f32x16& p0, f32x16& p1, float alpha, float& l_reg, bf16x8& pa0, bf16x8& pa1, bf16x8& pa2, bf16x8& pa3) {
#pragma unroll
    for (int r = 0; r < 16; ++r) p1[r] = __builtin_amdgcn_exp2f(p1[r]);
    float ps = 0;
#pragma unroll
    for (int r = 0; r < 16; ++r) ps += p0[r];
#pragma unroll
    for (int r = 0; r < 16; ++r) ps += p1[r];
    { auto rr = __builtin_amdgcn_permlane32_swap(__float_as_uint(ps), __float_as_uint(ps), false, false); ps = __uint_as_float(rr[0]) + __uint_as_float(rr[1]); }
    l_reg = l_reg * alpha + ps;
#define PK4(P, BASE, OUT) do { unsigned a0 = cvtpk(P[BASE + 0], P[BASE + 1]), a1 = cvtpk(P[BASE + 2], P[BASE + 3]);   \
    unsigned b0 = cvtpk(P[BASE + 4], P[BASE + 5]), b1 = cvtpk(P[BASE + 6], P[BASE + 7]);                              \
    auto r0 = __builtin_amdgcn_permlane32_swap(a0, b0, false, false); auto r1 = __builtin_amdgcn_permlane32_swap(a1, b1, false, false); \
    u32x4 w = {r0[0], r1[0], r0[1], r1[1]}; OUT = *reinterpret_cast<bf16x8*>(&w); } while (0)
    PK4(p0, 0, pa0); PK4(p0, 8, pa1); PK4(p1, 0, pa2); PK4(p1, 8, pa3);
#undef PK4
}
__device__ __forceinline__ void qkt(f32x16& p0, f32x16& p1, const LAS unsigned char* const (&kb)[4], const int boff, const bf16x8* qr) {
    p0 = f32x16{}; p1 = f32x16{};
#pragma unroll
    for (int m = 0; m < 3; ++m) {
#pragma unroll
        for (int r = 0; r < 4; ++r) { const int d0 = 4 * m + r;
            const bf16x8 b0 = *(const LAS bf16x8*)(kb[r] + boff + m * 128);
            const bf16x8 b1 = *(const LAS bf16x8*)(kb[r] + boff + m * 128 + 12288);
            p0 = __builtin_amdgcn_mfma_f32_32x32x16_bf16(b0, qr[d0], p0, 0, 0, 0);
            p1 = __builtin_amdgcn_mfma_f32_32x32x16_bf16(b1, qr[d0], p1, 0, 0, 0); }
        SBAR(); }
}
__device__ __forceinline__ int v_st(int k, int c) { const int kk = (k & ~0xC) | ((k & 4) << 1) | ((k & 8) >> 1); return ((kk >> 3) * 4 + (c >> 5)) * 512 + ((kk & 7) * 32 + (c & 31)) * 2; }
__device__ __forceinline__ int v_rd_base(int lane) { return ((lane & 3) << 3) | (((lane >> 2) & 3) << 6) | (((lane >> 4) & 1) << 5) | (((lane >> 5) & 1) << 8); }
constexpr int v_rd_off(int d0, int ks, int half) { return d0 * 512 + ks * 4096 + half * 2048; }
template <int OFF> __device__ __forceinline__ s16x4 tr_read(int vb) { s16x4 r; asm volatile("ds_read_b64_tr_b16 %0, %1 offset:%2" : "=&v"(r) : "v"(vb), "i"(OFF) : "memory"); return r; }
template <int D0> __device__ __forceinline__ void pv_one(f32x16& od, int vb, bf16x8 pa0, bf16x8 pa1, bf16x8 pa2, bf16x8 pa3) {
    const s16x4 l0 = tr_read<v_rd_off(D0, 0, 0)>(vb), h0 = tr_read<v_rd_off(D0, 0, 1)>(vb), l1 = tr_read<v_rd_off(D0, 1, 0)>(vb), h1 = tr_read<v_rd_off(D0, 1, 1)>(vb);
    const s16x4 l2 = tr_read<v_rd_off(D0, 2, 0)>(vb), h2 = tr_read<v_rd_off(D0, 2, 1)>(vb), l3 = tr_read<v_rd_off(D0, 3, 0)>(vb), h3 = tr_read<v_rd_off(D0, 3, 1)>(vb);
    asm volatile("s_waitcnt lgkmcnt(0)" ::: "memory"); SBAR();
#define PK(L, H) (bf16x8){L[0], L[1], L[2], L[3], H[0], H[1], H[2], H[3]}
    od = __builtin_amdgcn_mfma_f32_32x32x16_bf16(pa0, PK(l0, h0), od, 0, 0, 0);
    od = __builtin_amdgcn_mfma_f32_32x32x16_bf16(pa1, PK(l1, h1), od, 0, 0, 0);
    od = __builtin_amdgcn_mfma_f32_32x32x16_bf16(pa2, PK(l2, h2), od, 0, 0, 0);
    od = __builtin_amdgcn_mfma_f32_32x32x16_bf16(pa3, PK(l3, h3), od, 0, 0, 0);
#undef PK
}
__device__ __forceinline__ void pv_d0(f32x16* o, int vb, bf16x8 pa0, bf16x8 pa1, bf16x8 pa2, bf16x8 pa3) {
    pv_one<0>(o[0], vb, pa0, pa1, pa2, pa3); pv_one<1>(o[1], vb, pa0, pa1, pa2, pa3); pv_one<2>(o[2], vb, pa0, pa1, pa2, pa3); pv_one<3>(o[3], vb, pa0, pa1, pa2, pa3);
}
constexpr int NSLOT = 3, LDS_KR = NSLOT * SHM_V  , LDS_WS = NSLOT * (SHM_V + SHM_K);
__device__ __forceinline__ void attn_unit(const int tid, const bf16_t* __restrict__ Qb, const bf16_t* __restrict__ Kh, const bf16_t* __restrict__ Vh, bf16_t* __restrict__ Ob, LAS unsigned char* lds) {
    const int wid = __builtin_amdgcn_readfirstlane(tid >> 6), lane = tid & 63, r32 = lane & 31, hi = lane >> 5;
    LAS unsigned char* V_lds = lds; LAS unsigned char* K_lds = lds + LDS_KR;
    LAS float* ws = (LAS float*)(lds + LDS_WS) + wid * 64; LAS float* li_l = ws; LAS float* al_l = ws + 32;
    float m_reg = -1e30f, l_reg = 0; f32x16 o[4] = {}; bf16x8 qr[12];
    const bf16_t* Qw = Qb + (size_t)(wid * 32 + r32) * NQ + hi * 8;
#pragma unroll
    for (int d0 = 0; d0 < 12; ++d0) qr[d0] = *(const bf16x8*)(Qw + d0 * 16);
    unsigned kgo[3], vgo[2];
#pragma unroll
    for (int i = 0; i < 3; ++i) { const int q = (3 * wid + i) * 64 + lane, row = q / 24, chp = q % 24, ch = (chp & ~7) | ((chp ^ row) & 7); kgo[i] = (unsigned)(row * NQ + ch * 8) * 2u; }
#pragma unroll
    for (int i = 0; i < 2; ++i) { const int q = (2 * wid + i) * 64 + lane, st = q >> 5, wi = q & 31, kk = (st >> 2) * 8 + (wi >> 2), cc = (st & 3) * 32 + (wi & 3) * 8, k = (kk & ~0xC) | ((kk & 4) << 1) | ((kk & 8) >> 1); vgo[i] = (unsigned)(k * DM + cc) * 2u; }
    const int vb0 = (int)(uintptr_t)V_lds + v_rd_base(lane);
    const LAS unsigned char* kb[4];
#pragma unroll
    for (int r = 0; r < 4; ++r) kb[r] = K_lds + r32 * 384 + ((r * 32 + hi * 16) ^ ((r32 & 7) << 4));
#define DMA_K(t, slot) do { const char* kt_ = (const char*)Kh + (size_t)(t) * KVBLK * NQ * 2; _Pragma("unroll") for (int i_ = 0; i_ < 3; ++i_) \
    __builtin_amdgcn_global_load_lds((const unsigned*)(kt_ + kgo[i_]), (LAS unsigned*)(K_lds + (slot) * SHM_K + (3 * wid + i_) * 1024), 16, 0, 0); } while (0)
#define DMA_V(t, slot) do { const char* vt_ = (const char*)Vh + (size_t)(t) * KVBLK * DM * 2; _Pragma("unroll") for (int i_ = 0; i_ < 2; ++i_) \
    __builtin_amdgcn_global_load_lds((const unsigned*)(vt_ + vgo[i_]), (LAS unsigned*)(V_lds + (slot) * SHM_V + (2 * wid + i_) * 1024), 16, 0, 0); } while (0)
    const LAS float* al_hi = al_l + 4 * hi;
#define RESC(a) do { if (__any((a) < 1.f)) { if (hi == 0) al_l[r32] = (a); asm volatile("s_waitcnt lgkmcnt(0)" ::: "memory"); \
    _Pragma("unroll") for (int d_ = 0; d_ < 4; ++d_) _Pragma("unroll") for (int r_ = 0; r_ < 16; ++r_) o[d_][r_] *= al_hi[crow(r_, 0)]; } } while (0)
#define WAITBAR() do { asm volatile("s_waitcnt vmcnt(0)" ::: "memory"); __syncthreads(); } while (0)
    f32x16 pA0, pA1, pB0, pB1; float mnA, mnB, alA, alB; bf16x8 pa0, pa1, pa2, pa3; constexpr int NT = PB / KVBLK;
    int s0 = 0, s1 = 1, s2 = 2;
    DMA_K(0, 0); DMA_V(0, 0); DMA_K(1, 1); WAITBAR();
    DMA_K(2, 2); DMA_V(1, 1);
    qkt(pA0, pA1, kb, 0, qr); partialSM(pA0, pA1, m_reg, mnA, alA); RESC(alA);
    WAITBAR();
#define STEP(PC0, PC1, mnC, alC, PP0, PP1, alP, t) do { \
        { const int tmp_ = s0; s0 = s1; s1 = s2; s2 = tmp_; }              \
        SBAR(); \
        if ((t) + 2 < NT) DMA_K((t) + 2, s2);                               \
        qkt(PC0, PC1, kb, s0 * SHM_K, qr); \
        finishSM(PP0, PP1, alP, l_reg, pa0, pa1, pa2, pa3); SBAR(); \
        pv_d0(o, vb0 + s2 * SHM_V, pa0, pa1, pa2, pa3);                     \
        partialSM(PC0, PC1, m_reg, mnC, alC); \
        RESC(alC); \
        WAITBAR(); \
        if ((t) + 1 < NT) DMA_V((t) + 1, s1);                               \
    } while (0)
    for (int t = 1; t + 1 < NT; t += 2) {
        STEP(pB0, pB1, mnB, alB, pA0, pA1, alA, t);
        STEP(pA0, pA1, mnA, alA, pB0, pB1, alB, t + 1);
    }
    STEP(pB0, pB1, mnB, alB, pA0, pA1, alA, NT - 1);
    { const int tmp_ = s0; s0 = s1; s1 = s2; s2 = tmp_; }
    finishSM(pB0, pB1, alB, l_reg, pa0, pa1, pa2, pa3); SBAR();
    pv_d0(o, vb0 + s2 * SHM_V, pa0, pa1, pa2, pa3);
    if (hi == 0) li_l[r32] = l_reg; asm volatile("s_waitcnt lgkmcnt(0)" ::: "memory");
    __syncthreads();
    int lane2 = threadIdx.x & 63; asm volatile("" : "+v"(lane2));
    const int hi2 = lane2 >> 5, r322 = lane2 & 31;
    LAS bf16_t* stg = (LAS bf16_t*)(lds + wid * 8192);
    LAS bf16_t* stg_l = stg + 4 * hi2 * 128 + r322; const LAS float* li_hi = li_l + 4 * hi2;
#pragma unroll
    for (int r = 0; r < 16; ++r) { const float rl = __builtin_amdgcn_rcpf(li_hi[crow(r, 0)]);
#pragma unroll
        for (int d0 = 0; d0 < 4; ++d0) stg_l[crow(r, 0) * 128 + d0 * 32] = (bf16_t)f2bf(o[d0][r] * rl); }
    asm volatile("s_waitcnt lgkmcnt(0)" ::: "memory");
    bf16_t* Ow = Ob + (size_t)(wid * 32 + (lane2 >> 4)) * DM + (lane2 & 15) * 8; const LAS bf16_t* stg_r = stg + (lane2 >> 4) * 128 + (lane2 & 15) * 8;
#pragma unroll
    for (int i = 0; i < 8; ++i) { const u32x4 v = *(const LAS u32x4*)(stg_r + i * 4 * 128); *(u32x4*)(Ow + (size_t)(i * 4) * DM) = v; }
    __syncthreads();
#undef DMA_K
#undef DMA_V
#undef RESC
#undef WAITBAR
#undef STEP
}
}
__device__ __forceinline__ void p11_attention(Frame& F) {
    const bf16_t* Q = (const bf16_t*)(F.ws + WS_Q); const bf16_t* K = (const bf16_t*)(F.ws + WS_KB); const bf16_t* V = (const bf16_t*)(F.ws + WS_VB); bf16_t* O = (bf16_t*)(F.ws + WS_MIX);
    for (int i = 0; i < 4; ++i) {
        const int bh = (F.vcu >> 3) + 32 * i, qb = F.vcu & 7, b = bh >> 3, h = bh & 7;
        const size_t qrow = (size_t)b * PB + CTXL + qb * 256, krow = (size_t)b * PB;
        att::attn_unit(F.tid, Q + qrow * NQ + h * 192, K + krow * NQ + h * 192, V + krow * DM + h * 128, O + qrow * DM + h * 128, F.lds);
    }
}

__device__ __forceinline__ void ka_launder(Frame& F) { asm volatile("" : "+s"(F.ka)); int t = threadIdx.x; asm volatile("" : "+v"(t)); F.tid = t; F.lane = t & 63; F.wave = __builtin_amdgcn_readfirstlane(t >> 6); }
#ifndef DBG_MODE
#define DBG_MODE 0
#endif
constexpr int NPH = 21;
__device__ __forceinline__ void moe_gemms(Frame& F, int layer, int which) {
    const int nblk = __builtin_amdgcn_readfirstlane(*(const int*)(F.ws + WS_ROUTE + RT_NBLK));
    MoeSched S; S.init((const int*)(F.ws + WS_ROUTE + RT_BLKE), nblk, F.G, (int)blockIdx.x);
    const int* perm = (const int*)(F.ws + WS_ROUTE + RT_PERM);
    if (which == 0) {
        pg8::Gemm g{(const bf16_t*)(F.ws + WS_HX), (const bf16_t*)(F.ws + WS_WGU) + (size_t)layer * 32 * 1024 * DM, DM, DM, DM, perm};
        EpiSwiglu E{(bf16_t*)(F.ws + WS_ACT)};
        pg8::gemm_phase<EpiSwiglu, MoeSched, true>(F.lds, g, S, E);
    } else {
        pg8::Gemm g{(const bf16_t*)(F.ws + WS_ACT), (const bf16_t*)(F.ws + WS_WDN) + (size_t)layer * 32 * DM * MFF, MFF, MFF, MFF, nullptr};
        EpiScatter E{(bf16_t*)(F.ws + WS_YS), perm};
        pg8::gemm_phase<EpiScatter, MoeSched, false>(F.lds, g, S, E);
    }
}
__global__ void __launch_bounds__(512, 2) mega_fwd(Args args) {
    extern __shared__ __attribute__((aligned(16))) unsigned char lds_raw[];
    Frame F;
    F.lds = (LAS unsigned char*)lds_raw;
    F.tid = threadIdx.x; F.lane = F.tid & 63; F.wave = __builtin_amdgcn_readfirstlane(F.tid >> 6);
    F.G = gridDim.x; { const int bx = blockIdx.x; F.vcu = (F.G % 8 == 0) ? (bx % 8) * (F.G / 8) + bx / 8 : bx; }
    F.ws = args.ws; F.out = args.out;
    F.ka = (const __attribute__((address_space(4))) Args*)__builtin_amdgcn_kernarg_segment_ptr();
    for (int u = F.tid; u < (LDS_BYTES - LDSCTL_OFF) / 4; u += 512) ((LAS unsigned*)(F.lds + LDSCTL_OFF))[u] = 0u;
    __syncthreads();
    volatile LAS unsigned* MISC = (volatile LAS unsigned*)(F.lds + MISC_OFF);
    unsigned* ctl = (unsigned*)(F.ws + WS_CTL);
    XcdBarrier bar; bar.bar = ctl + CW_BAR; bar.x = 0; bar.st = nullptr;
    if (!args.nobar) bar = xcd_barrier_post(ctl + CW_BAR, MISC + 8);
    const int lo = args.ph_lo, hi = args.ph_hi;
#define IN(k) (lo <= (k) && (k) < hi)
#define SEAM(k) do { if (IN(k) && IN((k) + 1)) xcd_barrier(bar); } while (0)
    constexpr int LAST = DBG_MODE == 0 ? 20 : DBG_MODE == 1 ? -1 : DBG_MODE == 2 ? 6 : DBG_MODE == 3 ? 11 : DBG_MODE == 4 ? 15 : DBG_MODE == 10 ? 2 : DBG_MODE == 11 ? 3 : 5;
#ifndef PHMASK
#define PHMASK 0x1fffff
#endif
#define RUN(k) (ka_launder(F), IN(k) && (k) <= LAST && ((PHMASK >> (k)) & 1))

    if (RUN(0)) for (int rep_ = 0; rep_ < 1 + ((REPMASK >> 0) & 1); ++rep_) p0_prologue(F);
    SEAM(0);
    if (RUN(1)) for (int rep_ = 0; rep_ < 1 + ((REPMASK >> 1) & 1); ++rep_) p0b_mod(F);
    SEAM(1);
    if (RUN(2)) for (int rep_ = 0; rep_ < 1 + ((REPMASK >> 2) & 1); ++rep_) p1_norm_input(F);
    SEAM(2);
    if (RUN(3)) for (int rep_ = 0; rep_ < 1 + ((REPMASK >> 3) & 1); ++rep_) { pg8::Gemm g{(const bf16_t*)(F.ws + WS_HX), (const bf16_t*)(F.ws + WS_WIN0), DM, DM, DM, nullptr}; TileSched<false> S; S.init(EVIN / 256, F.G, (int)blockIdx.x);
        EpiStoreBf16 E{(bf16_t*)(F.ws + WS_PX0), EVIN}; pg8::gemm_phase<EpiStoreBf16, TileSched<false>, false>(F.lds, g, S, E); }
    SEAM(3);
    if (RUN(4)) for (int rep_ = 0; rep_ < 1 + ((REPMASK >> 4) & 1); ++rep_) p3_mixers(F);
    SEAM(4);
    if (RUN(5)) for (int rep_ = 0; rep_ < 1 + ((REPMASK >> 5) & 1); ++rep_) p3b_hgrn_out(F);
    SEAM(5);
    if (RUN(6)) for (int rep_ = 0; rep_ < 1 + ((REPMASK >> 6) & 1); ++rep_) { pg8::Gemm g{(const bf16_t*)(F.ws + WS_MIX), (const bf16_t*)(F.ws + WS_WOUT0), DM, DM, DM, nullptr}; TileSched<false> S; S.init(DM / 256, F.G, (int)blockIdx.x);
        EpiResidual E{&F, (float*)(F.ws + WS_XS), 0, true}; pg8::gemm_phase<EpiResidual, TileSched<false>, false>(F.lds, g, S, E); }
    SEAM(6);
    if (RUN(7)) for (int rep_ = 0; rep_ < 1 + ((REPMASK >> 7) & 1); ++rep_) p5_norm_route<false>(F, 0);
    SEAM(7);
    if (RUN(8)) for (int rep_ = 0; rep_ < 1 + ((REPMASK >> 8) & 1); ++rep_) p5b_perm<false>(F);
    SEAM(8);
    if (RUN(9)) for (int rep_ = 0; rep_ < 1 + ((REPMASK >> 9) & 1); ++rep_) moe_gemms(F, 0, 0);
    SEAM(9);
    if (RUN(10)) for (int rep_ = 0; rep_ < 1 + ((REPMASK >> 10) & 1); ++rep_) moe_gemms(F, 0, 1);
    SEAM(10);
    if (RUN(11)) for (int rep_ = 0; rep_ < 1 + ((REPMASK >> 11) & 1); ++rep_) p8_combine_norm(F);
    SEAM(11);
    if (RUN(12)) for (int rep_ = 0; rep_ < 1 + ((REPMASK >> 12) & 1); ++rep_) { pg8::Gemm g{(const bf16_t*)(F.ws + WS_HX), (const bf16_t*)(F.ws + WS_WIN1), DM, DM, DM, nullptr}; TileSched<false> S; S.init(CINP / 256, F.G, (int)blockIdx.x);
        EpiStoreStats E{(bf16_t*)(F.ws + WS_PX1), CINP, (float*)(F.ws + WS_STATS)}; pg8::gemm_phase<EpiStoreStats, TileSched<false>, false>(F.lds, g, S, E); }
    SEAM(12);
    if (RUN(13)) for (int rep_ = 0; rep_ < 1 + ((REPMASK >> 13) & 1); ++rep_) {
        { pg8::Gemm g{(const bf16_t*)(F.ws + WS_PX1), (const bf16_t*)(F.ws + WS_WUQ), CINP, QRANK, QRANK, nullptr}; TileSched<true> S; S.init(NQ / 256, F.G, (int)blockIdx.x);
          EpiQ E{(bf16_t*)(F.ws + WS_Q), (const float*)(F.ws + WS_STATS)}; pg8::gemm_phase<EpiQ, TileSched<true>, false>(F.lds, g, S, E); }
        { pg8::Gemm g{(const bf16_t*)(F.ws + WS_PX1) + QRANK, (const bf16_t*)(F.ws + WS_WUKV), CINP, KVRANK, KVRANK, nullptr}; TileSched<false> S; S.init(NKV / 256, F.G, (int)blockIdx.x);
          EpiKV E{(bf16_t*)(F.ws + WS_KB), (bf16_t*)(F.ws + WS_VB), (const float*)(F.ws + WS_STATS)}; pg8::gemm_phase<EpiKV, TileSched<false>, false>(F.lds, g, S, E); }
        ka_launder(F);
        p10_kr(F);
    }
    SEAM(13);
    if (RUN(14)) for (int rep_ = 0; rep_ < 1 + ((REPMASK >> 14) & 1); ++rep_) p11_attention(F);
    SEAM(14);
    if (RUN(15)) for (int rep_ = 0; rep_ < 1 + ((REPMASK >> 15) & 1); ++rep_) { pg8::Gemm g{(const bf16_t*)(F.ws + WS_MIX), (const bf16_t*)(F.ws + WS_WOUT1), DM, DM, DM, nullptr}; TileSched<true> S; S.init(DM / 256, F.G, (int)blockIdx.x);
        EpiResidual E{&F, (float*)(F.ws + WS_XS), 1, false}; pg8::gemm_phase<EpiResidual, TileSched<true>, false>(F.lds, g, S, E); }
    SEAM(15);
    if (RUN(16)) for (int rep_ = 0; rep_ < 1 + ((REPMASK >> 16) & 1); ++rep_) p5_norm_route<true>(F, 1);
    SEAM(16);
    if (RUN(17)) for (int rep_ = 0; rep_ < 1 + ((REPMASK >> 17) & 1); ++rep_) p5b_perm<true>(F);
    SEAM(17);
    if (RUN(18)) for (int rep_ = 0; rep_ < 1 + ((REPMASK >> 18) & 1); ++rep_) moe_gemms(F, 1, 0);
    SEAM(18);
    if (RUN(19)) for (int rep_ = 0; rep_ < 1 + ((REPMASK >> 19) & 1); ++rep_) moe_gemms(F, 1, 1);
    SEAM(19);
    ka_launder(F);
    if (IN(20) && ((PHMASK >> 20) & 1)) p16_final(F);
#undef IN
#undef SEAM
#undef RUN
}

#ifndef MK_N_LAUNCHES
#define MK_N_LAUNCHES 1
#endif
extern "C" void kernel_launch(void* const* d_in, const int* in_sizes, int n_in, void* d_out, int out_size, void* d_ws, size_t ws_size, hipStream_t stream) {
    static int grid = 0;
    if (grid == 0) {
        if (n_in != 28 || out_size != NB * SEQ * DM || ws_size < WS_END) { fprintf(stderr, "kernel_launch: unexpected shapes (n_in %d out %d ws %zu)\n", n_in, out_size, ws_size); grid = -1; return; }
        int dev = 0, cus = 0, per_cu = 0;
        if (hipGetDevice(&dev) != hipSuccess || hipDeviceGetAttribute(&cus, hipDeviceAttributeMultiprocessorCount, dev) != hipSuccess) { grid = -1; return; }
        if (hipFuncSetAttribute((const void*)mega_fwd, hipFuncAttributeMaxDynamicSharedMemorySize, LDS_BYTES) != hipSuccess) { fprintf(stderr, "kernel_launch: hipFuncSetAttribute failed\n"); grid = -1; return; }
        if (hipOccupancyMaxActiveBlocksPerMultiprocessor(&per_cu, (const void*)mega_fwd, 512, LDS_BYTES) != hipSuccess || per_cu < 1) { fprintf(stderr, "kernel_launch: occupancy query says %d blocks/CU\n", per_cu); per_cu = 1; }
        (void)hipGetLastError();
        grid = cus;
    }
    if (grid < 0) return;
    (void)hipMemsetAsync((char*)d_ws + WS_CTL, 0, CTL_ZERO_BYTES, stream);
    Args a{};
    for (int i = 0; i < 28; ++i) a.in[i] = (const float*)d_in[i];
    a.out = (float*)d_out; a.ws = (unsigned char*)d_ws;
    if (MK_N_LAUNCHES == 1) {
        a.ph_lo = 0; a.ph_hi = NPH; a.nobar = 0;
        void* kargs[] = {&a};
        hipError_t e = hipLaunchCooperativeKernel((const void*)mega_fwd, dim3(grid), dim3(512), kargs, LDS_BYTES, stream);
        if (e != hipSuccess) { (void)hipGetLastError(); fprintf(stderr, "kernel_launch: cooperative launch failed (%s), plain launch instead\n", hipGetErrorString(e)); hipLaunchKernelGGL(mega_fwd, dim3(grid), dim3(512), LDS_BYTES, stream, a); }
    } else {
        for (int p = 0; p < NPH; ++p) { a.ph_lo = p; a.ph_hi = p + 1; a.nobar = 1; hipLaunchKernelGGL(mega_fwd, dim3(grid), dim3(512), LDS_BYTES, stream, a); }
    }
}
```

```cpp
#include <hip/hip_runtime.h>
#include <cstdio>
#include <cstdint>
#define MK_N_LAUNCHES 1
#define DBG_MODE 0
#define REPMASK 0x0

#define LAS __attribute__((address_space(3)))
#define GAS __attribute__((address_space(1)))
typedef unsigned short bf16_t;
typedef short bf16x8 __attribute__((ext_vector_type(8)));
typedef short s16x4 __attribute__((ext_vector_type(4)));
typedef float f32x2 __attribute__((ext_vector_type(2)));
typedef float f32x4 __attribute__((ext_vector_type(4)));
typedef float f32x16 __attribute__((ext_vector_type(16)));
typedef unsigned u32x2 __attribute__((ext_vector_type(2)));
typedef unsigned u32x4 __attribute__((ext_vector_type(4)));

constexpr int DM = 1024, NB = 16, SEQ = 2048, CTXL = 256, PB = SEQ + CTXL  , R = NB * PB  ;
constexpr int NTILE = R / 256  , NXTILE = NB * SEQ / 256  ;
constexpr int EVIN = 3584;
constexpr int CIN = 704, CINP = 768, QRANK = 384, KVRANK = 256, NQ = 1536, NKV = 2048;
constexpr int NEXP = 32, MFF = 512;
constexpr int MAXSLOT = 81920;
constexpr float RMS_EPS = 1e-6f;
constexpr float ATT_C2 = 0.07216878364870322f * 1.4426950408889634f;

constexpr size_t MiB = 1u << 20;
constexpr size_t WS_CTL = 0, CTL_ZERO_BYTES = 1 * MiB;
constexpr size_t WS_MOD = 1 * MiB;
constexpr size_t WS_PART = 2 * MiB;
constexpr size_t WS_STATS = 9 * MiB;
constexpr size_t WS_ROUTE = 13 * MiB;
constexpr size_t WS_WIN0 = 16 * MiB, WS_WOUT0 = 23 * MiB, WS_WIN1 = 25 * MiB, WS_WUQ = 27 * MiB, WS_WUKV = 29 * MiB, WS_WOUT1 = 30 * MiB;
constexpr size_t WS_WGU = 32 * MiB;
constexpr size_t WS_WDN = 160 * MiB;
constexpr size_t WS_XS = 224 * MiB;
constexpr size_t WS_HX = 368 * MiB;
constexpr size_t WS_MIX = 440 * MiB;
constexpr size_t WS_RA = 512 * MiB;
constexpr size_t WS_PX0 = WS_RA, WS_Q = WS_RA, WS_KB = WS_RA + 108 * MiB, WS_ACT = WS_RA;
constexpr size_t WS_RB = 764 * MiB;
constexpr size_t WS_YS = WS_RB, WS_PX1 = WS_RB, WS_VB = WS_RB + 54 * MiB, WS_OG = WS_RB;
constexpr size_t WS_END = 908 * MiB;
constexpr size_t RT_AE = 0, RT_AP = 512 * 1024, RT_AW = 1024 * 1024, RT_PERM = 1536 * 1024, RT_CNTB = 2048 * 1024, RT_BLKE = 2048 * 1024 + 64 * 1024, RT_NBLK = RT_BLKE + 4096;
constexpr int CW_BAR = 4096;

constexpr int RING_BYTES = 131072;
constexpr int LDSCTL_OFF = 147456, MISC_OFF = LDSCTL_OFF + 320;
constexpr int LDS_BYTES = 149504;

#define LDS_WAIT() asm volatile("s_waitcnt lgkmcnt(0)" ::: "memory")
#define VM_WAIT() asm volatile("s_waitcnt vmcnt(0)" ::: "memory")
#define SBAR() __builtin_amdgcn_sched_barrier(0)
__device__ __forceinline__ unsigned f2bf(float f) { unsigned u = __builtin_bit_cast(unsigned, f); return (u + 0x7fffu + ((u >> 16) & 1u)) >> 16; }
__device__ __forceinline__ unsigned pk2(float lo, float hi) { return f2bf(lo) | (f2bf(hi) << 16); }
typedef __bf16 bf16x2_t __attribute__((ext_vector_type(2)));
__device__ __forceinline__ unsigned cvtpk(float lo, float hi) { f32x2 v = {lo, hi}; bf16x2_t b = __builtin_convertvector(v, bf16x2_t); return __builtin_bit_cast(unsigned, b); }
__device__ __forceinline__ float bf2f(unsigned short h) { return __builtin_bit_cast(float, (unsigned)h << 16); }
__device__ __forceinline__ float bflo(unsigned w) { return __builtin_bit_cast(float, w << 16); }
__device__ __forceinline__ float bfhi(unsigned w) { return __builtin_bit_cast(float, w & 0xffff0000u); }
__device__ __forceinline__ float dpp_add(float v, const int ctrl) { return v; }
#define DPP_ADD(v, ctrl) ((v) + __builtin_bit_cast(float, __builtin_amdgcn_update_dpp(0, __builtin_bit_cast(int, (v)), (ctrl), 0xf, 0xf, true)))
__device__ __forceinline__ float wave_sum(float v) {
    v = DPP_ADD(v, 0xB1);
    v = DPP_ADD(v, 0x4E);
    v = DPP_ADD(v, 0x141);
    v = DPP_ADD(v, 0x140);
    const int iv = __builtin_bit_cast(int, v);
    return (__builtin_bit_cast(float, __builtin_amdgcn_readlane(iv, 0)) + __builtin_bit_cast(float, __builtin_amdgcn_readlane(iv, 16))) +
           (__builtin_bit_cast(float, __builtin_amdgcn_readlane(iv, 32)) + __builtin_bit_cast(float, __builtin_amdgcn_readlane(iv, 48)));
}
constexpr float LOG2E = 1.4426950408889634f, LN2 = 0.6931471805599453f;
__device__ __forceinline__ float ex2(float x) { return __builtin_amdgcn_exp2f(x); }
__device__ __forceinline__ float lg2(float x) { return __builtin_amdgcn_logf(x); }
__device__ __forceinline__ float sigmoidf_(float x) { return __builtin_amdgcn_rcpf(1.0f + ex2(-LOG2E * x)); }
__device__ __forceinline__ float siluf_(float x) { return x * __builtin_amdgcn_rcpf(1.0f + ex2(-LOG2E * x)); }
__device__ __forceinline__ float geluf_(float x) { const float z = (-1.5957691216057308f * LOG2E) * (x + 0.044715f * x * x * x); return x * __builtin_amdgcn_rcpf(1.0f + ex2(z)); }

#define XB_TMO      128
#define XB_XCNT(j)  (256  + 64 * (j))
#define XB_XSUB(j)  (1280 + 64 * (j))
#define XB_XGEN(j)  (2304 + 64 * (j))
#define XB_TOP      3328
#define XB_TOPGEN   3392
#define XCD_BAR_WORDS 3456
#define XB_SPIN_CAP (1u << 22)
__device__ __forceinline__ unsigned xb_ld(unsigned* p)              { return __hip_atomic_load(p, __ATOMIC_RELAXED, __HIP_MEMORY_SCOPE_AGENT); }
__device__ __forceinline__ unsigned xb_add(unsigned* p, unsigned v) { return __hip_atomic_fetch_add(p, v, __ATOMIC_RELAXED, __HIP_MEMORY_SCOPE_AGENT); }
__device__ __forceinline__ unsigned xb_xcc_id() { return (unsigned)__builtin_amdgcn_s_getreg((3 << 11) | 20) & 0xFu; }
#define XB_SPIN(cond, bar) do { unsigned _sp = 0; while (cond) { __builtin_amdgcn_s_sleep(1); \
    if ((++_sp & 255u) == 0u) { if (xb_ld(&(bar)[XB_TMO])) break; if (_sp > XB_SPIN_CAP) { atomicAdd(&(bar)[XB_TMO], 1u); break; } } } } while (0)
struct XcdBarrier { unsigned* bar; unsigned x; volatile LAS unsigned* st; };
__device__ __forceinline__ XcdBarrier xcd_barrier_post(unsigned* bar, volatile LAS unsigned* st) {
    XcdBarrier b; b.bar = bar; b.x = xb_xcc_id(); b.st = st;
    if (threadIdx.x == 0) (void)xb_add(&bar[XB_XCNT(b.x)], 1u);
    return b;
}
__device__ __forceinline__ void xcd_barrier_complete(unsigned* bar, unsigned x, unsigned& nloc, unsigned& nx) {
    const unsigned G = gridDim.x * gridDim.y * gridDim.z;
    unsigned sum, cnt, mine, sp = 0u;
    for (;;) {
        sum = 0u; cnt = 0u; mine = 0u;
#pragma unroll
        for (unsigned j = 0; j < 16; ++j) { const unsigned c = xb_ld(&bar[XB_XCNT(j)]); sum += c; cnt += (c > 0u) ? 1u : 0u; mine = (j == x) ? c : mine; }
        if (sum == G) break;
        __builtin_amdgcn_s_sleep(1);
        if ((++sp & 255u) == 0u) { if (xb_ld(&bar[XB_TMO])) break; if (sp > XB_SPIN_CAP) { atomicAdd(&bar[XB_TMO], 1u); break; } }
    }
    nloc = mine > 0u ? mine : 1u; nx = cnt > 0u ? cnt : 1u;
}
__device__ __forceinline__ void xcd_barrier(const XcdBarrier& b) {
    asm volatile("s_waitcnt vmcnt(0)" ::: "memory");
    __syncthreads();
    if (threadIdx.x == 0) {
        unsigned* bar = b.bar;
        __builtin_amdgcn_s_waitcnt(0);
        unsigned nloc = b.st[0], nx = b.st[1];
        if (nloc == 0u) { xcd_barrier_complete(bar, b.x, nloc, nx); b.st[0] = nloc; b.st[1] = nx; }
        const unsigned old = xb_add(&bar[XB_XSUB(b.x)], 1u);
        const unsigned gen = old / nloc;
        if (old + 1u == (gen + 1u) * nloc) {
            __builtin_amdgcn_fence(__ATOMIC_RELEASE, "agent");
            asm volatile("s_waitcnt vmcnt(0)" ::: "memory");
            const unsigned og = xb_add(&bar[XB_TOP], 1u);
            const unsigned tg = og / nx;
            if (og + 1u == (tg + 1u) * nx) xb_add(&bar[XB_TOPGEN], 1u);
            else XB_SPIN(xb_ld(&bar[XB_TOPGEN]) == tg, bar);
            __builtin_amdgcn_fence(__ATOMIC_ACQUIRE, "agent");
            xb_add(&bar[XB_XGEN(b.x)], 1u);
            asm volatile("s_waitcnt vmcnt(0)" ::: "memory");
        } else {
            XB_SPIN(xb_ld(&bar[XB_XGEN(b.x)]) == gen, bar);
            __builtin_amdgcn_fence(__ATOMIC_ACQUIRE, "agent");
            asm volatile("s_waitcnt vmcnt(0)" ::: "memory");
        }
    }
    __syncthreads();
}

namespace pg8 {
constexpr int BM = 256, BK = 64, HALF = 128, HTB = HALF * BK * 2, STAGE_BYTES = 8 * HTB, NXCD = 8, WGM = 8;
__host__ __device__ __forceinline__ int lds_byte(int r, int c) { const int st = (r >> 4) * 2 + (c >> 5), rr = r & 15, cc = c & 31, ob = rr * 64 + cc * 2; return st * 1024 + (ob ^ (((ob >> 9) & 1) << 5)); }
__host__ __device__ __forceinline__ void stage_rc(int b, int& Rr, int& C) { const int st = b / 1024, sb = b % 1024, swz = sb ^ (((sb >> 9) & 1) << 5); Rr = (st >> 1) * 16 + swz / 64; C = (st & 1) * 32 + (swz % 64) / 2; }
__host__ __device__ __forceinline__ int perm32(int rho) { const int n = rho >> 4, i = rho & 15; return 8 * (i >> 2) + 4 * n + (i & 3); }

struct Unit { int arow0, brow0, pm, pn, ex; };
struct Gemm { const bf16_t* A; const bf16_t* Bt; int lda, ldb, K; const int* rowidx; };

template <class Epi, class Sched, bool GATHER>
__device__ __forceinline__ void gemm_phase(LAS unsigned char* lds, const Gemm g, const Sched& S, const Epi& E) {
    int tidl = threadIdx.x; asm volatile("" : "+v"(tidl));
    const int tid = tidl, wid = __builtin_amdgcn_readfirstlane(tid >> 6), lane = tid & 63, wr = wid >> 2, wc = wid & 3, fr = lane & 15, fq = lane >> 4;
    const int K = g.K, nt = K / BK;
    int sR[2], sC[2]; unsigned voffB[2], voffA[2];
#pragma unroll
    for (int i = 0; i < 2; ++i) { stage_rc(tid * 16 + i * 8192, sR[i], sC[i]); const int Rb = Epi::PERM ? ((sR[i] & ~31) + perm32(sR[i] & 31)) : sR[i];
        voffB[i] = (unsigned)(Rb * g.ldb + sC[i]) * 2u; voffA[i] = (unsigned)(sR[i] * g.lda + sC[i]) * 2u; }
    const size_t kstep = (size_t)(BK * 2);
    const size_t hstepB = (size_t)HALF * g.ldb * 2, hstepA = (size_t)HALF * g.lda * 2;
    const unsigned ldsw = (unsigned)wid * 1024u;
    const int aoff = lds_byte(wr * 64 + fr, fq * 8), boff = lds_byte(wc * 32 + fr, fq * 8);
#define PG8_SA(b, h) (((b) * 2 + (h)) * HTB)
#define PG8_SB(b, h) ((4 + (b) * 2 + (h)) * HTB)
#define PG8_GLDS(src, bufoff, i) __builtin_amdgcn_global_load_lds((const unsigned*)(src), (LAS unsigned*)(lds + (bufoff) + ldsw + (i) * 8192), 16, 0, 0)
#define PG8_STAGEB(bufoff, gbase) do { _Pragma("unroll") for (int _i = 0; _i < 2; ++_i) PG8_GLDS((const char*)(gbase) + voffB[_i], bufoff, _i); } while (0)
#define PG8_STAGEA(bufoff, h, isnext, kb) do { \
        if constexpr (GATHER) { _Pragma("unroll") for (int _i = 0; _i < 2; ++_i) PG8_GLDS(gA + (kb) + ((isnext) ? nvo[h][_i] : cvo[h][_i]), bufoff, _i); } \
        else { const char* _b = ((isnext) ? nA : cA) + (h) * hstepA + (kb); _Pragma("unroll") for (int _i = 0; _i < 2; ++_i) PG8_GLDS(_b + voffA[_i], bufoff, _i); } } while (0)
#define PG8_LDA(dst, b, h) do { _Pragma("unroll") for (int m = 0; m < 4; ++m) _Pragma("unroll") for (int k = 0; k < 2; ++k) dst[m][k] = *(const LAS bf16x8*)(lds + PG8_SA(b, h) + aoff + m * 2048 + k * 1024); } while (0)
#define PG8_LDB(dst, b, h) do { _Pragma("unroll") for (int n = 0; n < 2; ++n) _Pragma("unroll") for (int k = 0; k < 2; ++k) dst[n][k] = *(const LAS bf16x8*)(lds + PG8_SB(b, h) + boff + n * 2048 + k * 1024); } while (0)
#define PG8_MMA(ai, bj, At, Bt) do { __builtin_amdgcn_s_setprio(1); _Pragma("unroll") for (int m = 0; m < 4; ++m) _Pragma("unroll") for (int n = 0; n < 2; ++n) _Pragma("unroll") for (int k = 0; k < 2; ++k) \
        acc[ai][bj][m][n] = __builtin_amdgcn_mfma_f32_16x16x32_bf16(Bt[n][k], At[m][k], acc[ai][bj][m][n], 0, 0, 0); __builtin_amdgcn_s_setprio(0); } while (0)
#define PG8_WAIT_V(n) asm volatile("s_waitcnt vmcnt(" #n ")" ::: "memory")
#define PG8_WAIT_L(n) asm volatile("s_waitcnt lgkmcnt(" #n ")" ::: "memory")
#define PG8_BAR __builtin_amdgcn_s_barrier()
#define PG8_SCHED __builtin_amdgcn_sched_barrier(0)
    unsigned cvo[2][2], nvo[2][2];
    auto a_offsets = [&](const Unit& u, unsigned (&vo)[2][2]) {
#pragma unroll
        for (int h = 0; h < 2; ++h)
#pragma unroll
            for (int i = 0; i < 2; ++i) { const int a = g.rowidx[u.arow0 + h * HALF + sR[i]]; const int row = a < 0 ? 0 : (a >> 1); vo[h][i] = (unsigned)((size_t)row * g.lda + sC[i]) * 2u; }
    };
    Unit cur, nxt; int ui = 0;
    if (!S.next(0, cur)) return;
    f32x4 acc[2][2][4][2];
#pragma unroll
    for (int a = 0; a < 2; ++a)
#pragma unroll
        for (int b = 0; b < 2; ++b)
#pragma unroll
            for (int m = 0; m < 4; ++m)
#pragma unroll
                for (int n = 0; n < 2; ++n) acc[a][b][m][n] = (f32x4){0.f, 0.f, 0.f, 0.f};
    bf16x8 At[4][2], B0[2][2], B1[2][2];
    const char* gA = (const char*)g.A;
    const char* cA = gA + (size_t)cur.arow0 * g.lda * 2; const char* nA = cA;
    const char* cB = (const char*)g.Bt + (size_t)cur.brow0 * g.ldb * 2;
    if constexpr (GATHER) { a_offsets(cur, cvo);
#pragma unroll
        for (int h = 0; h < 2; ++h)
#pragma unroll
            for (int i = 0; i < 2; ++i) nvo[h][i] = cvo[h][i]; }
    PG8_STAGEB(PG8_SB(0, 0), cB); PG8_STAGEB(PG8_SB(0, 1), cB + hstepB); PG8_STAGEA(PG8_SA(0, 0), 0, false, 0); PG8_STAGEA(PG8_SA(0, 1), 1, false, 0);
    if (wr == 1) PG8_BAR;
    PG8_WAIT_V(2); PG8_BAR;
    PG8_STAGEB(PG8_SB(1, 0), cB + kstep); PG8_STAGEA(PG8_SA(1, 0), 0, false, kstep); PG8_STAGEB(PG8_SB(1, 1), cB + hstepB + kstep);
    PG8_WAIT_V(6); PG8_BAR;
    for (;;) {
        const bool has_next = S.next(ui + 1, nxt);
        const char* nB = has_next ? (const char*)g.Bt + (size_t)nxt.brow0 * g.ldb * 2 : cB;
        nA = has_next ? gA + (size_t)nxt.arow0 * g.lda * 2 : cA;
        if constexpr (GATHER) { if (has_next) a_offsets(nxt, nvo); }
        for (int t = 0; t < nt; t += 2) {
            const bool last = (t == nt - 2);
            const size_t k1 = (size_t)(t + 1) * kstep, k2 = last ? 0 : (size_t)(t + 2) * kstep, k3 = k2 + kstep;
            const char* b2 = last ? nB : cB + (size_t)(t + 2) * kstep; const char* b3 = b2 + kstep;
            PG8_LDB(B0, 0, 0); PG8_LDB(B1, 0, 1); PG8_SCHED; PG8_LDA(At, 0, 0); PG8_STAGEA(PG8_SA(1, 1), 1, false, k1);
            PG8_WAIT_V(8); PG8_WAIT_L(0); PG8_BAR; PG8_MMA(0, 0, At, B0); PG8_MMA(0, 1, At, B1); PG8_BAR; PG8_SCHED;
            PG8_LDA(At, 0, 1); PG8_STAGEB(PG8_SB(0, 0), b2); PG8_STAGEB(PG8_SB(0, 1), b2 + hstepB); PG8_STAGEA(PG8_SA(0, 0), 0, last, k2);
            PG8_WAIT_V(8); PG8_WAIT_L(0); PG8_BAR; PG8_MMA(1, 0, At, B0); PG8_MMA(1, 1, At, B1); PG8_BAR; PG8_SCHED;
            PG8_LDB(B0, 1, 0); PG8_LDB(B1, 1, 1); PG8_SCHED; PG8_LDA(At, 1, 0); PG8_STAGEA(PG8_SA(0, 1), 1, last, k2);
            PG8_WAIT_V(8); PG8_WAIT_L(0); PG8_BAR; PG8_MMA(0, 0, At, B0); PG8_MMA(0, 1, At, B1); PG8_BAR; PG8_SCHED;
            PG8_LDA(At, 1, 1); PG8_STAGEB(PG8_SB(1, 0), b3); PG8_STAGEB(PG8_SB(1, 1), b3 + hstepB); PG8_STAGEA(PG8_SA(1, 0), 0, last, k3);
            PG8_WAIT_V(8); PG8_WAIT_L(0); PG8_BAR; PG8_MMA(1, 0, At, B0); PG8_MMA(1, 1, At, B1); PG8_BAR; PG8_SCHED;
        }
        if (wr == 0) PG8_BAR;
        { int l2 = threadIdx.x; asm volatile("" : "+v"(l2)); E(acc, cur, wr, wc, l2 & 15, (l2 >> 4) & 3); }
        if (!has_next) break;
#pragma unroll
        for (int a = 0; a < 2; ++a)
#pragma unroll
            for (int b = 0; b < 2; ++b)
#pragma unroll
                for (int m = 0; m < 4; ++m)
#pragma unroll
                    for (int n = 0; n < 2; ++n) acc[a][b][m][n] = (f32x4){0.f, 0.f, 0.f, 0.f};
        cur = nxt; cB = nB; cA = nA; ++ui;
        if constexpr (GATHER) {
#pragma unroll
            for (int h = 0; h < 2; ++h)
#pragma unroll
                for (int i = 0; i < 2; ++i) cvo[h][i] = nvo[h][i]; }
        if (wr == 1) PG8_BAR;
    }
    PG8_WAIT_V(0);
    PG8_BAR;
#undef PG8_SA
#undef PG8_SB
#undef PG8_GLDS
#undef PG8_STAGEA
#undef PG8_STAGEB
#undef PG8_LDA
#undef PG8_LDB
#undef PG8_MMA
#undef PG8_WAIT_V
#undef PG8_WAIT_L
#undef PG8_BAR
#undef PG8_SCHED
}
}

struct Args {
    const float* in[28]; float* out; unsigned char* ws; int ph_lo, ph_hi, nobar, pad;
};
enum In { I_X = 0, I_C, I_CTX, I_CCTX, I_ADAW, I_ADAB, I_NMIXG, I_NFFNG, I_EVWIN, I_EVLB, I_EVONORM, I_EVSGUG, I_EVWS, I_EVBS, I_EVWOUT,
          I_ODWIN, I_ODQG, I_ODWUQ, I_ODKVG, I_ODWUKV, I_ODWOUT, I_MR1W, I_MR1B, I_MR2W, I_MR2B, I_MGU, I_MDN, I_FING };
struct Frame {
    LAS unsigned char* lds;
    const __attribute__((address_space(4))) Args* ka;
    float* out;
    int tid, lane, wave, vcu, G;
    unsigned char* ws;
};
__device__ __forceinline__ const float* mod_ptr(const Frame& F, int layer, int mrow, int which) { return (const float*)(F.ws + WS_MOD) + ((size_t)(layer * 17 + mrow) * 6 + which) * DM; }
__device__ __forceinline__ int row_b(int row) { return row / PB; }
__device__ __forceinline__ const float* input_row(const Frame& F, int row) {
    const int b = row / PB, pos = row - b * PB;
    return pos < CTXL ? F.ka->in[I_CTX] + ((size_t)b * CTXL + pos) * DM : F.ka->in[I_X] + ((size_t)b * SEQ + (pos - CTXL)) * DM;
}

template <bool XONLY> struct TileSched {
    int nM, nN, nwg, G, c;
    __device__ __forceinline__ void init(int nN_, int G_, int c_) { nM = XONLY ? NXTILE : NTILE; nN = nN_; nwg = nM * nN; G = G_; c = c_; }
    __device__ __forceinline__ bool next(int i, pg8::Unit& u) const {
        const long L = (long)i * G + c; if (L >= nwg) return false;
        int wgid = (int)L; { const int q = nwg / 8, r = nwg % 8, xcd = wgid % 8, off = wgid / 8; wgid = (xcd < r ? xcd * (q + 1) : r * (q + 1) + (xcd - r) * q) + off; }
        const int nig = 8 * nN, gid = wgid / nig, fm = gid * 8, gsz = (nM - fm) < 8 ? (nM - fm) : 8;
        int pm = fm + ((wgid % nig) % gsz); const int pn = (wgid % nig) / gsz;
        if (XONLY) pm = (pm >> 3) * 9 + 1 + (pm & 7);
        u.pm = pm; u.pn = pn; u.ex = 0; u.arow0 = pm * 256; u.brow0 = pn * 256; return true;
    }
};
struct MoeSched {
    const int* blke; int nwg, G, c, brows;
    __device__ __forceinline__ void init(const int* blke_, int nblk, int G_, int c_) { blke = blke_; nwg = nblk * 4; G = G_; c = c_; brows = 1024; }
    __device__ __forceinline__ bool next(int i, pg8::Unit& u) const {
        const long L = (long)i * G + c; if (L >= nwg) return false;
        int wgid = (int)L; { const int q = nwg / 8, r = nwg % 8, xcd = wgid % 8, off = wgid / 8; wgid = (xcd < r ? xcd * (q + 1) : r * (q + 1) + (xcd - r) * q) + off; }
        const int blk = wgid >> 2, pn = wgid & 3; const int e = __builtin_amdgcn_readfirstlane(blke[blk]);
        u.pm = blk; u.pn = pn; u.ex = e; u.arow0 = blk * 256; u.brow0 = e * brows + pn * 256; return true;
    }
};

struct EpiStoreBf16 {
    static constexpr bool PERM = true;
    bf16_t* O; int ldc;
    __device__ __forceinline__ void operator()(const f32x4 (&acc)[2][2][4][2], const pg8::Unit& u, int wr, int wc, int fr, int fq) const {
        const int row0 = u.arow0 + wr * 64 + fr, col0 = u.pn * 256 + wc * 32 + 8 * fq;
#pragma unroll
        for (int ai = 0; ai < 2; ++ai)
#pragma unroll
            for (int m = 0; m < 4; ++m) { bf16_t* rowp = O + (size_t)(row0 + ai * 128 + m * 16) * ldc + col0;
#pragma unroll
                for (int bj = 0; bj < 2; ++bj) { const f32x4 v0 = acc[ai][bj][m][0], v1 = acc[ai][bj][m][1];
                    u32x4 w; w.x = cvtpk(v0[0], v0[1]); w.y = cvtpk(v0[2], v0[3]); w.z = cvtpk(v1[0], v1[1]); w.w = cvtpk(v1[2], v1[3]);
                    *(u32x4*)(rowp + bj * 128) = w; } }
    }
};
struct EpiStoreStats {
    static constexpr bool PERM = true;
    bf16_t* O; int ldc; float* stats;
    __device__ __forceinline__ void operator()(const f32x4 (&acc)[2][2][4][2], const pg8::Unit& u, int wr, int wc, int fr, int fq) const {
        const int row0 = u.arow0 + wr * 64 + fr, col0 = u.pn * 256 + wc * 32 + 8 * fq;
#pragma unroll
        for (int ai = 0; ai < 2; ++ai)
#pragma unroll
            for (int m = 0; m < 4; ++m) { const int row = row0 + ai * 128 + m * 16; bf16_t* rowp = O + (size_t)row * ldc + col0;
#pragma unroll
                for (int bj = 0; bj < 2; ++bj) { const f32x4 v0 = acc[ai][bj][m][0], v1 = acc[ai][bj][m][1];
                    u32x4 w; w.x = cvtpk(v0[0], v0[1]); w.y = cvtpk(v0[2], v0[3]); w.z = cvtpk(v1[0], v1[1]); w.w = cvtpk(v1[2], v1[3]);
                    *(u32x4*)(rowp + bj * 128) = w;
                    float s = (v0[0] * v0[0] + v0[1] * v0[1]) + (v0[2] * v0[2] + v0[3] * v0[3]) + (v1[0] * v1[0] + v1[1] * v1[1]) + (v1[2] * v1[2] + v1[3] * v1[3]);
                    s += __shfl_xor(s, 16); s += __shfl_xor(s, 32);
                    if (fq == 0) stats[(size_t)row * 24 + u.pn * 8 + bj * 4 + wc] = s; } }
    }
};
struct EpiResidual {
    static constexpr bool PERM = false;
    const Frame* F; float* dst; int layer; bool from_input;
    __device__ __forceinline__ void operator()(const f32x4 (&acc)[2][2][4][2], const pg8::Unit& u, int wr, int wc, int fr, int fq) const {
        const int b = u.pm / 9, isctx = (u.pm % 9) == 0, mrow = isctx ? 16 : b;
        const float* gate = mod_ptr(*F, layer, mrow, 2);
        const int col0 = u.pn * 256 + wc * 32 + 4 * fq;
        f32x4 gv[2][2];
#pragma unroll
        for (int bj = 0; bj < 2; ++bj)
#pragma unroll
            for (int n = 0; n < 2; ++n) gv[bj][n] = *(const f32x4*)(gate + col0 + bj * 128 + n * 16);
#pragma unroll
        for (int ai = 0; ai < 2; ++ai)
#pragma unroll
            for (int m = 0; m < 4; ++m) { const int row = u.arow0 + ai * 128 + wr * 64 + m * 16 + fr;
                const float* bp = from_input ? input_row(*F, row) : dst + (size_t)row * DM; float* dp = dst + (size_t)row * DM;
#pragma unroll
                for (int bj = 0; bj < 2; ++bj)
#pragma unroll
                    for (int n = 0; n < 2; ++n) { const int c = col0 + bj * 128 + n * 16; const f32x4 bs = *(const f32x4*)(bp + c);
                        *(f32x4*)(dp + c) = bs + gv[bj][n] * acc[ai][bj][m][n]; } }
    }
};
struct EpiSwiglu {
    static constexpr bool PERM = true;
    bf16_t* O;
    __device__ __forceinline__ void operator()(const f32x4 (&acc)[2][2][4][2], const pg8::Unit& u, int wr, int wc, int fr, int fq) const {
        const int row0 = u.arow0 + wr * 64 + fr, col0 = u.pn * 128 + wc * 32 + 8 * fq;
#pragma unroll
        for (int ai = 0; ai < 2; ++ai)
#pragma unroll
            for (int m = 0; m < 4; ++m) { bf16_t* rowp = O + (size_t)(row0 + ai * 128 + m * 16) * MFF + col0;
                float h[8];
#pragma unroll
                for (int n = 0; n < 2; ++n)
#pragma unroll
                    for (int j = 0; j < 4; ++j) h[n * 4 + j] = siluf_(acc[ai][0][m][n][j]) * acc[ai][1][m][n][j];
                u32x4 w; w.x = cvtpk(h[0], h[1]); w.y = cvtpk(h[2], h[3]); w.z = cvtpk(h[4], h[5]); w.w = cvtpk(h[6], h[7]);
                *(u32x4*)rowp = w; }
    }
};
struct EpiScatter {
    static constexpr bool PERM = true;
    bf16_t* O; const int* perm;
    __device__ __forceinline__ void operator()(const f32x4 (&acc)[2][2][4][2], const pg8::Unit& u, int wr, int wc, int fr, int fq) const {
        const int row0 = u.arow0 + wr * 64 + fr, col0 = u.pn * 256 + wc * 32 + 8 * fq;
#pragma unroll
        for (int ai = 0; ai < 2; ++ai)
#pragma unroll
            for (int m = 0; m < 4; ++m) { const int a = perm[row0 + ai * 128 + m * 16];
                if (a >= 0) { bf16_t* rowp = O + (size_t)a * DM + col0;
#pragma unroll
                    for (int bj = 0; bj < 2; ++bj) { const f32x4 v0 = acc[ai][bj][m][0], v1 = acc[ai][bj][m][1];
                        u32x4 w; w.x = cvtpk(v0[0], v0[1]); w.y = cvtpk(v0[2], v0[3]); w.z = cvtpk(v1[0], v1[1]); w.w = cvtpk(v1[2], v1[3]);
                        *(u32x4*)(rowp + bj * 128) = w; } } }
    }
};
struct EpiQ {
    static constexpr bool PERM = false;
    bf16_t* O; const float* stats;
    __device__ __forceinline__ void operator()(const f32x4 (&acc)[2][2][4][2], const pg8::Unit& u, int wr, int wc, int fr, int fq) const {
        float invf[4]; int fq2 = fq; asm volatile("" : "+v"(fq2));
#pragma unroll
        for (int j = 0; j < 4; ++j) invf[j] = __expf(-(float)(4 * fq2 + j) * (2.0f / 32.0f) * 9.210340371976184f);
#pragma unroll
        for (int ai = 0; ai < 2; ++ai)
#pragma unroll
            for (int m = 0; m < 4; ++m) { const int row = u.arow0 + ai * 128 + wr * 64 + m * 16 + fr;
                const float* st = stats + (size_t)row * 24; float ss = 0.f;
#pragma unroll
                for (int q = 0; q < 3; ++q) { const f32x4 s4 = *(const f32x4*)(st + 4 * q); ss += (s4[0] + s4[1]) + (s4[2] + s4[3]); }
                const float sc = __builtin_amdgcn_rsqf(ss * (1.0f / QRANK) + RMS_EPS) * ATT_C2;
                const int t = (row % PB) - CTXL; const float gr = (float)(t >> 6), gc = (float)(t & 63);
#pragma unroll
                for (int bj = 0; bj < 2; ++bj) { const int cg = u.pn * 256 + bj * 128 + wc * 32; const int within = cg % 192;
                    f32x4 v0 = acc[ai][bj][m][0] * sc, v1 = acc[ai][bj][m][1] * sc;
                    if (within >= 128) { const float p = (within == 128) ? gr : gc;
#pragma unroll
                        for (int j = 0; j < 4; ++j) { const float ang = p * invf[j]; const float cs = __cosf(ang), sn = __sinf(ang);
                            const float x1 = v0[j], x2 = v1[j]; v0[j] = x1 * cs - x2 * sn; v1[j] = x1 * sn + x2 * cs; } }
                    bf16_t* rowp = O + (size_t)row * NQ + cg + 4 * fq;
                    u32x2 w0; w0.x = cvtpk(v0[0], v0[1]); w0.y = cvtpk(v0[2], v0[3]); *(u32x2*)rowp = w0;
                    u32x2 w1; w1.x = cvtpk(v1[0], v1[1]); w1.y = cvtpk(v1[2], v1[3]); *(u32x2*)(rowp + 16) = w1; } }
    }
};
struct EpiKV {
    static constexpr bool PERM = true;
    bf16_t* KBp; bf16_t* VBp; const float* stats;
    __device__ __forceinline__ void operator()(const f32x4 (&acc)[2][2][4][2], const pg8::Unit& u, int wr, int wc, int fr, int fq) const {
        const int h = u.pn, c0 = wc * 32 + 8 * fq;
#pragma unroll
        for (int ai = 0; ai < 2; ++ai)
#pragma unroll
            for (int m = 0; m < 4; ++m) { const int row = u.arow0 + ai * 128 + wr * 64 + m * 16 + fr;
                const float* st = stats + (size_t)row * 24 + 12; const f32x4 s0 = *(const f32x4*)st, s1 = *(const f32x4*)(st + 4);
                const float ss = ((s0[0] + s0[1]) + (s0[2] + s0[3])) + ((s1[0] + s1[1]) + (s1[2] + s1[3]));
                const float sc = __builtin_amdgcn_rsqf(ss * (1.0f / KVRANK) + RMS_EPS);
#pragma unroll
                for (int bj = 0; bj < 2; ++bj) { const f32x4 v0 = acc[ai][bj][m][0] * sc, v1 = acc[ai][bj][m][1] * sc;
                    u32x4 w; w.x = cvtpk(v0[0], v0[1]); w.y = cvtpk(v0[2], v0[3]); w.z = cvtpk(v1[0], v1[1]); w.w = cvtpk(v1[2], v1[3]);
                    bf16_t* p = bj == 0 ? KBp + (size_t)row * NQ + h * 192 + c0 : VBp + (size_t)row * DM + h * 128 + c0;
                    *(u32x4*)p = w; } }
    }
};

__device__ __forceinline__ void tr_item(const float* W, int K, int N, bf16_t* WT, bool gu, const float* kscale, LAS float* scr, int item, int lane) {
    const int nblk = N / 64, kb = item / nblk, nb = item % nblk, k0 = 64 * kb, n0 = 64 * nb;
    f32x4 v[16];
#pragma unroll
    for (int i = 0; i < 16; ++i) v[i] = *(const f32x4*)(W + (size_t)(k0 + 4 * i + (lane >> 4)) * N + n0 + 4 * (lane & 15));
#pragma unroll
    for (int i = 0; i < 16; ++i) { const int kk = 4 * i + (lane >> 4); f32x4 w = v[i]; if (kscale) w = w * kscale[k0 + kk]; LAS float* p = scr + kk * 65 + 4 * (lane & 15); p[0] = w[0]; p[1] = w[1]; p[2] = w[2]; p[3] = w[3]; }
    LDS_WAIT(); asm volatile("" ::: "memory");
    int d0 = n0;
    if (gu) { const int i0 = n0 & 511; d0 = 256 * (i0 >> 7) + (n0 >= 512 ? 128 : 0) + (i0 & 127); }
    const int c = lane & 7;
#pragma unroll
    for (int j = 0; j < 8; ++j) { const int n = (lane >> 3) + 8 * j; const LAS float* sp = scr + (8 * c) * 65 + n;
        u32x4 o; o.x = pk2(sp[0 * 65], sp[1 * 65]); o.y = pk2(sp[2 * 65], sp[3 * 65]); o.z = pk2(sp[4 * 65], sp[5 * 65]); o.w = pk2(sp[6 * 65], sp[7 * 65]);
        *(u32x4*)(WT + (size_t)(d0 + n) * K + k0 + 8 * c) = o; }
    LDS_WAIT(); asm volatile("" ::: "memory");
}
constexpr int MOE_W_ITEMS = 32 * 256 + 32 * 128;
__device__ __forceinline__ void moe_w_item(Frame& F, int layer, int it, LAS float* scr) {
    if (it < 32 * 256) { const int e = layer * 32 + it / 256; tr_item(F.ka->in[I_MGU] + (size_t)e * DM * 1024, DM, 1024, (bf16_t*)(F.ws + WS_WGU) + (size_t)e * 1024 * DM, true, nullptr, scr, it % 256, F.lane); }
    else { it -= 32 * 256; const int e = layer * 32 + it / 128; tr_item(F.ka->in[I_MDN] + (size_t)e * MFF * DM, MFF, DM, (bf16_t*)(F.ws + WS_WDN) + (size_t)e * DM * MFF, false, nullptr, scr, it % 128, F.lane); }
}
__device__ __forceinline__ void p0_prologue(Frame& F) {
    __syncthreads();

    LAS float* S = (LAS float*)F.lds;
    for (int idx = F.tid; idx < 17 * DM; idx += 512) { const int r = idx >> 10, k = idx & 1023; const float cv = r < 16 ? F.ka->in[I_C][r * DM + k] : F.ka->in[I_CCTX][k]; S[k * 20 + r] = siluf_(cv); }
    __syncthreads();
    const int gw = F.vcu * 8 + F.wave, NGW = F.G * 8;
    float* part = (float*)(F.ws + WS_PART);
    for (int it = gw; it < 2 * 8 * 96; it += NGW) {
        const int l = it / 768, rem = it % 768, kc = rem / 96, slab = rem % 96, n0 = slab * 64;
        const float* w = F.ka->in[I_ADAW] + ((size_t)l * DM + kc * 128) * 6144 + n0 + F.lane;
        float acc[17];
#pragma unroll
        for (int r = 0; r < 17; ++r) acc[r] = 0.f;
#pragma unroll 4
        for (int kk = 0; kk < 128; ++kk) {
            const float wv = w[(size_t)kk * 6144];
            const LAS float* s = S + (kc * 128 + kk) * 20;
            const f32x4 s0 = *(const LAS f32x4*)s, s1 = *(const LAS f32x4*)(s + 4), s2 = *(const LAS f32x4*)(s + 8), s3 = *(const LAS f32x4*)(s + 12); const float s4 = s[16];
            acc[0] += s0[0] * wv; acc[1] += s0[1] * wv; acc[2] += s0[2] * wv; acc[3] += s0[3] * wv;
            acc[4] += s1[0] * wv; acc[5] += s1[1] * wv; acc[6] += s1[2] * wv; acc[7] += s1[3] * wv;
            acc[8] += s2[0] * wv; acc[9] += s2[1] * wv; acc[10] += s2[2] * wv; acc[11] += s2[3] * wv;
            acc[12] += s3[0] * wv; acc[13] += s3[1] * wv; acc[14] += s3[2] * wv; acc[15] += s3[3] * wv; acc[16] += s4 * wv;
        }
#pragma unroll
        for (int r = 0; r < 17; ++r) part[((size_t)(l * 8 + kc) * 17 + r) * 6144 + n0 + F.lane] = acc[r];
    }
    __syncthreads();
    LAS float* scr = (LAS float*)(F.lds + F.wave * 16640);
    constexpr int I_A = 16 * 56, I_B = 16 * 16, I_C2 = 16 * 11, I_D = 6 * 24, I_E = 4 * 32, I_F = 16 * 16, I_GU = 16 * 16, I_DN = 8 * 16;
    constexpr int NITEMS = I_A + I_B + I_C2 + I_D + I_E + I_F + MOE_W_ITEMS;
    for (int it = gw; it < NITEMS; it += NGW) {
        int r = it;
        if (r < I_A) { tr_item(F.ka->in[I_EVWIN], DM, EVIN, (bf16_t*)(F.ws + WS_WIN0), false, nullptr, scr, r, F.lane); continue; } r -= I_A;
        if (r < I_B) { tr_item(F.ka->in[I_EVWOUT], DM, DM, (bf16_t*)(F.ws + WS_WOUT0), false, nullptr, scr, r, F.lane); continue; } r -= I_B;
        if (r < I_C2) { tr_item(F.ka->in[I_ODWIN], DM, CIN, (bf16_t*)(F.ws + WS_WIN1), false, nullptr, scr, r, F.lane); continue; } r -= I_C2;
        if (r < I_D) { tr_item(F.ka->in[I_ODWUQ], QRANK, NQ, (bf16_t*)(F.ws + WS_WUQ), false, F.ka->in[I_ODQG], scr, r, F.lane); continue; } r -= I_D;
        if (r < I_E) { tr_item(F.ka->in[I_ODWUKV], KVRANK, NKV, (bf16_t*)(F.ws + WS_WUKV), false, F.ka->in[I_ODKVG], scr, r, F.lane); continue; } r -= I_E;
        if (r < I_F) { tr_item(F.ka->in[I_ODWOUT], DM, DM, (bf16_t*)(F.ws + WS_WOUT1), false, nullptr, scr, r, F.lane); continue; } r -= I_F;
        moe_w_item(F, 0, r, scr);
    }
}
__device__ __forceinline__ void moe_l1_convert(Frame& F, int lo, int hi, int w0, int nw) {
    LAS float* scr = (LAS float*)(F.lds + F.wave * 16640);
    for (int it = lo + w0; it < hi; it += nw) moe_w_item(F, 1, it, scr);
}
__device__ __forceinline__ void p0b_mod(Frame& F) {
    const float* part = (const float*)(F.ws + WS_PART); float* mod = (float*)(F.ws + WS_MOD);
    const int gt = F.vcu * 512 + F.tid, NGT = F.G * 512;
    for (int idx = gt; idx < 2 * 17 * 6144; idx += NGT) {
        const int l = idx / (17 * 6144), rem = idx % (17 * 6144), r = rem / 6144, n = rem % 6144;
        float s = F.ka->in[I_ADAB][l * 6144 + n];
#pragma unroll
        for (int kc = 0; kc < 8; ++kc) s += part[((size_t)(l * 8 + kc) * 17 + r) * 6144 + n];
        mod[idx] = s;
    }
}

__device__ __forceinline__ void load_row4(const float* p, int lane, f32x4 (&v)[4]) {
#pragma unroll
    for (int j = 0; j < 4; ++j) v[j] = *(const f32x4*)(p + 4 * lane + 256 * j);
}
__device__ __forceinline__ float sumsq4(const f32x4 (&v)[4]) {
    float s = 0.f;
#pragma unroll
    for (int j = 0; j < 4; ++j) s += (v[j][0] * v[j][0] + v[j][1] * v[j][1]) + (v[j][2] * v[j][2] + v[j][3] * v[j][3]);
    return wave_sum(s);
}
__device__ __forceinline__ void norm_mod4(f32x4 (&v)[4], const float* g, const float* shift, const float* scale, int lane) {
    const float rstd = __builtin_amdgcn_rsqf(sumsq4(v) * (1.0f / DM) + RMS_EPS);
#pragma unroll
    for (int j = 0; j < 4; ++j) { const int c = 4 * lane + 256 * j; const f32x4 gg = *(const f32x4*)(g + c), sh = *(const f32x4*)(shift + c), sc = *(const f32x4*)(scale + c);
        v[j] = v[j] * rstd * gg * (sc + 1.0f) + sh; }
}
__device__ __forceinline__ void store_row_bf16(bf16_t* p, int lane, const f32x4 (&v)[4]) {
#pragma unroll
    for (int j = 0; j < 4; ++j) { u32x2 w; w.x = cvtpk(v[j][0], v[j][1]); w.y = cvtpk(v[j][2], v[j][3]); *(u32x2*)(p + 4 * lane + 256 * j) = w; }
}
__device__ __forceinline__ void moe_combine4(Frame& F, int row, int layer, int mrow, f32x4 (&v)[4]) {
    const bf16_t* ys = (const bf16_t*)(F.ws + WS_YS) + (size_t)(2 * row) * DM; const float* aw = (const float*)(F.ws + WS_ROUTE + RT_AW);
    const float w0 = aw[2 * row], w1 = aw[2 * row + 1]; const float* gate = mod_ptr(F, layer, mrow, 5);
#pragma unroll
    for (int j = 0; j < 4; ++j) { const int c = 4 * F.lane + 256 * j; const u32x2 y0 = *(const u32x2*)(ys + c), y1 = *(const u32x2*)(ys + DM + c); const f32x4 gg = *(const f32x4*)(gate + c);
        f32x4 y; y[0] = w0 * bflo(y0.x) + w1 * bflo(y1.x); y[1] = w0 * bfhi(y0.x) + w1 * bfhi(y1.x); y[2] = w0 * bflo(y0.y) + w1 * bflo(y1.y); y[3] = w0 * bfhi(y0.y) + w1 * bfhi(y1.y);
        v[j] = v[j] + gg * y; }
}
__device__ __forceinline__ void p1_norm_input(Frame& F) {
    const int gw = F.vcu * 8 + F.wave, NGW = F.G * 8; bf16_t* hx = (bf16_t*)(F.ws + WS_HX);
    for (int row = gw; row < R; row += NGW) {
        const int b = row / PB, pos = row - b * PB, mrow = pos < CTXL ? 16 : b;
        f32x4 v[4]; load_row4(input_row(F, row), F.lane, v);
        norm_mod4(v, F.ka->in[I_NMIXG], mod_ptr(F, 0, mrow, 0), mod_ptr(F, 0, mrow, 1), F.lane);
        store_row_bf16(hx + (size_t)row * DM, F.lane, v);
    }
}
__device__ __forceinline__ void p8_combine_norm(Frame& F) {
    const int gw = F.vcu * 8 + F.wave, NGW = F.G * 8; bf16_t* hx = (bf16_t*)(F.ws + WS_HX); float* xs = (float*)(F.ws + WS_XS);
    for (int row = gw; row < R; row += NGW) {
        const int b = row / PB, pos = row - b * PB, mrow = pos < CTXL ? 16 : b;
        f32x4 v[4]; load_row4(xs + (size_t)row * DM, F.lane, v);
        moe_combine4(F, row, 0, mrow, v);
#pragma unroll
        for (int j = 0; j < 4; ++j) *(f32x4*)(xs + (size_t)row * DM + 4 * F.lane + 256 * j) = v[j];
        norm_mod4(v, F.ka->in[I_NMIXG] + DM, mod_ptr(F, 1, mrow, 0), mod_ptr(F, 1, mrow, 1), F.lane);
        store_row_bf16(hx + (size_t)row * DM, F.lane, v);
    }
}
__device__ __forceinline__ void p16_final(Frame& F) {
    const int gw = F.vcu * 8 + F.wave, NGW = F.G * 8; const float* xs = (const float*)(F.ws + WS_XS);
    for (int row = gw; row < R; row += NGW) {
        const int b = row / PB, pos = row - b * PB; if (pos < CTXL) continue;
        f32x4 v[4];
        if (DBG_MODE >= 10) {
            const bf16_t* hx = (const bf16_t*)(F.ws + WS_HX) + (size_t)row * DM; const bf16_t* px = (const bf16_t*)(F.ws + WS_PX0) + (size_t)row * EVIN; const bf16_t* mx = (const bf16_t*)(F.ws + WS_MIX) + (size_t)row * DM;
#pragma unroll
            for (int j = 0; j < 4; ++j)
#pragma unroll
                for (int e = 0; e < 4; ++e) { const int c = 4 * F.lane + 256 * j + e;
                    v[j][e] = DBG_MODE == 10 ? bf2f(hx[c]) : DBG_MODE == 11 ? bf2f(px[c]) + bf2f(px[1024 + c]) + bf2f(px[2048 + c]) + bf2f(px[3072 + (c & 511)]) : bf2f(mx[c]); }
        } else load_row4(DBG_MODE == 1 ? input_row(F, row) : xs + (size_t)row * DM, F.lane, v);
        if (DBG_MODE == 0) moe_combine4(F, row, 1, b, v);
        const float rstd = __builtin_amdgcn_rsqf(sumsq4(v) * (1.0f / DM) + RMS_EPS);
        float* o = F.out + ((size_t)b * SEQ + (pos - CTXL)) * DM;
#pragma unroll
        for (int j = 0; j < 4; ++j) { const int c = 4 * F.lane + 256 * j; const f32x4 gg = *(const f32x4*)(F.ka->in[I_FING] + c); *(f32x4*)(o + c) = v[j] * rstd * gg; }
    }
}

template <bool XONLY>
__device__ __forceinline__ void p5_norm_route(Frame& F, int layer) {

    LAS float* W1L = (LAS float*)F.lds; LAS float* W2L = W1L + 4096;
    volatile LAS int* lcnt = (volatile LAS int*)(F.lds + LDSCTL_OFF + 64);
    const float* wr1 = F.ka->in[I_MR1W] + (size_t)layer * DM * 4; const float* wr2 = F.ka->in[I_MR2W] + (size_t)layer * 4 * DM * 8;
    for (int k = F.tid; k < DM; k += 512) { const int l = (k & 255) >> 2, j = k >> 8, e = k & 3; *(LAS f32x4*)(W1L + ((j * 4 + e) * 64 + l) * 4) = *(const f32x4*)(wr1 + k * 4); }
    for (int idx = F.tid; idx < 4 * DM * 2; idx += 512) { const int half = idx & 1, k = (idx >> 1) & 1023, g = idx >> 11; const int l = (k & 255) >> 2, j = k >> 8, e = k & 3;
        *(LAS f32x4*)(W2L + ((((g * 16 + j * 4 + e) * 2 + half) * 64) + l) * 4) = *(const f32x4*)(wr2 + ((size_t)g * DM + k) * 8 + half * 4); }
    if (F.tid < 32) lcnt[F.tid] = 0;
    __syncthreads();
    const int gw = F.vcu * 8 + F.wave, NGW = F.G * 8; bf16_t* hx = (bf16_t*)(F.ws + WS_HX); const float* xs = (const float*)(F.ws + WS_XS);
    int* ae = (int*)(F.ws + WS_ROUTE + RT_AE); int* ap = (int*)(F.ws + WS_ROUTE + RT_AP); float* aw = (float*)(F.ws + WS_ROUTE + RT_AW);
    const float* b1 = F.ka->in[I_MR1B] + layer * 4; const float* b2 = F.ka->in[I_MR2B] + layer * 32;
    for (int row = gw; row < R; row += NGW) {
        const int b = row / PB, pos = row - b * PB; if (XONLY && pos < CTXL) continue;
        const int mrow = pos < CTXL ? 16 : b;
        f32x4 v[4]; load_row4(xs + (size_t)row * DM, F.lane, v);
        norm_mod4(v, F.ka->in[I_NFFNG] + layer * DM, mod_ptr(F, layer, mrow, 3), mod_ptr(F, layer, mrow, 4), F.lane);
        store_row_bf16(hx + (size_t)row * DM, F.lane, v);
        f32x4 l1 = {0.f, 0.f, 0.f, 0.f};
#pragma unroll
        for (int j = 0; j < 4; ++j)
#pragma unroll
            for (int e = 0; e < 4; ++e) l1 += *(const LAS f32x4*)(W1L + ((j * 4 + e) * 64 + F.lane) * 4) * v[j][e];
        float g0 = wave_sum(l1[0]) + b1[0], g1 = wave_sum(l1[1]) + b1[1], g2 = wave_sum(l1[2]) + b1[2], g3 = wave_sum(l1[3]) + b1[3];
        int grp = 0; float gm = g0;
        if (g1 > gm) { gm = g1; grp = 1; } if (g2 > gm) { gm = g2; grp = 2; } if (g3 > gm) { gm = g3; grp = 3; }
        grp = __builtin_amdgcn_readfirstlane(grp);
        const float pg = 1.0f / (__expf(g0 - gm) + __expf(g1 - gm) + __expf(g2 - gm) + __expf(g3 - gm));
        f32x4 la = {0.f, 0.f, 0.f, 0.f}, lb = {0.f, 0.f, 0.f, 0.f};
        const LAS float* w2 = W2L + grp * 16 * 2 * 64 * 4;
#pragma unroll
        for (int j = 0; j < 4; ++j)
#pragma unroll
            for (int e = 0; e < 4; ++e) { const LAS float* p = w2 + (((j * 4 + e) * 2) * 64 + F.lane) * 4; la += *(const LAS f32x4*)p * v[j][e]; lb += *(const LAS f32x4*)(p + 256) * v[j][e]; }
        float lg[8];
#pragma unroll
        for (int q = 0; q < 4; ++q) { lg[q] = wave_sum(la[q]) + b2[grp * 8 + q]; lg[4 + q] = wave_sum(lb[q]) + b2[grp * 8 + 4 + q]; }
        int e0 = 0; float m0 = lg[0];
#pragma unroll
        for (int q = 1; q < 8; ++q) if (lg[q] > m0) { m0 = lg[q]; e0 = q; }
        int e1 = -1; float m1 = -3.0e38f;
#pragma unroll
        for (int q = 0; q < 8; ++q) if (q != e0 && lg[q] > m1) { m1 = lg[q]; e1 = q; }
        const float pb = __expf(m1 - m0), inv = pg / (1.0f + pb);
        if (F.lane < 2) {
            const int ex = grp * 8 + (F.lane == 0 ? e0 : e1);
            const int lp = __hip_atomic_fetch_add((LAS int*)lcnt + ex, 1, __ATOMIC_RELAXED, __HIP_MEMORY_SCOPE_WORKGROUP);
            const int a = 2 * row + F.lane; ae[a] = ex; ap[a] = lp; aw[a] = F.lane == 0 ? inv : inv * pb;
        }
    }
    __syncthreads();
    if (F.tid < 32) ((int*)(F.ws + WS_ROUTE + RT_CNTB))[F.vcu * 32 + F.tid] = lcnt[F.tid];
}
template <bool XONLY>
__device__ __forceinline__ void p5b_perm(Frame& F) {
    LAS int* seg = (LAS int*)F.lds;
    LAS int* mypre = seg + 512;
    LAS int* tot = mypre + 32;
    LAS int* base = tot + 32;
    LAS int* pst = base + 32;
    const int* cntb = (const int*)(F.ws + WS_ROUTE + RT_CNTB);
    { const int e = F.tid & 31, sg = F.tid >> 5; int s = 0, pre = 0;
      for (int i = 0; i < 16; ++i) { const int B = sg * 16 + i; const int c = cntb[B * 32 + e]; if (B < F.vcu) pre += c; s += c; }
      seg[sg * 32 + e] = s; if (sg == (F.vcu >> 4)) mypre[e] = pre; }
    __syncthreads();
    if (F.tid < 32) { int t = 0, bs = 0; for (int sg = 0; sg < 16; ++sg) { const int s = seg[sg * 32 + F.tid]; if (sg < (F.vcu >> 4)) bs += s; t += s; } tot[F.tid] = t; base[F.tid] = bs + mypre[F.tid]; }
    __syncthreads();
    if (F.tid == 0) { int ps = 0; for (int e = 0; e < 32; ++e) { pst[e] = ps; ps += ((tot[e] + 255) >> 8) << 8; } pst[32] = ps; }
    __syncthreads();
    const int gw = F.vcu * 8 + F.wave, NGW = F.G * 8;
    const int* ae = (const int*)(F.ws + WS_ROUTE + RT_AE); const int* ap = (const int*)(F.ws + WS_ROUTE + RT_AP); int* perm = (int*)(F.ws + WS_ROUTE + RT_PERM);
    for (int row = gw; row < R; row += NGW) {
        const int b = row / PB, pos = row - b * PB; if (XONLY && pos < CTXL) continue;
        if (F.lane < 2) { const int a = 2 * row + F.lane; const int e = ae[a]; perm[pst[e] + base[e] + ap[a]] = a; }
    }
    if (F.vcu < 32) { const int e = F.vcu; for (int s = pst[e] + tot[e] + F.tid; s < pst[e + 1]; s += 512) perm[s] = -1; }
    if (F.vcu == 0) { int* blke = (int*)(F.ws + WS_ROUTE + RT_BLKE);
        if (F.tid < 32) { const int e = F.tid; for (int blk = pst[e] >> 8; blk < (pst[e + 1] >> 8); ++blk) blke[blk] = e; }
        if (F.tid == 0) *(int*)(F.ws + WS_ROUTE + RT_NBLK) = pst[32] >> 8; }
}

__device__ __forceinline__ bf16x8 lds_frag256(const LAS unsigned char* base, int row, int chunk) { return *(const LAS bf16x8*)(base + row * 256 + ((chunk ^ (row & 7)) << 4)); }
__device__ __forceinline__ bf16x8 lds_frag128(const LAS unsigned char* base, int row, int chunk) { return *(const LAS bf16x8*)(base + row * 128 + ((chunk ^ (row & 7)) << 4)); }
#define MFMA16(a, b, c) __builtin_amdgcn_mfma_f32_16x16x32_bf16((a), (b), (c), 0, 0, 0)

typedef short v4i16_t __attribute__((ext_vector_type(4)));
__device__ __forceinline__ int trswz256(int r, int cb) { return r * 256 + (cb ^ (((r & 3) | ((r >> 1) & 4)) << 5)); }
__device__ __forceinline__ int trswz128(int r, int cb) { return r * 128 + (cb ^ ((((r >> 1) & 1) | ((r >> 2) & 2)) << 5)); }
template <int ROWB> __device__ __forceinline__ bf16x8 lds_trfrag(const LAS unsigned char* tile, int s0, int c0, int lane) {
    const int i = lane & 15, r0 = s0 + (i >> 2), r1 = r0 + 4, cb = (c0 + 4 * (i & 3)) * 2;
    const int a0 = ROWB == 256 ? trswz256(r0, cb) : trswz128(r0, cb), a1 = ROWB == 256 ? trswz256(r1, cb) : trswz128(r1, cb);
    const v4i16_t lo = __builtin_amdgcn_ds_read_tr16_b64_v4i16((LAS v4i16_t*)(tile + a0)), hi = __builtin_amdgcn_ds_read_tr16_b64_v4i16((LAS v4i16_t*)(tile + a1));
    return (bf16x8){lo[0], lo[1], lo[2], lo[3], hi[0], hi[1], hi[2], hi[3]};
}
__device__ __forceinline__ void gla_item(Frame& F, int item) {
    const int b = item >> 3, h = (item >> 1) & 3, dir = item & 1;
    LAS unsigned char* QD = F.lds; LAS unsigned char* KD = F.lds + 16384; LAS unsigned char* KT = F.lds + 32768  ; LAS unsigned char* VR = F.lds + 49152  ;
    LAS unsigned char* PS = F.lds + 65536; LAS unsigned char* ST = F.lds + 73728  ; LAS float* LF = (LAS float*)(F.lds + 106496); LAS float* SEGT = (LAS float*)(F.lds + 139264); LAS float* DEC = (LAS float*)(F.lds + 141312);
    const int tid = F.tid, lane = F.lane, wave = F.wave, fr = lane & 15, fq = lane >> 4;
    const int t0 = tid >> 4, c = tid & 15, tv = tid >> 3, cv = tid & 7;
    const bf16_t* px = (const bf16_t*)(F.ws + WS_PX0);
    bf16_t* og = (bf16_t*)(F.ws + WS_OG) + (size_t)dir * R * 512;
    float lbv[8], oml[8];
    { const float* lg = F.ka->in[I_EVLB] + h * 128 + 8 * c;
#pragma unroll
      for (int e = 0; e < 8; ++e) { lbv[e] = 1.0f / (1.0f + __expf(lg[512 + e] - lg[e])); oml[e] = 1.0f - lbv[e]; } }
    { u32x4 z = {0u, 0u, 0u, 0u};
#pragma unroll
      for (int i = 0; i < 4; ++i) *(LAS u32x4*)(ST + tid * 64 + 16 * i) = z; }
    f32x4 S[8];
#pragma unroll
    for (int i = 0; i < 8; ++i) S[i] = (f32x4){0.f, 0.f, 0.f, 0.f};
    auto chunk_p0 = [&](int j) { return dir == 0 ? 64 * j : (j < 4 ? 192 - 64 * j : PB - 64 * (j - 3)); };
    auto row_of = [&](int p0, int tau) { return b * PB + (dir == 0 ? p0 + tau : p0 + 63 - tau); };
    u32x4 rqA[2], rfA[2], rvA[2];
#define GLA_LOAD(j, RQ, RF, RV) do { const int p0_ = chunk_p0(j); \
        _Pragma("unroll") for (int i_ = 0; i_ < 2; ++i_) { const bf16_t* rp_ = px + (size_t)row_of(p0_, t0 + 32 * i_) * EVIN + h * 128 + 8 * c; RQ[i_] = *(const u32x4*)rp_; RF[i_] = *(const u32x4*)(rp_ + 512 * (1 + dir)); } \
        { const bf16_t* vp_ = px + (size_t)row_of(p0_, tv) * EVIN + 1536 + h * 128 + 8 * cv; RV[0] = *(const u32x4*)vp_; RV[1] = *(const u32x4*)(vp_ + 64); } } while (0)
    GLA_LOAD(0, rqA, rfA, rvA);
    __syncthreads();
    const int ti = wave & 3, sp = wave >> 2, ki = wave;
#define GLA_STEP(j, RQ, RF, RV) do { \
        const int p0 = chunk_p0(j); float qv[2][8], kv[2][8]; const u32x4 vraw0 = RV[0], vraw1 = RV[1]; \
        _Pragma("unroll") for (int i = 0; i < 2; ++i) { const int tau = t0 + 32 * i; float lf[8]; \
            _Pragma("unroll") for (int e = 0; e < 4; ++e) { const unsigned wq = RQ[i][e], wf = RF[i][e]; \
                qv[i][2 * e] = bflo(wq); qv[i][2 * e + 1] = bfhi(wq); \
                const float s0_ = sigmoidf_(bflo(wf)), s1_ = sigmoidf_(bfhi(wf)); \
                const float f0 = lbv[2 * e] + oml[2 * e] * s0_, f1 = lbv[2 * e + 1] + oml[2 * e + 1] * s1_; \
                kv[i][2 * e] = 1.0f - f0; kv[i][2 * e + 1] = 1.0f - f1; lf[2 * e] = lg2(f0); lf[2 * e + 1] = lg2(f1); } \
            *(LAS f32x4*)(LF + tau * 128 + 8 * c) = (f32x4){lf[0], lf[1], lf[2], lf[3]}; *(LAS f32x4*)(LF + tau * 128 + 8 * c + 4) = (f32x4){lf[4], lf[5], lf[6], lf[7]}; } \
        if ((j) + 1 < 36) GLA_LOAD((j) + 1, RQ, RF, RV); \
        __syncthreads(); \
        { const int k = tid & 127, sg = tid >> 7; float run = 0.f; \
          _Pragma("unroll") for (int i = 0; i < 16; ++i) { const int idx = (16 * sg + i) * 128 + k; run += LF[idx]; LF[idx] = run; } \
          SEGT[sg * 128 + k] = run; } \
        __syncthreads(); \
        { float seg[4][8]; float ebl[8]; \
          _Pragma("unroll") for (int s = 0; s < 4; ++s) { const f32x4 a0 = *(const LAS f32x4*)(SEGT + s * 128 + 8 * c), a1 = *(const LAS f32x4*)(SEGT + s * 128 + 8 * c + 4); \
              _Pragma("unroll") for (int e = 0; e < 4; ++e) { seg[s][e] = a0[e]; seg[s][4 + e] = a1[e]; } } \
          float offr[2][8]; const bool odd = (t0 >> 4) != 0; \
          _Pragma("unroll") for (int e = 0; e < 8; ++e) { ebl[e] = ex2((seg[0][e] + seg[1][e]) + (seg[2][e] + seg[3][e])); offr[0][e] = odd ? seg[0][e] : 0.f; offr[1][e] = (seg[0][e] + seg[1][e]) + (odd ? seg[2][e] : 0.f); } \
          _Pragma("unroll") for (int i = 0; i < 2; ++i) { const int tau = t0 + 32 * i; \
              const f32x4 c0 = *(const LAS f32x4*)(LF + tau * 128 + 8 * c), c1 = *(const LAS f32x4*)(LF + tau * 128 + 8 * c + 4); \
              float qd[8], kd[8], kt[8]; \
              _Pragma("unroll") for (int e = 0; e < 8; ++e) { \
                  const float bb = (e < 4 ? c0[e] : c1[e - 4]) + offr[i][e]; const float eb = ex2(bb); \
                  qd[e] = qv[i][e] * eb; kd[e] = kv[i][e] * __builtin_amdgcn_rcpf(eb); kt[e] = kd[e] * ebl[e]; } \
              u32x4 w; w.x = cvtpk(qd[0], qd[1]); w.y = cvtpk(qd[2], qd[3]); w.z = cvtpk(qd[4], qd[5]); w.w = cvtpk(qd[6], qd[7]); \
              *(LAS u32x4*)(QD + tau * 256 + ((c ^ (tau & 7)) << 4)) = w; \
              w.x = cvtpk(kd[0], kd[1]); w.y = cvtpk(kd[2], kd[3]); w.z = cvtpk(kd[4], kd[5]); w.w = cvtpk(kd[6], kd[7]); \
              *(LAS u32x4*)(KD + tau * 256 + ((c ^ (tau & 7)) << 4)) = w; \
              w.x = cvtpk(kt[0], kt[1]); w.y = cvtpk(kt[2], kt[3]); w.z = cvtpk(kt[4], kt[5]); w.w = cvtpk(kt[6], kt[7]); \
              *(LAS u32x4*)(KT + trswz256(tau, 16 * c)) = w; } \
          *(LAS u32x4*)(VR + trswz256(tv, 16 * cv)) = vraw0; *(LAS u32x4*)(VR + trswz256(tv, 16 * (cv + 8))) = vraw1; \
          if (tid < 128) DEC[tid] = ex2((SEGT[tid] + SEGT[128 + tid]) + (SEGT[256 + tid] + SEGT[384 + tid])); } \
        __syncthreads(); \
        bf16x8 bq[4]; \
        _Pragma("unroll") for (int ks = 0; ks < 4; ++ks) bq[ks] = lds_frag256(QD, 16 * ti + fr, ks * 4 + fq); \
        _Pragma("unroll") for (int u = 0; u < 2; ++u) { const int si = 2 * sp + u; f32x4 a = {0.f, 0.f, 0.f, 0.f}; \
            _Pragma("unroll") for (int ks = 0; ks < 4; ++ks) a = MFMA16(lds_frag256(KD, 16 * si + fr, ks * 4 + fq), bq[ks], a); \
            const int tt = 16 * ti + fr, s0 = 16 * si + 4 * fq; \
            u32x2 w; w.x = cvtpk(s0 <= tt ? a[0] : 0.f, s0 + 1 <= tt ? a[1] : 0.f); w.y = cvtpk(s0 + 2 <= tt ? a[2] : 0.f, s0 + 3 <= tt ? a[3] : 0.f); \
            *(LAS u32x2*)(PS + tt * 128 + ((2 * s0) ^ ((tt & 7) << 4))) = w; } \
        f32x4 oacc[4]; \
        _Pragma("unroll") for (int u = 0; u < 4; ++u) { const int vi = 4 * sp + u; f32x4 o = {0.f, 0.f, 0.f, 0.f}; \
            _Pragma("unroll") for (int ks = 0; ks < 4; ++ks) o = MFMA16(lds_frag256(ST, 16 * vi + fr, ks * 4 + fq), bq[ks], o); \
            oacc[u] = o; } \
        { const f32x4 dk = *(const LAS f32x4*)(DEC + 16 * ki + 4 * fq); \
          bf16x8 ak[2]; \
          _Pragma("unroll") for (int ks = 0; ks < 2; ++ks) ak[ks] = lds_trfrag<256>(KT, 32 * ks + 8 * fq, 16 * ki, lane); \
          _Pragma("unroll") for (int vi = 0; vi < 8; ++vi) { f32x4 s = S[vi] * dk; \
              _Pragma("unroll") for (int ks = 0; ks < 2; ++ks) s = MFMA16(ak[ks], lds_trfrag<256>(VR, 32 * ks + 8 * fq, 16 * vi, lane), s); \
              S[vi] = s; } } \
        __syncthreads(); \
        { bf16x8 bp[2]; \
          _Pragma("unroll") for (int ks = 0; ks < 2; ++ks) bp[ks] = lds_frag128(PS, 16 * ti + fr, ks * 4 + fq); \
          const int orow = row_of(p0, 16 * ti + fr); \
          _Pragma("unroll") for (int u = 0; u < 4; ++u) { const int vi = 4 * sp + u; f32x4 o = oacc[u]; \
              _Pragma("unroll") for (int ks = 0; ks < 2; ++ks) o = MFMA16(lds_trfrag<256>(VR, 32 * ks + 8 * fq, 16 * vi, lane), bp[ks], o); \
              u32x2 w; w.x = cvtpk(o[0], o[1]); w.y = cvtpk(o[2], o[3]); \
              *(u32x2*)(og + (size_t)orow * 512 + h * 128 + 16 * vi + 4 * fq) = w; } \
          _Pragma("unroll") for (int vi = 0; vi < 8; ++vi) { const int v = 16 * vi + fr, k0 = 16 * ki + 4 * fq; u32x2 w; w.x = cvtpk(S[vi][0], S[vi][1]); w.y = cvtpk(S[vi][2], S[vi][3]); \
              *(LAS u32x2*)(ST + v * 256 + ((2 * k0) ^ ((v & 7) << 4))) = w; } } \
    } while (0)
    for (int j = 0; j < 36; ++j) { GLA_STEP(j, rqA, rfA, rvA); }
    __syncthreads();
#undef GLA_LOAD
#undef GLA_STEP
}

__device__ __forceinline__ void sgu_item(Frame& F, int ci) {
    LAS unsigned char* VN = F.lds; LAS unsigned char* WS = F.lds + 32768;
    const int tid = F.tid, lane = F.lane, wave = F.wave, fr = lane & 15, fq = lane >> 4;
    const int r0 = ci * 128, row = tid >> 2, q = tid & 3;
    const bf16_t* px = (const bf16_t*)(F.ws + WS_PX0); bf16_t* mix = (bf16_t*)(F.ws + WS_MIX);
    const bf16_t* vrow = px + (size_t)(r0 + row) * EVIN + 3072 + 32 * q;
    float sum = 0.f, sq = 0.f;
    { u32x4 vr[16];
#pragma unroll
      for (int j = 0; j < 4; ++j)
#pragma unroll
        for (int i = 0; i < 4; ++i) vr[4 * j + i] = *(const u32x4*)(vrow + 128 * j + 8 * i);
#pragma unroll
      for (int i = 0; i < 16; ++i) {
#pragma unroll
        for (int e = 0; e < 4; ++e) { const float a = geluf_(bflo(vr[i][e])), bb = geluf_(bfhi(vr[i][e])); sum += a + bb; sq += a * a + bb * bb; } } }
    sum += __shfl_xor(sum, 1); sum += __shfl_xor(sum, 2); sq += __shfl_xor(sq, 1); sq += __shfl_xor(sq, 2);
    const float mean = sum * (1.0f / 512.0f), rstd = __builtin_amdgcn_rsqf(fmaxf(sq * (1.0f / 512.0f) - mean * mean, 0.f) + RMS_EPS);
    u32x4 vg[4]; f32x4 wsr[8];
#define SGU_LOADG(g) do { const float* wsg_ = F.ka->in[I_EVWS] + (size_t)(g) * 128 * 128; _Pragma("unroll") for (int it_ = 0; it_ < 4; ++it_) { const int idx_ = tid + 512 * it_; \
        wsr[2 * it_] = *(const f32x4*)(wsg_ + (idx_ >> 4) * 128 + 8 * (idx_ & 15)); wsr[2 * it_ + 1] = *(const f32x4*)(wsg_ + (idx_ >> 4) * 128 + 8 * (idx_ & 15) + 4); } \
        _Pragma("unroll") for (int i_ = 0; i_ < 4; ++i_) vg[i_] = *(const u32x4*)(vrow + 128 * (g) + 8 * i_); } while (0)
    SGU_LOADG(0);
#pragma unroll 1
    for (int g = 0; g < 4; ++g) {
        const float* gain = F.ka->in[I_EVSGUG] + 128 * g + 32 * q;
#pragma unroll
        for (int i = 0; i < 4; ++i) { const u32x4 w = vg[i]; const f32x4 g0 = *(const f32x4*)(gain + 8 * i), g1 = *(const f32x4*)(gain + 8 * i + 4);
            u32x4 o;
            o.x = cvtpk((geluf_(bflo(w.x)) - mean) * rstd * g0[0], (geluf_(bfhi(w.x)) - mean) * rstd * g0[1]); o.y = cvtpk((geluf_(bflo(w.y)) - mean) * rstd * g0[2], (geluf_(bfhi(w.y)) - mean) * rstd * g0[3]);
            o.z = cvtpk((geluf_(bflo(w.z)) - mean) * rstd * g1[0], (geluf_(bfhi(w.z)) - mean) * rstd * g1[1]); o.w = cvtpk((geluf_(bflo(w.w)) - mean) * rstd * g1[2], (geluf_(bfhi(w.w)) - mean) * rstd * g1[3]);
            *(LAS u32x4*)(VN + trswz256(row, (32 * q + 8 * i) * 2)) = o; }
#pragma unroll
        for (int it = 0; it < 4; ++it) { const int idx = tid + 512 * it, t = idx >> 4, ch = idx & 15; const f32x4 a = wsr[2 * it], bb = wsr[2 * it + 1];
            u32x4 w; w.x = cvtpk(a[0], a[1]); w.y = cvtpk(a[2], a[3]); w.z = cvtpk(bb[0], bb[1]); w.w = cvtpk(bb[2], bb[3]);
            *(LAS u32x4*)(WS + t * 256 + ((ch ^ (t & 7)) << 4)) = w; }
        __syncthreads();
        if (g < 3) SGU_LOADG(g + 1);
        const int c0 = 128 * g + 16 * wave + 4 * fq;
        u32x2 uw[8]; float bsv[8];
#pragma unroll
        for (int tt = 0; tt < 8; ++tt) { const int t = 16 * tt + fr; uw[tt] = *(const u32x2*)(px + (size_t)(r0 + t) * EVIN + 2560 + c0); bsv[tt] = F.ka->in[I_EVBS][g * 128 + t]; }
        bf16x8 av[4];
#pragma unroll
        for (int ks = 0; ks < 4; ++ks) av[ks] = lds_trfrag<256>(VN, 32 * ks + 8 * fq, 16 * wave, lane);
#pragma unroll
        for (int tt = 0; tt < 8; ++tt) { f32x4 a = {0.f, 0.f, 0.f, 0.f};
#pragma unroll
            for (int ks = 0; ks < 4; ++ks) a = MFMA16(av[ks], lds_frag256(WS, 16 * tt + fr, ks * 4 + fq), a);
            const int t = 16 * tt + fr; const float bs = bsv[tt]; const u32x2 u2 = uw[tt];
            u32x2 w; w.x = cvtpk(geluf_(bflo(u2.x)) * (a[0] + bs), geluf_(bfhi(u2.x)) * (a[1] + bs)); w.y = cvtpk(geluf_(bflo(u2.y)) * (a[2] + bs), geluf_(bfhi(u2.y)) * (a[3] + bs));
            *(u32x2*)(mix + (size_t)(r0 + t) * DM + 512 + c0) = w; }
        __syncthreads();
    }
#undef SGU_LOADG
}
constexpr int MOE_L1_SPLIT = 6656;
__device__ __forceinline__ void p3_mixers(Frame& F) {
    const int half = F.G >> 1;
    if (F.vcu < half) { for (int rep_ = 0; rep_ < 1 + ((REPMASK >> 21) & 1); ++rep_) for (int it = F.vcu; it < 128; it += half) gla_item(F, it); }
    else { for (int rep_ = 0; rep_ < 1 + ((REPMASK >> 22) & 1); ++rep_) for (int ci = F.vcu - half; ci < R / 128; ci += F.G - half) sgu_item(F, ci);
        moe_l1_convert(F, 0, MOE_L1_SPLIT, (F.vcu - half) * 8 + F.wave, (F.G - half) * 8); }
}
__device__ __forceinline__ void p3b_hgrn_out(Frame& F) {
    const int gw = F.vcu * 8 + F.wave, NGW = F.G * 8; const bf16_t* og = (const bf16_t*)(F.ws + WS_OG); const bf16_t* px = (const bf16_t*)(F.ws + WS_PX0); bf16_t* mix = (bf16_t*)(F.ws + WS_MIX);
    const int c0 = 8 * F.lane; float gn[8];
#pragma unroll
    for (int e = 0; e < 8; ++e) gn[e] = F.ka->in[I_EVONORM][(c0 & 127) + e];
    for (int row = gw; row < R; row += NGW) {
        const u32x4 a = *(const u32x4*)(og + (size_t)row * 512 + c0), bb = *(const u32x4*)(og + (size_t)(R + row) * 512 + c0), gg = *(const u32x4*)(px + (size_t)row * EVIN + 2048 + c0);
        float o[8]; float ss = 0.f;
#pragma unroll
        for (int e = 0; e < 4; ++e) { o[2 * e] = bflo(a[e]) + bflo(bb[e]); o[2 * e + 1] = bfhi(a[e]) + bfhi(bb[e]); ss += o[2 * e] * o[2 * e] + o[2 * e + 1] * o[2 * e + 1]; }
        ss += __shfl_xor(ss, 1); ss += __shfl_xor(ss, 2); ss += __shfl_xor(ss, 4); ss += __shfl_xor(ss, 8);
        const float rstd = __builtin_amdgcn_rsqf(ss * (1.0f / 128.0f) + RMS_EPS);
        u32x4 w;
#pragma unroll
        for (int e = 0; e < 4; ++e) w[e] = cvtpk(o[2 * e] * rstd * gn[2 * e] * siluf_(bflo(gg[e])), o[2 * e + 1] * rstd * gn[2 * e + 1] * siluf_(bfhi(gg[e])));
        *(u32x4*)(mix + (size_t)row * DM + c0) = w;
    }
}

__device__ __forceinline__ void p10_kr(Frame& F) {
    const int gw = F.vcu * 8 + F.wave, NGW = F.G * 8; const bf16_t* px1 = (const bf16_t*)(F.ws + WS_PX1); bf16_t* kb = (bf16_t*)(F.ws + WS_KB);
    const int d = F.lane, i16 = d & 15; const float invf = __expf(-(float)i16 * (2.0f / 32.0f) * 9.210340371976184f);
    for (int row = gw; row < R; row += NGW) {
        const int pos = row % PB; float x = bf2f(px1[(size_t)row * CINP + 640 + d]);
        const float xo = __shfl_xor(x, 16);
        if (pos >= CTXL) { const int t = pos - CTXL; const float p = (d < 32) ? (float)(t >> 6) : (float)(t & 63); const float ang = p * invf, cs = __cosf(ang), sn = __sinf(ang);
            x = (d & 16) ? (xo * sn + x * cs) : (x * cs - xo * sn); }
        const unsigned short hb = (unsigned short)f2bf(x);
#pragma unroll
        for (int h = 0; h < 8; ++h) kb[(size_t)row * NQ + h * 192 + 128 + d] = hb;
    }
}

namespace att {
constexpr int KVBLK = 64, SHM_V = 64 * 128 * 2, SHM_K = 64 * 192 * 2;
constexpr float THR = 8.0f * 1.4426950408889634f;
#define KSWZ192(row, colB) ((row) * 384 + ((colB) ^ (((row) & 7) << 4)))
__device__ __forceinline__ int crow(int r, int hi) { return (r & 3) + 8 * (r >> 2) + 4 * hi; }
__device__ __forceinline__ void partialSM(f32x16& p0, f32x16& p1, float& m_reg, float& mn, float& alpha) {
    float pmax = p0[0];
#pragma unroll
    for (int r = 1; r < 16; ++r) pmax = fmaxf(pmax, p0[r]);
#pragma unroll
    for (int r = 0; r < 16; ++r) pmax = fmaxf(pmax, p1[r]);
    { auto rr = __builtin_amdgcn_permlane32_swap(__float_as_uint(pmax), __float_as_uint(pmax), false, false); pmax = fmaxf(__uint_as_float(rr[0]), __uint_as_float(rr[1])); }
    if (__builtin_expect(__all(pmax - m_reg <= THR), 1)) { mn = m_reg; alpha = 1.f; }
    else { mn = fmaxf(m_reg, pmax); alpha = __builtin_amdgcn_exp2f(m_reg - mn); m_reg = mn; }
#pragma unroll
    for (int r = 0; r < 16; ++r) p0[r] = p0[r] - mn;
#pragma unroll
    for (int r = 0; r < 16; ++r) p1[r] = p1[r] - mn;
#pragma unroll
    for (int r = 0; r < 16; ++r) p0[r] = __builtin_amdgcn_exp2f(p0[r]);
}
__device__ __forceinline__ void finishSM(f32x16& p0, f32x16& p1, float alpha, float& l_reg, bf16x8& pa0, bf16x8& pa1, bf16x8& pa2, bf16x8& pa3) {
#pragma unroll
    for (int r = 0; r < 16; ++r) p1[r] = __builtin_amdgcn_exp2f(p1[r]);
    float ps = 0;
#pragma unroll
    for (int r = 0; r < 16; ++r) ps += p0[r];
#pragma unroll
    for (int r = 0; r < 16; ++r) ps += p1[r];
    { auto rr = __builtin_amdgcn_permlane32_swap(__float_as_uint(ps), __float_as_uint(ps), false, false); ps = __uint_as_float(rr[0]) + __uint_as_float(rr[1]); }
    l_reg = l_reg * alpha + ps;
#define PK4(P, BASE, OUT) do { unsigned a0 = cvtpk(P[BASE + 0], P[BASE + 1]), a1 = cvtpk(P[BASE + 2], P[BASE + 3]);   \
    unsigned b0 = cvtpk(P[BASE + 4], P[BASE + 5]), b1 = cvtpk(P[BASE + 6], P[BASE + 7]);                              \
    auto r0 = __builtin_amdgcn_permlane32_swap(a0, b0, false, false); auto r1 = __builtin_amdgcn_permlane32_swap(a1, b1, false, false); \
    u32x4 w = {r0[0], r1[0], r0[1], r1[1]}; OUT = *reinterpret_cast<bf16x8*>(&w); } while (0)
    PK4(p0, 0, pa0); PK4(p0, 8, pa1); PK4(p1, 0, pa2); PK4(p1, 8, pa3);
#undef PK4
}
__device__ __forceinline__ void qkt(f32x16& p0, f32x16& p1, const LAS unsigned char* const (&kb)[4], const int boff, const bf16x8* qr) {
    p0 = f32x16{}; p1 = f32x16{};
#pragma unroll
    for (int m = 0; m < 3; ++m) {
#pragma unroll
        for (int r = 0; r < 4; ++r) { const int d0 = 4 * m + r;
            const bf16x8 b0 = *(const LAS bf16x8*)(kb[r] + boff + m * 128);
            const bf16x8 b1 = *(const LAS bf16x8*)(kb[r] + boff + m * 128 + 12288);
            p0 = __builtin_amdgcn_mfma_f32_32x32x16_bf16(b0, qr[d0], p0, 0, 0, 0);
            p1 = __builtin_amdgcn_mfma_f32_32x32x16_bf16(b1, qr[d0], p1, 0, 0, 0); }
        SBAR(); }
}
__device__ __forceinline__ int v_st(int k, int c) { const int kk = (k & ~0xC) | ((k & 4) << 1) | ((k & 8) >> 1); return ((kk >> 3) * 4 + (c >> 5)) * 512 + ((kk & 7) * 32 + (c & 31)) * 2; }
__device__ __forceinline__ int v_rd_base(int lane) { return ((lane & 3) << 3) | (((lane >> 2) & 3) << 6) | (((lane >> 4) & 1) << 5) | (((lane >> 5) & 1) << 8); }
constexpr int v_rd_off(int d0, int ks, int half) { return d0 * 512 + ks * 4096 + half * 2048; }
template <int OFF> __device__ __forceinline__ s16x4 tr_read(int vb) { s16x4 r; asm volatile("ds_read_b64_tr_b16 %0, %1 offset:%2" : "=&v"(r) : "v"(vb), "i"(OFF) : "memory"); return r; }
template <int D0> __device__ __forceinline__ void pv_one(f32x16& od, int vb, bf16x8 pa0, bf16x8 pa1, bf16x8 pa2, bf16x8 pa3) {
    const s16x4 l0 = tr_read<v_rd_off(D0, 0, 0)>(vb), h0 = tr_read<v_rd_off(D0, 0, 1)>(vb), l1 = tr_read<v_rd_off(D0, 1, 0)>(vb), h1 = tr_read<v_rd_off(D0, 1, 1)>(vb);
    const s16x4 l2 = tr_read<v_rd_off(D0, 2, 0)>(vb), h2 = tr_read<v_rd_off(D0, 2, 1)>(vb), l3 = tr_read<v_rd_off(D0, 3, 0)>(vb), h3 = tr_read<v_rd_off(D0, 3, 1)>(vb);
    asm volatile("s_waitcnt lgkmcnt(0)" ::: "memory"); SBAR();
#define PK(L, H) (bf16x8){L[0], L[1], L[2], L[3], H[0], H[1], H[2], H[3]}
    od = __builtin_amdgcn_mfma_f32_32x32x16_bf16(pa0, PK(l0, h0), od, 0, 0, 0);
    od = __builtin_amdgcn_mfma_f32_32x32x16_bf16(pa1, PK(l1, h1), od, 0, 0, 0);
    od = __builtin_amdgcn_mfma_f32_32x32x16_bf16(pa2, PK(l2, h2), od, 0, 0, 0);
    od = __builtin_amdgcn_mfma_f32_32x32x16_bf16(pa3, PK(l3, h3), od, 0, 0, 0);
#undef PK
}
__device__ __forceinline__ void pv_d0(f32x16* o, int vb, bf16x8 pa0, bf16x8 pa1, bf16x8 pa2, bf16x8 pa3) {
    pv_one<0>(o[0], vb, pa0, pa1, pa2, pa3); pv_one<1>(o[1], vb, pa0, pa1, pa2, pa3); pv_one<2>(o[2], vb, pa0, pa1, pa2, pa3); pv_one<3>(o[3], vb, pa0, pa1, pa2, pa3);
}
constexpr int NSLOT = 3, LDS_KR = NSLOT * SHM_V  , LDS_WS = NSLOT * (SHM_V + SHM_K);
__device__ __forceinline__ void attn_unit(const int tid, const bf16_t* __restrict__ Qb, const bf16_t* __restrict__ Kh, const bf16_t* __restrict__ Vh, bf16_t* __restrict__ Ob, LAS unsigned char* lds) {
    const int wid = __builtin_amdgcn_readfirstlane(tid >> 6), lane = tid & 63, r32 = lane & 31, hi = lane >> 5;
    LAS unsigned char* V_lds = lds; LAS unsigned char* K_lds = lds + LDS_KR;
    LAS float* ws = (LAS float*)(lds + LDS_WS) + wid * 64; LAS float* li_l = ws; LAS float* al_l = ws + 32;
    float m_reg = -1e30f, l_reg = 0; f32x16 o[4] = {}; bf16x8 qr[12];
    const bf16_t* Qw = Qb + (size_t)(wid * 32 + r32) * NQ + hi * 8;
#pragma unroll
    for (int d0 = 0; d0 < 12; ++d0) qr[d0] = *(const bf16x8*)(Qw + d0 * 16);
    unsigned kgo[3], vgo[2];
#pragma unroll
    for (int i = 0; i < 3; ++i) { const int q = (3 * wid + i) * 64 + lane, row = q / 24, chp = q % 24, ch = (chp & ~7) | ((chp ^ row) & 7); kgo[i] = (unsigned)(row * NQ + ch * 8) * 2u; }
#pragma unroll
    for (int i = 0; i < 2; ++i) { const int q = (2 * wid + i) * 64 + lane, st = q >> 5, wi = q & 31, kk = (st >> 2) * 8 + (wi >> 2), cc = (st & 3) * 32 + (wi & 3) * 8, k = (kk & ~0xC) | ((kk & 4) << 1) | ((kk & 8) >> 1); vgo[i] = (unsigned)(k * DM + cc) * 2u; }
    const int vb0 = (int)(uintptr_t)V_lds + v_rd_base(lane);
    const LAS unsigned char* kb[4];
#pragma unroll
    for (int r = 0; r < 4; ++r) kb[r] = K_lds + r32 * 384 + ((r * 32 + hi * 16) ^ ((r32 & 7) << 4));
#define DMA_K(t, slot) do { const char* kt_ = (const char*)Kh + (size_t)(t) * KVBLK * NQ * 2; _Pragma("unroll") for (int i_ = 0; i_ < 3; ++i_) \
    __builtin_amdgcn_global_load_lds((const unsigned*)(kt_ + kgo[i_]), (LAS unsigned*)(K_lds + (slot) * SHM_K + (3 * wid + i_) * 1024), 16, 0, 0); } while (0)
#define DMA_V(t, slot) do { const char* vt_ = (const char*)Vh + (size_t)(t) * KVBLK * DM * 2; _Pragma("unroll") for (int i_ = 0; i_ < 2; ++i_) \
    __builtin_amdgcn_global_load_lds((const unsigned*)(vt_ + vgo[i_]), (LAS unsigned*)(V_lds + (slot) * SHM_V + (2 * wid + i_) * 1024), 16, 0, 0); } while (0)
    const LAS float* al_hi = al_l + 4 * hi;
#define RESC(a) do { if (__any((a) < 1.f)) { if (hi == 0) al_l[r32] = (a); asm volatile("s_waitcnt lgkmcnt(0)" ::: "memory"); \
    _Pragma("unroll") for (int d_ = 0; d_ < 4; ++d_) _Pragma("unroll") for (int r_ = 0; r_ < 16; ++r_) o[d_][r_] *= al_hi[crow(r_, 0)]; } } while (0)
#define WAITBAR() do { asm volatile("s_waitcnt vmcnt(0)" ::: "memory"); __syncthreads(); } while (0)
    f32x16 pA0, pA1, pB0, pB1; float mnA, mnB, alA, alB; bf16x8 pa0, pa1, pa2, pa3; constexpr int NT = PB / KVBLK;
    int s0 = 0, s1 = 1, s2 = 2;
    DMA_K(0, 0); DMA_V(0, 0); DMA_K(1, 1); WAITBAR();
    DMA_K(2, 2); DMA_V(1, 1);
    qkt(pA0, pA1, kb, 0, qr); partialSM(pA0, pA1, m_reg, mnA, alA); RESC(alA);
    WAITBAR();
#define STEP(PC0, PC1, mnC, alC, PP0, PP1, alP, t) do { \
        { const int tmp_ = s0; s0 = s1; s1 = s2; s2 = tmp_; }              \
        SBAR(); \
        if ((t) + 2 < NT) DMA_K((t) + 2, s2);                               \
        qkt(PC0, PC1, kb, s0 * SHM_K, qr); \
        finishSM(PP0, PP1, alP, l_reg, pa0, pa1, pa2, pa3); SBAR(); \
        pv_d0(o, vb0 + s2 * SHM_V, pa0, pa1, pa2, pa3);                     \
        partialSM(PC0, PC1, m_reg, mnC, alC); \
        RESC(alC); \
        WAITBAR(); \
        if ((t) + 1 < NT) DMA_V((t) + 1, s1);                               \
    } while (0)
    for (int t = 1; t + 1 < NT; t += 2) {
        STEP(pB0, pB1, mnB, alB, pA0, pA1, alA, t);
        STEP(pA0, pA1, mnA, alA, pB0, pB1, alB, t + 1);
    }
    STEP(pB0, pB1, mnB, alB, pA0, pA1, alA, NT - 1);
    { const int tmp_ = s0; s0 = s1; s1 = s2; s2 = tmp_; }
    finishSM(pB0, pB1, alB, l_reg, pa0, pa1, pa2, pa3); SBAR();
    pv_d0(o, vb0 + s2 * SHM_V, pa0, pa1, pa2, pa3);
    if (hi == 0) li_l[r32] = l_reg; asm volatile("s_waitcnt lgkmcnt(0)" ::: "memory");
    __syncthreads();
    int lane2 = threadIdx.x & 63; asm volatile("" : "+v"(lane2));
    const int hi2 = lane2 >> 5, r322 = lane2 & 31;
    LAS bf16_t* stg = (LAS bf16_t*)(lds + wid * 8192);
    LAS bf16_t* stg_l = stg + 4 * hi2 * 128 + r322; const LAS float* li_hi = li_l + 4 * hi2;
#pragma unroll
    for (int r = 0; r < 16; ++r) { const float rl = __builtin_amdgcn_rcpf(li_hi[crow(r, 0)]);
#pragma unroll
        for (int d0 = 0; d0 < 4; ++d0) stg_l[crow(r, 0) * 128 + d0 * 32] = (bf16_t)f2bf(o[d0][r] * rl); }
    asm volatile("s_waitcnt lgkmcnt(0)" ::: "memory");
    bf16_t* Ow = Ob + (size_t)(wid * 32 + (lane2 >> 4)) * DM + (lane2 & 15) * 8; const LAS bf16_t* stg_r = stg + (lane2 >> 4) * 128 + (lane2 & 15) * 8;
#pragma unroll
    for (int i = 0; i < 8; ++i) { const u32x4 v = *(const LAS u32x4*)(stg_r + i * 4 * 128); *(u32x4*)(Ow + (size_t)(i * 4) * DM) = v; }
    __syncthreads();
#undef DMA_K
#undef DMA_V
#undef RESC
#undef WAITBAR
#undef STEP
}
}
__device__ __forceinline__ void p11_attention(Frame& F) {
    const bf16_t* Q = (const bf16_t*)(F.ws + WS_Q); const bf16_t* K = (const bf16_t*)(F.ws + WS_KB); const bf16_t* V = (const bf16_t*)(F.ws + WS_VB); bf16_t* O = (bf16_t*)(F.ws + WS_MIX);
    for (int i = 0; i < 4; ++i) {
        const int bh = (F.vcu >> 3) + 32 * i, qb = F.vcu & 7, b = bh >> 3, h = bh & 7;
        const size_t qrow = (size_t)b * PB + CTXL + qb * 256, krow = (size_t)b * PB;
        att::attn_unit(F.tid, Q + qrow * NQ + h * 192, K + krow * NQ + h * 192, V + krow * DM + h * 128, O + qrow * DM + h * 128, F.lds);
    }
}

__device__ __forceinline__ void ka_launder(Frame& F) { asm volatile("" : "+s"(F.ka)); int t = threadIdx.x; asm volatile("" : "+v"(t)); F.tid = t; F.lane = t & 63; F.wave = __builtin_amdgcn_readfirstlane(t >> 6); }
#ifndef DBG_MODE
#define DBG_MODE 0
#endif
constexpr int NPH = 21;
__device__ __forceinline__ void moe_gemms(Frame& F, int layer, int which) {
    const int nblk = __builtin_amdgcn_readfirstlane(*(const int*)(F.ws + WS_ROUTE + RT_NBLK));
    MoeSched S; S.init((const int*)(F.ws + WS_ROUTE + RT_BLKE), nblk, F.G, (int)blockIdx.x);
    const int* perm = (const int*)(F.ws + WS_ROUTE + RT_PERM);
    if (which == 0) {
        pg8::Gemm g{(const bf16_t*)(F.ws + WS_HX), (const bf16_t*)(F.ws + WS_WGU) + (size_t)layer * 32 * 1024 * DM, DM, DM, DM, perm};
        EpiSwiglu E{(bf16_t*)(F.ws + WS_ACT)};
        pg8::gemm_phase<EpiSwiglu, MoeSched, true>(F.lds, g, S, E);
    } else {
        pg8::Gemm g{(const bf16_t*)(F.ws + WS_ACT), (const bf16_t*)(F.ws + WS_WDN) + (size_t)layer * 32 * DM * MFF, MFF, MFF, MFF, nullptr};
        EpiScatter E{(bf16_t*)(F.ws + WS_YS), perm};
        pg8::gemm_phase<EpiScatter, MoeSched, false>(F.lds, g, S, E);
    }
}
__global__ void __launch_bounds__(512, 2) mega_fwd(Args args) {
    extern __shared__ __attribute__((aligned(16))) unsigned char lds_raw[];
    Frame F;
    F.lds = (LAS unsigned char*)lds_raw;
    F.tid = threadIdx.x; F.lane = F.tid & 63; F.wave = __builtin_amdgcn_readfirstlane(F.tid >> 6);
    F.G = gridDim.x; { const int bx = blockIdx.x; F.vcu = (F.G % 8 == 0) ? (bx % 8) * (F.G / 8) + bx / 8 : bx; }
    F.ws = args.ws; F.out = args.out;
    F.ka = (const __attribute__((address_space(4))) Args*)__builtin_amdgcn_kernarg_segment_ptr();
    for (int u = F.tid; u < (LDS_BYTES - LDSCTL_OFF) / 4; u += 512) ((LAS unsigned*)(F.lds + LDSCTL_OFF))[u] = 0u;
    __syncthreads();
    volatile LAS unsigned* MISC = (volatile LAS unsigned*)(F.lds + MISC_OFF);
    unsigned* ctl = (unsigned*)(F.ws + WS_CTL);
    XcdBarrier bar; bar.bar = ctl + CW_BAR; bar.x = 0; bar.st = nullptr;
    if (!args.nobar) bar = xcd_barrier_post(ctl + CW_BAR, MISC + 8);
    const int lo = args.ph_lo, hi = args.ph_hi;
#define IN(k) (lo <= (k) && (k) < hi)
#define SEAM(k) do { if (IN(k) && IN((k) + 1)) xcd_barrier(bar); } while (0)
    constexpr int LAST = DBG_MODE == 0 ? 20 : DBG_MODE == 1 ? -1 : DBG_MODE == 2 ? 6 : DBG_MODE == 3 ? 11 : DBG_MODE == 4 ? 15 : DBG_MODE == 10 ? 2 : DBG_MODE == 11 ? 3 : 5;
#ifndef PHMASK
#define PHMASK 0x1fffff
#endif
#define RUN(k) (ka_launder(F), IN(k) && (k) <= LAST && ((PHMASK >> (k)) & 1))

    if (RUN(0)) for (int rep_ = 0; rep_ < 1 + ((REPMASK >> 0) & 1); ++rep_) p0_prologue(F);
    SEAM(0);
    if (RUN(1)) for (int rep_ = 0; rep_ < 1 + ((REPMASK >> 1) & 1); ++rep_) p0b_mod(F);
    SEAM(1);
    if (RUN(2)) for (int rep_ = 0; rep_ < 1 + ((REPMASK >> 2) & 1); ++rep_) p1_norm_input(F);
    SEAM(2);
    if (RUN(3)) for (int rep_ = 0; rep_ < 1 + ((REPMASK >> 3) & 1); ++rep_) { pg8::Gemm g{(const bf16_t*)(F.ws + WS_HX), (const bf16_t*)(F.ws + WS_WIN0), DM, DM, DM, nullptr}; TileSched<false> S; S.init(EVIN / 256, F.G, (int)blockIdx.x);
        EpiStoreBf16 E{(bf16_t*)(F.ws + WS_PX0), EVIN}; pg8::gemm_phase<EpiStoreBf16, TileSched<false>, false>(F.lds, g, S, E); }
    SEAM(3);
    if (RUN(4)) for (int rep_ = 0; rep_ < 1 + ((REPMASK >> 4) & 1); ++rep_) p3_mixers(F);
    SEAM(4);
    if (RUN(5)) for (int rep_ = 0; rep_ < 1 + ((REPMASK >> 5) & 1); ++rep_) p3b_hgrn_out(F);
    SEAM(5);
    if (RUN(6)) for (int rep_ = 0; rep_ < 1 + ((REPMASK >> 6) & 1); ++rep_) { pg8::Gemm g{(const bf16_t*)(F.ws + WS_MIX), (const bf16_t*)(F.ws + WS_WOUT0), DM, DM, DM, nullptr}; TileSched<false> S; S.init(DM / 256, F.G, (int)blockIdx.x);
        EpiResidual E{&F, (float*)(F.ws + WS_XS), 0, true}; pg8::gemm_phase<EpiResidual, TileSched<false>, false>(F.lds, g, S, E);
        { const int n3 = (NTILE * 4) % F.G;
          if (rep_ == 0 && (int)blockIdx.x >= n3) { ka_launder(F); moe_l1_convert(F, MOE_L1_SPLIT, MOE_W_ITEMS, ((int)blockIdx.x - n3) * 8 + F.wave, (F.G - n3) * 8); } } }
    SEAM(6);
    if (RUN(7)) for (int rep_ = 0; rep_ < 1 + ((REPMASK >> 7) & 1); ++rep_) p5_norm_route<false>(F, 0);
    SEAM(7);
    if (RUN(8)) for (int rep_ = 0; rep_ < 1 + ((REPMASK >> 8) & 1); ++rep_) p5b_perm<false>(F);
    SEAM(8);
    if (RUN(9)) for (int rep_ = 0; rep_ < 1 + ((REPMASK >> 9) & 1); ++rep_) moe_gemms(F, 0, 0);
    SEAM(9);
    if (RUN(10)) for (int rep_ = 0; rep_ < 1 + ((REPMASK >> 10) & 1); ++rep_) moe_gemms(F, 0, 1);
    SEAM(10);
    if (RUN(11)) for (int rep_ = 0; rep_ < 1 + ((REPMASK >> 11) & 1); ++rep_) p8_combine_norm(F);
    SEAM(11);
    if (RUN(12)) for (int rep_ = 0; rep_ < 1 + ((REPMASK >> 12) & 1); ++rep_) { pg8::Gemm g{(const bf16_t*)(F.ws + WS_HX), (const bf16_t*)(F.ws + WS_WIN1), DM, DM, DM, nullptr}; TileSched<false> S; S.init(CINP / 256, F.G, (int)blockIdx.x);
        EpiStoreStats E{(bf16_t*)(F.ws + WS_PX1), CINP, (float*)(F.ws + WS_STATS)}; pg8::gemm_phase<EpiStoreStats, TileSched<false>, false>(F.lds, g, S, E); }
    SEAM(12);
    if (RUN(13)) for (int rep_ = 0; rep_ < 1 + ((REPMASK >> 13) & 1); ++rep_) {
        { pg8::Gemm g{(const bf16_t*)(F.ws + WS_PX1), (const bf16_t*)(F.ws + WS_WUQ), CINP, QRANK, QRANK, nullptr}; TileSched<true> S; S.init(NQ / 256, F.G, (int)blockIdx.x);
          EpiQ E{(bf16_t*)(F.ws + WS_Q), (const float*)(F.ws + WS_STATS)}; pg8::gemm_phase<EpiQ, TileSched<true>, false>(F.lds, g, S, E); }
        { pg8::Gemm g{(const bf16_t*)(F.ws + WS_PX1) + QRANK, (const bf16_t*)(F.ws + WS_WUKV), CINP, KVRANK, KVRANK, nullptr}; TileSched<false> S; S.init(NKV / 256, F.G, (int)blockIdx.x);
          EpiKV E{(bf16_t*)(F.ws + WS_KB), (bf16_t*)(F.ws + WS_VB), (const float*)(F.ws + WS_STATS)}; pg8::gemm_phase<EpiKV, TileSched<false>, false>(F.lds, g, S, E); }
        ka_launder(F);
        p10_kr(F);
    }
    SEAM(13);
    if (RUN(14)) for (int rep_ = 0; rep_ < 1 + ((REPMASK >> 14) & 1); ++rep_) p11_attention(F);
    SEAM(14);
    if (RUN(15)) for (int rep_ = 0; rep_ < 1 + ((REPMASK >> 15) & 1); ++rep_) { pg8::Gemm g{(const bf16_t*)(F.ws + WS_MIX), (const bf16_t*)(F.ws + WS_WOUT1), DM, DM, DM, nullptr}; TileSched<true> S; S.init(DM / 256, F.G, (int)blockIdx.x);
        EpiResidual E{&F, (float*)(F.ws + WS_XS), 1, false}; pg8::gemm_phase<EpiResidual, TileSched<true>, false>(F.lds, g, S, E); }
    SEAM(15);
    if (RUN(16)) for (int rep_ = 0; rep_ < 1 + ((REPMASK >> 16) & 1); ++rep_) p5_norm_route<true>(F, 1);
    SEAM(16);
    if (RUN(17)) for (int rep_ = 0; rep_ < 1 + ((REPMASK >> 17) & 1); ++rep_) p5b_perm<true>(F);
    SEAM(17);
    if (RUN(18)) for (int rep_ = 0; rep_ < 1 + ((REPMASK >> 18) & 1); ++rep_) moe_gemms(F, 1, 0);
    SEAM(18);
    if (RUN(19)) for (int rep_ = 0; rep_ < 1 + ((REPMASK >> 19) & 1); ++rep_) moe_gemms(F, 1, 1);
    SEAM(19);
    ka_launder(F);
    if (IN(20) && ((PHMASK >> 20) & 1)) p16_final(F);
#undef IN
#undef SEAM
#undef RUN
}

#ifndef MK_N_LAUNCHES
#define MK_N_LAUNCHES 1
#endif
extern "C" void kernel_launch(void* const* d_in, const int* in_sizes, int n_in, void* d_out, int out_size, void* d_ws, size_t ws_size, hipStream_t stream) {
    static int grid = 0;
    if (grid == 0) {
        if (n_in != 28 || out_size != NB * SEQ * DM || ws_size < WS_END) { fprintf(stderr, "kernel_launch: unexpected shapes (n_in %d out %d ws %zu)\n", n_in, out_size, ws_size); grid = -1; return; }
        int dev = 0, cus = 0, per_cu = 0;
        if (hipGetDevice(&dev) != hipSuccess || hipDeviceGetAttribute(&cus, hipDeviceAttributeMultiprocessorCount, dev) != hipSuccess) { grid = -1; return; }
        if (hipFuncSetAttribute((const void*)mega_fwd, hipFuncAttributeMaxDynamicSharedMemorySize, LDS_BYTES) != hipSuccess) { fprintf(stderr, "kernel_launch: hipFuncSetAttribute failed\n"); grid = -1; return; }
        if (hipOccupancyMaxActiveBlocksPerMultiprocessor(&per_cu, (const void*)mega_fwd, 512, LDS_BYTES) != hipSuccess || per_cu < 1) { fprintf(stderr, "kernel_launch: occupancy query says %d blocks/CU\n", per_cu); per_cu = 1; }
        (void)hipGetLastError();
        grid = cus;
    }
    if (grid < 0) return;
    (void)hipMemsetAsync((char*)d_ws + WS_CTL, 0, CTL_ZERO_BYTES, stream);
    Args a{};
    for (int i = 0; i < 28; ++i) a.in[i] = (const float*)d_in[i];
    a.out = (float*)d_out; a.ws = (unsigned char*)d_ws;
    if (MK_N_LAUNCHES == 1) {
        a.ph_lo = 0; a.ph_hi = NPH; a.nobar = 0;
        void* kargs[] = {&a};
        hipError_t e = hipLaunchCooperativeKernel((const void*)mega_fwd, dim3(grid), dim3(512), kargs, LDS_BYTES, stream);
        if (e != hipSuccess) { (void)hipGetLastError(); fprintf(stderr, "kernel_launch: cooperative launch failed (%s), plain launch instead\n", hipGetErrorString(e)); hipLaunchKernelGGL(mega_fwd, dim3(grid), dim3(512), LDS_BYTES, stream, a); }
    } else {
        for (int p = 0; p < NPH; ++p) { a.ph_lo = p; a.ph_hi = p + 1; a.nobar = 1; hipLaunchKernelGGL(mega_fwd, dim3(grid), dim3(512), LDS_BYTES, stream, a); }
    }
}
```

```cpp
#include <hip/hip_runtime.h>
#include <cstdio>
#include <cstdint>
#define MK_N_LAUNCHES 1
#define DBG_MODE 0
#define STAMP_PHASE -1
#define EPI_TWICE 0
#define REPMASK 0x0

#define LAS __attribute__((address_space(3)))
#define GAS __attribute__((address_space(1)))
typedef unsigned short bf16_t;
typedef short bf16x8 __attribute__((ext_vector_type(8)));
typedef short s16x4 __attribute__((ext_vector_type(4)));
typedef float f32x2 __attribute__((ext_vector_type(2)));
typedef float f32x4 __attribute__((ext_vector_type(4)));
typedef float f32x16 __attribute__((ext_vector_type(16)));
typedef unsigned u32x2 __attribute__((ext_vector_type(2)));
typedef unsigned u32x4 __attribute__((ext_vector_type(4)));
typedef int i32x4_t __attribute__((ext_vector_type(4)));
typedef int i32x8_t __attribute__((ext_vector_type(8)));

constexpr int DM = 1024, NB = 16, SEQ = 2048, CTXL = 256, PB = SEQ + CTXL  , R = NB * PB  ;
constexpr int NTILE = R / 256  , NXTILE = NB * SEQ / 256  ;
constexpr int EVIN = 3584;
constexpr int CIN = 704, CINP = 768, QRANK = 384, KVRANK = 256, NQ = 1536, NKV = 2048;
constexpr int NEXP = 32, MFF = 512;
constexpr int ECAP = 4096, MAXSLOT = NEXP * ECAP;
constexpr float RMS_EPS = 1e-6f;
constexpr float ATT_C2 = 0.07216878364870322f * 1.4426950408889634f;

constexpr size_t MiB = 1u << 20;
constexpr size_t WS_CTL = 0, CTL_ZERO_BYTES = 1 * MiB;
constexpr size_t WS_MOD = 1 * MiB;
constexpr size_t WS_PART = 2 * MiB;
constexpr size_t WS_STATS = 9 * MiB;
constexpr size_t WS_ROUTE = 13 * MiB;
constexpr size_t WS_WIN0 = 16 * MiB, WS_WOUT0 = 23 * MiB, WS_WIN1 = 25 * MiB, WS_WUQ = 27 * MiB, WS_WUKV = 29 * MiB, WS_WOUT1 = 30 * MiB;
constexpr size_t WS_WGU = 32 * MiB;
constexpr size_t WS_WDN = 160 * MiB;
constexpr size_t WS_XS = 224 * MiB;
constexpr size_t WS_HX = 368 * MiB;
constexpr size_t WS_MIX = 440 * MiB;
constexpr size_t WS_RA = 512 * MiB;
constexpr size_t WS_PX0 = WS_RA, WS_Q = WS_RA, WS_KB = WS_RA + 108 * MiB, WS_ACT = WS_RA;
constexpr size_t WS_RB = 764 * MiB;
constexpr size_t WS_YS = WS_RB, WS_PX1 = WS_RB, WS_VB = WS_RB + 54 * MiB, WS_OG = WS_RB;
constexpr size_t WS_END = 908 * MiB;
constexpr size_t RT_AE = 0, RT_AP = 512 * 1024, RT_AW = 1024 * 1024, RT_PERM = 1536 * 1024, RT_CNTB = 2048 * 1024, RT_BLKE = 2048 * 1024 + 64 * 1024, RT_NBLK = RT_BLKE + 4096;
constexpr int CW_BAR = 4096, CW_GC = 8192;

constexpr int RING_BYTES = 131072;
constexpr int LDSCTL_OFF = 147456, MISC_OFF = LDSCTL_OFF + 320;
constexpr int LDS_BYTES = 149504;

#define LDS_WAIT() asm volatile("s_waitcnt lgkmcnt(0)" ::: "memory")
#define VM_WAIT() asm volatile("s_waitcnt vmcnt(0)" ::: "memory")
#define SBAR() __builtin_amdgcn_sched_barrier(0)
__device__ __forceinline__ unsigned f2bf(float f) { unsigned u = __builtin_bit_cast(unsigned, f); return (u + 0x7fffu + ((u >> 16) & 1u)) >> 16; }
__device__ __forceinline__ unsigned pk2(float lo, float hi) { return f2bf(lo) | (f2bf(hi) << 16); }
typedef __bf16 bf16x2_t __attribute__((ext_vector_type(2)));
__device__ __forceinline__ unsigned cvtpk(float lo, float hi) { f32x2 v = {lo, hi}; bf16x2_t b = __builtin_convertvector(v, bf16x2_t); return __builtin_bit_cast(unsigned, b); }
__device__ __forceinline__ unsigned pk4_fp8(float a, float b, float c, float d) {
    a = __builtin_amdgcn_fmed3f(a, -448.f, 448.f); b = __builtin_amdgcn_fmed3f(b, -448.f, 448.f); c = __builtin_amdgcn_fmed3f(c, -448.f, 448.f); d = __builtin_amdgcn_fmed3f(d, -448.f, 448.f);
    int p = __builtin_amdgcn_cvt_pk_fp8_f32(a, b, 0, false); p = __builtin_amdgcn_cvt_pk_fp8_f32(c, d, p, true); return (unsigned)p;
}
__device__ __forceinline__ unsigned pk4_fp8_nc(float a, float b, float c, float d) { int p = __builtin_amdgcn_cvt_pk_fp8_f32(a, b, 0, false); p = __builtin_amdgcn_cvt_pk_fp8_f32(c, d, p, true); return (unsigned)p; }
constexpr float S8_Q = 128.f, S8_K = 16.f, S8_V = 16.f;
constexpr float S8_W1 = 512.f, S8_O = 16.f, S8_M = 2.f;
constexpr float S8_X = 16.f, S8_WGU = 512.f, S8_H = 16.f, S8_WDN = 256.f, S8_Y = 16.f;
__device__ __forceinline__ float bf2f(unsigned short h) { return __builtin_bit_cast(float, (unsigned)h << 16); }
__device__ __forceinline__ float bflo(unsigned w) { return __builtin_bit_cast(float, w << 16); }
__device__ __forceinline__ float bfhi(unsigned w) { return __builtin_bit_cast(float, w & 0xffff0000u); }
__device__ __forceinline__ float dpp_add(float v, const int ctrl) { return v; }
#define DPP_ADD(v, ctrl) ((v) + __builtin_bit_cast(float, __builtin_amdgcn_update_dpp(0, __builtin_bit_cast(int, (v)), (ctrl), 0xf, 0xf, true)))
__device__ __forceinline__ float fold32(float a, float b) { const auto r = __builtin_amdgcn_permlane32_swap(__builtin_bit_cast(unsigned, a), __builtin_bit_cast(unsigned, b), false, false);
    return __builtin_bit_cast(float, (unsigned)r[0]) + __builtin_bit_cast(float, (unsigned)r[1]); }
__device__ __forceinline__ float fold16(float a, float b) { const auto r = __builtin_amdgcn_permlane16_swap(__builtin_bit_cast(unsigned, a), __builtin_bit_cast(unsigned, b), false, false);
    return __builtin_bit_cast(float, (unsigned)r[0]) + __builtin_bit_cast(float, (unsigned)r[1]); }
__device__ __forceinline__ float rdlane(float v, int l) { return __builtin_bit_cast(float, __builtin_amdgcn_readlane(__builtin_bit_cast(int, v), l)); }
__device__ __forceinline__ void wave_sum4(const f32x4 x, float& s0, float& s1, float& s2, float& s3) {
    float t = fold16(fold32(x[0], x[1]), fold32(x[2], x[3]));
    t = DPP_ADD(t, 0xB1); t = DPP_ADD(t, 0x4E); t = DPP_ADD(t, 0x141); t = DPP_ADD(t, 0x140);
    s0 = rdlane(t, 0); s2 = rdlane(t, 16); s1 = rdlane(t, 32); s3 = rdlane(t, 48);
}
__device__ __forceinline__ void wave_sum8(const f32x4 x, const f32x4 y, int lane, float (&s)[8]) {
    const float q0 = fold16(fold32(x[0], x[1]), fold32(x[2], x[3])), q1 = fold16(fold32(y[0], y[1]), fold32(y[2], y[3]));
    const bool up = (lane & 8) != 0; const float keep = up ? q1 : q0, give = up ? q0 : q1;
    float t = keep + __builtin_bit_cast(float, __builtin_amdgcn_update_dpp(0, __builtin_bit_cast(int, give), 0x128  , 0xf, 0xf, true));
    t = DPP_ADD(t, 0xB1); t = DPP_ADD(t, 0x4E); t = DPP_ADD(t, 0x141);
    s[0] = rdlane(t, 0); s[4] = rdlane(t, 8); s[2] = rdlane(t, 16); s[6] = rdlane(t, 24); s[1] = rdlane(t, 32); s[5] = rdlane(t, 40); s[3] = rdlane(t, 48); s[7] = rdlane(t, 56);
}
__device__ __forceinline__ float wave_sum(float v) {
    v = DPP_ADD(v, 0xB1);
    v = DPP_ADD(v, 0x4E);
    v = DPP_ADD(v, 0x141);
    v = DPP_ADD(v, 0x140);
    const int iv = __builtin_bit_cast(int, v);
    return (__builtin_bit_cast(float, __builtin_amdgcn_readlane(iv, 0)) + __builtin_bit_cast(float, __builtin_amdgcn_readlane(iv, 16))) +
           (__builtin_bit_cast(float, __builtin_amdgcn_readlane(iv, 32)) + __builtin_bit_cast(float, __builtin_amdgcn_readlane(iv, 48)));
}
constexpr float LOG2E = 1.4426950408889634f, LN2 = 0.6931471805599453f;
__device__ __forceinline__ float ex2(float x) { return __builtin_amdgcn_exp2f(x); }
__device__ __forceinline__ float lg2(float x) { return __builtin_amdgcn_logf(x); }
__device__ __forceinline__ float sigmoidf_(float x) { return __builtin_amdgcn_rcpf(1.0f + ex2(-LOG2E * x)); }
__device__ __forceinline__ float siluf_(float x) { return x * __builtin_amdgcn_rcpf(1.0f + ex2(-LOG2E * x)); }
__device__ __forceinline__ float geluf_(float x) { const float z = (-1.5957691216057308f * LOG2E) * (x + 0.044715f * x * x * x); return x * __builtin_amdgcn_rcpf(1.0f + ex2(z)); }

#define XB_TMO      128
#define XB_XCNT(j)  (256  + 64 * (j))
#define XB_XSUB(j)  (1280 + 64 * (j))
#define XB_XGEN(j)  (2304 + 64 * (j))
#define XB_TOP      3328
#define XB_TOPGEN   3392
#define XCD_BAR_WORDS 3456
#define XB_SPIN_CAP (1u << 22)
__device__ __forceinline__ unsigned xb_ld(unsigned* p)              { return __hip_atomic_load(p, __ATOMIC_RELAXED, __HIP_MEMORY_SCOPE_AGENT); }
__device__ __forceinline__ unsigned xb_add(unsigned* p, unsigned v) { return __hip_atomic_fetch_add(p, v, __ATOMIC_RELAXED, __HIP_MEMORY_SCOPE_AGENT); }
__device__ __forceinline__ unsigned xb_xcc_id() { return (unsigned)__builtin_amdgcn_s_getreg((3 << 11) | 20) & 0xFu; }
#define XB_SPIN(cond, bar) do { unsigned _sp = 0; while (cond) { __builtin_amdgcn_s_sleep(1); \
    if ((++_sp & 255u) == 0u) { if (xb_ld(&(bar)[XB_TMO])) break; if (_sp > XB_SPIN_CAP) { atomicAdd(&(bar)[XB_TMO], 1u); break; } } } } while (0)
struct XcdBarrier { unsigned* bar; unsigned x; volatile LAS unsigned* st; };
__device__ __forceinline__ XcdBarrier xcd_barrier_post(unsigned* bar, volatile LAS unsigned* st) {
    XcdBarrier b; b.bar = bar; b.x = xb_xcc_id(); b.st = st;
    if (threadIdx.x == 0) (void)xb_add(&bar[XB_XCNT(b.x)], 1u);
    return b;
}
__device__ __forceinline__ void xcd_barrier_complete(unsigned* bar, unsigned x, unsigned& nloc, unsigned& nx) {
    const unsigned G = gridDim.x * gridDim.y * gridDim.z;
    unsigned sum, cnt, mine, sp = 0u;
    for (;;) {
        sum = 0u; cnt = 0u; mine = 0u;
#pragma unroll
        for (unsigned j = 0; j < 16; ++j) { const unsigned c = xb_ld(&bar[XB_XCNT(j)]); sum += c; cnt += (c > 0u) ? 1u : 0u; mine = (j == x) ? c : mine; }
        if (sum == G) break;
        __builtin_amdgcn_s_sleep(1);
        if ((++sp & 255u) == 0u) { if (xb_ld(&bar[XB_TMO])) break; if (sp > XB_SPIN_CAP) { atomicAdd(&bar[XB_TMO], 1u); break; } }
    }
    nloc = mine > 0u ? mine : 1u; nx = cnt > 0u ? cnt : 1u;
}
__device__ __forceinline__ void xcd_barrier(const XcdBarrier& b) {
    asm volatile("s_waitcnt vmcnt(0)" ::: "memory");
    __syncthreads();
    if (threadIdx.x == 0) {
        unsigned* bar = b.bar;
        __builtin_amdgcn_s_waitcnt(0);
        unsigned nloc = b.st[0], nx = b.st[1];
        if (nloc == 0u) { xcd_barrier_complete(bar, b.x, nloc, nx); b.st[0] = nloc; b.st[1] = nx; }
        const unsigned old = xb_add(&bar[XB_XSUB(b.x)], 1u);
        const unsigned gen = old / nloc;
        if (old + 1u == (gen + 1u) * nloc) {
            __builtin_amdgcn_fence(__ATOMIC_RELEASE, "agent");
            asm volatile("s_waitcnt vmcnt(0)" ::: "memory");
            const unsigned og = xb_add(&bar[XB_TOP], 1u);
            const unsigned tg = og / nx;
            if (og + 1u == (tg + 1u) * nx) xb_add(&bar[XB_TOPGEN], 1u);
            else XB_SPIN(xb_ld(&bar[XB_TOPGEN]) == tg, bar);
            __builtin_amdgcn_fence(__ATOMIC_ACQUIRE, "agent");
            xb_add(&bar[XB_XGEN(b.x)], 1u);
            asm volatile("s_waitcnt vmcnt(0)" ::: "memory");
        } else {
            XB_SPIN(xb_ld(&bar[XB_XGEN(b.x)]) == gen, bar);
            __builtin_amdgcn_fence(__ATOMIC_ACQUIRE, "agent");
            asm volatile("s_waitcnt vmcnt(0)" ::: "memory");
        }
    }
    __syncthreads();
}

namespace pg8 {
constexpr int BM = 256, BK = 64, HALF = 128, HTB = HALF * BK * 2, STAGE_BYTES = 8 * HTB, NXCD = 8, WGM = 8;
__host__ __device__ __forceinline__ int lds_byte(int r, int c) { const int st = (r >> 4) * 2 + (c >> 5), rr = r & 15, cc = c & 31, ob = rr * 64 + cc * 2; return st * 1024 + (ob ^ (((ob >> 9) & 1) << 5)); }
__host__ __device__ __forceinline__ void stage_rc(int b, int& Rr, int& C) { const int st = b / 1024, sb = b % 1024, swz = sb ^ (((sb >> 9) & 1) << 5); Rr = (st >> 1) * 16 + swz / 64; C = (st & 1) * 32 + (swz % 64) / 2; }
__host__ __device__ __forceinline__ int keyperm64(int b) { const int hi = b >> 5, j = b & 31, half = j >> 4, jj = j & 15; return 32 * half + (jj & 3) + 8 * (jj >> 2) + 4 * hi; }
__host__ __device__ __forceinline__ int perm32(int rho) { const int n = rho >> 4, i = rho & 15; return 8 * (i >> 2) + 4 * n + (i & 3); }

struct Unit { int arow0, brow0, pm, pn, ex; };
struct Gemm { const bf16_t* A; const bf16_t* Bt; int lda, ldb, K; const int* rowidx; };

template <class Epi, class Sched, bool GATHER, bool FP8 = false>
__device__ __forceinline__ void gemm_phase(LAS unsigned char* lds, const Gemm g, const Sched& S, const Epi& E) {
    int tidl = threadIdx.x; asm volatile("" : "+v"(tidl));
    const int tid = tidl, wid = __builtin_amdgcn_readfirstlane(tid >> 6), lane = tid & 63, wr = wid >> 2, wc = wid & 3, fr = lane & 15, fq = lane >> 4;
    const int K = g.K, nt = K / BK;
    int sR[2], sC[2]; unsigned voffB[2], voffA[2];
#pragma unroll
    for (int i = 0; i < 2; ++i) { stage_rc(tid * 16 + i * 8192, sR[i], sC[i]); int Rb = Epi::PERM ? ((sR[i] & ~31) + perm32(sR[i] & 31)) : sR[i];
        if constexpr (Epi::KEYPERM) Rb = (Rb & ~63) + keyperm64(Rb & 63);
        voffB[i] = (unsigned)(Rb * g.ldb + sC[i]) * 2u; voffA[i] = (unsigned)(sR[i] * g.lda + sC[i]) * 2u; }
    const unsigned kstep = BK * 2;
    const unsigned hstepB = (unsigned)(HALF * g.ldb * 2), hstepA = (unsigned)(HALF * g.lda * 2);
    const unsigned ldsw = (unsigned)wid * 1024u;
    const int aoff = lds_byte(wr * 64 + fr, fq * 8), boff = lds_byte(wc * 32 + fr, fq * 8);
#define PG8_SA(b, h) (((b) * 2 + (h)) * HTB)
#define PG8_SB(b, h) ((4 + (b) * 2 + (h)) * HTB)
    const __amdgpu_buffer_rsrc_t rsA = __builtin_amdgcn_make_buffer_rsrc((void*)g.A, 0, 0x7fffffff, 0x00020000), rsB = __builtin_amdgcn_make_buffer_rsrc((void*)g.Bt, 0, 0x7fffffff, 0x00020000);
#define PG8_GLDS(rs, voff, soff, bufoff, i) __builtin_amdgcn_raw_ptr_buffer_load_lds((rs), (LAS unsigned*)(lds + (bufoff) + ldsw + (i) * 8192), 16, (int)(voff), (int)(soff), 0, 0)
#define PG8_STAGEB(bufoff, sbase) do { _Pragma("unroll") for (int _i = 0; _i < 2; ++_i) PG8_GLDS(rsB, voffB[_i], (sbase), bufoff, _i); } while (0)
#define PG8_STAGEA(bufoff, h, isnext, kb) do { \
        if constexpr (GATHER) { _Pragma("unroll") for (int _i = 0; _i < 2; ++_i) PG8_GLDS(rsA, ((isnext) ? nvo[h][_i] : cvo[h][_i]), (kb), bufoff, _i); } \
        else { const unsigned _b = ((isnext) ? nA : cA) + (unsigned)((h) * hstepA + (kb)); _Pragma("unroll") for (int _i = 0; _i < 2; ++_i) PG8_GLDS(rsA, voffA[_i], _b, bufoff, _i); } } while (0)
#define PG8_LD16(p) (*(const LAS i32x4_t*)(p))
#define PG8_LDA(dst, b, h) do { if constexpr (FP8) { _Pragma("unroll") for (int m = 0; m < 4; ++m) dst##8[m] = __builtin_shufflevector(PG8_LD16(lds + PG8_SA(b, h) + aoff + m * 2048), PG8_LD16(lds + PG8_SA(b, h) + aoff + m * 2048 + 1024), 0, 1, 2, 3, 4, 5, 6, 7); } \
        else { _Pragma("unroll") for (int m = 0; m < 4; ++m) _Pragma("unroll") for (int k = 0; k < 2; ++k) dst[m][k] = *(const LAS bf16x8*)(lds + PG8_SA(b, h) + aoff + m * 2048 + k * 1024); } } while (0)
#define PG8_LDB(dst, b, h) do { if constexpr (FP8) { _Pragma("unroll") for (int n = 0; n < 2; ++n) dst##8[n] = __builtin_shufflevector(PG8_LD16(lds + PG8_SB(b, h) + boff + n * 2048), PG8_LD16(lds + PG8_SB(b, h) + boff + n * 2048 + 1024), 0, 1, 2, 3, 4, 5, 6, 7); } \
        else { _Pragma("unroll") for (int n = 0; n < 2; ++n) _Pragma("unroll") for (int k = 0; k < 2; ++k) dst[n][k] = *(const LAS bf16x8*)(lds + PG8_SB(b, h) + boff + n * 2048 + k * 1024); } } while (0)
#define PG8_CAT(x) __builtin_shufflevector(__builtin_bit_cast(i32x4_t, (x)[0]), __builtin_bit_cast(i32x4_t, (x)[1]), 0, 1, 2, 3, 4, 5, 6, 7)
#define PG8_MMA(ai, bj, At, Bt) do { __builtin_amdgcn_s_setprio(1); \
        if constexpr (FP8) { _Pragma("unroll") for (int m = 0; m < 4; ++m) _Pragma("unroll") for (int n = 0; n < 2; ++n) \
            acc[ai][bj][m][n] = __builtin_amdgcn_mfma_scale_f32_16x16x128_f8f6f4(Bt##8[n], At##8[m], acc[ai][bj][m][n], 0, 0, 0, 0x7f7f7f7f, 0, 0x7f7f7f7f); \
            _Pragma("unroll") for (int m = 0; m < 4; ++m) _Pragma("unroll") for (int n = 0; n < 2; ++n) asm volatile("" : "+v"(acc[ai][bj][m][n])); }     \
        else { _Pragma("unroll") for (int m = 0; m < 4; ++m) _Pragma("unroll") for (int n = 0; n < 2; ++n) _Pragma("unroll") for (int k = 0; k < 2; ++k) \
            acc[ai][bj][m][n] = __builtin_amdgcn_mfma_f32_16x16x32_bf16(Bt[n][k], At[m][k], acc[ai][bj][m][n], 0, 0, 0); } \
        __builtin_amdgcn_s_setprio(0); } while (0)
#define PG8_WAIT_V(n) asm volatile("s_waitcnt vmcnt(" #n ")" ::: "memory")
#define PG8_WAIT_L(n) asm volatile("s_waitcnt lgkmcnt(" #n ")" ::: "memory")
#define PG8_BAR __builtin_amdgcn_s_barrier()
#define PG8_SCHED __builtin_amdgcn_sched_barrier(0)
    unsigned cvo[2][2], nvo[2][2];
    auto a_offsets = [&](const Unit& u, unsigned (&vo)[2][2]) {
#pragma unroll
        for (int h = 0; h < 2; ++h)
#pragma unroll
            for (int i = 0; i < 2; ++i) { const int a = g.rowidx[u.arow0 + h * HALF + sR[i]]; const int row = a < 0 ? 0 : (a >> 1); vo[h][i] = (unsigned)((size_t)row * g.lda + sC[i]) * 2u; }
    };
    Unit cur, nxt; int ui = 0;
    if (!S.next(0, cur)) return;
    f32x4 acc[2][2][4][2];
#pragma unroll
    for (int a = 0; a < 2; ++a)
#pragma unroll
        for (int b = 0; b < 2; ++b)
#pragma unroll
            for (int m = 0; m < 4; ++m)
#pragma unroll
                for (int n = 0; n < 2; ++n) acc[a][b][m][n] = (f32x4){0.f, 0.f, 0.f, 0.f};
    bf16x8 At[4][2], B0[2][2], B1[2][2]; i32x8_t At8[4], B08[2], B18[2];
    unsigned cA = (unsigned)((size_t)cur.arow0 * g.lda * 2), nA = cA;
    unsigned cB = (unsigned)((size_t)cur.brow0 * g.ldb * 2);
    if constexpr (GATHER) { a_offsets(cur, cvo);
#pragma unroll
        for (int h = 0; h < 2; ++h)
#pragma unroll
            for (int i = 0; i < 2; ++i) nvo[h][i] = cvo[h][i]; }
    PG8_STAGEB(PG8_SB(0, 0), cB); PG8_STAGEB(PG8_SB(0, 1), cB + hstepB); PG8_STAGEA(PG8_SA(0, 0), 0, false, 0); PG8_STAGEA(PG8_SA(0, 1), 1, false, 0);
    if (wr == 1) PG8_BAR;
    PG8_WAIT_V(2); PG8_BAR;
    PG8_STAGEB(PG8_SB(1, 0), cB + kstep); PG8_STAGEA(PG8_SA(1, 0), 0, false, kstep); PG8_STAGEB(PG8_SB(1, 1), cB + hstepB + kstep);
    PG8_WAIT_V(6); PG8_BAR;
    for (;;) {
        const bool has_next = S.next(ui + 1, nxt);
        const unsigned nB = has_next ? (unsigned)((size_t)nxt.brow0 * g.ldb * 2) : cB;
        nA = has_next ? (unsigned)((size_t)nxt.arow0 * g.lda * 2) : cA;
        if constexpr (GATHER) { if (has_next) a_offsets(nxt, nvo); }
        for (int t = 0; t < nt; t += 2) {
            const bool last = (t == nt - 2);
            const unsigned k1 = (unsigned)((t + 1) * kstep), k2 = last ? 0u : (unsigned)((t + 2) * kstep), k3 = k2 + (unsigned)kstep;
            const unsigned b2 = last ? nB : cB + (unsigned)((t + 2) * kstep); const unsigned b3 = b2 + (unsigned)kstep;
            PG8_LDB(B0, 0, 0); PG8_LDB(B1, 0, 1); PG8_SCHED; PG8_LDA(At, 0, 0); PG8_STAGEA(PG8_SA(1, 1), 1, false, k1);
            PG8_WAIT_V(8); PG8_WAIT_L(0); PG8_BAR; PG8_MMA(0, 0, At, B0); PG8_MMA(0, 1, At, B1); PG8_BAR; PG8_SCHED;
            PG8_LDA(At, 0, 1); PG8_STAGEB(PG8_SB(0, 0), b2); PG8_STAGEB(PG8_SB(0, 1), b2 + hstepB); PG8_STAGEA(PG8_SA(0, 0), 0, last, k2);
            PG8_WAIT_V(8); PG8_WAIT_L(0); PG8_BAR; PG8_MMA(1, 0, At, B0); PG8_MMA(1, 1, At, B1); PG8_BAR; PG8_SCHED;
            PG8_LDB(B0, 1, 0); PG8_LDB(B1, 1, 1); PG8_SCHED; PG8_LDA(At, 1, 0); PG8_STAGEA(PG8_SA(0, 1), 1, last, k2);
            PG8_WAIT_V(8); PG8_WAIT_L(0); PG8_BAR; PG8_MMA(0, 0, At, B0); PG8_MMA(0, 1, At, B1); PG8_BAR; PG8_SCHED;
            PG8_LDA(At, 1, 1); PG8_STAGEB(PG8_SB(1, 0), b3); PG8_STAGEB(PG8_SB(1, 1), b3 + hstepB); PG8_STAGEA(PG8_SA(1, 0), 0, last, k3);
            PG8_WAIT_V(8); PG8_WAIT_L(0); PG8_BAR; PG8_MMA(1, 0, At, B0); PG8_MMA(1, 1, At, B1); PG8_BAR; PG8_SCHED;
        }
        if (wr == 0) PG8_BAR;
        { int l2 = threadIdx.x; asm volatile("" : "+v"(l2)); E(acc, cur, wr, wc, l2 & 15, (l2 >> 4) & 3); if (EPI_TWICE && Epi::IDEM) { asm volatile("" : "+v"(l2)); E(acc, cur, wr, wc, l2 & 15, (l2 >> 4) & 3); } }
        if (!has_next) break;
#pragma unroll
        for (int a = 0; a < 2; ++a)
#pragma unroll
            for (int b = 0; b < 2; ++b)
#pragma unroll
                for (int m = 0; m < 4; ++m)
#pragma unroll
                    for (int n = 0; n < 2; ++n) acc[a][b][m][n] = (f32x4){0.f, 0.f, 0.f, 0.f};
        cur = nxt; cB = nB; cA = nA; ++ui;
        if constexpr (GATHER) {
#pragma unroll
            for (int h = 0; h < 2; ++h)
#pragma unroll
                for (int i = 0; i < 2; ++i) cvo[h][i] = nvo[h][i]; }
        if (wr == 1) PG8_BAR;
    }
    PG8_WAIT_V(0);
    PG8_BAR;
#undef PG8_SA
#undef PG8_SB
#undef PG8_GLDS
#undef PG8_STAGEA
#undef PG8_STAGEB
#undef PG8_LDA
#undef PG8_LD16
#undef PG8_LDB
#undef PG8_MMA
#undef PG8_CAT
#undef PG8_WAIT_V
#undef PG8_WAIT_L
#undef PG8_BAR
#undef PG8_SCHED
}
}

struct Args {
    const float* in[28]; float* out; unsigned char* ws; int ph_lo, ph_hi, nobar, pad;
};
enum In { I_X = 0, I_C, I_CTX, I_CCTX, I_ADAW, I_ADAB, I_NMIXG, I_NFFNG, I_EVWIN, I_EVLB, I_EVONORM, I_EVSGUG, I_EVWS, I_EVBS, I_EVWOUT,
          I_ODWIN, I_ODQG, I_ODWUQ, I_ODKVG, I_ODWUKV, I_ODWOUT, I_MR1W, I_MR1B, I_MR2W, I_MR2B, I_MGU, I_MDN, I_FING };
struct Frame {
    LAS unsigned char* lds;
    const __attribute__((address_space(4))) Args* ka;
    float* out;
    int tid, lane, wave, vcu, G;
    unsigned char* ws;
};
__device__ __forceinline__ const float* mod_ptr(const Frame& F, int layer, int mrow, int which) { return (const float*)(F.ws + WS_MOD) + ((size_t)(layer * 17 + mrow) * 6 + which) * DM; }
__device__ __forceinline__ int row_b(int row) { return row / PB; }
__device__ __forceinline__ const float* input_row(const Frame& F, int row) {
    const int b = row / PB, pos = row - b * PB;
    return pos < CTXL ? F.ka->in[I_CTX] + ((size_t)b * CTXL + pos) * DM : F.ka->in[I_X] + ((size_t)b * SEQ + (pos - CTXL)) * DM;
}

template <bool XONLY> struct TileSched {
    int nM, nN, nwg, G, c;
    __device__ __forceinline__ void init(int nN_, int G_, int c_) { nM = XONLY ? NXTILE : NTILE; nN = nN_; nwg = nM * nN; G = G_; c = c_; }
    __device__ __forceinline__ void init_mn(int nM_, int nN_, int G_, int c_) { nM = nM_; nN = nN_; nwg = nM * nN; G = G_; c = c_; }
    __device__ __forceinline__ bool next(int i, pg8::Unit& u) const {
        const int L = i * G + c; if (L >= nwg) return false;
        int wgid = L; { const int q = nwg / 8, r = nwg % 8, xcd = wgid % 8, off = wgid / 8; wgid = (xcd < r ? xcd * (q + 1) : r * (q + 1) + (xcd - r) * q) + off; }
        const int nig = 8 * nN, gid = wgid / nig, fm = gid * 8, gsz = (nM - fm) < 8 ? (nM - fm) : 8;
        int pm = fm + ((wgid % nig) % gsz); const int pn = (wgid % nig) / gsz;
        if (XONLY) pm = (pm >> 3) * 9 + 1 + (pm & 7);
        u.pm = pm; u.pn = pn; u.ex = 0; u.arow0 = pm * 256; u.brow0 = pn * 256; return true;
    }
};
struct MoeSched {
    const LAS int* pfx; const LAS unsigned char* tab; int nwg, G, c;
    __device__ __forceinline__ bool next(int i, pg8::Unit& u) const {
        const int L = i * G + c; if (L >= nwg) return false;
        int wgid = L; { const int q = nwg / 8, r = nwg % 8, xcd = wgid % 8, off = wgid / 8; wgid = (xcd < r ? xcd * (q + 1) : r * (q + 1) + (xcd - r) * q) + off; }
        const int blk = wgid >> 2, pn = wgid & 3; const int e = __builtin_amdgcn_readfirstlane((int)tab[blk]); const int j = blk - __builtin_amdgcn_readfirstlane(pfx[e]);
        u.pm = blk; u.pn = pn; u.ex = e; u.arow0 = e * ECAP + j * 256; u.brow0 = e * 1024 + pn * 256; return true;
    }
};
__device__ __forceinline__ u32x4 widen16(u32x2 w0, u32x2 w1) {
    const auto rx = __builtin_amdgcn_permlane16_swap(w0.x, w1.x, false, false), ry = __builtin_amdgcn_permlane16_swap(w0.y, w1.y, false, false);
    return (u32x4){(unsigned)rx[0], (unsigned)ry[0], (unsigned)rx[1], (unsigned)ry[1]};
}
struct EpiStoreBf16 {
    static constexpr bool PERM = true; static constexpr bool IDEM = true; static constexpr bool KEYPERM = false;
    bf16_t* O; int ldc;
    __device__ __forceinline__ void operator()(const f32x4 (&acc)[2][2][4][2], const pg8::Unit& u, int wr, int wc, int fr, int fq) const {
        const int row0 = u.arow0 + wr * 64 + fr, col0 = u.pn * 256 + wc * 32 + 8 * fq;
#pragma unroll
        for (int ai = 0; ai < 2; ++ai)
#pragma unroll
            for (int m = 0; m < 4; ++m) { bf16_t* rowp = O + (size_t)(row0 + ai * 128 + m * 16) * ldc + col0;
#pragma unroll
                for (int bj = 0; bj < 2; ++bj) { const f32x4 v0 = acc[ai][bj][m][0], v1 = acc[ai][bj][m][1];
                    u32x4 w; w.x = cvtpk(v0[0], v0[1]); w.y = cvtpk(v0[2], v0[3]); w.z = cvtpk(v1[0], v1[1]); w.w = cvtpk(v1[2], v1[3]);
                    *(u32x4*)(rowp + bj * 128) = w; } }
    }
};
struct EpiStoreStats {
    static constexpr bool PERM = true; static constexpr bool IDEM = true; static constexpr bool KEYPERM = false;
    bf16_t* O; int ldc; float* stats; float sc;
    __device__ __forceinline__ void operator()(const f32x4 (&acc)[2][2][4][2], const pg8::Unit& u, int wr, int wc, int fr, int fq) const {
        const int row0 = u.arow0 + wr * 64 + fr, col0 = u.pn * 256 + wc * 32 + 8 * fq;
#pragma unroll
        for (int ai = 0; ai < 2; ++ai)
#pragma unroll
            for (int m = 0; m < 4; ++m) { const int row = row0 + ai * 128 + m * 16; bf16_t* rowp = O + (size_t)row * ldc + col0;
#pragma unroll
                for (int bj = 0; bj < 2; ++bj) { const f32x4 v0 = acc[ai][bj][m][0] * sc, v1 = acc[ai][bj][m][1] * sc;
                    u32x4 w; w.x = cvtpk(v0[0], v0[1]); w.y = cvtpk(v0[2], v0[3]); w.z = cvtpk(v1[0], v1[1]); w.w = cvtpk(v1[2], v1[3]);
                    *(u32x4*)(rowp + bj * 128) = w;
                    float s = (v0[0] * v0[0] + v0[1] * v0[1]) + (v0[2] * v0[2] + v0[3] * v0[3]) + (v1[0] * v1[0] + v1[1] * v1[1]) + (v1[2] * v1[2] + v1[3] * v1[3]);
                    s += __shfl_xor(s, 16); s += __shfl_xor(s, 32);
                    if (fq == 0) stats[(size_t)row * 24 + u.pn * 8 + bj * 4 + wc] = s; } }
    }
};
struct EpiResidual {
    static constexpr bool PERM = true; static constexpr bool IDEM = false; static constexpr bool KEYPERM = false;
    const Frame* F; bf16_t* dst; int layer; bool from_input; float sc;
    __device__ __forceinline__ void operator()(const f32x4 (&acc)[2][2][4][2], const pg8::Unit& u, int wr, int wc, int fr, int fq) const {
        const int b = u.pm / 9, isctx = (u.pm % 9) == 0, mrow = isctx ? 16 : b;
        const float* gate = mod_ptr(*F, layer, mrow, 2);
        const int col0 = u.pn * 256 + wc * 32 + 8 * fq;
        f32x4 gv[2][2];
#pragma unroll
        for (int bj = 0; bj < 2; ++bj)
#pragma unroll
            for (int n = 0; n < 2; ++n) gv[bj][n] = *(const f32x4*)(gate + col0 + bj * 128 + n * 4) * sc;
#pragma unroll
        for (int ai = 0; ai < 2; ++ai)
#pragma unroll
            for (int m = 0; m < 4; ++m) { const int row = u.arow0 + ai * 128 + wr * 64 + m * 16 + fr;
                const float* bp = input_row(*F, row); bf16_t* dp = dst + (size_t)row * DM;
#pragma unroll
                for (int bj = 0; bj < 2; ++bj) { const int c = col0 + bj * 128; f32x4 b0, b1;
                    if (from_input) { b0 = *(const f32x4*)(bp + c); b1 = *(const f32x4*)(bp + c + 4); }
                    else { const u32x4 w = *(const u32x4*)(dp + c); b0 = (f32x4){bflo(w.x), bfhi(w.x), bflo(w.y), bfhi(w.y)}; b1 = (f32x4){bflo(w.z), bfhi(w.z), bflo(w.w), bfhi(w.w)}; }
                    const f32x4 r0 = b0 + gv[bj][0] * acc[ai][bj][m][0], r1 = b1 + gv[bj][1] * acc[ai][bj][m][1];
                    u32x4 o; o.x = cvtpk(r0[0], r0[1]); o.y = cvtpk(r0[2], r0[3]); o.z = cvtpk(r1[0], r1[1]); o.w = cvtpk(r1[2], r1[3]); *(u32x4*)(dp + c) = o; } }
    }
};
struct EpiSwiglu {
    static constexpr bool PERM = true; static constexpr bool IDEM = true; static constexpr bool KEYPERM = false;
    unsigned char* O;
    __device__ __forceinline__ void operator()(const f32x4 (&acc)[2][2][4][2], const pg8::Unit& u, int wr, int wc, int fr, int fq) const {
        const int row0 = u.arow0 + wr * 64 + fr + 16 * (fq & 1), col0 = u.pn * 128 + wc * 32 + 16 * (fq >> 1); constexpr float SI = 1.0f / (S8_X * S8_WGU);
#pragma unroll
        for (int ai = 0; ai < 2; ++ai)
#pragma unroll
            for (int mp = 0; mp < 4; mp += 2) { u32x2 w[2];
#pragma unroll
                for (int mm = 0; mm < 2; ++mm) { const int m = mp + mm; float h[8];
#pragma unroll
                    for (int n = 0; n < 2; ++n)
#pragma unroll
                        for (int j = 0; j < 4; ++j) h[n * 4 + j] = siluf_(acc[ai][0][m][n][j] * SI) * (acc[ai][1][m][n][j] * (SI * S8_H));
                    w[mm].x = pk4_fp8(h[0], h[1], h[2], h[3]); w[mm].y = pk4_fp8(h[4], h[5], h[6], h[7]); }
                *(u32x4*)(O + (size_t)(row0 + ai * 128 + mp * 16) * MFF + col0) = widen16(w[0], w[1]); }
    }
};
struct EpiScatter {
    static constexpr bool PERM = true; static constexpr bool IDEM = true; static constexpr bool KEYPERM = false;
    unsigned char* O; const int* perm;
    __device__ __forceinline__ void operator()(const f32x4 (&acc)[2][2][4][2], const pg8::Unit& u, int wr, int wc, int fr, int fq) const {
        const int row0 = u.arow0 + wr * 64 + fr + 16 * (fq & 1), col0 = u.pn * 256 + wc * 32 + 16 * (fq >> 1); constexpr float SI = S8_Y / (S8_H * S8_WDN);
#pragma unroll
        for (int ai = 0; ai < 2; ++ai)
#pragma unroll
            for (int mp = 0; mp < 4; mp += 2) { const int a = perm[row0 + ai * 128 + mp * 16];
                unsigned char* rowp = O + (size_t)(a < 0 ? 0 : a) * DM + col0;
#pragma unroll
                for (int bj = 0; bj < 2; ++bj) { u32x2 w[2];
#pragma unroll
                    for (int mm = 0; mm < 2; ++mm) { const f32x4 v0 = acc[ai][bj][mp + mm][0] * SI, v1 = acc[ai][bj][mp + mm][1] * SI;
                        w[mm].x = pk4_fp8_nc(v0[0], v0[1], v0[2], v0[3]); w[mm].y = pk4_fp8_nc(v1[0], v1[1], v1[2], v1[3]); }
                    const u32x4 o = widen16(w[0], w[1]);
                    if (a >= 0) *(u32x4*)(rowp + bj * 128) = o; }
                asm volatile("" ::: "memory"); }
    }
};
struct EpiQ {
    static constexpr bool PERM = true; static constexpr bool IDEM = true; static constexpr bool KEYPERM = false;
    unsigned char* O; const float* stats;
    __device__ __forceinline__ void operator()(const f32x4 (&acc)[2][2][4][2], const pg8::Unit& u, int wr, int wc, int fr, int fq) const {
        float invf[2][4]; int fq2 = fq; asm volatile("" : "+v"(fq2));
#pragma unroll
        for (int n = 0; n < 2; ++n)
#pragma unroll
            for (int j = 0; j < 4; ++j) invf[n][j] = __expf(-(float)(8 * (fq2 & 1) + 4 * n + j) * (2.0f / 32.0f) * 9.210340371976184f);
        const bool lowhalf = fq2 < 2;
#pragma unroll
        for (int ai = 0; ai < 2; ++ai)
#pragma unroll
            for (int mp = 0; mp < 4; mp += 2) { u32x2 w[2][2];
#pragma unroll
                for (int mm = 0; mm < 2; ++mm) { const int m = mp + mm; const int row = u.arow0 + ai * 128 + wr * 64 + m * 16 + fr;
                    const float* st = stats + (size_t)row * 24; float ss = 0.f;
#pragma unroll
                    for (int q = 0; q < 3; ++q) { const f32x4 s4 = *(const f32x4*)(st + 4 * q); ss += (s4[0] + s4[1]) + (s4[2] + s4[3]); }
                    const float sc = __builtin_amdgcn_rsqf(ss * (1.0f / QRANK) + RMS_EPS) * (ATT_C2 * S8_Q);
                    const int t = (row % PB) - CTXL; const float gr = (float)(t >> 6), gc = (float)(t & 63);
#pragma unroll
                    for (int bj = 0; bj < 2; ++bj) { const int cg = u.pn * 256 + bj * 128 + wc * 32; const int within = cg % 192;
                        f32x4 v[2] = {acc[ai][bj][m][0] * sc, acc[ai][bj][m][1] * sc};
                        if (within >= 128) { const float p = (within == 128) ? gr : gc;
#pragma unroll
                            for (int n = 0; n < 2; ++n)
#pragma unroll
                                for (int j = 0; j < 4; ++j) { const float x = v[n][j], xo = __shfl_xor(x, 32); const float ang = p * invf[n][j]; const float cs = __cosf(ang), sn = __sinf(ang);
                                    v[n][j] = lowhalf ? (x * cs - xo * sn) : (xo * sn + x * cs); } }
                        w[mm][bj].x = pk4_fp8(v[0][0], v[0][1], v[0][2], v[0][3]); w[mm][bj].y = pk4_fp8(v[1][0], v[1][1], v[1][2], v[1][3]); } }
                const int srow = u.arow0 + ai * 128 + wr * 64 + (mp + (fq2 & 1)) * 16 + fr;
#pragma unroll
                for (int bj = 0; bj < 2; ++bj) *(u32x4*)(O + (size_t)srow * NQ + u.pn * 256 + bj * 128 + wc * 32 + 16 * (fq2 >> 1)) = widen16(w[0][bj], w[1][bj]); }
    }
};
struct EpiK {
    static constexpr bool PERM = true; static constexpr bool IDEM = true; static constexpr bool KEYPERM = false;
    unsigned char* KBp; const float* stats;
    __device__ __forceinline__ void operator()(const f32x4 (&acc)[2][2][4][2], const pg8::Unit& u, int wr, int wc, int fr, int fq) const {
#pragma unroll
        for (int ai = 0; ai < 2; ++ai)
#pragma unroll
            for (int mp = 0; mp < 4; mp += 2) { u32x2 wk[2][2];
#pragma unroll
                for (int mm = 0; mm < 2; ++mm) { const int m = mp + mm; const int row = u.arow0 + ai * 128 + wr * 64 + m * 16 + fr;
                    const float* st = stats + (size_t)row * 24 + 12; const f32x4 s0 = *(const f32x4*)st, s1 = *(const f32x4*)(st + 4);
                    const float ss = ((s0[0] + s0[1]) + (s0[2] + s0[3])) + ((s1[0] + s1[1]) + (s1[2] + s1[3]));
                    const float sc = __builtin_amdgcn_rsqf(ss * (1.0f / KVRANK) + RMS_EPS) * S8_K;
#pragma unroll
                    for (int bj = 0; bj < 2; ++bj) { const f32x4 v0 = acc[ai][bj][m][0] * sc, v1 = acc[ai][bj][m][1] * sc;
                        wk[mm][bj].x = pk4_fp8(v0[0], v0[1], v0[2], v0[3]); wk[mm][bj].y = pk4_fp8(v1[0], v1[1], v1[2], v1[3]); } }
                const int srow = u.arow0 + ai * 128 + wr * 64 + (mp + (fq & 1)) * 16 + fr;
#pragma unroll
                for (int bj = 0; bj < 2; ++bj) *(u32x4*)(KBp + (size_t)srow * NQ + (2 * u.pn + bj) * 192 + wc * 32 + 16 * (fq >> 1)) = widen16(wk[0][bj], wk[1][bj]); }
    }
};
struct EpiVT {
    static constexpr bool PERM = true; static constexpr bool IDEM = true; static constexpr bool KEYPERM = true;
    unsigned char* VT; const float* stats;
    __device__ __forceinline__ void operator()(const f32x4 (&acc)[2][2][4][2], const pg8::Unit& u, int wr, int wc, int fr, int fq) const {
        int fq2 = fq; asm volatile("" : "+v"(fq2));
#pragma unroll
        for (int bj = 0; bj < 2; ++bj) { float sc[8]; const int cm0 = 128 * bj + 32 * wc + 8 * fq2;
#pragma unroll
            for (int e = 0; e < 8; ++e) { const int cm = cm0 + e; const int pos = u.brow0 + (cm & ~63) + pg8::keyperm64(cm & 63);
                const float* st = stats + (size_t)pos * 24 + 12; const f32x4 s0 = *(const f32x4*)st, s1 = *(const f32x4*)(st + 4);
                const float ss = ((s0[0] + s0[1]) + (s0[2] + s0[3])) + ((s1[0] + s1[1]) + (s1[2] + s1[3]));
                sc[e] = __builtin_amdgcn_rsqf(ss * (1.0f / KVRANK) + RMS_EPS) * S8_V; }
#pragma unroll
            for (int ai = 0; ai < 2; ++ai)
#pragma unroll
                for (int mp = 0; mp < 4; mp += 2) { u32x2 w[2];
#pragma unroll
                    for (int mm = 0; mm < 2; ++mm) { const f32x4 v0 = acc[ai][bj][mp + mm][0], v1 = acc[ai][bj][mp + mm][1];
                        w[mm].x = pk4_fp8(v0[0] * sc[0], v0[1] * sc[1], v0[2] * sc[2], v0[3] * sc[3]); w[mm].y = pk4_fp8(v1[0] * sc[4], v1[1] * sc[5], v1[2] * sc[6], v1[3] * sc[7]); }
                    const int srow = u.arow0 + ai * 128 + wr * 64 + (mp + (fq2 & 1)) * 16 + fr;
                    *(u32x4*)(VT + (size_t)srow * R + u.brow0 + 128 * bj + 32 * wc + 16 * (fq2 >> 1)) = widen16(w[0], w[1]); } }
    }
};

__device__ __forceinline__ void tr_item(const float* W, int K, int N, bf16_t* WT, int gu, const float* kscale, LAS float* scr, int item, int lane) {
    const int nblk = N / 64, kb = item / nblk, nb = item % nblk, k0 = 64 * kb, n0 = 64 * nb;
    f32x4 v[16];
#pragma unroll
    for (int i = 0; i < 16; ++i) v[i] = *(const f32x4*)(W + (size_t)(k0 + 4 * i + (lane >> 4)) * N + n0 + 4 * (lane & 15));
#pragma unroll
    for (int i = 0; i < 16; ++i) { const int kk = 4 * i + (lane >> 4); f32x4 w = v[i]; if (kscale) w = w * kscale[k0 + kk]; LAS float* p = scr + kk * 65 + 4 * (lane & 15); p[0] = w[0]; p[1] = w[1]; p[2] = w[2]; p[3] = w[3]; }
    LDS_WAIT(); asm volatile("" ::: "memory");
    int d0 = n0;
    if (gu == 1) { const int i0 = n0 & 511; d0 = 256 * (i0 >> 7) + (n0 >= 512 ? 128 : 0) + (i0 & 127); }
    if (gu == 2) { const int hh = n0 >> 8, jj = n0 & 255; d0 = jj < 128 ? hh * 128 + jj : 1024 + hh * 128 + (jj - 128); }
    const int c = lane & 7;
#pragma unroll
    for (int j = 0; j < 8; ++j) { const int n = (lane >> 3) + 8 * j; const LAS float* sp = scr + (8 * c) * 65 + n;
        u32x4 o; o.x = pk2(sp[0 * 65], sp[1 * 65]); o.y = pk2(sp[2 * 65], sp[3 * 65]); o.z = pk2(sp[4 * 65], sp[5 * 65]); o.w = pk2(sp[6 * 65], sp[7 * 65]);
        *(u32x4*)(WT + (size_t)(d0 + n) * K + k0 + 8 * c) = o; }
    LDS_WAIT(); asm volatile("" ::: "memory");
}
__device__ __forceinline__ void tr_item8(const float* W, int K, int N, unsigned char* WT, bool gu, float scale, LAS float* scr, int item, int lane) {
    const int nblk = N / 64, kb = item / nblk, nb = item % nblk, k0 = 64 * kb, n0 = 64 * nb;
    f32x4 v[16];
#pragma unroll
    for (int i = 0; i < 16; ++i) v[i] = *(const f32x4*)(W + (size_t)(k0 + 4 * i + (lane >> 4)) * N + n0 + 4 * (lane & 15));
#pragma unroll
    for (int i = 0; i < 16; ++i) { const int kk = 4 * i + (lane >> 4); const f32x4 w = v[i] * scale; LAS float* p = scr + kk * 65 + 4 * (lane & 15); p[0] = w[0]; p[1] = w[1]; p[2] = w[2]; p[3] = w[3]; }
    LDS_WAIT(); asm volatile("" ::: "memory");
    int d0 = n0;
    if (gu) { const int i0 = n0 & 511; d0 = 256 * (i0 >> 7) + (n0 >= 512 ? 128 : 0) + (i0 & 127); }
    const int c = lane & 7;
#pragma unroll
    for (int j = 0; j < 8; ++j) { const int n = (lane >> 3) + 8 * j; const LAS float* sp = scr + (8 * c) * 65 + n;
        u32x2 o; o.x = pk4_fp8(sp[0 * 65], sp[1 * 65], sp[2 * 65], sp[3 * 65]); o.y = pk4_fp8(sp[4 * 65], sp[5 * 65], sp[6 * 65], sp[7 * 65]);
        *(u32x2*)(WT + (size_t)(d0 + n) * K + k0 + 8 * c) = o; }
    LDS_WAIT(); asm volatile("" ::: "memory");
}
constexpr int MOE_W_ITEMS = 32 * 256 + 32 * 128;
__device__ __forceinline__ void moe_w_item(Frame& F, int layer, int it, LAS float* scr) {
    if (it < 32 * 256) { const int e = layer * 32 + it / 256; tr_item8(F.ka->in[I_MGU] + (size_t)e * DM * 1024, DM, 1024, F.ws + WS_WGU + (size_t)e * 1024 * DM, true, S8_WGU, scr, it % 256, F.lane); }
    else { it -= 32 * 256; const int e = layer * 32 + it / 128; tr_item8(F.ka->in[I_MDN] + (size_t)e * MFF * DM, MFF, DM, F.ws + WS_WDN + (size_t)e * DM * MFF, false, S8_WDN, scr, it % 128, F.lane); }
}
__device__ __forceinline__ void p0_prologue(Frame& F) {
    __syncthreads();

    LAS float* S = (LAS float*)F.lds;
    for (int idx = F.tid; idx < 17 * DM; idx += 512) { const int r = idx >> 10, k = idx & 1023; const float cv = r < 16 ? F.ka->in[I_C][r * DM + k] : F.ka->in[I_CCTX][k]; S[k * 20 + r] = siluf_(cv); }
    __syncthreads();
    const int gw = F.vcu * 8 + F.wave, NGW = F.G * 8;
    float* part = (float*)(F.ws + WS_PART);
    for (int it = gw; it < 2 * 8 * 96; it += NGW) {
        const int l = it / 768, rem = it % 768, kc = rem / 96, slab = rem % 96, n0 = slab * 64;
        const float* w = F.ka->in[I_ADAW] + ((size_t)l * DM + kc * 128) * 6144 + n0 + F.lane;
        float acc[17];
#pragma unroll
        for (int r = 0; r < 17; ++r) acc[r] = 0.f;
#pragma unroll 4
        for (int kk = 0; kk < 128; ++kk) {
            const float wv = w[(size_t)kk * 6144];
            const LAS float* s = S + (kc * 128 + kk) * 20;
            const f32x4 s0 = *(const LAS f32x4*)s, s1 = *(const LAS f32x4*)(s + 4), s2 = *(const LAS f32x4*)(s + 8), s3 = *(const LAS f32x4*)(s + 12); const float s4 = s[16];
            acc[0] += s0[0] * wv; acc[1] += s0[1] * wv; acc[2] += s0[2] * wv; acc[3] += s0[3] * wv;
            acc[4] += s1[0] * wv; acc[5] += s1[1] * wv; acc[6] += s1[2] * wv; acc[7] += s1[3] * wv;
            acc[8] += s2[0] * wv; acc[9] += s2[1] * wv; acc[10] += s2[2] * wv; acc[11] += s2[3] * wv;
            acc[12] += s3[0] * wv; acc[13] += s3[1] * wv; acc[14] += s3[2] * wv; acc[15] += s3[3] * wv; acc[16] += s4 * wv;
        }
#pragma unroll
        for (int r = 0; r < 17; ++r) part[((size_t)(l * 8 + kc) * 17 + r) * 6144 + n0 + F.lane] = acc[r];
    }
    __syncthreads();
    LAS float* scr = (LAS float*)(F.lds + F.wave * 16640);
    constexpr int I_A = 16 * 56, I_B = 16 * 16, I_C2 = 16 * 11, I_D = 6 * 24, I_E = 4 * 32, I_F = 16 * 16, I_GU = 16 * 16, I_DN = 8 * 16;
    constexpr int NITEMS = I_A + I_B + I_C2 + I_D + I_E + I_F + 32 * 256;
    for (int it = gw; it < NITEMS; it += NGW) {
        int r = it;
        if (r < I_A) { tr_item(F.ka->in[I_EVWIN], DM, EVIN, (bf16_t*)(F.ws + WS_WIN0), false, nullptr, scr, r, F.lane); continue; } r -= I_A;
        if (r < I_B) { tr_item8(F.ka->in[I_EVWOUT], DM, DM, F.ws + WS_WOUT0, false, S8_W1, scr, r, F.lane); continue; } r -= I_B;
        if (r < I_C2) { tr_item8(F.ka->in[I_ODWIN], DM, CIN, F.ws + WS_WIN1, false, S8_W1, scr, r, F.lane); continue; } r -= I_C2;
        if (r < I_D) { tr_item(F.ka->in[I_ODWUQ], QRANK, NQ, (bf16_t*)(F.ws + WS_WUQ), false, F.ka->in[I_ODQG], scr, r, F.lane); continue; } r -= I_D;
        if (r < I_E) { tr_item(F.ka->in[I_ODWUKV], KVRANK, NKV, (bf16_t*)(F.ws + WS_WUKV), 2, F.ka->in[I_ODKVG], scr, r, F.lane); continue; } r -= I_E;
        if (r < I_F) { tr_item8(F.ka->in[I_ODWOUT], DM, DM, F.ws + WS_WOUT1, false, S8_W1, scr, r, F.lane); continue; } r -= I_F;
        moe_w_item(F, 0, r, scr);
    }
}
__device__ __forceinline__ void moe_l1_convert(Frame& F, int lo, int hi, int w0, int nw) {
    LAS float* scr = (LAS float*)(F.lds + F.wave * 16640);
    for (int it = lo + w0; it < hi; it += nw) moe_w_item(F, 1, it, scr);
}
__device__ __forceinline__ void moe_l0_dn_convert(Frame& F, int w0, int nw) {
    LAS float* scr = (LAS float*)(F.lds + F.wave * 16640);
    for (int it = 32 * 256 + w0; it < MOE_W_ITEMS; it += nw) moe_w_item(F, 0, it, scr);
}
__device__ __forceinline__ void p0b_mod(Frame& F) {
    const float* part = (const float*)(F.ws + WS_PART); float* mod = (float*)(F.ws + WS_MOD);
    const int gt = F.vcu * 512 + F.tid, NGT = F.G * 512;
    for (int idx = gt; idx < 2 * 17 * 6144; idx += NGT) {
        const int l = idx / (17 * 6144), rem = idx % (17 * 6144), r = rem / 6144, n = rem % 6144;
        float s = F.ka->in[I_ADAB][l * 6144 + n];
#pragma unroll
        for (int kc = 0; kc < 8; ++kc) s += part[((size_t)(l * 8 + kc) * 17 + r) * 6144 + n];
        mod[idx] = s;
    }
}

__device__ __forceinline__ void load_row4(const float* p, int lane, f32x4 (&v)[4]) {
#pragma unroll
    for (int j = 0; j < 4; ++j) v[j] = *(const f32x4*)(p + 4 * lane + 256 * j);
}
__device__ __forceinline__ void load_row4_bf16(const bf16_t* p, int lane, f32x4 (&v)[4]) {
#pragma unroll
    for (int j = 0; j < 4; ++j) { const u32x2 w = *(const u32x2*)(p + 4 * lane + 256 * j); v[j] = (f32x4){bflo(w.x), bfhi(w.x), bflo(w.y), bfhi(w.y)}; }
}
__device__ __forceinline__ float sumsq4(const f32x4 (&v)[4]) {
    float s = 0.f;
#pragma unroll
    for (int j = 0; j < 4; ++j) s += (v[j][0] * v[j][0] + v[j][1] * v[j][1]) + (v[j][2] * v[j][2] + v[j][3] * v[j][3]);
    return wave_sum(s);
}
__device__ __forceinline__ void norm_mod4(f32x4 (&v)[4], const float* g, const float* shift, const float* scale, int lane) {
    const float rstd = __builtin_amdgcn_rsqf(sumsq4(v) * (1.0f / DM) + RMS_EPS);
#pragma unroll
    for (int j = 0; j < 4; ++j) { const int c = 4 * lane + 256 * j; const f32x4 gg = *(const f32x4*)(g + c), sh = *(const f32x4*)(shift + c), sc = *(const f32x4*)(scale + c);
        v[j] = v[j] * rstd * gg * (sc + 1.0f) + sh; }
}
__device__ __forceinline__ void store_row_bf16(bf16_t* p, int lane, const f32x4 (&v)[4]) {
#pragma unroll
    for (int j = 0; j < 4; ++j) { u32x2 w; w.x = cvtpk(v[j][0], v[j][1]); w.y = cvtpk(v[j][2], v[j][3]); *(u32x2*)(p + 4 * lane + 256 * j) = w; }
}
__device__ __forceinline__ void moe_combine4(Frame& F, int row, int layer, int mrow, f32x4 (&v)[4]) {
    const unsigned char* ys = F.ws + WS_YS + (size_t)(2 * row) * DM; const float* aw = (const float*)(F.ws + WS_ROUTE + RT_AW);
    const float w0 = aw[2 * row] * (1.0f / S8_Y), w1 = aw[2 * row + 1] * (1.0f / S8_Y); const float* gate = mod_ptr(F, layer, mrow, 5);
#pragma unroll
    for (int j = 0; j < 4; ++j) { const int c = 4 * F.lane + 256 * j; const unsigned y0 = *(const unsigned*)(ys + c), y1 = *(const unsigned*)(ys + DM + c); const f32x4 gg = *(const f32x4*)(gate + c);
        const f32x2 a0 = __builtin_amdgcn_cvt_pk_f32_fp8((int)y0, false), a1 = __builtin_amdgcn_cvt_pk_f32_fp8((int)y0, true), b0 = __builtin_amdgcn_cvt_pk_f32_fp8((int)y1, false), b1 = __builtin_amdgcn_cvt_pk_f32_fp8((int)y1, true);
        f32x4 y; y[0] = w0 * a0[0] + w1 * b0[0]; y[1] = w0 * a0[1] + w1 * b0[1]; y[2] = w0 * a1[0] + w1 * b1[0]; y[3] = w0 * a1[1] + w1 * b1[1];
        v[j] = v[j] + gg * y; }
}
__device__ __forceinline__ void p1_norm_input(Frame& F) {
    const int gw = F.vcu * 8 + F.wave, NGW = F.G * 8; bf16_t* hx = (bf16_t*)(F.ws + WS_HX);
    for (int row = gw; row < R; row += NGW) {
        const int b = row / PB, pos = row - b * PB, mrow = pos < CTXL ? 16 : b;
        f32x4 v[4]; load_row4(input_row(F, row), F.lane, v);
        norm_mod4(v, F.ka->in[I_NMIXG], mod_ptr(F, 0, mrow, 0), mod_ptr(F, 0, mrow, 1), F.lane);
        store_row_bf16(hx + (size_t)row * DM, F.lane, v);
    }
}
__device__ __forceinline__ void p8_combine_norm(Frame& F) {
    const int gw = F.vcu * 8 + F.wave, NGW = F.G * 8; bf16_t* hx = (bf16_t*)(F.ws + WS_HX); bf16_t* xs = (bf16_t*)(F.ws + WS_XS);
    for (int row = gw; row < R; row += NGW) {
        const int b = row / PB, pos = row - b * PB, mrow = pos < CTXL ? 16 : b;
        f32x4 v[4]; load_row4_bf16(xs + (size_t)row * DM, F.lane, v);
        moe_combine4(F, row, 0, mrow, v);
        store_row_bf16(xs + (size_t)row * DM, F.lane, v);
        norm_mod4(v, F.ka->in[I_NMIXG] + DM, mod_ptr(F, 1, mrow, 0), mod_ptr(F, 1, mrow, 1), F.lane);
#pragma unroll
        for (int j = 0; j < 4; ++j) *(unsigned*)((unsigned char*)hx + (size_t)row * DM + 4 * F.lane + 256 * j) = pk4_fp8(v[j][0] * S8_X, v[j][1] * S8_X, v[j][2] * S8_X, v[j][3] * S8_X);
    }
}
__device__ __forceinline__ void p16_final(Frame& F) {
    const int gw = F.vcu * 8 + F.wave, NGW = F.G * 8; const bf16_t* xs = (const bf16_t*)(F.ws + WS_XS);
    for (int row = gw; row < R; row += NGW) {
        const int b = row / PB, pos = row - b * PB; if (pos < CTXL) continue;
        f32x4 v[4];
        if (DBG_MODE >= 10) {
            const bf16_t* hx = (const bf16_t*)(F.ws + WS_HX) + (size_t)row * DM; const bf16_t* px = (const bf16_t*)(F.ws + WS_PX0) + (size_t)row * EVIN; const bf16_t* mx = (const bf16_t*)(F.ws + WS_MIX) + (size_t)row * DM;
#pragma unroll
            for (int j = 0; j < 4; ++j)
#pragma unroll
                for (int e = 0; e < 4; ++e) { const int c = 4 * F.lane + 256 * j + e;
                    v[j][e] = DBG_MODE == 10 ? bf2f(hx[c]) : DBG_MODE == 11 ? bf2f(px[c]) + bf2f(px[1024 + c]) + bf2f(px[2048 + c]) + bf2f(px[3072 + (c & 511)]) : bf2f(mx[c]); }
        } else if (DBG_MODE == 1) load_row4(input_row(F, row), F.lane, v); else load_row4_bf16(xs + (size_t)row * DM, F.lane, v);
        if (DBG_MODE == 0) moe_combine4(F, row, 1, b, v);
        const float rstd = __builtin_amdgcn_rsqf(sumsq4(v) * (1.0f / DM) + RMS_EPS);
        float* o = F.out + ((size_t)b * SEQ + (pos - CTXL)) * DM;
#pragma unroll
        for (int j = 0; j < 4; ++j) { const int c = 4 * F.lane + 256 * j; const f32x4 gg = *(const f32x4*)(F.ka->in[I_FING] + c); *(f32x4*)(o + c) = v[j] * rstd * gg; }
        if (STAMP_PHASE >= 0 && row == CTXL && F.lane == 0) o[0] = ((const float*)(F.ws + WS_CTL))[2048];
    }
}

template <bool XONLY>
__device__ __forceinline__ void p5_norm_route(Frame& F, int layer) {

    LAS float* W1L = (LAS float*)F.lds; LAS float* W2L = W1L + 4096;
    volatile LAS int* lcnt = (volatile LAS int*)(F.lds + LDSCTL_OFF + 64);
    volatile LAS int* gbase = (volatile LAS int*)(F.lds + LDSCTL_OFF + 192);
    LAS int* wrec = (LAS int*)(F.lds + LDSCTL_OFF + 512) + F.wave * 40; int ri = 0;
    const float* wr1 = F.ka->in[I_MR1W] + (size_t)layer * DM * 4; const float* wr2 = F.ka->in[I_MR2W] + (size_t)layer * 4 * DM * 8;
    f32x4 w1r[16];
#pragma unroll
    for (int je = 0; je < 16; ++je) w1r[je] = *(const f32x4*)(wr1 + (4 * F.lane + 256 * (je >> 2) + (je & 3)) * 4);
    for (int idx = F.tid; idx < 4 * DM * 2; idx += 512) { const int half = idx & 1, k = (idx >> 1) & 1023, g = idx >> 11; const int l = (k & 255) >> 2, j = k >> 8, e = k & 3;
        *(LAS f32x4*)(W2L + ((((g * 16 + j * 4 + e) * 2 + half) * 64) + l) * 4) = *(const f32x4*)(wr2 + ((size_t)g * DM + k) * 8 + half * 4); }
    if (F.tid < 32) lcnt[F.tid] = 0;
    __syncthreads();
    const int gw = F.vcu * 8 + F.wave, NGW = F.G * 8; unsigned char* hx8 = F.ws + WS_HX; const bf16_t* xs = (const bf16_t*)(F.ws + WS_XS);
    float* aw = (float*)(F.ws + WS_ROUTE + RT_AW);
    const float* b1 = F.ka->in[I_MR1B] + layer * 4; const float* b2 = F.ka->in[I_MR2B] + layer * 32;
    for (int row = gw; row < R; row += NGW) {
        const int b = row / PB, pos = row - b * PB; if (XONLY && pos < CTXL) continue;
        const int mrow = pos < CTXL ? 16 : b;
        f32x4 v[4]; load_row4_bf16(xs + (size_t)row * DM, F.lane, v);
        norm_mod4(v, F.ka->in[I_NFFNG] + layer * DM, mod_ptr(F, layer, mrow, 3), mod_ptr(F, layer, mrow, 4), F.lane);
#pragma unroll
        for (int j = 0; j < 4; ++j) *(unsigned*)(hx8 + (size_t)row * DM + 4 * F.lane + 256 * j) = pk4_fp8(v[j][0] * S8_X, v[j][1] * S8_X, v[j][2] * S8_X, v[j][3] * S8_X);
        f32x4 l1 = {0.f, 0.f, 0.f, 0.f};
#pragma unroll
        for (int j = 0; j < 4; ++j)
#pragma unroll
            for (int e = 0; e < 4; ++e) l1 += w1r[j * 4 + e] * v[j][e];
        float g0, g1, g2, g3; wave_sum4(l1, g0, g1, g2, g3); g0 += b1[0]; g1 += b1[1]; g2 += b1[2]; g3 += b1[3];
        int grp = 0; float gm = g0;
        if (g1 > gm) { gm = g1; grp = 1; } if (g2 > gm) { gm = g2; grp = 2; } if (g3 > gm) { gm = g3; grp = 3; }
        grp = __builtin_amdgcn_readfirstlane(grp);
        const float pg = 1.0f / (__expf(g0 - gm) + __expf(g1 - gm) + __expf(g2 - gm) + __expf(g3 - gm));
        f32x4 la = {0.f, 0.f, 0.f, 0.f}, lb = {0.f, 0.f, 0.f, 0.f};
        const LAS float* w2 = W2L + grp * 16 * 2 * 64 * 4;
#pragma unroll
        for (int j = 0; j < 4; ++j)
#pragma unroll
            for (int e = 0; e < 4; ++e) { const LAS float* p = w2 + (((j * 4 + e) * 2) * 64 + F.lane) * 4; la += *(const LAS f32x4*)p * v[j][e]; lb += *(const LAS f32x4*)(p + 256) * v[j][e]; }
        float lg[8]; wave_sum8(la, lb, F.lane, lg);
#pragma unroll
        for (int q = 0; q < 8; ++q) lg[q] += b2[grp * 8 + q];
        int e0 = 0; float m0 = lg[0];
#pragma unroll
        for (int q = 1; q < 8; ++q) if (lg[q] > m0) { m0 = lg[q]; e0 = q; }
        int e1 = -1; float m1 = -3.0e38f;
#pragma unroll
        for (int q = 0; q < 8; ++q) if (q != e0 && lg[q] > m1) { m1 = lg[q]; e1 = q; }
        const float pb = __expf(m1 - m0), inv = pg / (1.0f + pb);
        if (F.lane < 2) {
            const int ex = grp * 8 + (F.lane == 0 ? e0 : e1);
            const int lp = __hip_atomic_fetch_add((LAS int*)lcnt + ex, 1, __ATOMIC_RELAXED, __HIP_MEMORY_SCOPE_WORKGROUP);
            const int a = 2 * row + F.lane; aw[a] = F.lane == 0 ? inv : inv * pb; wrec[2 * ri + F.lane] = ex | (lp << 8);
        }
        ++ri;
    }
    __syncthreads();
    if (F.tid < 32) gbase[F.tid] = (int)__hip_atomic_fetch_add((unsigned*)(F.ws + WS_CTL) + CW_GC + 64 * layer + F.tid, (unsigned)lcnt[F.tid], __ATOMIC_RELAXED, __HIP_MEMORY_SCOPE_AGENT);
    __syncthreads();
    int* perm = (int*)(F.ws + WS_ROUTE + RT_PERM); ri = 0;
    for (int row = gw; row < R; row += NGW) {
        const int b = row / PB, pos = row - b * PB; if (XONLY && pos < CTXL) continue;
        if (F.lane < 2) { const int rec = wrec[2 * ri + F.lane], e = rec & 255, p = gbase[e] + (rec >> 8); const int a = 2 * row + F.lane;
            if (p < ECAP) perm[e * ECAP + p] = a;
            else { aw[a] = 0.f; u32x4* yz = (u32x4*)(F.ws + WS_YS + (size_t)a * DM); for (int q = 0; q < DM / 16; ++q) yz[q] = (u32x4){0u, 0u, 0u, 0u}; } }
        ++ri;
    }
}
__device__ __forceinline__ void perm_clear(Frame& F) {
    int* perm = (int*)(F.ws + WS_ROUTE + RT_PERM);
    for (int i = F.vcu * 512 + F.tid; i < MAXSLOT; i += F.G * 512) perm[i] = -1;
}

__device__ __forceinline__ bf16x8 lds_frag256(const LAS unsigned char* base, int row, int chunk) { return *(const LAS bf16x8*)(base + row * 256 + ((chunk ^ (row & 15)) << 4)); }
__device__ __forceinline__ bf16x8 lds_frag128(const LAS unsigned char* base, int row, int chunk) { return *(const LAS bf16x8*)(base + row * 128 + ((chunk ^ (row & 7)) << 4)); }
#define MFMA16(a, b, c) __builtin_amdgcn_mfma_f32_16x16x32_bf16((a), (b), (c), 0, 0, 0)

typedef short v4i16_t __attribute__((ext_vector_type(4)));
__device__ __forceinline__ int trswz256(int r, int cb) { return r * 256 + (cb ^ (((r & 3) | ((r >> 1) & 4)) << 5)); }
__device__ __forceinline__ int trswz128(int r, int cb) { return r * 128 + (cb ^ ((((r >> 1) & 1) | ((r >> 2) & 2)) << 5)); }
template <int ROWB> __device__ __forceinline__ bf16x8 lds_trfrag(const LAS unsigned char* tile, int s0, int c0, int lane) {
    const int i = lane & 15, r0 = s0 + (i >> 2), r1 = r0 + 4, cb = (c0 + 4 * (i & 3)) * 2;
    const int a0 = ROWB == 256 ? trswz256(r0, cb) : trswz128(r0, cb), a1 = ROWB == 256 ? trswz256(r1, cb) : trswz128(r1, cb);
    const v4i16_t lo = __builtin_amdgcn_ds_read_tr16_b64_v4i16((LAS v4i16_t*)(tile + a0)), hi = __builtin_amdgcn_ds_read_tr16_b64_v4i16((LAS v4i16_t*)(tile + a1));
    return (bf16x8){lo[0], lo[1], lo[2], lo[3], hi[0], hi[1], hi[2], hi[3]};
}
__device__ __forceinline__ void gla_item(Frame& F, int item) {
    const int b = item >> 3, h = (item >> 1) & 3, dir = item & 1;
    LAS unsigned char* QD = F.lds; LAS unsigned char* KD = F.lds + 16384; LAS unsigned char* KT = F.lds + 32768  ; LAS unsigned char* VR = F.lds + 49152  ;
    LAS unsigned char* PS = F.lds + 65536; LAS unsigned char* ST = F.lds + 73728  ; LAS float* LF = (LAS float*)(F.lds + 106496); LAS float* SEGT = (LAS float*)(F.lds + 139264); LAS float* DEC = (LAS float*)(F.lds + 141312);
    const int tid = F.tid, lane = F.lane, wave = F.wave, fr = lane & 15, fq = lane >> 4;
    const int t0 = tid >> 4, c = tid & 15, tv = tid >> 3, cv = tid & 7;
    const bf16_t* px = (const bf16_t*)(F.ws + WS_PX0);
    bf16_t* og = (bf16_t*)(F.ws + WS_OG) + (size_t)dir * R * 512;
    float lbv[8], oml[8];
    { const float* lg = F.ka->in[I_EVLB] + h * 128 + 8 * c;
#pragma unroll
      for (int e = 0; e < 8; ++e) { lbv[e] = 1.0f / (1.0f + __expf(lg[512 + e] - lg[e])); oml[e] = 1.0f - lbv[e]; } }
    { u32x4 z = {0u, 0u, 0u, 0u};
#pragma unroll
      for (int i = 0; i < 4; ++i) *(LAS u32x4*)(ST + tid * 64 + 16 * i) = z; }
    f32x4 S[8];
#pragma unroll
    for (int i = 0; i < 8; ++i) S[i] = (f32x4){0.f, 0.f, 0.f, 0.f};
    auto chunk_p0 = [&](int j) { return dir == 0 ? 64 * j : (j < 4 ? 192 - 64 * j : PB - 64 * (j - 3)); };
    auto row_of = [&](int p0, int tau) { return b * PB + (dir == 0 ? p0 + tau : p0 + 63 - tau); };
    u32x4 rqA[2], rfA[2], rvA[2];
#define GLA_LOAD(j, RQ, RF, RV) do { const int p0_ = chunk_p0(j); \
        _Pragma("unroll") for (int i_ = 0; i_ < 2; ++i_) { const bf16_t* rp_ = px + (size_t)row_of(p0_, t0 + 32 * i_) * EVIN + h * 128 + 8 * c; RQ[i_] = *(const u32x4*)rp_; RF[i_] = *(const u32x4*)(rp_ + 512 * (1 + dir)); } \
        { const bf16_t* vp_ = px + (size_t)row_of(p0_, tv) * EVIN + 1536 + h * 128 + 8 * cv; RV[0] = *(const u32x4*)vp_; RV[1] = *(const u32x4*)(vp_ + 64); } } while (0)
    GLA_LOAD(0, rqA, rfA, rvA);
    __syncthreads();
    const int ti = wave & 3, sp = wave >> 2, ki = wave;
#define GLA_STEP(j, RQ, RF, RV) do { \
        const int p0 = chunk_p0(j); float qv[2][8], kv[2][8]; const u32x4 vraw0 = RV[0], vraw1 = RV[1]; \
        _Pragma("unroll") for (int i = 0; i < 2; ++i) { const int tau = t0 + 32 * i; float lf[8]; \
            _Pragma("unroll") for (int e = 0; e < 4; ++e) { const unsigned wq = RQ[i][e], wf = RF[i][e]; \
                qv[i][2 * e] = bflo(wq); qv[i][2 * e + 1] = bfhi(wq); \
                const float s0_ = sigmoidf_(bflo(wf)), s1_ = sigmoidf_(bfhi(wf)); \
                const float f0 = lbv[2 * e] + oml[2 * e] * s0_, f1 = lbv[2 * e + 1] + oml[2 * e + 1] * s1_; \
                kv[i][2 * e] = 1.0f - f0; kv[i][2 * e + 1] = 1.0f - f1; lf[2 * e] = lg2(f0); lf[2 * e + 1] = lg2(f1); } \
            *(LAS f32x4*)(LF + tau * 128 + 8 * c) = (f32x4){lf[0], lf[1], lf[2], lf[3]}; *(LAS f32x4*)(LF + tau * 128 + 8 * c + 4) = (f32x4){lf[4], lf[5], lf[6], lf[7]}; } \
        if ((j) + 1 < 36) GLA_LOAD((j) + 1, RQ, RF, RV); \
        __syncthreads(); \
        { const int k = tid & 127, sg = tid >> 7; float run = 0.f; \
          _Pragma("unroll") for (int i = 0; i < 16; ++i) { const int idx = (16 * sg + i) * 128 + k; run += LF[idx]; LF[idx] = run; } \
          SEGT[sg * 128 + k] = run; } \
        __syncthreads(); \
        { float seg[4][8]; float ebl[8]; \
          _Pragma("unroll") for (int s = 0; s < 4; ++s) { const f32x4 a0 = *(const LAS f32x4*)(SEGT + s * 128 + 8 * c), a1 = *(const LAS f32x4*)(SEGT + s * 128 + 8 * c + 4); \
              _Pragma("unroll") for (int e = 0; e < 4; ++e) { seg[s][e] = a0[e]; seg[s][4 + e] = a1[e]; } } \
          float offr[2][8]; const bool odd = (t0 >> 4) != 0; \
          _Pragma("unroll") for (int e = 0; e < 8; ++e) { ebl[e] = ex2((seg[0][e] + seg[1][e]) + (seg[2][e] + seg[3][e])); offr[0][e] = odd ? seg[0][e] : 0.f; offr[1][e] = (seg[0][e] + seg[1][e]) + (odd ? seg[2][e] : 0.f); } \
          _Pragma("unroll") for (int i = 0; i < 2; ++i) { const int tau = t0 + 32 * i; \
              const f32x4 c0 = *(const LAS f32x4*)(LF + tau * 128 + 8 * c), c1 = *(const LAS f32x4*)(LF + tau * 128 + 8 * c + 4); \
              float qd[8], kd[8], kt[8]; \
              _Pragma("unroll") for (int e = 0; e < 8; ++e) { \
                  const float bb = (e < 4 ? c0[e] : c1[e - 4]) + offr[i][e]; const float eb = ex2(bb); \
                  qd[e] = qv[i][e] * eb; kd[e] = kv[i][e] * __builtin_amdgcn_rcpf(eb); kt[e] = kd[e] * ebl[e]; } \
              u32x4 w; w.x = cvtpk(qd[0], qd[1]); w.y = cvtpk(qd[2], qd[3]); w.z = cvtpk(qd[4], qd[5]); w.w = cvtpk(qd[6], qd[7]); \
              *(LAS u32x4*)(QD + tau * 256 + ((c ^ (tau & 15)) << 4)) = w; \
              w.x = cvtpk(kd[0], kd[1]); w.y = cvtpk(kd[2], kd[3]); w.z = cvtpk(kd[4], kd[5]); w.w = cvtpk(kd[6], kd[7]); \
              *(LAS u32x4*)(KD + tau * 256 + ((c ^ (tau & 15)) << 4)) = w; \
              w.x = cvtpk(kt[0], kt[1]); w.y = cvtpk(kt[2], kt[3]); w.z = cvtpk(kt[4], kt[5]); w.w = cvtpk(kt[6], kt[7]); \
              *(LAS u32x4*)(KT + trswz256(tau, 16 * c)) = w; } \
          *(LAS u32x4*)(VR + trswz256(tv, 16 * cv)) = vraw0; *(LAS u32x4*)(VR + trswz256(tv, 16 * (cv + 8))) = vraw1; \
          if (tid < 128) DEC[tid] = ex2((SEGT[tid] + SEGT[128 + tid]) + (SEGT[256 + tid] + SEGT[384 + tid])); } \
        __syncthreads(); \
        bf16x8 bq[4]; \
        _Pragma("unroll") for (int ks = 0; ks < 4; ++ks) bq[ks] = lds_frag256(QD, 16 * ti + fr, ks * 4 + fq); \
        _Pragma("unroll") for (int u = 0; u < 2; ++u) { const int si = 2 * sp + u; f32x4 a = {0.f, 0.f, 0.f, 0.f}; \
            _Pragma("unroll") for (int ks = 0; ks < 4; ++ks) a = MFMA16(lds_frag256(KD, 16 * si + fr, ks * 4 + fq), bq[ks], a); \
            const int tt = 16 * ti + fr, s0 = 16 * si + 4 * fq; \
            u32x2 w; w.x = cvtpk(s0 <= tt ? a[0] : 0.f, s0 + 1 <= tt ? a[1] : 0.f); w.y = cvtpk(s0 + 2 <= tt ? a[2] : 0.f, s0 + 3 <= tt ? a[3] : 0.f); \
            *(LAS u32x2*)(PS + tt * 128 + ((2 * s0) ^ ((tt & 7) << 4))) = w; } \
        f32x4 oacc[4]; \
        _Pragma("unroll") for (int u = 0; u < 4; ++u) { const int vi = 4 * sp + u; f32x4 o = {0.f, 0.f, 0.f, 0.f}; \
            _Pragma("unroll") for (int ks = 0; ks < 4; ++ks) o = MFMA16(lds_frag256(ST, 16 * vi + fr, ks * 4 + fq), bq[ks], o); \
            oacc[u] = o; } \
        { const f32x4 dk = *(const LAS f32x4*)(DEC + 16 * ki + 4 * fq); \
          bf16x8 ak[2]; \
          _Pragma("unroll") for (int ks = 0; ks < 2; ++ks) ak[ks] = lds_trfrag<256>(KT, 32 * ks + 8 * fq, 16 * ki, lane); \
          _Pragma("unroll") for (int vi = 0; vi < 8; ++vi) { f32x4 s = S[vi] * dk; \
              _Pragma("unroll") for (int ks = 0; ks < 2; ++ks) s = MFMA16(ak[ks], lds_trfrag<256>(VR, 32 * ks + 8 * fq, 16 * vi, lane), s); \
              S[vi] = s; } } \
        __syncthreads(); \
        { bf16x8 bp[2]; \
          _Pragma("unroll") for (int ks = 0; ks < 2; ++ks) bp[ks] = lds_frag128(PS, 16 * ti + fr, ks * 4 + fq); \
          const int orow = row_of(p0, 16 * ti + fr); \
          _Pragma("unroll") for (int u = 0; u < 4; ++u) { const int vi = 4 * sp + u; f32x4 o = oacc[u]; \
              _Pragma("unroll") for (int ks = 0; ks < 2; ++ks) o = MFMA16(lds_trfrag<256>(VR, 32 * ks + 8 * fq, 16 * vi, lane), bp[ks], o); \
              u32x2 w; w.x = cvtpk(o[0], o[1]); w.y = cvtpk(o[2], o[3]); \
              *(u32x2*)(og + (size_t)orow * 512 + h * 128 + 16 * vi + 4 * fq) = w; } \
          _Pragma("unroll") for (int vi = 0; vi < 8; ++vi) { const int v = 16 * vi + fr, k0 = 16 * ki + 4 * fq; u32x2 w; w.x = cvtpk(S[vi][0], S[vi][1]); w.y = cvtpk(S[vi][2], S[vi][3]); \
              *(LAS u32x2*)(ST + v * 256 + ((2 * k0) ^ ((v & 15) << 4))) = w; } } \
    } while (0)
    for (int j = 0; j < 36; ++j) { GLA_STEP(j, rqA, rfA, rvA); }
    __syncthreads();
#undef GLA_LOAD
#undef GLA_STEP
}

__device__ __forceinline__ void sgu_item(Frame& F, int ci) {
    LAS unsigned char* VN = F.lds; LAS unsigned char* WS = F.lds + 32768;
    const int tid = F.tid, lane = F.lane, wave = F.wave, fr = lane & 15, fq = lane >> 4;
    const int r0 = ci * 128, row = tid >> 2, q = tid & 3;
    const bf16_t* px = (const bf16_t*)(F.ws + WS_PX0); unsigned char* mix = F.ws + WS_MIX;
    const bf16_t* vrow = px + (size_t)(r0 + row) * EVIN + 3072 + 32 * q;
    float sum = 0.f, sq = 0.f;
    { u32x4 vr[16];
#pragma unroll
      for (int j = 0; j < 4; ++j)
#pragma unroll
        for (int i = 0; i < 4; ++i) vr[4 * j + i] = *(const u32x4*)(vrow + 128 * j + 8 * i);
#pragma unroll
      for (int i = 0; i < 16; ++i) {
#pragma unroll
        for (int e = 0; e < 4; ++e) { const float a = geluf_(bflo(vr[i][e])), bb = geluf_(bfhi(vr[i][e])); sum += a + bb; sq += a * a + bb * bb; } } }
    sum += __shfl_xor(sum, 1); sum += __shfl_xor(sum, 2); sq += __shfl_xor(sq, 1); sq += __shfl_xor(sq, 2);
    const float mean = sum * (1.0f / 512.0f), rstd = __builtin_amdgcn_rsqf(fmaxf(sq * (1.0f / 512.0f) - mean * mean, 0.f) + RMS_EPS);
    u32x4 vg[4]; f32x4 wsr[8];
#define SGU_LOADG(g) do { const float* wsg_ = F.ka->in[I_EVWS] + (size_t)(g) * 128 * 128; _Pragma("unroll") for (int it_ = 0; it_ < 4; ++it_) { const int idx_ = tid + 512 * it_; \
        wsr[2 * it_] = *(const f32x4*)(wsg_ + (idx_ >> 4) * 128 + 8 * (idx_ & 15)); wsr[2 * it_ + 1] = *(const f32x4*)(wsg_ + (idx_ >> 4) * 128 + 8 * (idx_ & 15) + 4); } \
        _Pragma("unroll") for (int i_ = 0; i_ < 4; ++i_) vg[i_] = *(const u32x4*)(vrow + 128 * (g) + 8 * i_); } while (0)
    SGU_LOADG(0);
#pragma unroll 1
    for (int g = 0; g < 4; ++g) {
        const float* gain = F.ka->in[I_EVSGUG] + 128 * g + 32 * q;
#pragma unroll
        for (int i = 0; i < 4; ++i) { const u32x4 w = vg[i]; const f32x4 g0 = *(const f32x4*)(gain + 8 * i), g1 = *(const f32x4*)(gain + 8 * i + 4);
            u32x4 o;
            o.x = cvtpk((geluf_(bflo(w.x)) - mean) * rstd * g0[0], (geluf_(bfhi(w.x)) - mean) * rstd * g0[1]); o.y = cvtpk((geluf_(bflo(w.y)) - mean) * rstd * g0[2], (geluf_(bfhi(w.y)) - mean) * rstd * g0[3]);
            o.z = cvtpk((geluf_(bflo(w.z)) - mean) * rstd * g1[0], (geluf_(bfhi(w.z)) - mean) * rstd * g1[1]); o.w = cvtpk((geluf_(bflo(w.w)) - mean) * rstd * g1[2], (geluf_(bfhi(w.w)) - mean) * rstd * g1[3]);
            *(LAS u32x4*)(VN + trswz256(row, (32 * q + 8 * i) * 2)) = o; }
#pragma unroll
        for (int it = 0; it < 4; ++it) { const int idx = tid + 512 * it, t = idx >> 4, ch = idx & 15; const f32x4 a = wsr[2 * it], bb = wsr[2 * it + 1];
            u32x4 w; w.x = cvtpk(a[0], a[1]); w.y = cvtpk(a[2], a[3]); w.z = cvtpk(bb[0], bb[1]); w.w = cvtpk(bb[2], bb[3]);
            *(LAS u32x4*)(WS + t * 256 + ((ch ^ (t & 15)) << 4)) = w; }
        __syncthreads();
        if (g < 3) SGU_LOADG(g + 1);
        const int c0 = 128 * g + 16 * wave + 4 * fq;
        u32x2 uw[8]; float bsv[8];
#pragma unroll
        for (int tt = 0; tt < 8; ++tt) { const int t = 16 * tt + fr; uw[tt] = *(const u32x2*)(px + (size_t)(r0 + t) * EVIN + 2560 + c0); bsv[tt] = F.ka->in[I_EVBS][g * 128 + t]; }
        bf16x8 av[4];
#pragma unroll
        for (int ks = 0; ks < 4; ++ks) av[ks] = lds_trfrag<256>(VN, 32 * ks + 8 * fq, 16 * wave, lane);
#pragma unroll
        for (int tt = 0; tt < 8; ++tt) { f32x4 a = {0.f, 0.f, 0.f, 0.f};
#pragma unroll
            for (int ks = 0; ks < 4; ++ks) a = MFMA16(av[ks], lds_frag256(WS, 16 * tt + fr, ks * 4 + fq), a);
            const int t = 16 * tt + fr; const float bs = bsv[tt]; const u32x2 u2 = uw[tt];
            *(unsigned*)(mix + (size_t)(r0 + t) * DM + 512 + c0) = pk4_fp8(geluf_(bflo(u2.x)) * (a[0] + bs) * S8_M, geluf_(bfhi(u2.x)) * (a[1] + bs) * S8_M, geluf_(bflo(u2.y)) * (a[2] + bs) * S8_M, geluf_(bfhi(u2.y)) * (a[3] + bs) * S8_M); }
        __syncthreads();
    }
#undef SGU_LOADG
}
constexpr int MOE_L1_SPLIT = 3584;
__device__ __forceinline__ void p3_mixers(Frame& F) {
    const int half = F.G >> 1;
    if (F.vcu < half) { for (int rep_ = 0; rep_ < 1 + ((REPMASK >> 21) & 1); ++rep_) for (int it = F.vcu; it < 128; it += half) gla_item(F, it); }
    else { for (int rep_ = 0; rep_ < 1 + ((REPMASK >> 22) & 1); ++rep_) for (int ci = F.vcu - half; ci < R / 128; ci += F.G - half) sgu_item(F, ci);
        moe_l0_dn_convert(F, (F.vcu - half) * 8 + F.wave, (F.G - half) * 8);
        moe_l1_convert(F, 0, MOE_L1_SPLIT, (F.vcu - half) * 8 + F.wave, (F.G - half) * 8); }
}
__device__ __forceinline__ void p3b_hgrn_out(Frame& F) {
    const int gw = F.vcu * 8 + F.wave, NGW = F.G * 8; const bf16_t* og = (const bf16_t*)(F.ws + WS_OG); const bf16_t* px = (const bf16_t*)(F.ws + WS_PX0); unsigned char* mix = F.ws + WS_MIX;
    const int c0 = 8 * F.lane; float gn[8];
#pragma unroll
    for (int e = 0; e < 8; ++e) gn[e] = F.ka->in[I_EVONORM][(c0 & 127) + e] * S8_M;
    for (int row = gw; row < R; row += NGW) {
        const u32x4 a = *(const u32x4*)(og + (size_t)row * 512 + c0), bb = *(const u32x4*)(og + (size_t)(R + row) * 512 + c0), gg = *(const u32x4*)(px + (size_t)row * EVIN + 2048 + c0);
        float o[8]; float ss = 0.f;
#pragma unroll
        for (int e = 0; e < 4; ++e) { o[2 * e] = bflo(a[e]) + bflo(bb[e]); o[2 * e + 1] = bfhi(a[e]) + bfhi(bb[e]); ss += o[2 * e] * o[2 * e] + o[2 * e + 1] * o[2 * e + 1]; }
        ss += __shfl_xor(ss, 1); ss += __shfl_xor(ss, 2); ss += __shfl_xor(ss, 4); ss += __shfl_xor(ss, 8);
        const float rstd = __builtin_amdgcn_rsqf(ss * (1.0f / 128.0f) + RMS_EPS);
        float y[8];
#pragma unroll
        for (int e = 0; e < 4; ++e) { y[2 * e] = o[2 * e] * rstd * gn[2 * e] * siluf_(bflo(gg[e])); y[2 * e + 1] = o[2 * e + 1] * rstd * gn[2 * e + 1] * siluf_(bfhi(gg[e])); }
        u32x2 w; w.x = pk4_fp8(y[0], y[1], y[2], y[3]); w.y = pk4_fp8(y[4], y[5], y[6], y[7]);
        *(u32x2*)(mix + (size_t)row * DM + c0) = w;
    }
}

__device__ __forceinline__ void p10_kr(Frame& F) {
    const int gw = F.vcu * 8 + F.wave, NGW = F.G * 8; const bf16_t* px1 = (const bf16_t*)(F.ws + WS_PX1); unsigned char* kb = F.ws + WS_KB;
    const int d = F.lane, i16 = d & 15; const float invf = __expf(-(float)i16 * (2.0f / 32.0f) * 9.210340371976184f);
    for (int row = gw; row < R; row += NGW) {
        const int pos = row % PB; float x = bf2f(px1[(size_t)row * CINP + 640 + d]);
        const float xo = __shfl_xor(x, 16);
        if (pos >= CTXL) { const int t = pos - CTXL; const float p = (d < 32) ? (float)(t >> 6) : (float)(t & 63); const float ang = p * invf, cs = __cosf(ang), sn = __sinf(ang);
            x = (d & 16) ? (xo * sn + x * cs) : (x * cs - xo * sn); }
        const unsigned char hb = (unsigned char)(pk4_fp8(x * S8_K, 0.f, 0.f, 0.f) & 0xffu);
#pragma unroll
        for (int h = 0; h < 8; ++h) kb[(size_t)row * NQ + h * 192 + 128 + d] = hb;
    }
}

namespace att {
constexpr int KVBLK = 64, SHM_V = 128 * 64, SHM_K = 64 * 192;
constexpr float THR = 8.0f;
#define KSWZ192(row, colB) ((row) * 384 + ((colB) ^ (((row) & 7) << 4)))
__device__ __forceinline__ int crow(int r, int hi) { return (r & 3) + 8 * (r >> 2) + 4 * hi; }
template <bool FIRST>
__device__ __forceinline__ void partialSM(f32x16& p0, f32x16& p1, float& m_reg, f32x16& negm, float& alpha) {
    float pmax = p0[0];
#pragma unroll
    for (int r = 1; r < 16; ++r) pmax = fmaxf(pmax, p0[r]);
#pragma unroll
    for (int r = 0; r < 16; ++r) pmax = fmaxf(pmax, p1[r]);
    { auto rr = __builtin_amdgcn_permlane32_swap(__float_as_uint(pmax), __float_as_uint(pmax), false, false); pmax = fmaxf(__uint_as_float(rr[0]), __uint_as_float(rr[1])); }
    if (!FIRST && __builtin_expect(__all(pmax <= THR), 1)) { alpha = 1.f; }
    else { const float d = FIRST ? pmax : fmaxf(pmax, 0.f); alpha = FIRST ? 1.f : __builtin_amdgcn_exp2f(-d); m_reg += d;
#pragma unroll
        for (int r = 0; r < 16; ++r) { p0[r] -= d; p1[r] -= d; negm[r] = -m_reg; } }
#pragma unroll
    for (int r = 0; r < 16; ++r) p0[r] = __builtin_amdgcn_exp2f(p0[r]);
}
__device__ __forceinline__ void finishSM(f32x16& p0, f32x16& p1, float alpha, float& l_reg, i32x8_t& pa) {
#pragma unroll
    for (int r = 0; r < 16; ++r) p1[r] = __builtin_amdgcn_exp2f(p1[r]);
    float ps = 0;
#pragma unroll
    for (int r = 0; r < 16; ++r) ps += p0[r];
#pragma unroll
    for (int r = 0; r < 16; ++r) ps += p1[r];
    { auto rr = __builtin_amdgcn_permlane32_swap(__float_as_uint(ps), __float_as_uint(ps), false, false); ps = __uint_as_float(rr[0]) + __uint_as_float(rr[1]); }
    l_reg = l_reg * alpha + ps;
#pragma unroll
    for (int k = 0; k < 4; ++k) { pa[k] = (int)pk4_fp8_nc(p0[4 * k], p0[4 * k + 1], p0[4 * k + 2], p0[4 * k + 3]); pa[4 + k] = (int)pk4_fp8_nc(p1[4 * k], p1[4 * k + 1], p1[4 * k + 2], p1[4 * k + 3]); }
}
__device__ __forceinline__ void kload1(i32x8_t (&a)[2], const LAS unsigned char* const (&kb)[3][2], const int boff, const int m) {
    a[0] = __builtin_shufflevector(*(const LAS i32x4_t*)(kb[m][0] + boff), *(const LAS i32x4_t*)(kb[m][1] + boff), 0, 1, 2, 3, 4, 5, 6, 7);
    a[1] = __builtin_shufflevector(*(const LAS i32x4_t*)(kb[m][0] + boff + 6144), *(const LAS i32x4_t*)(kb[m][1] + boff + 6144), 0, 1, 2, 3, 4, 5, 6, 7);
}
__device__ __forceinline__ void kload01(i32x8_t (&a0)[2], i32x8_t (&a1)[2], const LAS unsigned char* const (&kb)[3][2], const int boff) { kload1(a0, kb, boff, 0); kload1(a1, kb, boff, 1); }
__device__ __forceinline__ void qmma(f32x16& p0, f32x16& p1, i32x8_t (&a0)[2], i32x8_t (&a1)[2], const LAS unsigned char* const (&kb)[3][2], const int boff, const i32x8_t* qr, const f32x16& negm) {
    constexpr int SA = 0x7d7d7d7d, SB = 0x76767676;
    static_assert(S8_Q * S8_K == 2048.f, "block scales assume 2^11");
    p0 = __builtin_amdgcn_mfma_scale_f32_32x32x64_f8f6f4(a0[0], qr[0], negm, 0, 0, 0, SA, 0, SB);
    p1 = __builtin_amdgcn_mfma_scale_f32_32x32x64_f8f6f4(a0[1], qr[0], negm, 0, 0, 0, SA, 0, SB);
    i32x8_t a2[2]; kload1(a2, kb, boff, 2);
    p0 = __builtin_amdgcn_mfma_scale_f32_32x32x64_f8f6f4(a1[0], qr[1], p0, 0, 0, 0, SA, 0, SB);
    p1 = __builtin_amdgcn_mfma_scale_f32_32x32x64_f8f6f4(a1[1], qr[1], p1, 0, 0, 0, SA, 0, SB);
    p0 = __builtin_amdgcn_mfma_scale_f32_32x32x64_f8f6f4(a2[0], qr[2], p0, 0, 0, 0, SA, 0, SB);
    p1 = __builtin_amdgcn_mfma_scale_f32_32x32x64_f8f6f4(a2[1], qr[2], p1, 0, 0, 0, SA, 0, SB);
    asm volatile("" : "+v"(p0), "+v"(p1));
    SBAR();
}
__device__ __forceinline__ void qkt(f32x16& p0, f32x16& p1, const LAS unsigned char* const (&kb)[3][2], const int boff, const i32x8_t* qr, const f32x16& negm) {
    i32x8_t a0[2], a1[2]; kload01(a0, a1, kb, boff); qmma(p0, p1, a0, a1, kb, boff, qr, negm);
}
__device__ __forceinline__ void pv_d0(f32x16* o, const LAS unsigned char* vt, int vo0, int vo1, const i32x8_t pa) {
#pragma unroll
    for (int d0 = 0; d0 < 4; ++d0) {
        const i32x8_t vf = __builtin_shufflevector(*(const LAS i32x4_t*)(vt + vo0 + d0 * 2048), *(const LAS i32x4_t*)(vt + vo1 + d0 * 2048), 0, 1, 2, 3, 4, 5, 6, 7);
        o[d0] = __builtin_amdgcn_mfma_scale_f32_32x32x64_f8f6f4(pa, vf, o[d0], 0, 0, 0, 0x7d7d7d7d, 0, 0x7d7d7d7d);
        SBAR(); }
    static_assert(S8_V == 16.f, "block scale assumes 2^4");
}
constexpr int NSLOT = 3, LDS_KR = NSLOT * SHM_V  , LDS_WS = NSLOT * (SHM_V + SHM_K);
__device__ __forceinline__ void attn_unit(const int tid, const unsigned char* __restrict__ Qb, const unsigned char* __restrict__ Kh, const unsigned char* __restrict__ Vh, unsigned char* __restrict__ Ob, LAS unsigned char* lds) {
    const int wid = __builtin_amdgcn_readfirstlane(tid >> 6), lane = tid & 63, r32 = lane & 31, hi = lane >> 5;
    LAS unsigned char* V_lds = lds; LAS unsigned char* K_lds = lds + LDS_KR;
    LAS float* ws = (LAS float*)(lds + LDS_WS) + wid * 64; LAS float* li_l = ws; LAS float* al_l = ws + 32;
    float m_reg = 0.f, l_reg = 0; f32x16 negm = {}; f32x16 o[4] = {}; i32x8_t qr[3];
    const unsigned char* Qw = Qb + (size_t)(wid * 32 + r32) * NQ + hi * 32;
#pragma unroll
    for (int m = 0; m < 3; ++m) qr[m] = __builtin_shufflevector(*(const i32x4_t*)(Qw + 64 * m), *(const i32x4_t*)(Qw + 64 * m + 16), 0, 1, 2, 3, 4, 5, 6, 7);
    unsigned kgo[2], vgo;
#pragma unroll
    for (int i = 0; i < 2; ++i) { const int q = (8 * i + wid) * 64 + lane, row = q / 12, chp = q % 12, ch = (chp & ~3) | ((chp ^ (row >> 2)) & 3); kgo[i] = (unsigned)(row * NQ + ch * 16); }
    { const int q = wid * 64 + lane, d = q >> 2, ch = (q & 3) ^ ((d >> 2) & 3); vgo = (unsigned)d * (unsigned)R + 16u * (unsigned)ch; }
    const int vo0 = r32 * 64 + (((2 * hi) ^ ((r32 >> 2) & 3)) << 4), vo1 = r32 * 64 + (((2 * hi + 1) ^ ((r32 >> 2) & 3)) << 4);
    const LAS unsigned char* kb[3][2];
    { const LAS unsigned char* k0_ = K_lds + r32 * 192 + ((32 * hi) ^ (((r32 >> 2) & 3) << 4)); const LAS unsigned char* k1_ = K_lds + r32 * 192 + ((32 * hi + 16) ^ (((r32 >> 2) & 3) << 4));
#pragma unroll
      for (int m = 0; m < 3; ++m) { kb[m][0] = k0_ + 64 * m; kb[m][1] = k1_ + 64 * m; } }
    const __amdgpu_buffer_rsrc_t rsK = __builtin_amdgcn_make_buffer_rsrc((void*)Kh, 0, 0x7fffffff, 0x00020000), rsV = __builtin_amdgcn_make_buffer_rsrc((void*)Vh, 0, 0x7fffffff, 0x00020000);
#define DMA_K(t, slot) do { const int so_ = (t) * (KVBLK * NQ); \
    __builtin_amdgcn_raw_ptr_buffer_load_lds(rsK, (LAS unsigned*)(K_lds + (slot) * SHM_K + wid * 1024), 16, (int)kgo[0], so_, 0, 0); \
    if (wid < 4) __builtin_amdgcn_raw_ptr_buffer_load_lds(rsK, (LAS unsigned*)(K_lds + (slot) * SHM_K + (8 + wid) * 1024), 16, (int)kgo[1], so_, 0, 0); } while (0)
#define DMA_V(t, slot) do { __builtin_amdgcn_raw_ptr_buffer_load_lds(rsV, (LAS unsigned*)(V_lds + (slot) * SHM_V + wid * 1024), 16, (int)vgo, (t) * KVBLK, 0, 0); } while (0)
#define RESC(a) do { if (__any((a) < 1.f)) { int l_ = threadIdx.x & 63; asm volatile("" : "+v"(l_));              \
    LAS float* al_ = (LAS float*)(lds + LDS_WS) + wid * 64 + 32; if (l_ < 32) al_[l_] = (a); asm volatile("s_waitcnt lgkmcnt(0)" ::: "memory"); const LAS float* alh_ = al_ + 4 * (l_ >> 5); \
    _Pragma("unroll") for (int d_ = 0; d_ < 4; ++d_) _Pragma("unroll") for (int r_ = 0; r_ < 16; ++r_) o[d_][r_] *= alh_[crow(r_, 0)]; } } while (0)
#define WAITBAR() do { asm volatile("s_waitcnt vmcnt(0)" ::: "memory"); __syncthreads(); } while (0)
#define WAITBAR3() do { if (wid < 4) asm volatile("s_waitcnt vmcnt(2) lgkmcnt(0)" ::: "memory"); else asm volatile("s_waitcnt vmcnt(1) lgkmcnt(0)" ::: "memory"); __builtin_amdgcn_s_barrier(); asm volatile("" ::: "memory"); } while (0)
    f32x16 pA0, pA1, pB0, pB1; float mnA, mnB, alA, alB; i32x8_t pa; constexpr int NT = PB / KVBLK;
    int s0 = 0, s1 = 1, s2 = 2;
    DMA_K(0, 0); DMA_V(0, 0); DMA_K(1, 1); WAITBAR();
    DMA_K(2, 2); DMA_V(1, 1);
    qkt(pA0, pA1, kb, 0, qr, negm); partialSM<true>(pA0, pA1, m_reg, negm, alA); RESC(alA);
    WAITBAR();
#define STEP(PC0, PC1, mnC, alC, PP0, PP1, alP, t) do { \
        { const int tmp_ = s0; s0 = s1; s1 = s2; s2 = tmp_; }              \
        SBAR(); \
        if ((t) + 2 < NT) DMA_K((t) + 2, s2);                               \
        { i32x8_t ka0_[2], ka1_[2]; kload01(ka0_, ka1_, kb, s0 * SHM_K); SBAR();     \
          finishSM(PP0, PP1, alP, l_reg, pa); SBAR(); \
          qmma(PC0, PC1, ka0_, ka1_, kb, s0 * SHM_K, qr, negm); } \
        pv_d0(o, V_lds + s2 * SHM_V, vo0, vo1, pa);                        \
        partialSM<false>(PC0, PC1, m_reg, negm, alC); \
        RESC(alC); \
        if ((t) + 2 < NT) WAITBAR3(); else WAITBAR(); \
        if ((t) + 1 < NT) DMA_V((t) + 1, s1);                               \
    } while (0)
    for (int t = 1; t + 1 < NT; t += 2) {
        STEP(pB0, pB1, mnB, alB, pA0, pA1, alA, t);
        STEP(pA0, pA1, mnA, alA, pB0, pB1, alB, t + 1);
    }
    STEP(pB0, pB1, mnB, alB, pA0, pA1, alA, NT - 1);
    { const int tmp_ = s0; s0 = s1; s1 = s2; s2 = tmp_; }
    finishSM(pB0, pB1, alB, l_reg, pa); SBAR();
    pv_d0(o, V_lds + s2 * SHM_V, vo0, vo1, pa);
    { int l_ = threadIdx.x & 63; asm volatile("" : "+v"(l_)); if (l_ < 32) ((LAS float*)(lds + LDS_WS) + wid * 64)[l_] = l_reg; } asm volatile("s_waitcnt lgkmcnt(0)" ::: "memory");
    __syncthreads();
    int lane2 = threadIdx.x & 63; asm volatile("" : "+v"(lane2));
    const int hi2 = lane2 >> 5, r322 = lane2 & 31;
    LAS unsigned char* stg = lds + wid * 4096;
    LAS unsigned char* stg_l = stg + 4 * hi2 * 128 + r322; const LAS float* li_hi = li_l + 4 * hi2;
#pragma unroll
    for (int r = 0; r < 16; ++r) { const float rl = __builtin_amdgcn_rcpf(li_hi[crow(r, 0)]) * S8_O;
        const unsigned pk = pk4_fp8(o[0][r] * rl, o[1][r] * rl, o[2][r] * rl, o[3][r] * rl);
#pragma unroll
        for (int d0 = 0; d0 < 4; ++d0) stg_l[crow(r, 0) * 128 + d0 * 32] = (unsigned char)(pk >> (8 * d0)); }
    asm volatile("s_waitcnt lgkmcnt(0)" ::: "memory");
    unsigned char* Ow = Ob + (size_t)(wid * 32 + (lane2 >> 3)) * DM + (lane2 & 7) * 16; const LAS unsigned char* stg_r = stg + (lane2 >> 3) * 128 + (lane2 & 7) * 16;
#pragma unroll
    for (int i = 0; i < 4; ++i) { const u32x4 v = *(const LAS u32x4*)(stg_r + i * 8 * 128); *(u32x4*)(Ow + (size_t)(i * 8) * DM) = v; }
    __syncthreads();
#undef DMA_K
#undef DMA_V
#undef RESC
#undef WAITBAR
#undef WAITBAR3
#undef STEP
}
}
__device__ __forceinline__ void p11_attention(Frame& F) {
    const unsigned char* Q = F.ws + WS_Q; const unsigned char* K = F.ws + WS_KB; const unsigned char* V = F.ws + WS_VB; unsigned char* O = F.ws + WS_MIX;
    for (int i = 0; i < 4; ++i) {
        const int bh = (F.vcu >> 3) + 32 * i, qb = F.vcu & 7, b = bh >> 3, h = bh & 7;
        const size_t qrow = (size_t)b * PB + CTXL + qb * 256, krow = (size_t)b * PB;
        int t_ = threadIdx.x; asm volatile("" : "+v"(t_));
        att::attn_unit(t_, Q + qrow * NQ + h * 192, K + krow * NQ + h * 192, V + (size_t)(h * 128) * R + krow, O + qrow * DM + h * 128, F.lds);
    }
}

__device__ __forceinline__ void ka_launder(Frame& F) { asm volatile("" : "+s"(F.ka)); int t = threadIdx.x; asm volatile("" : "+v"(t)); F.tid = t; F.lane = t & 63; F.wave = __builtin_amdgcn_readfirstlane(t >> 6); }
#ifndef DBG_MODE
#define DBG_MODE 0
#endif
constexpr int NPH = 21;
__device__ __forceinline__ void moe_gemms(Frame& F, int layer, int which) {
    LAS int* pfx = (LAS int*)(F.lds + LDSCTL_OFF + 512); LAS unsigned char* tab = (LAS unsigned char*)(F.lds + LDSCTL_OFF + 768);
    { const unsigned* gc = (const unsigned*)(F.ws + WS_CTL) + CW_GC + 64 * layer;
      if (F.tid < 32) { int cnt = (int)gc[F.tid]; cnt = cnt > ECAP ? ECAP : cnt; pfx[F.tid + 1] = (cnt + 255) >> 8; }
      __syncthreads();
      if (F.tid == 0) { int sacc = 0; pfx[0] = 0; for (int e = 0; e < 32; ++e) { sacc += pfx[e + 1]; pfx[e + 1] = sacc; } }
      __syncthreads();
      { const int blk = F.tid; if (blk < pfx[32]) { int e = 0; while (pfx[e + 1] <= blk) ++e; tab[blk] = (unsigned char)e; } }
      __syncthreads(); }
    MoeSched S; S.pfx = pfx; S.tab = tab; S.nwg = __builtin_amdgcn_readfirstlane(pfx[32]) * 4; S.G = F.G; S.c = (int)blockIdx.x;
    const int* perm = (const int*)(F.ws + WS_ROUTE + RT_PERM);
    if (which == 0) {
        pg8::Gemm g{(const bf16_t*)(F.ws + WS_HX), (const bf16_t*)(F.ws + WS_WGU + (size_t)layer * 32 * 1024 * DM), DM / 2, DM / 2, DM / 2, perm};
        EpiSwiglu E{F.ws + WS_ACT};
        pg8::gemm_phase<EpiSwiglu, MoeSched, true, true>(F.lds, g, S, E);
    } else {
        pg8::Gemm g{(const bf16_t*)(F.ws + WS_ACT), (const bf16_t*)(F.ws + WS_WDN + (size_t)layer * 32 * DM * MFF), MFF / 2, MFF / 2, MFF / 2, nullptr};
        EpiScatter E{F.ws + WS_YS, perm};
        pg8::gemm_phase<EpiScatter, MoeSched, false, true>(F.lds, g, S, E);
    }
}
__global__ void __launch_bounds__(512, 2) mega_fwd(Args args) {
    extern __shared__ __attribute__((aligned(16))) unsigned char lds_raw[];
    Frame F;
    F.lds = (LAS unsigned char*)lds_raw;
    F.tid = threadIdx.x; F.lane = F.tid & 63; F.wave = __builtin_amdgcn_readfirstlane(F.tid >> 6);
    F.G = gridDim.x; { const int bx = blockIdx.x; F.vcu = (F.G % 8 == 0) ? (bx % 8) * (F.G / 8) + bx / 8 : bx; }
    F.ws = args.ws; F.out = args.out;
    F.ka = (const __attribute__((address_space(4))) Args*)__builtin_amdgcn_kernarg_segment_ptr();
    for (int u = F.tid; u < (LDS_BYTES - LDSCTL_OFF) / 4; u += 512) ((LAS unsigned*)(F.lds + LDSCTL_OFF))[u] = 0u;
    __syncthreads();
    volatile LAS unsigned* MISC = (volatile LAS unsigned*)(F.lds + MISC_OFF);
    unsigned* ctl = (unsigned*)(F.ws + WS_CTL);
    XcdBarrier bar; bar.bar = ctl + CW_BAR; bar.x = 0; bar.st = nullptr;
    if (!args.nobar) bar = xcd_barrier_post(ctl + CW_BAR, MISC + 8);
    const int lo = args.ph_lo, hi = args.ph_hi;
    const unsigned long long t_start = (STAMP_PHASE >= 0) ? __builtin_amdgcn_s_memrealtime() : 0ull;
#define IN(k) (lo <= (k) && (k) < hi)
#define SEAM(k) do { if (IN(k) && IN((k) + 1)) xcd_barrier(bar); \
    if (STAMP_PHASE == (k) && blockIdx.x == 0 && threadIdx.x == 0) { const unsigned long long t1_ = __builtin_amdgcn_s_memrealtime(); ((float*)(F.ws + WS_CTL))[2048] = (float)(t1_ - t_start) * 0.01f; } } while (0)
    constexpr int LAST = DBG_MODE == 0 ? 20 : DBG_MODE == 1 ? -1 : DBG_MODE == 2 ? 6 : DBG_MODE == 3 ? 11 : DBG_MODE == 4 ? 15 : DBG_MODE == 10 ? 2 : DBG_MODE == 11 ? 3 : 5;
#ifndef PHMASK
#define PHMASK 0x1fffff
#endif
#define RUN(k) (ka_launder(F), IN(k) && (k) <= LAST && ((PHMASK >> (k)) & 1))

    if (RUN(0)) for (int rep_ = 0; rep_ < 1 + ((REPMASK >> 0) & 1); ++rep_) p0_prologue(F);
    SEAM(0);
    if (RUN(1)) for (int rep_ = 0; rep_ < 1 + ((REPMASK >> 1) & 1); ++rep_) p0b_mod(F);
    SEAM(1);
    if (RUN(2)) for (int rep_ = 0; rep_ < 1 + ((REPMASK >> 2) & 1); ++rep_) p1_norm_input(F);
    SEAM(2);
    if (RUN(3)) for (int rep_ = 0; rep_ < 1 + ((REPMASK >> 3) & 1); ++rep_) { pg8::Gemm g{(const bf16_t*)(F.ws + WS_HX), (const bf16_t*)(F.ws + WS_WIN0), DM, DM, DM, nullptr}; TileSched<false> S; S.init(EVIN / 256, F.G, (int)blockIdx.x);
        EpiStoreBf16 E{(bf16_t*)(F.ws + WS_PX0), EVIN}; pg8::gemm_phase<EpiStoreBf16, TileSched<false>, false>(F.lds, g, S, E); }
    SEAM(3);
    if (RUN(4)) for (int rep_ = 0; rep_ < 1 + ((REPMASK >> 4) & 1); ++rep_) p3_mixers(F);
    SEAM(4);
    if (RUN(5)) for (int rep_ = 0; rep_ < 1 + ((REPMASK >> 5) & 1); ++rep_) { p3b_hgrn_out(F); perm_clear(F); }
    SEAM(5);
    if (RUN(6)) for (int rep_ = 0; rep_ < 1 + ((REPMASK >> 6) & 1); ++rep_) { pg8::Gemm g{(const bf16_t*)(F.ws + WS_MIX), (const bf16_t*)(F.ws + WS_WOUT0), DM / 2, DM / 2, DM / 2, nullptr}; TileSched<false> S; S.init(DM / 256, F.G, (int)blockIdx.x);
        EpiResidual E{&F, (bf16_t*)(F.ws + WS_XS), 0, true, 1.0f / (S8_M * S8_W1)}; pg8::gemm_phase<EpiResidual, TileSched<false>, false, true>(F.lds, g, S, E);
        { const int n3 = (NTILE * 4) % F.G;
          if (rep_ == 0 && (int)blockIdx.x >= n3) { ka_launder(F); moe_l1_convert(F, MOE_L1_SPLIT, MOE_W_ITEMS, ((int)blockIdx.x - n3) * 8 + F.wave, (F.G - n3) * 8); } } }
    SEAM(6);
    if (RUN(7)) for (int rep_ = 0; rep_ < 1 + ((REPMASK >> 7) & 1); ++rep_) p5_norm_route<false>(F, 0);
    SEAM(7);
    if (RUN(9)) for (int rep_ = 0; rep_ < 1 + ((REPMASK >> 9) & 1); ++rep_) moe_gemms(F, 0, 0);
    SEAM(9);
    if (RUN(10)) for (int rep_ = 0; rep_ < 1 + ((REPMASK >> 10) & 1); ++rep_) moe_gemms(F, 0, 1);
    SEAM(10);
    if (RUN(11)) for (int rep_ = 0; rep_ < 1 + ((REPMASK >> 11) & 1); ++rep_) { p8_combine_norm(F); perm_clear(F); }
    SEAM(11);
    if (RUN(12)) for (int rep_ = 0; rep_ < 1 + ((REPMASK >> 12) & 1); ++rep_) { pg8::Gemm g{(const bf16_t*)(F.ws + WS_HX), (const bf16_t*)(F.ws + WS_WIN1), DM / 2, DM / 2, DM / 2, nullptr}; TileSched<false> S; S.init(CINP / 256, F.G, (int)blockIdx.x);
        EpiStoreStats E{(bf16_t*)(F.ws + WS_PX1), CINP, (float*)(F.ws + WS_STATS), 1.0f / (S8_X * S8_W1)}; pg8::gemm_phase<EpiStoreStats, TileSched<false>, false, true>(F.lds, g, S, E); }
    SEAM(12);
    if (RUN(13)) for (int rep_ = 0; rep_ < 1 + ((REPMASK >> 13) & 1); ++rep_) {
        { pg8::Gemm g{(const bf16_t*)(F.ws + WS_PX1), (const bf16_t*)(F.ws + WS_WUQ), CINP, QRANK, QRANK, nullptr}; TileSched<true> S; S.init(NQ / 256, F.G, (int)blockIdx.x);
          EpiQ E{F.ws + WS_Q, (const float*)(F.ws + WS_STATS)}; pg8::gemm_phase<EpiQ, TileSched<true>, false>(F.lds, g, S, E); }
        { pg8::Gemm g{(const bf16_t*)(F.ws + WS_PX1) + QRANK, (const bf16_t*)(F.ws + WS_WUKV), CINP, KVRANK, KVRANK, nullptr}; TileSched<false> S; S.init(1024 / 256, F.G, (int)blockIdx.x);
          EpiK E{F.ws + WS_KB, (const float*)(F.ws + WS_STATS)}; pg8::gemm_phase<EpiK, TileSched<false>, false>(F.lds, g, S, E); }
        { pg8::Gemm g{(const bf16_t*)(F.ws + WS_WUKV) + (size_t)1024 * KVRANK, (const bf16_t*)(F.ws + WS_PX1) + QRANK, KVRANK, CINP, KVRANK, nullptr};
          TileSched<false> S; S.init_mn(1024 / 256, NTILE, F.G, F.G - 1 - (int)blockIdx.x);
          EpiVT E{F.ws + WS_VB, (const float*)(F.ws + WS_STATS)}; pg8::gemm_phase<EpiVT, TileSched<false>, false>(F.lds, g, S, E); }
        ka_launder(F);
        p10_kr(F);
    }
    SEAM(13);
    if (RUN(14)) for (int rep_ = 0; rep_ < 1 + ((REPMASK >> 14) & 1); ++rep_) p11_attention(F);
    SEAM(14);
    if (RUN(15)) for (int rep_ = 0; rep_ < 1 + ((REPMASK >> 15) & 1); ++rep_) { pg8::Gemm g{(const bf16_t*)(F.ws + WS_MIX), (const bf16_t*)(F.ws + WS_WOUT1), DM / 2, DM / 2, DM / 2, nullptr}; TileSched<true> S; S.init(DM / 256, F.G, (int)blockIdx.x);
        EpiResidual E{&F, (bf16_t*)(F.ws + WS_XS), 1, false, 1.0f / (S8_O * S8_W1)}; pg8::gemm_phase<EpiResidual, TileSched<true>, false, true>(F.lds, g, S, E); }
    SEAM(15);
    if (RUN(16)) for (int rep_ = 0; rep_ < 1 + ((REPMASK >> 16) & 1); ++rep_) p5_norm_route<true>(F, 1);
    SEAM(16);
    if (RUN(18)) for (int rep_ = 0; rep_ < 1 + ((REPMASK >> 18) & 1); ++rep_) moe_gemms(F, 1, 0);
    SEAM(18);
    if (RUN(19)) for (int rep_ = 0; rep_ < 1 + ((REPMASK >> 19) & 1); ++rep_) moe_gemms(F, 1, 1);
    SEAM(19);
    ka_launder(F);
    if (IN(20) && ((PHMASK >> 20) & 1)) p16_final(F);
#undef IN
#undef SEAM
#undef RUN
}

#ifndef MK_N_LAUNCHES
#define MK_N_LAUNCHES 1
#endif
extern "C" void kernel_launch(void* const* d_in, const int* in_sizes, int n_in, void* d_out, int out_size, void* d_ws, size_t ws_size, hipStream_t stream) {
    static int grid = 0;
    if (grid == 0) {
        if (n_in != 28 || out_size != NB * SEQ * DM || ws_size < WS_END) { fprintf(stderr, "kernel_launch: unexpected shapes (n_in %d out %d ws %zu)\n", n_in, out_size, ws_size); grid = -1; return; }
        int dev = 0, cus = 0, per_cu = 0;
        if (hipGetDevice(&dev) != hipSuccess || hipDeviceGetAttribute(&cus, hipDeviceAttributeMultiprocessorCount, dev) != hipSuccess) { grid = -1; return; }
        if (hipFuncSetAttribute((const void*)mega_fwd, hipFuncAttributeMaxDynamicSharedMemorySize, LDS_BYTES) != hipSuccess) { fprintf(stderr, "kernel_launch: hipFuncSetAttribute failed\n"); grid = -1; return; }
        if (hipOccupancyMaxActiveBlocksPerMultiprocessor(&per_cu, (const void*)mega_fwd, 512, LDS_BYTES) != hipSuccess || per_cu < 1) { fprintf(stderr, "kernel_launch: occupancy query says %d blocks/CU\n", per_cu); per_cu = 1; }
        (void)hipGetLastError();
        grid = cus;
    }
    if (grid < 0) return;
    (void)hipMemsetAsync((char*)d_ws + WS_CTL, 0, CTL_ZERO_BYTES, stream);
    Args a{};
    for (int i = 0; i < 28; ++i) a.in[i] = (const float*)d_in[i];
    a.out = (float*)d_out; a.ws = (unsigned char*)d_ws;
    if (MK_N_LAUNCHES == 1) {
        a.ph_lo = 0; a.ph_hi = NPH; a.nobar = 0;
        void* kargs[] = {&a};
        hipError_t e = hipLaunchCooperativeKernel((const void*)mega_fwd, dim3(grid), dim3(512), kargs, LDS_BYTES, stream);
        if (e != hipSuccess) { (void)hipGetLastError(); fprintf(stderr, "kernel_launch: cooperative launch failed (%s), plain launch instead\n", hipGetErrorString(e)); hipLaunchKernelGGL(mega_fwd, dim3(grid), dim3(512), LDS_BYTES, stream, a); }
    } else {
        for (int p = 0; p < NPH; ++p) { a.ph_lo = p; a.ph_hi = p + 1; a.nobar = 1; hipLaunchKernelGGL(mega_fwd, dim3(grid), dim3(512), LDS_BYTES, stream, a); }
    }
}
```

```cpp
#include <hip/hip_runtime.h>
#include <cstdio>
#include <cstdint>
#define MK_N_LAUNCHES 1
#define DBG_MODE 0
#define STAMP_PHASE -1
#define EPI_TWICE 0
#define REPMASK 0x0

#define LAS __attribute__((address_space(3)))
#define GAS __attribute__((address_space(1)))
typedef unsigned short bf16_t;
typedef short bf16x8 __attribute__((ext_vector_type(8)));
typedef short s16x4 __attribute__((ext_vector_type(4)));
typedef float f32x2 __attribute__((ext_vector_type(2)));
typedef float f32x4 __attribute__((ext_vector_type(4)));
typedef float f32x16 __attribute__((ext_vector_type(16)));
typedef unsigned u32x2 __attribute__((ext_vector_type(2)));
typedef unsigned u32x4 __attribute__((ext_vector_type(4)));
typedef int i32x4_t __attribute__((ext_vector_type(4)));
typedef int i32x8_t __attribute__((ext_vector_type(8)));

constexpr int DM = 1024, NB = 16, SEQ = 2048, CTXL = 256, PB = SEQ + CTXL  , R = NB * PB  ;
constexpr int NTILE = R / 256  , NXTILE = NB * SEQ / 256  ;
constexpr int EVIN = 3584;
constexpr int CIN = 704, CINP = 768, QRANK = 384, KVRANK = 256, NQ = 1536, NKV = 2048;
constexpr int NEXP = 32, MFF = 512;
constexpr int ECAP = 4096, MAXSLOT = NEXP * ECAP;
constexpr float RMS_EPS = 1e-6f;
constexpr float ATT_C2 = 0.07216878364870322f * 1.4426950408889634f;

constexpr size_t MiB = 1u << 20;
constexpr size_t WS_CTL = 0, CTL_ZERO_BYTES = 1 * MiB;
constexpr size_t WS_MOD = 1 * MiB;
constexpr size_t WS_PART = 2 * MiB;
constexpr size_t WS_STATS = 9 * MiB;
constexpr size_t WS_ROUTE = 13 * MiB;
constexpr size_t WS_WIN0 = 16 * MiB, WS_WOUT0 = 23 * MiB, WS_WIN1 = 25 * MiB, WS_WUQ = 27 * MiB, WS_WUKV = 29 * MiB, WS_WOUT1 = 30 * MiB;
constexpr size_t WS_WGU = 32 * MiB;
constexpr size_t WS_WDN = 160 * MiB;
constexpr size_t WS_XS = 224 * MiB;
constexpr size_t WS_HX = 368 * MiB;
constexpr size_t WS_MIX = 440 * MiB;
constexpr size_t WS_RA = 512 * MiB;
constexpr size_t WS_PX0 = WS_RA, WS_Q = WS_RA, WS_KB = WS_RA + 108 * MiB, WS_ACT = WS_RA;
constexpr size_t WS_RB = 764 * MiB;
constexpr size_t WS_YS = WS_RB, WS_PX1 = WS_RB, WS_VB = WS_RB + 54 * MiB, WS_OG = WS_RB;
constexpr size_t WS_END = 908 * MiB;
constexpr size_t RT_AE = 0, RT_AP = 512 * 1024, RT_AW = 1024 * 1024, RT_PERM = 1536 * 1024, RT_CNTB = 2048 * 1024, RT_BLKE = 2048 * 1024 + 64 * 1024, RT_NBLK = RT_BLKE + 4096;
constexpr int CW_BAR = 4096, CW_GC = 8192;

constexpr int RING_BYTES = 131072;
constexpr int LDSCTL_OFF = 147456, MISC_OFF = LDSCTL_OFF + 320;
constexpr int LDS_BYTES = 149504;

#define LDS_WAIT() asm volatile("s_waitcnt lgkmcnt(0)" ::: "memory")
#define VM_WAIT() asm volatile("s_waitcnt vmcnt(0)" ::: "memory")
#define SBAR() __builtin_amdgcn_sched_barrier(0)
__device__ __forceinline__ unsigned f2bf(float f) { unsigned u = __builtin_bit_cast(unsigned, f); return (u + 0x7fffu + ((u >> 16) & 1u)) >> 16; }
__device__ __forceinline__ unsigned pk2(float lo, float hi) { return f2bf(lo) | (f2bf(hi) << 16); }
typedef __bf16 bf16x2_t __attribute__((ext_vector_type(2)));
__device__ __forceinline__ unsigned cvtpk(float lo, float hi) { f32x2 v = {lo, hi}; bf16x2_t b = __builtin_convertvector(v, bf16x2_t); return __builtin_bit_cast(unsigned, b); }
__device__ __forceinline__ unsigned pk4_fp8(float a, float b, float c, float d) {
    a = __builtin_amdgcn_fmed3f(a, -448.f, 448.f); b = __builtin_amdgcn_fmed3f(b, -448.f, 448.f); c = __builtin_amdgcn_fmed3f(c, -448.f, 448.f); d = __builtin_amdgcn_fmed3f(d, -448.f, 448.f);
    int p = __builtin_amdgcn_cvt_pk_fp8_f32(a, b, 0, false); p = __builtin_amdgcn_cvt_pk_fp8_f32(c, d, p, true); return (unsigned)p;
}
__device__ __forceinline__ unsigned pk4_fp8_nc(float a, float b, float c, float d) { int p = __builtin_amdgcn_cvt_pk_fp8_f32(a, b, 0, false); p = __builtin_amdgcn_cvt_pk_fp8_f32(c, d, p, true); return (unsigned)p; }
constexpr float S8_Q = 128.f, S8_K = 16.f, S8_V = 16.f;
constexpr float S8_W1 = 512.f, S8_O = 16.f, S8_M = 2.f;
constexpr float S8_X = 16.f, S8_WGU = 512.f, S8_H = 16.f, S8_WDN = 256.f, S8_Y = 16.f;
__device__ __forceinline__ float bf2f(unsigned short h) { return __builtin_bit_cast(float, (unsigned)h << 16); }
__device__ __forceinline__ float bflo(unsigned w) { return __builtin_bit_cast(float, w << 16); }
__device__ __forceinline__ float bfhi(unsigned w) { return __builtin_bit_cast(float, w & 0xffff0000u); }
__device__ __forceinline__ float dpp_add(float v, const int ctrl) { return v; }
#define DPP_ADD(v, ctrl) ((v) + __builtin_bit_cast(float, __builtin_amdgcn_update_dpp(0, __builtin_bit_cast(int, (v)), (ctrl), 0xf, 0xf, true)))
__device__ __forceinline__ float fold32(float a, float b) { const auto r = __builtin_amdgcn_permlane32_swap(__builtin_bit_cast(unsigned, a), __builtin_bit_cast(unsigned, b), false, false);
    return __builtin_bit_cast(float, (unsigned)r[0]) + __builtin_bit_cast(float, (unsigned)r[1]); }
__device__ __forceinline__ float fold16(float a, float b) { const auto r = __builtin_amdgcn_permlane16_swap(__builtin_bit_cast(unsigned, a), __builtin_bit_cast(unsigned, b), false, false);
    return __builtin_bit_cast(float, (unsigned)r[0]) + __builtin_bit_cast(float, (unsigned)r[1]); }
__device__ __forceinline__ float rdlane(float v, int l) { return __builtin_bit_cast(float, __builtin_amdgcn_readlane(__builtin_bit_cast(int, v), l)); }
__device__ __forceinline__ void wave_sum4(const f32x4 x, float& s0, float& s1, float& s2, float& s3) {
    float t = fold16(fold32(x[0], x[1]), fold32(x[2], x[3]));
    t = DPP_ADD(t, 0xB1); t = DPP_ADD(t, 0x4E); t = DPP_ADD(t, 0x141); t = DPP_ADD(t, 0x140);
    s0 = rdlane(t, 0); s2 = rdlane(t, 16); s1 = rdlane(t, 32); s3 = rdlane(t, 48);
}
__device__ __forceinline__ void wave_sum8(const f32x4 x, const f32x4 y, int lane, float (&s)[8]) {
    const float q0 = fold16(fold32(x[0], x[1]), fold32(x[2], x[3])), q1 = fold16(fold32(y[0], y[1]), fold32(y[2], y[3]));
    const bool up = (lane & 8) != 0; const float keep = up ? q1 : q0, give = up ? q0 : q1;
    float t = keep + __builtin_bit_cast(float, __builtin_amdgcn_update_dpp(0, __builtin_bit_cast(int, give), 0x128  , 0xf, 0xf, true));
    t = DPP_ADD(t, 0xB1); t = DPP_ADD(t, 0x4E); t = DPP_ADD(t, 0x141);
    s[0] = rdlane(t, 0); s[4] = rdlane(t, 8); s[2] = rdlane(t, 16); s[6] = rdlane(t, 24); s[1] = rdlane(t, 32); s[5] = rdlane(t, 40); s[3] = rdlane(t, 48); s[7] = rdlane(t, 56);
}
__device__ __forceinline__ float wave_sum(float v) {
    v = DPP_ADD(v, 0xB1);
    v = DPP_ADD(v, 0x4E);
    v = DPP_ADD(v, 0x141);
    v = DPP_ADD(v, 0x140);
    const int iv = __builtin_bit_cast(int, v);
    return (__builtin_bit_cast(float, __builtin_amdgcn_readlane(iv, 0)) + __builtin_bit_cast(float, __builtin_amdgcn_readlane(iv, 16))) +
           (__builtin_bit_cast(float, __builtin_amdgcn_readlane(iv, 32)) + __builtin_bit_cast(float, __builtin_amdgcn_readlane(iv, 48)));
}
constexpr float LOG2E = 1.4426950408889634f, LN2 = 0.6931471805599453f;
__device__ __forceinline__ float ex2(float x) { return __builtin_amdgcn_exp2f(x); }
__device__ __forceinline__ float lg2(float x) { return __builtin_amdgcn_logf(x); }
__device__ __forceinline__ float sigmoidf_(float x) { return __builtin_amdgcn_rcpf(1.0f + ex2(-LOG2E * x)); }
__device__ __forceinline__ float siluf_(float x) { return x * __builtin_amdgcn_rcpf(1.0f + ex2(-LOG2E * x)); }
__device__ __forceinline__ float geluf_(float x) { const float z = (-1.5957691216057308f * LOG2E) * (x + 0.044715f * x * x * x); return x * __builtin_amdgcn_rcpf(1.0f + ex2(z)); }

#define XB_TMO      128
#define XB_XCNT(j)  (256  + 64 * (j))
#define XB_XSUB(j)  (1280 + 64 * (j))
#define XB_XGEN(j)  (2304 + 64 * (j))
#define XB_TOP      3328
#define XB_TOPGEN   3392
#define XCD_BAR_WORDS 3456
#define XB_SPIN_CAP (1u << 22)
__device__ __forceinline__ unsigned xb_ld(unsigned* p)              { return __hip_atomic_load(p, __ATOMIC_RELAXED, __HIP_MEMORY_SCOPE_AGENT); }
__device__ __forceinline__ unsigned xb_add(unsigned* p, unsigned v) { return __hip_atomic_fetch_add(p, v, __ATOMIC_RELAXED, __HIP_MEMORY_SCOPE_AGENT); }
__device__ __forceinline__ unsigned xb_xcc_id() { return (unsigned)__builtin_amdgcn_s_getreg((3 << 11) | 20) & 0xFu; }
#define XB_SPIN(cond, bar) do { unsigned _sp = 0; while (cond) { __builtin_amdgcn_s_sleep(1); \
    if ((++_sp & 255u) == 0u) { if (xb_ld(&(bar)[XB_TMO])) break; if (_sp > XB_SPIN_CAP) { atomicAdd(&(bar)[XB_TMO], 1u); break; } } } } while (0)
struct XcdBarrier { unsigned* bar; unsigned x; volatile LAS unsigned* st; };
__device__ __forceinline__ XcdBarrier xcd_barrier_post(unsigned* bar, volatile LAS unsigned* st) {
    XcdBarrier b; b.bar = bar; b.x = xb_xcc_id(); b.st = st;
    if (threadIdx.x == 0) (void)xb_add(&bar[XB_XCNT(b.x)], 1u);
    return b;
}
__device__ __forceinline__ void xcd_barrier_complete(unsigned* bar, unsigned x, unsigned& nloc, unsigned& nx) {
    const unsigned G = gridDim.x * gridDim.y * gridDim.z;
    unsigned sum, cnt, mine, sp = 0u;
    for (;;) {
        sum = 0u; cnt = 0u; mine = 0u;
#pragma unroll
        for (unsigned j = 0; j < 16; ++j) { const unsigned c = xb_ld(&bar[XB_XCNT(j)]); sum += c; cnt += (c > 0u) ? 1u : 0u; mine = (j == x) ? c : mine; }
        if (sum == G) break;
        __builtin_amdgcn_s_sleep(1);
        if ((++sp & 255u) == 0u) { if (xb_ld(&bar[XB_TMO])) break; if (sp > XB_SPIN_CAP) { atomicAdd(&bar[XB_TMO], 1u); break; } }
    }
    nloc = mine > 0u ? mine : 1u; nx = cnt > 0u ? cnt : 1u;
}
__device__ __forceinline__ void xcd_barrier(const XcdBarrier& b) {
    asm volatile("s_waitcnt vmcnt(0)" ::: "memory");
    __syncthreads();
    if (threadIdx.x == 0) {
        unsigned* bar = b.bar;
        __builtin_amdgcn_s_waitcnt(0);
        unsigned nloc = b.st[0], nx = b.st[1];
        if (nloc == 0u) { xcd_barrier_complete(bar, b.x, nloc, nx); b.st[0] = nloc; b.st[1] = nx; }
        const unsigned old = xb_add(&bar[XB_XSUB(b.x)], 1u);
        const unsigned gen = old / nloc;
        if (old + 1u == (gen + 1u) * nloc) {
            __builtin_amdgcn_fence(__ATOMIC_RELEASE, "agent");
            asm volatile("s_waitcnt vmcnt(0)" ::: "memory");
            const unsigned og = xb_add(&bar[XB_TOP], 1u);
            const unsigned tg = og / nx;
            if (og + 1u == (tg + 1u) * nx) xb_add(&bar[XB_TOPGEN], 1u);
            else XB_SPIN(xb_ld(&bar[XB_TOPGEN]) == tg, bar);
            __builtin_amdgcn_fence(__ATOMIC_ACQUIRE, "agent");
            xb_add(&bar[XB_XGEN(b.x)], 1u);
            asm volatile("s_waitcnt vmcnt(0)" ::: "memory");
        } else {
            XB_SPIN(xb_ld(&bar[XB_XGEN(b.x)]) == gen, bar);
            __builtin_amdgcn_fence(__ATOMIC_ACQUIRE, "agent");
            asm volatile("s_waitcnt vmcnt(0)" ::: "memory");
        }
    }
    __syncthreads();
}

namespace pg8 {
constexpr int BM = 256, BK = 64, HALF = 128, HTB = HALF * BK * 2, STAGE_BYTES = 8 * HTB, NXCD = 8, WGM = 8;
__host__ __device__ __forceinline__ int lds_byte(int r, int c) { const int st = (r >> 4) * 2 + (c >> 5), rr = r & 15, cc = c & 31, ob = rr * 64 + cc * 2; return st * 1024 + (ob ^ (((ob >> 9) & 1) << 5)); }
__host__ __device__ __forceinline__ void stage_rc(int b, int& Rr, int& C) { const int st = b / 1024, sb = b % 1024, swz = sb ^ (((sb >> 9) & 1) << 5); Rr = (st >> 1) * 16 + swz / 64; C = (st & 1) * 32 + (swz % 64) / 2; }
__host__ __device__ __forceinline__ int keyperm64(int b) { const int hi = b >> 5, j = b & 31, half = j >> 4, jj = j & 15; return 32 * half + (jj & 3) + 8 * (jj >> 2) + 4 * hi; }
__host__ __device__ __forceinline__ int perm32(int rho) { const int n = rho >> 4, i = rho & 15; return 8 * (i >> 2) + 4 * n + (i & 3); }

struct Unit { int arow0, brow0, pm, pn, ex; };
struct Gemm { const bf16_t* A; const bf16_t* Bt; int lda, ldb, K; const int* rowidx; };

template <class Epi, class Sched, bool GATHER, bool FP8 = false>
__device__ __forceinline__ void gemm_phase(LAS unsigned char* lds, const Gemm g, const Sched& S, const Epi& E) {
    int tidl = threadIdx.x; asm volatile("" : "+v"(tidl));
    const int tid = tidl, wid = __builtin_amdgcn_readfirstlane(tid >> 6), lane = tid & 63, wr = wid >> 2, wc = wid & 3, fr = lane & 15, fq = lane >> 4;
    const int K = g.K, nt = K / BK;
    int sR[2], sC[2]; unsigned voffB[2], voffA[2];
#pragma unroll
    for (int i = 0; i < 2; ++i) { stage_rc(tid * 16 + i * 8192, sR[i], sC[i]); int Rb = Epi::PERM ? ((sR[i] & ~31) + perm32(sR[i] & 31)) : sR[i];
        if constexpr (Epi::KEYPERM) Rb = (Rb & ~63) + keyperm64(Rb & 63);
        voffB[i] = (unsigned)(Rb * g.ldb + sC[i]) * 2u; voffA[i] = (unsigned)(sR[i] * g.lda + sC[i]) * 2u; }
    const unsigned kstep = BK * 2;
    const unsigned hstepB = (unsigned)(HALF * g.ldb * 2), hstepA = (unsigned)(HALF * g.lda * 2);
    const unsigned ldsw = (unsigned)wid * 1024u;
    const int aoff = lds_byte(wr * 64 + fr, fq * 8), boff = lds_byte(wc * 32 + fr, fq * 8);
#define PG8_SA(b, h) (((b) * 2 + (h)) * HTB)
#define PG8_SB(b, h) ((4 + (b) * 2 + (h)) * HTB)
    const __amdgpu_buffer_rsrc_t rsA = __builtin_amdgcn_make_buffer_rsrc((void*)g.A, 0, 0x7fffffff, 0x00020000), rsB = __builtin_amdgcn_make_buffer_rsrc((void*)g.Bt, 0, 0x7fffffff, 0x00020000);
#define PG8_GLDS(rs, voff, soff, bufoff, i) __builtin_amdgcn_raw_ptr_buffer_load_lds((rs), (LAS unsigned*)(lds + (bufoff) + ldsw + (i) * 8192), 16, (int)(voff), (int)(soff), 0, 0)
#define PG8_STAGEB(bufoff, sbase) do { _Pragma("unroll") for (int _i = 0; _i < 2; ++_i) PG8_GLDS(rsB, voffB[_i], (sbase), bufoff, _i); } while (0)
#define PG8_STAGEA(bufoff, h, isnext, kb) do { \
        if constexpr (GATHER) { _Pragma("unroll") for (int _i = 0; _i < 2; ++_i) PG8_GLDS(rsA, ((isnext) ? nvo[h][_i] : cvo[h][_i]), (kb), bufoff, _i); } \
        else { const unsigned _b = ((isnext) ? nA : cA) + (unsigned)((h) * hstepA + (kb)); _Pragma("unroll") for (int _i = 0; _i < 2; ++_i) PG8_GLDS(rsA, voffA[_i], _b, bufoff, _i); } } while (0)
#define PG8_LD16(p) (*(const LAS i32x4_t*)(p))
#define PG8_LDA(dst, b, h) do { if constexpr (FP8) { _Pragma("unroll") for (int m = 0; m < 4; ++m) dst##8[m] = __builtin_shufflevector(PG8_LD16(lds + PG8_SA(b, h) + aoff + m * 2048), PG8_LD16(lds + PG8_SA(b, h) + aoff + m * 2048 + 1024), 0, 1, 2, 3, 4, 5, 6, 7); } \
        else { _Pragma("unroll") for (int m = 0; m < 4; ++m) _Pragma("unroll") for (int k = 0; k < 2; ++k) dst[m][k] = *(const LAS bf16x8*)(lds + PG8_SA(b, h) + aoff + m * 2048 + k * 1024); } } while (0)
#define PG8_LDB(dst, b, h) do { if constexpr (FP8) { _Pragma("unroll") for (int n = 0; n < 2; ++n) dst##8[n] = __builtin_shufflevector(PG8_LD16(lds + PG8_SB(b, h) + boff + n * 2048), PG8_LD16(lds + PG8_SB(b, h) + boff + n * 2048 + 1024), 0, 1, 2, 3, 4, 5, 6, 7); } \
        else { _Pragma("unroll") for (int n = 0; n < 2; ++n) _Pragma("unroll") for (int k = 0; k < 2; ++k) dst[n][k] = *(const LAS bf16x8*)(lds + PG8_SB(b, h) + boff + n * 2048 + k * 1024); } } while (0)
#define PG8_CAT(x) __builtin_shufflevector(__builtin_bit_cast(i32x4_t, (x)[0]), __builtin_bit_cast(i32x4_t, (x)[1]), 0, 1, 2, 3, 4, 5, 6, 7)
#define PG8_MMA(ai, bj, At, Bt) do { __builtin_amdgcn_s_setprio(1); \
        if constexpr (FP8) { _Pragma("unroll") for (int m = 0; m < 4; ++m) _Pragma("unroll") for (int n = 0; n < 2; ++n) \
            acc[ai][bj][m][n] = __builtin_amdgcn_mfma_scale_f32_16x16x128_f8f6f4(Bt##8[n], At##8[m], acc[ai][bj][m][n], 0, 0, 0, 0x7f7f7f7f, 0, 0x7f7f7f7f); \
            _Pragma("unroll") for (int m = 0; m < 4; ++m) _Pragma("unroll") for (int n = 0; n < 2; ++n) asm volatile("" : "+v"(acc[ai][bj][m][n])); }     \
        else { _Pragma("unroll") for (int m = 0; m < 4; ++m) _Pragma("unroll") for (int n = 0; n < 2; ++n) _Pragma("unroll") for (int k = 0; k < 2; ++k) \
            acc[ai][bj][m][n] = __builtin_amdgcn_mfma_f32_16x16x32_bf16(Bt[n][k], At[m][k], acc[ai][bj][m][n], 0, 0, 0); } \
        __builtin_amdgcn_s_setprio(0); } while (0)
#define PG8_WAIT_V(n) asm volatile("s_waitcnt vmcnt(" #n ")" ::: "memory")
#define PG8_WAIT_L(n) asm volatile("s_waitcnt lgkmcnt(" #n ")" ::: "memory")
#define PG8_BAR __builtin_amdgcn_s_barrier()
#define PG8_SCHED __builtin_amdgcn_sched_barrier(0)
    unsigned cvo[2][2], nvo[2][2];
    auto a_offsets = [&](const Unit& u, unsigned (&vo)[2][2]) {
#pragma unroll
        for (int h = 0; h < 2; ++h)
#pragma unroll
            for (int i = 0; i < 2; ++i) { const int a = g.rowidx[u.arow0 + h * HALF + sR[i]]; const int row = a < 0 ? 0 : (a >> 1); vo[h][i] = (unsigned)((size_t)row * g.lda + sC[i]) * 2u; }
    };
    Unit cur, nxt; int ui = 0;
    if (!S.next(0, cur)) return;
    f32x4 acc[2][2][4][2];
#pragma unroll
    for (int a = 0; a < 2; ++a)
#pragma unroll
        for (int b = 0; b < 2; ++b)
#pragma unroll
            for (int m = 0; m < 4; ++m)
#pragma unroll
                for (int n = 0; n < 2; ++n) acc[a][b][m][n] = (f32x4){0.f, 0.f, 0.f, 0.f};
    bf16x8 At[4][2], B0[2][2], B1[2][2]; i32x8_t At8[4], B08[2], B18[2];
    unsigned cA = (unsigned)((size_t)cur.arow0 * g.lda * 2), nA = cA;
    unsigned cB = (unsigned)((size_t)cur.brow0 * g.ldb * 2);
    if constexpr (GATHER) { a_offsets(cur, cvo);
#pragma unroll
        for (int h = 0; h < 2; ++h)
#pragma unroll
            for (int i = 0; i < 2; ++i) nvo[h][i] = cvo[h][i]; }
    PG8_STAGEB(PG8_SB(0, 0), cB); PG8_STAGEB(PG8_SB(0, 1), cB + hstepB); PG8_STAGEA(PG8_SA(0, 0), 0, false, 0); PG8_STAGEA(PG8_SA(0, 1), 1, false, 0);
    if (wr == 1) PG8_BAR;
    PG8_WAIT_V(2); PG8_BAR;
    PG8_STAGEB(PG8_SB(1, 0), cB + kstep); PG8_STAGEA(PG8_SA(1, 0), 0, false, kstep); PG8_STAGEB(PG8_SB(1, 1), cB + hstepB + kstep);
    PG8_WAIT_V(6); PG8_BAR;
    for (;;) {
        const bool has_next = S.next(ui + 1, nxt);
        const unsigned nB = has_next ? (unsigned)((size_t)nxt.brow0 * g.ldb * 2) : cB;
        nA = has_next ? (unsigned)((size_t)nxt.arow0 * g.lda * 2) : cA;
        if constexpr (GATHER) { if (has_next) a_offsets(nxt, nvo); }
        for (int t = 0; t < nt; t += 2) {
            const bool last = (t == nt - 2);
            const unsigned k1 = (unsigned)((t + 1) * kstep), k2 = last ? 0u : (unsigned)((t + 2) * kstep), k3 = k2 + (unsigned)kstep;
            const unsigned b2 = last ? nB : cB + (unsigned)((t + 2) * kstep); const unsigned b3 = b2 + (unsigned)kstep;
            PG8_LDB(B0, 0, 0); PG8_LDB(B1, 0, 1); PG8_SCHED; PG8_LDA(At, 0, 0); PG8_STAGEA(PG8_SA(1, 1), 1, false, k1);
            PG8_WAIT_V(8); PG8_WAIT_L(0); PG8_BAR; PG8_MMA(0, 0, At, B0); PG8_MMA(0, 1, At, B1); PG8_BAR; PG8_SCHED;
            PG8_LDA(At, 0, 1); PG8_STAGEB(PG8_SB(0, 0), b2); PG8_STAGEB(PG8_SB(0, 1), b2 + hstepB); PG8_STAGEA(PG8_SA(0, 0), 0, last, k2);
            PG8_WAIT_V(8); PG8_WAIT_L(0); PG8_BAR; PG8_MMA(1, 0, At, B0); PG8_MMA(1, 1, At, B1); PG8_BAR; PG8_SCHED;
            PG8_LDB(B0, 1, 0); PG8_LDB(B1, 1, 1); PG8_SCHED; PG8_LDA(At, 1, 0); PG8_STAGEA(PG8_SA(0, 1), 1, last, k2);
            PG8_WAIT_V(8); PG8_WAIT_L(0); PG8_BAR; PG8_MMA(0, 0, At, B0); PG8_MMA(0, 1, At, B1); PG8_BAR; PG8_SCHED;
            PG8_LDA(At, 1, 1); PG8_STAGEB(PG8_SB(1, 0), b3); PG8_STAGEB(PG8_SB(1, 1), b3 + hstepB); PG8_STAGEA(PG8_SA(1, 0), 0, last, k3);
            PG8_WAIT_V(8); PG8_WAIT_L(0); PG8_BAR; PG8_MMA(1, 0, At, B0); PG8_MMA(1, 1, At, B1); PG8_BAR; PG8_SCHED;
        }
        if (wr == 0) PG8_BAR;
        { int l2 = threadIdx.x; asm volatile("" : "+v"(l2)); E(acc, cur, wr, wc, l2 & 15, (l2 >> 4) & 3); if (EPI_TWICE && Epi::IDEM) { asm volatile("" : "+v"(l2)); E(acc, cur, wr, wc, l2 & 15, (l2 >> 4) & 3); } }
        if (!has_next) break;
#pragma unroll
        for (int a = 0; a < 2; ++a)
#pragma unroll
            for (int b = 0; b < 2; ++b)
#pragma unroll
                for (int m = 0; m < 4; ++m)
#pragma unroll
                    for (int n = 0; n < 2; ++n) acc[a][b][m][n] = (f32x4){0.f, 0.f, 0.f, 0.f};
        cur = nxt; cB = nB; cA = nA; ++ui;
        if constexpr (GATHER) {
#pragma unroll
            for (int h = 0; h < 2; ++h)
#pragma unroll
                for (int i = 0; i < 2; ++i) cvo[h][i] = nvo[h][i]; }
        if (wr == 1) PG8_BAR;
    }
    PG8_WAIT_V(0);
    PG8_BAR;
#undef PG8_SA
#undef PG8_SB
#undef PG8_GLDS
#undef PG8_STAGEA
#undef PG8_STAGEB
#undef PG8_LDA
#undef PG8_LD16
#undef PG8_LDB
#undef PG8_MMA
#undef PG8_CAT
#undef PG8_WAIT_V
#undef PG8_WAIT_L
#undef PG8_BAR
#undef PG8_SCHED
}
}

struct Args {
    const float* in[28]; float* out; unsigned char* ws; int ph_lo, ph_hi, nobar, pad;
};
enum In { I_X = 0, I_C, I_CTX, I_CCTX, I_ADAW, I_ADAB, I_NMIXG, I_NFFNG, I_EVWIN, I_EVLB, I_EVONORM, I_EVSGUG, I_EVWS, I_EVBS, I_EVWOUT,
          I_ODWIN, I_ODQG, I_ODWUQ, I_ODKVG, I_ODWUKV, I_ODWOUT, I_MR1W, I_MR1B, I_MR2W, I_MR2B, I_MGU, I_MDN, I_FING };
struct Frame {
    LAS unsigned char* lds;
    const __attribute__((address_space(4))) Args* ka;
    float* out;
    int tid, lane, wave, vcu, G;
    unsigned char* ws;
};
__device__ __forceinline__ const float* mod_ptr(const Frame& F, int layer, int mrow, int which) { return (const float*)(F.ws + WS_MOD) + ((size_t)(layer * 17 + mrow) * 6 + which) * DM; }
__device__ __forceinline__ int row_b(int row) { return row / PB; }
__device__ __forceinline__ const float* input_row(const Frame& F, int row) {
    const int b = row / PB, pos = row - b * PB;
    return pos < CTXL ? F.ka->in[I_CTX] + ((size_t)b * CTXL + pos) * DM : F.ka->in[I_X] + ((size_t)b * SEQ + (pos - CTXL)) * DM;
}

template <bool XONLY> struct TileSched {
    int nM, nN, nwg, G, c;
    __device__ __forceinline__ void init(int nN_, int G_, int c_) { nM = XONLY ? NXTILE : NTILE; nN = nN_; nwg = nM * nN; G = G_; c = c_; }
    __device__ __forceinline__ void init_mn(int nM_, int nN_, int G_, int c_) { nM = nM_; nN = nN_; nwg = nM * nN; G = G_; c = c_; }
    __device__ __forceinline__ bool next(int i, pg8::Unit& u) const {
        const int L = i * G + c; if (L >= nwg) return false;
        int wgid = L; { const int q = nwg / 8, r = nwg % 8, xcd = wgid % 8, off = wgid / 8; wgid = (xcd < r ? xcd * (q + 1) : r * (q + 1) + (xcd - r) * q) + off; }
        const int nig = 8 * nN, gid = wgid / nig, fm = gid * 8, gsz = (nM - fm) < 8 ? (nM - fm) : 8;
        int pm = fm + ((wgid % nig) % gsz); const int pn = (wgid % nig) / gsz;
        if (XONLY) pm = (pm >> 3) * 9 + 1 + (pm & 7);
        u.pm = pm; u.pn = pn; u.ex = 0; u.arow0 = pm * 256; u.brow0 = pn * 256; return true;
    }
};
struct MoeSched {
    const LAS int* pfx; const LAS unsigned char* tab; int nwg, G, c;
    __device__ __forceinline__ bool next(int i, pg8::Unit& u) const {
        const int L = i * G + c; if (L >= nwg) return false;
        int wgid = L; { const int q = nwg / 8, r = nwg % 8, xcd = wgid % 8, off = wgid / 8; wgid = (xcd < r ? xcd * (q + 1) : r * (q + 1) + (xcd - r) * q) + off; }
        const int blk = wgid >> 2, pn = wgid & 3; const int e = __builtin_amdgcn_readfirstlane((int)tab[blk]); const int j = blk - __builtin_amdgcn_readfirstlane(pfx[e]);
        u.pm = blk; u.pn = pn; u.ex = e; u.arow0 = e * ECAP + j * 256; u.brow0 = e * 1024 + pn * 256; return true;
    }
};
__device__ __forceinline__ u32x4 widen16(u32x2 w0, u32x2 w1) {
    const auto rx = __builtin_amdgcn_permlane16_swap(w0.x, w1.x, false, false), ry = __builtin_amdgcn_permlane16_swap(w0.y, w1.y, false, false);
    return (u32x4){(unsigned)rx[0], (unsigned)ry[0], (unsigned)rx[1], (unsigned)ry[1]};
}
struct EpiStoreBf16 {
    static constexpr bool PERM = true; static constexpr bool IDEM = true; static constexpr bool KEYPERM = false;
    bf16_t* O; int ldc;
    __device__ __forceinline__ void operator()(const f32x4 (&acc)[2][2][4][2], const pg8::Unit& u, int wr, int wc, int fr, int fq) const {
        const int row0 = u.arow0 + wr * 64 + fr, col0 = u.pn * 256 + wc * 32 + 8 * fq;
#pragma unroll
        for (int ai = 0; ai < 2; ++ai)
#pragma unroll
            for (int m = 0; m < 4; ++m) { bf16_t* rowp = O + (size_t)(row0 + ai * 128 + m * 16) * ldc + col0;
#pragma unroll
                for (int bj = 0; bj < 2; ++bj) { const f32x4 v0 = acc[ai][bj][m][0], v1 = acc[ai][bj][m][1];
                    u32x4 w; w.x = cvtpk(v0[0], v0[1]); w.y = cvtpk(v0[2], v0[3]); w.z = cvtpk(v1[0], v1[1]); w.w = cvtpk(v1[2], v1[3]);
                    *(u32x4*)(rowp + bj * 128) = w; } }
    }
};
struct EpiStoreStats {
    static constexpr bool PERM = true; static constexpr bool IDEM = true; static constexpr bool KEYPERM = false;
    bf16_t* O; int ldc; float* stats; float sc;
    __device__ __forceinline__ void operator()(const f32x4 (&acc)[2][2][4][2], const pg8::Unit& u, int wr, int wc, int fr, int fq) const {
        const int row0 = u.arow0 + wr * 64 + fr, col0 = u.pn * 256 + wc * 32 + 8 * fq;
#pragma unroll
        for (int ai = 0; ai < 2; ++ai)
#pragma unroll
            for (int m = 0; m < 4; ++m) { const int row = row0 + ai * 128 + m * 16; bf16_t* rowp = O + (size_t)row * ldc + col0;
#pragma unroll
                for (int bj = 0; bj < 2; ++bj) { const f32x4 v0 = acc[ai][bj][m][0] * sc, v1 = acc[ai][bj][m][1] * sc;
                    u32x4 w; w.x = cvtpk(v0[0], v0[1]); w.y = cvtpk(v0[2], v0[3]); w.z = cvtpk(v1[0], v1[1]); w.w = cvtpk(v1[2], v1[3]);
                    *(u32x4*)(rowp + bj * 128) = w;
                    float s = (v0[0] * v0[0] + v0[1] * v0[1]) + (v0[2] * v0[2] + v0[3] * v0[3]) + (v1[0] * v1[0] + v1[1] * v1[1]) + (v1[2] * v1[2] + v1[3] * v1[3]);
                    s += __shfl_xor(s, 16); s += __shfl_xor(s, 32);
                    if (fq == 0) stats[(size_t)row * 24 + u.pn * 8 + bj * 4 + wc] = s; } }
    }
};
struct EpiResidual {
    static constexpr bool PERM = true; static constexpr bool IDEM = false; static constexpr bool KEYPERM = false;
    const Frame* F; bf16_t* dst; int layer; bool from_input; float sc;
    __device__ __forceinline__ void operator()(const f32x4 (&acc)[2][2][4][2], const pg8::Unit& u, int wr, int wc, int fr, int fq) const {
        const int b = u.pm / 9, isctx = (u.pm % 9) == 0, mrow = isctx ? 16 : b;
        const float* gate = mod_ptr(*F, layer, mrow, 2);
        const int col0 = u.pn * 256 + wc * 32 + 8 * fq;
        f32x4 gv[2][2];
#pragma unroll
        for (int bj = 0; bj < 2; ++bj)
#pragma unroll
            for (int n = 0; n < 2; ++n) gv[bj][n] = *(const f32x4*)(gate + col0 + bj * 128 + n * 4) * sc;
#pragma unroll
        for (int ai = 0; ai < 2; ++ai)
#pragma unroll
            for (int m = 0; m < 4; ++m) { const int row = u.arow0 + ai * 128 + wr * 64 + m * 16 + fr;
                const float* bp = input_row(*F, row); bf16_t* dp = dst + (size_t)row * DM;
#pragma unroll
                for (int bj = 0; bj < 2; ++bj) { const int c = col0 + bj * 128; f32x4 b0, b1;
                    if (from_input) { b0 = *(const f32x4*)(bp + c); b1 = *(const f32x4*)(bp + c + 4); }
                    else { const u32x4 w = *(const u32x4*)(dp + c); b0 = (f32x4){bflo(w.x), bfhi(w.x), bflo(w.y), bfhi(w.y)}; b1 = (f32x4){bflo(w.z), bfhi(w.z), bflo(w.w), bfhi(w.w)}; }
                    const f32x4 r0 = b0 + gv[bj][0] * acc[ai][bj][m][0], r1 = b1 + gv[bj][1] * acc[ai][bj][m][1];
                    u32x4 o; o.x = cvtpk(r0[0], r0[1]); o.y = cvtpk(r0[2], r0[3]); o.z = cvtpk(r1[0], r1[1]); o.w = cvtpk(r1[2], r1[3]); *(u32x4*)(dp + c) = o; } }
    }
};
struct EpiSwiglu {
    static constexpr bool PERM = true; static constexpr bool IDEM = true; static constexpr bool KEYPERM = false;
    unsigned char* O;
    __device__ __forceinline__ void operator()(const f32x4 (&acc)[2][2][4][2], const pg8::Unit& u, int wr, int wc, int fr, int fq) const {
        const int row0 = u.arow0 + wr * 64 + fr + 16 * (fq & 1), col0 = u.pn * 128 + wc * 32 + 16 * (fq >> 1); constexpr float SI = 1.0f / (S8_X * S8_WGU);
#pragma unroll
        for (int ai = 0; ai < 2; ++ai)
#pragma unroll
            for (int mp = 0; mp < 4; mp += 2) { u32x2 w[2];
#pragma unroll
                for (int mm = 0; mm < 2; ++mm) { const int m = mp + mm; float h[8];
#pragma unroll
                    for (int n = 0; n < 2; ++n)
#pragma unroll
                        for (int j = 0; j < 4; ++j) h[n * 4 + j] = siluf_(acc[ai][0][m][n][j] * SI) * (acc[ai][1][m][n][j] * (SI * S8_H));
                    w[mm].x = pk4_fp8(h[0], h[1], h[2], h[3]); w[mm].y = pk4_fp8(h[4], h[5], h[6], h[7]); }
                *(u32x4*)(O + (size_t)(row0 + ai * 128 + mp * 16) * MFF + col0) = widen16(w[0], w[1]); }
    }
};
struct EpiScatter {
    static constexpr bool PERM = true; static constexpr bool IDEM = true; static constexpr bool KEYPERM = false;
    unsigned char* O; const int* perm;
    __device__ __forceinline__ void operator()(const f32x4 (&acc)[2][2][4][2], const pg8::Unit& u, int wr, int wc, int fr, int fq) const {
        const int row0 = u.arow0 + wr * 64 + fr + 16 * (fq & 1), col0 = u.pn * 256 + wc * 32 + 16 * (fq >> 1); constexpr float SI = S8_Y / (S8_H * S8_WDN);
#pragma unroll
        for (int ai = 0; ai < 2; ++ai)
#pragma unroll
            for (int mp = 0; mp < 4; mp += 2) { const int a = perm[row0 + ai * 128 + mp * 16];
                unsigned char* rowp = O + (size_t)(a < 0 ? 0 : a) * DM + col0;
#pragma unroll
                for (int bj = 0; bj < 2; ++bj) { u32x2 w[2];
#pragma unroll
                    for (int mm = 0; mm < 2; ++mm) { const f32x4 v0 = acc[ai][bj][mp + mm][0] * SI, v1 = acc[ai][bj][mp + mm][1] * SI;
                        w[mm].x = pk4_fp8_nc(v0[0], v0[1], v0[2], v0[3]); w[mm].y = pk4_fp8_nc(v1[0], v1[1], v1[2], v1[3]); }
                    const u32x4 o = widen16(w[0], w[1]);
                    if (a >= 0) *(u32x4*)(rowp + bj * 128) = o; }
                asm volatile("" ::: "memory"); }
    }
};
struct EpiQ {
    static constexpr bool PERM = true; static constexpr bool IDEM = true; static constexpr bool KEYPERM = false;
    unsigned char* O; const float* stats;
    __device__ __forceinline__ void operator()(const f32x4 (&acc)[2][2][4][2], const pg8::Unit& u, int wr, int wc, int fr, int fq) const {
        float invf[2][4]; int fq2 = fq; asm volatile("" : "+v"(fq2));
#pragma unroll
        for (int n = 0; n < 2; ++n)
#pragma unroll
            for (int j = 0; j < 4; ++j) invf[n][j] = __expf(-(float)(8 * (fq2 & 1) + 4 * n + j) * (2.0f / 32.0f) * 9.210340371976184f);
        const bool lowhalf = fq2 < 2;
#pragma unroll
        for (int ai = 0; ai < 2; ++ai)
#pragma unroll
            for (int mp = 0; mp < 4; mp += 2) { u32x2 w[2][2];
#pragma unroll
                for (int mm = 0; mm < 2; ++mm) { const int m = mp + mm; const int row = u.arow0 + ai * 128 + wr * 64 + m * 16 + fr;
                    const float* st = stats + (size_t)row * 24; float ss = 0.f;
#pragma unroll
                    for (int q = 0; q < 3; ++q) { const f32x4 s4 = *(const f32x4*)(st + 4 * q); ss += (s4[0] + s4[1]) + (s4[2] + s4[3]); }
                    const float sc = __builtin_amdgcn_rsqf(ss * (1.0f / QRANK) + RMS_EPS) * (ATT_C2 * S8_Q);
                    const int t = (row % PB) - CTXL; const float gr = (float)(t >> 6), gc = (float)(t & 63);
#pragma unroll
                    for (int bj = 0; bj < 2; ++bj) { const int cg = u.pn * 256 + bj * 128 + wc * 32; const int within = cg % 192;
                        f32x4 v[2] = {acc[ai][bj][m][0] * sc, acc[ai][bj][m][1] * sc};
                        if (within >= 128) { const float p = (within == 128) ? gr : gc;
#pragma unroll
                            for (int n = 0; n < 2; ++n)
#pragma unroll
                                for (int j = 0; j < 4; ++j) { const float x = v[n][j], xo = __shfl_xor(x, 32); const float ang = p * invf[n][j]; const float cs = __cosf(ang), sn = __sinf(ang);
                                    v[n][j] = lowhalf ? (x * cs - xo * sn) : (xo * sn + x * cs); } }
                        w[mm][bj].x = pk4_fp8(v[0][0], v[0][1], v[0][2], v[0][3]); w[mm][bj].y = pk4_fp8(v[1][0], v[1][1], v[1][2], v[1][3]); } }
                const int srow = u.arow0 + ai * 128 + wr * 64 + (mp + (fq2 & 1)) * 16 + fr;
#pragma unroll
                for (int bj = 0; bj < 2; ++bj) *(u32x4*)(O + (size_t)srow * NQ + u.pn * 256 + bj * 128 + wc * 32 + 16 * (fq2 >> 1)) = widen16(w[0][bj], w[1][bj]); }
    }
};
struct EpiK {
    static constexpr bool PERM = true; static constexpr bool IDEM = true; static constexpr bool KEYPERM = false;
    unsigned char* KBp; const float* stats;
    __device__ __forceinline__ void operator()(const f32x4 (&acc)[2][2][4][2], const pg8::Unit& u, int wr, int wc, int fr, int fq) const {
#pragma unroll
        for (int ai = 0; ai < 2; ++ai)
#pragma unroll
            for (int mp = 0; mp < 4; mp += 2) { u32x2 wk[2][2];
#pragma unroll
                for (int mm = 0; mm < 2; ++mm) { const int m = mp + mm; const int row = u.arow0 + ai * 128 + wr * 64 + m * 16 + fr;
                    const float* st = stats + (size_t)row * 24 + 12; const f32x4 s0 = *(const f32x4*)st, s1 = *(const f32x4*)(st + 4);
                    const float ss = ((s0[0] + s0[1]) + (s0[2] + s0[3])) + ((s1[0] + s1[1]) + (s1[2] + s1[3]));
                    const float sc = __builtin_amdgcn_rsqf(ss * (1.0f / KVRANK) + RMS_EPS) * S8_K;
#pragma unroll
                    for (int bj = 0; bj < 2; ++bj) { const f32x4 v0 = acc[ai][bj][m][0] * sc, v1 = acc[ai][bj][m][1] * sc;
                        wk[mm][bj].x = pk4_fp8(v0[0], v0[1], v0[2], v0[3]); wk[mm][bj].y = pk4_fp8(v1[0], v1[1], v1[2], v1[3]); } }
                const int srow = u.arow0 + ai * 128 + wr * 64 + (mp + (fq & 1)) * 16 + fr;
#pragma unroll
                for (int bj = 0; bj < 2; ++bj) *(u32x4*)(KBp + (size_t)srow * NQ + (2 * u.pn + bj) * 192 + wc * 32 + 16 * (fq >> 1)) = widen16(wk[0][bj], wk[1][bj]); }
    }
};
struct EpiVT {
    static constexpr bool PERM = true; static constexpr bool IDEM = true; static constexpr bool KEYPERM = true;
    unsigned char* VT; const float* stats;
    __device__ __forceinline__ void operator()(const f32x4 (&acc)[2][2][4][2], const pg8::Unit& u, int wr, int wc, int fr, int fq) const {
        int fq2 = fq; asm volatile("" : "+v"(fq2));
#pragma unroll
        for (int bj = 0; bj < 2; ++bj) { float sc[8]; const int cm0 = 128 * bj + 32 * wc + 8 * fq2;
#pragma unroll
            for (int e = 0; e < 8; ++e) { const int cm = cm0 + e; const int pos = u.brow0 + (cm & ~63) + pg8::keyperm64(cm & 63);
                const float* st = stats + (size_t)pos * 24 + 12; const f32x4 s0 = *(const f32x4*)st, s1 = *(const f32x4*)(st + 4);
                const float ss = ((s0[0] + s0[1]) + (s0[2] + s0[3])) + ((s1[0] + s1[1]) + (s1[2] + s1[3]));
                sc[e] = __builtin_amdgcn_rsqf(ss * (1.0f / KVRANK) + RMS_EPS) * S8_V; }
#pragma unroll
            for (int ai = 0; ai < 2; ++ai)
#pragma unroll
                for (int mp = 0; mp < 4; mp += 2) { u32x2 w[2];
#pragma unroll
                    for (int mm = 0; mm < 2; ++mm) { const f32x4 v0 = acc[ai][bj][mp + mm][0], v1 = acc[ai][bj][mp + mm][1];
                        w[mm].x = pk4_fp8(v0[0] * sc[0], v0[1] * sc[1], v0[2] * sc[2], v0[3] * sc[3]); w[mm].y = pk4_fp8(v1[0] * sc[4], v1[1] * sc[5], v1[2] * sc[6], v1[3] * sc[7]); }
                    const int srow = u.arow0 + ai * 128 + wr * 64 + (mp + (fq2 & 1)) * 16 + fr;
                    *(u32x4*)(VT + (size_t)srow * R + u.brow0 + 128 * bj + 32 * wc + 16 * (fq2 >> 1)) = widen16(w[0], w[1]); } }
    }
};

__device__ __forceinline__ void tr_item(const float* W, int K, int N, bf16_t* WT, int gu, const float* kscale, LAS float* scr, int item, int lane) {
    const int nblk = N / 64, kb = item / nblk, nb = item % nblk, k0 = 64 * kb, n0 = 64 * nb;
    f32x4 v[16];
#pragma unroll
    for (int i = 0; i < 16; ++i) v[i] = *(const f32x4*)(W + (size_t)(k0 + 4 * i + (lane >> 4)) * N + n0 + 4 * (lane & 15));
#pragma unroll
    for (int i = 0; i < 16; ++i) { const int kk = 4 * i + (lane >> 4); f32x4 w = v[i]; if (kscale) w = w * kscale[k0 + kk]; LAS float* p = scr + kk * 65 + 4 * (lane & 15); p[0] = w[0]; p[1] = w[1]; p[2] = w[2]; p[3] = w[3]; }
    LDS_WAIT(); asm volatile("" ::: "memory");
    int d0 = n0;
    if (gu == 1) { const int i0 = n0 & 511; d0 = 256 * (i0 >> 7) + (n0 >= 512 ? 128 : 0) + (i0 & 127); }
    if (gu == 2) { const int hh = n0 >> 8, jj = n0 & 255; d0 = jj < 128 ? hh * 128 + jj : 1024 + hh * 128 + (jj - 128); }
    const int c = lane & 7;
#pragma unroll
    for (int j = 0; j < 8; ++j) { const int n = (lane >> 3) + 8 * j; const LAS float* sp = scr + (8 * c) * 65 + n;
        u32x4 o; o.x = pk2(sp[0 * 65], sp[1 * 65]); o.y = pk2(sp[2 * 65], sp[3 * 65]); o.z = pk2(sp[4 * 65], sp[5 * 65]); o.w = pk2(sp[6 * 65], sp[7 * 65]);
        *(u32x4*)(WT + (size_t)(d0 + n) * K + k0 + 8 * c) = o; }
    LDS_WAIT(); asm volatile("" ::: "memory");
}
__device__ __forceinline__ void tr_item8(const float* W, int K, int N, unsigned char* WT, bool gu, float scale, LAS float* scr, int item, int lane) {
    const int nblk = N / 64, kb = item / nblk, nb = item % nblk, k0 = 64 * kb, n0 = 64 * nb;
    f32x4 v[16];
#pragma unroll
    for (int i = 0; i < 16; ++i) v[i] = *(const f32x4*)(W + (size_t)(k0 + 4 * i + (lane >> 4)) * N + n0 + 4 * (lane & 15));
#pragma unroll
    for (int i = 0; i < 16; ++i) { const int kk = 4 * i + (lane >> 4); const f32x4 w = v[i] * scale; LAS float* p = scr + kk * 65 + 4 * (lane & 15); p[0] = w[0]; p[1] = w[1]; p[2] = w[2]; p[3] = w[3]; }
    LDS_WAIT(); asm volatile("" ::: "memory");
    int d0 = n0;
    if (gu) { const int i0 = n0 & 511; d0 = 256 * (i0 >> 7) + (n0 >= 512 ? 128 : 0) + (i0 & 127); }
    const int c = lane & 7;
#pragma unroll
    for (int j = 0; j < 8; ++j) { const int n = (lane >> 3) + 8 * j; const LAS float* sp = scr + (8 * c) * 65 + n;
        u32x2 o; o.x = pk4_fp8(sp[0 * 65], sp[1 * 65], sp[2 * 65], sp[3 * 65]); o.y = pk4_fp8(sp[4 * 65], sp[5 * 65], sp[6 * 65], sp[7 * 65]);
        *(u32x2*)(WT + (size_t)(d0 + n) * K + k0 + 8 * c) = o; }
    LDS_WAIT(); asm volatile("" ::: "memory");
}
constexpr int MOE_W_ITEMS = 32 * 256 + 32 * 128;
__device__ __forceinline__ void moe_w_item(Frame& F, int layer, int it, LAS float* scr) {
    if (it < 32 * 256) { const int e = layer * 32 + it / 256; tr_item8(F.ka->in[I_MGU] + (size_t)e * DM * 1024, DM, 1024, F.ws + WS_WGU + (size_t)e * 1024 * DM, true, S8_WGU, scr, it % 256, F.lane); }
    else { it -= 32 * 256; const int e = layer * 32 + it / 128; tr_item8(F.ka->in[I_MDN] + (size_t)e * MFF * DM, MFF, DM, F.ws + WS_WDN + (size_t)e * DM * MFF, false, S8_WDN, scr, it % 128, F.lane); }
}
__device__ __forceinline__ void p0_prologue(Frame& F) {
    __syncthreads();

    LAS float* S = (LAS float*)F.lds;
    for (int idx = F.tid; idx < 17 * DM; idx += 512) { const int r = idx >> 10, k = idx & 1023; const float cv = r < 16 ? F.ka->in[I_C][r * DM + k] : F.ka->in[I_CCTX][k]; S[k * 20 + r] = siluf_(cv); }
    __syncthreads();
    const int gw = F.vcu * 8 + F.wave, NGW = F.G * 8;
    float* part = (float*)(F.ws + WS_PART);
    for (int it = gw; it < 2 * 8 * 96; it += NGW) {
        const int l = it / 768, rem = it % 768, kc = rem / 96, slab = rem % 96, n0 = slab * 64;
        const float* w = F.ka->in[I_ADAW] + ((size_t)l * DM + kc * 128) * 6144 + n0 + F.lane;
        float acc[17];
#pragma unroll
        for (int r = 0; r < 17; ++r) acc[r] = 0.f;
#pragma unroll 4
        for (int kk = 0; kk < 128; ++kk) {
            const float wv = w[(size_t)kk * 6144];
            const LAS float* s = S + (kc * 128 + kk) * 20;
            const f32x4 s0 = *(const LAS f32x4*)s, s1 = *(const LAS f32x4*)(s + 4), s2 = *(const LAS f32x4*)(s + 8), s3 = *(const LAS f32x4*)(s + 12); const float s4 = s[16];
            acc[0] += s0[0] * wv; acc[1] += s0[1] * wv; acc[2] += s0[2] * wv; acc[3] += s0[3] * wv;
            acc[4] += s1[0] * wv; acc[5] += s1[1] * wv; acc[6] += s1[2] * wv; acc[7] += s1[3] * wv;
            acc[8] += s2[0] * wv; acc[9] += s2[1] * wv; acc[10] += s2[2] * wv; acc[11] += s2[3] * wv;
            acc[12] += s3[0] * wv; acc[13] += s3[1] * wv; acc[14] += s3[2] * wv; acc[15] += s3[3] * wv; acc[16] += s4 * wv;
        }
#pragma unroll
        for (int r = 0; r < 17; ++r) part[((size_t)(l * 8 + kc) * 17 + r) * 6144 + n0 + F.lane] = acc[r];
    }
    __syncthreads();
    LAS float* scr = (LAS float*)(F.lds + F.wave * 16640);
    constexpr int I_A = 16 * 56, I_B = 16 * 16, I_C2 = 16 * 11, I_D = 6 * 24, I_E = 4 * 32, I_F = 16 * 16, I_GU = 16 * 16, I_DN = 8 * 16;
    constexpr int NITEMS = I_A + I_B + I_C2 + I_D + I_E + I_F + 32 * 256;
    for (int it = gw; it < NITEMS; it += NGW) {
        int r = it;
        if (r < I_A) { tr_item(F.ka->in[I_EVWIN], DM, EVIN, (bf16_t*)(F.ws + WS_WIN0), false, nullptr, scr, r, F.lane); continue; } r -= I_A;
        if (r < I_B) { tr_item8(F.ka->in[I_EVWOUT], DM, DM, F.ws + WS_WOUT0, false, S8_W1, scr, r, F.lane); continue; } r -= I_B;
        if (r < I_C2) { tr_item8(F.ka->in[I_ODWIN], DM, CIN, F.ws + WS_WIN1, false, S8_W1, scr, r, F.lane); continue; } r -= I_C2;
        if (r < I_D) { tr_item(F.ka->in[I_ODWUQ], QRANK, NQ, (bf16_t*)(F.ws + WS_WUQ), false, F.ka->in[I_ODQG], scr, r, F.lane); continue; } r -= I_D;
        if (r < I_E) { tr_item(F.ka->in[I_ODWUKV], KVRANK, NKV, (bf16_t*)(F.ws + WS_WUKV), 2, F.ka->in[I_ODKVG], scr, r, F.lane); continue; } r -= I_E;
        if (r < I_F) { tr_item8(F.ka->in[I_ODWOUT], DM, DM, F.ws + WS_WOUT1, false, S8_W1, scr, r, F.lane); continue; } r -= I_F;
        moe_w_item(F, 0, r, scr);
    }
}
__device__ __forceinline__ void moe_l1_convert(Frame& F, int lo, int hi, int w0, int nw) {
    LAS float* scr = (LAS float*)(F.lds + F.wave * 16640);
    for (int it = lo + w0; it < hi; it += nw) moe_w_item(F, 1, it, scr);
}
__device__ __forceinline__ void moe_l0_dn_convert(Frame& F, int w0, int nw) {
    LAS float* scr = (LAS float*)(F.lds + F.wave * 16640);
    for (int it = 32 * 256 + w0; it < MOE_W_ITEMS; it += nw) moe_w_item(F, 0, it, scr);
}
__device__ __forceinline__ void p0b_mod(Frame& F) {
    const float* part = (const float*)(F.ws + WS_PART); float* mod = (float*)(F.ws + WS_MOD);
    const int gt = F.vcu * 512 + F.tid, NGT = F.G * 512;
    for (int idx = gt; idx < 2 * 17 * 6144; idx += NGT) {
        const int l = idx / (17 * 6144), rem = idx % (17 * 6144), r = rem / 6144, n = rem % 6144;
        float s = F.ka->in[I_ADAB][l * 6144 + n];
#pragma unroll
        for (int kc = 0; kc < 8; ++kc) s += part[((size_t)(l * 8 + kc) * 17 + r) * 6144 + n];
        mod[idx] = s;
    }
}

__device__ __forceinline__ void load_row4(const float* p, int lane, f32x4 (&v)[4]) {
#pragma unroll
    for (int j = 0; j < 4; ++j) v[j] = *(const f32x4*)(p + 4 * lane + 256 * j);
}
__device__ __forceinline__ void load_row4_bf16(const bf16_t* p, int lane, f32x4 (&v)[4]) {
#pragma unroll
    for (int j = 0; j < 4; ++j) { const u32x2 w = *(const u32x2*)(p + 4 * lane + 256 * j); v[j] = (f32x4){bflo(w.x), bfhi(w.x), bflo(w.y), bfhi(w.y)}; }
}
__device__ __forceinline__ float sumsq4(const f32x4 (&v)[4]) {
    float s = 0.f;
#pragma unroll
    for (int j = 0; j < 4; ++j) s += (v[j][0] * v[j][0] + v[j][1] * v[j][1]) + (v[j][2] * v[j][2] + v[j][3] * v[j][3]);
    return wave_sum(s);
}
__device__ __forceinline__ void norm_mod4(f32x4 (&v)[4], const float* g, const float* shift, const float* scale, int lane) {
    const float rstd = __builtin_amdgcn_rsqf(sumsq4(v) * (1.0f / DM) + RMS_EPS);
#pragma unroll
    for (int j = 0; j < 4; ++j) { const int c = 4 * lane + 256 * j; const f32x4 gg = *(const f32x4*)(g + c), sh = *(const f32x4*)(shift + c), sc = *(const f32x4*)(scale + c);
        v[j] = v[j] * rstd * gg * (sc + 1.0f) + sh; }
}
__device__ __forceinline__ void store_row_bf16(bf16_t* p, int lane, const f32x4 (&v)[4]) {
#pragma unroll
    for (int j = 0; j < 4; ++j) { u32x2 w; w.x = cvtpk(v[j][0], v[j][1]); w.y = cvtpk(v[j][2], v[j][3]); *(u32x2*)(p + 4 * lane + 256 * j) = w; }
}
__device__ __forceinline__ void moe_combine4(Frame& F, int row, int layer, int mrow, f32x4 (&v)[4]) {
    const unsigned char* ys = F.ws + WS_YS + (size_t)(2 * row) * DM; const float* aw = (const float*)(F.ws + WS_ROUTE + RT_AW);
    const float w0 = aw[2 * row] * (1.0f / S8_Y), w1 = aw[2 * row + 1] * (1.0f / S8_Y); const float* gate = mod_ptr(F, layer, mrow, 5);
#pragma unroll
    for (int j = 0; j < 4; ++j) { const int c = 4 * F.lane + 256 * j; const unsigned y0 = *(const unsigned*)(ys + c), y1 = *(const unsigned*)(ys + DM + c); const f32x4 gg = *(const f32x4*)(gate + c);
        const f32x2 a0 = __builtin_amdgcn_cvt_pk_f32_fp8((int)y0, false), a1 = __builtin_amdgcn_cvt_pk_f32_fp8((int)y0, true), b0 = __builtin_amdgcn_cvt_pk_f32_fp8((int)y1, false), b1 = __builtin_amdgcn_cvt_pk_f32_fp8((int)y1, true);
        f32x4 y; y[0] = w0 * a0[0] + w1 * b0[0]; y[1] = w0 * a0[1] + w1 * b0[1]; y[2] = w0 * a1[0] + w1 * b1[0]; y[3] = w0 * a1[1] + w1 * b1[1];
        v[j] = v[j] + gg * y; }
}
__device__ __forceinline__ void p1_norm_input(Frame& F) {
    const int gw = F.vcu * 8 + F.wave, NGW = F.G * 8; bf16_t* hx = (bf16_t*)(F.ws + WS_HX);
    for (int row = gw; row < R; row += NGW) {
        const int b = row / PB, pos = row - b * PB, mrow = pos < CTXL ? 16 : b;
        f32x4 v[4]; load_row4(input_row(F, row), F.lane, v);
        norm_mod4(v, F.ka->in[I_NMIXG], mod_ptr(F, 0, mrow, 0), mod_ptr(F, 0, mrow, 1), F.lane);
        store_row_bf16(hx + (size_t)row * DM, F.lane, v);
    }
}
__device__ __forceinline__ void p8_combine_norm(Frame& F) {
    const int gw = F.vcu * 8 + F.wave, NGW = F.G * 8; bf16_t* hx = (bf16_t*)(F.ws + WS_HX); bf16_t* xs = (bf16_t*)(F.ws + WS_XS);
    for (int row = gw; row < R; row += NGW) {
        const int b = row / PB, pos = row - b * PB, mrow = pos < CTXL ? 16 : b;
        f32x4 v[4]; load_row4_bf16(xs + (size_t)row * DM, F.lane, v);
        moe_combine4(F, row, 0, mrow, v);
        store_row_bf16(xs + (size_t)row * DM, F.lane, v);
        norm_mod4(v, F.ka->in[I_NMIXG] + DM, mod_ptr(F, 1, mrow, 0), mod_ptr(F, 1, mrow, 1), F.lane);
#pragma unroll
        for (int j = 0; j < 4; ++j) *(unsigned*)((unsigned char*)hx + (size_t)row * DM + 4 * F.lane + 256 * j) = pk4_fp8(v[j][0] * S8_X, v[j][1] * S8_X, v[j][2] * S8_X, v[j][3] * S8_X);
    }
}
__device__ __forceinline__ void p16_final(Frame& F) {
    const int gw = F.vcu * 8 + F.wave, NGW = F.G * 8; const bf16_t* xs = (const bf16_t*)(F.ws + WS_XS);
    for (int row = gw; row < R; row += NGW) {
        const int b = row / PB, pos = row - b * PB; if (pos < CTXL) continue;
        f32x4 v[4];
        if (DBG_MODE >= 10) {
            const bf16_t* hx = (const bf16_t*)(F.ws + WS_HX) + (size_t)row * DM; const bf16_t* px = (const bf16_t*)(F.ws + WS_PX0) + (size_t)row * EVIN; const bf16_t* mx = (const bf16_t*)(F.ws + WS_MIX) + (size_t)row * DM;
#pragma unroll
            for (int j = 0; j < 4; ++j)
#pragma unroll
                for (int e = 0; e < 4; ++e) { const int c = 4 * F.lane + 256 * j + e;
                    v[j][e] = DBG_MODE == 10 ? bf2f(hx[c]) : DBG_MODE == 11 ? bf2f(px[c]) + bf2f(px[1024 + c]) + bf2f(px[2048 + c]) + bf2f(px[3072 + (c & 511)]) : bf2f(mx[c]); }
        } else if (DBG_MODE == 1) load_row4(input_row(F, row), F.lane, v); else load_row4_bf16(xs + (size_t)row * DM, F.lane, v);
        if (DBG_MODE == 0) moe_combine4(F, row, 1, b, v);
        const float rstd = __builtin_amdgcn_rsqf(sumsq4(v) * (1.0f / DM) + RMS_EPS);
        float* o = F.out + ((size_t)b * SEQ + (pos - CTXL)) * DM;
#pragma unroll
        for (int j = 0; j < 4; ++j) { const int c = 4 * F.lane + 256 * j; const f32x4 gg = *(const f32x4*)(F.ka->in[I_FING] + c); *(f32x4*)(o + c) = v[j] * rstd * gg; }
        if (STAMP_PHASE >= 0 && row == CTXL && F.lane == 0) o[0] = ((const float*)(F.ws + WS_CTL))[2048];
    }
}

template <bool XONLY>
__device__ __forceinline__ void p5_norm_route(Frame& F, int layer) {

    LAS float* W1L = (LAS float*)F.lds; LAS float* W2L = W1L + 4096;
    volatile LAS int* lcnt = (volatile LAS int*)(F.lds + LDSCTL_OFF + 64);
    volatile LAS int* gbase = (volatile LAS int*)(F.lds + LDSCTL_OFF + 192);
    LAS int* wrec = (LAS int*)(F.lds + LDSCTL_OFF + 512) + F.wave * 40; int ri = 0;
    const float* wr1 = F.ka->in[I_MR1W] + (size_t)layer * DM * 4; const float* wr2 = F.ka->in[I_MR2W] + (size_t)layer * 4 * DM * 8;
    f32x4 w1r[16];
#pragma unroll
    for (int je = 0; je < 16; ++je) w1r[je] = *(const f32x4*)(wr1 + (4 * F.lane + 256 * (je >> 2) + (je & 3)) * 4);
    for (int idx = F.tid; idx < 4 * DM * 2; idx += 512) { const int half = idx & 1, k = (idx >> 1) & 1023, g = idx >> 11; const int l = (k & 255) >> 2, j = k >> 8, e = k & 3;
        *(LAS f32x4*)(W2L + ((((g * 16 + j * 4 + e) * 2 + half) * 64) + l) * 4) = *(const f32x4*)(wr2 + ((size_t)g * DM + k) * 8 + half * 4); }
    if (F.tid < 32) lcnt[F.tid] = 0;
    __syncthreads();
    const int gw = F.vcu * 8 + F.wave, NGW = F.G * 8; unsigned char* hx8 = F.ws + WS_HX; const bf16_t* xs = (const bf16_t*)(F.ws + WS_XS);
    float* aw = (float*)(F.ws + WS_ROUTE + RT_AW);
    const float* b1 = F.ka->in[I_MR1B] + layer * 4; const float* b2 = F.ka->in[I_MR2B] + layer * 32;
    for (int row = gw; row < R; row += NGW) {
        const int b = row / PB, pos = row - b * PB; if (XONLY && pos < CTXL) continue;
        const int mrow = pos < CTXL ? 16 : b;
        f32x4 v[4]; load_row4_bf16(xs + (size_t)row * DM, F.lane, v);
        norm_mod4(v, F.ka->in[I_NFFNG] + layer * DM, mod_ptr(F, layer, mrow, 3), mod_ptr(F, layer, mrow, 4), F.lane);
#pragma unroll
        for (int j = 0; j < 4; ++j) *(unsigned*)(hx8 + (size_t)row * DM + 4 * F.lane + 256 * j) = pk4_fp8(v[j][0] * S8_X, v[j][1] * S8_X, v[j][2] * S8_X, v[j][3] * S8_X);
        f32x4 l1 = {0.f, 0.f, 0.f, 0.f};
#pragma unroll
        for (int j = 0; j < 4; ++j)
#pragma unroll
            for (int e = 0; e < 4; ++e) l1 += w1r[j * 4 + e] * v[j][e];
        float g0, g1, g2, g3; wave_sum4(l1, g0, g1, g2, g3); g0 += b1[0]; g1 += b1[1]; g2 += b1[2]; g3 += b1[3];
        int grp = 0; float gm = g0;
        if (g1 > gm) { gm = g1; grp = 1; } if (g2 > gm) { gm = g2; grp = 2; } if (g3 > gm) { gm = g3; grp = 3; }
        grp = __builtin_amdgcn_readfirstlane(grp);
        const float pg = 1.0f / (__expf(g0 - gm) + __expf(g1 - gm) + __expf(g2 - gm) + __expf(g3 - gm));
        f32x4 la = {0.f, 0.f, 0.f, 0.f}, lb = {0.f, 0.f, 0.f, 0.f};
        const LAS float* w2 = W2L + grp * 16 * 2 * 64 * 4;
#pragma unroll
        for (int j = 0; j < 4; ++j)
#pragma unroll
            for (int e = 0; e < 4; ++e) { const LAS float* p = w2 + (((j * 4 + e) * 2) * 64 + F.lane) * 4; la += *(const LAS f32x4*)p * v[j][e]; lb += *(const LAS f32x4*)(p + 256) * v[j][e]; }
        float lg[8]; wave_sum8(la, lb, F.lane, lg);
#pragma unroll
        for (int q = 0; q < 8; ++q) lg[q] += b2[grp * 8 + q];
        int e0 = 0; float m0 = lg[0];
#pragma unroll
        for (int q = 1; q < 8; ++q) if (lg[q] > m0) { m0 = lg[q]; e0 = q; }
        int e1 = -1; float m1 = -3.0e38f;
#pragma unroll
        for (int q = 0; q < 8; ++q) if (q != e0 && lg[q] > m1) { m1 = lg[q]; e1 = q; }
        const float pb = __expf(m1 - m0), inv = pg / (1.0f + pb);
        if (F.lane < 2) {
            const int ex = grp * 8 + (F.lane == 0 ? e0 : e1);
            const int lp = __hip_atomic_fetch_add((LAS int*)lcnt + ex, 1, __ATOMIC_RELAXED, __HIP_MEMORY_SCOPE_WORKGROUP);
            const int a = 2 * row + F.lane; aw[a] = F.lane == 0 ? inv : inv * pb; wrec[2 * ri + F.lane] = ex | (lp << 8);
        }
        ++ri;
    }
    __syncthreads();
    if (F.tid < 32) gbase[F.tid] = (int)__hip_atomic_fetch_add((unsigned*)(F.ws + WS_CTL) + CW_GC + 64 * layer + F.tid, (unsigned)lcnt[F.tid], __ATOMIC_RELAXED, __HIP_MEMORY_SCOPE_AGENT);
    __syncthreads();
    int* perm = (int*)(F.ws + WS_ROUTE + RT_PERM); ri = 0;
    for (int row = gw; row < R; row += NGW) {
        const int b = row / PB, pos = row - b * PB; if (XONLY && pos < CTXL) continue;
        if (F.lane < 2) { const int rec = wrec[2 * ri + F.lane], e = rec & 255, p = gbase[e] + (rec >> 8); const int a = 2 * row + F.lane;
            if (p < ECAP) perm[e * ECAP + p] = a;
            else { aw[a] = 0.f; u32x4* yz = (u32x4*)(F.ws + WS_YS + (size_t)a * DM); for (int q = 0; q < DM / 16; ++q) yz[q] = (u32x4){0u, 0u, 0u, 0u}; } }
        ++ri;
    }
}
__device__ __forceinline__ void perm_clear(Frame& F) {
    int* perm = (int*)(F.ws + WS_ROUTE + RT_PERM);
    for (int i = F.vcu * 512 + F.tid; i < MAXSLOT; i += F.G * 512) perm[i] = -1;
}

__device__ __forceinline__ bf16x8 lds_frag256(const LAS unsigned char* base, int row, int chunk) { return *(const LAS bf16x8*)(base + row * 256 + ((chunk ^ (row & 15)) << 4)); }
__device__ __forceinline__ bf16x8 lds_frag128(const LAS unsigned char* base, int row, int chunk) { return *(const LAS bf16x8*)(base + row * 128 + ((chunk ^ (row & 7)) << 4)); }
#define MFMA16(a, b, c) __builtin_amdgcn_mfma_f32_16x16x32_bf16((a), (b), (c), 0, 0, 0)

typedef short v4i16_t __attribute__((ext_vector_type(4)));
__device__ __forceinline__ int trswz256(int r, int cb) { return r * 256 + (cb ^ (((r & 3) | ((r >> 1) & 4)) << 5)); }
__device__ __forceinline__ int trswz128(int r, int cb) { return r * 128 + (cb ^ ((((r >> 1) & 1) | ((r >> 2) & 2)) << 5)); }
template <int ROWB> __device__ __forceinline__ bf16x8 lds_trfrag(const LAS unsigned char* tile, int s0, int c0, int lane) {
    const int i = lane & 15, r0 = s0 + (i >> 2), r1 = r0 + 4, cb = (c0 + 4 * (i & 3)) * 2;
    const int a0 = ROWB == 256 ? trswz256(r0, cb) : trswz128(r0, cb), a1 = ROWB == 256 ? trswz256(r1, cb) : trswz128(r1, cb);
    const v4i16_t lo = __builtin_amdgcn_ds_read_tr16_b64_v4i16((LAS v4i16_t*)(tile + a0)), hi = __builtin_amdgcn_ds_read_tr16_b64_v4i16((LAS v4i16_t*)(tile + a1));
    return (bf16x8){lo[0], lo[1], lo[2], lo[3], hi[0], hi[1], hi[2], hi[3]};
}
__device__ __forceinline__ void gla_item(Frame& F, int item) {
    const int b = item >> 3, h = (item >> 1) & 3, dir = item & 1;
    LAS unsigned char* QD = F.lds; LAS unsigned char* KD = F.lds + 16384; LAS unsigned char* KT = F.lds + 32768  ; LAS unsigned char* VR = F.lds + 49152  ;
    LAS unsigned char* PS = F.lds + 65536; LAS unsigned char* ST = F.lds + 73728  ; LAS float* LF = (LAS float*)(F.lds + 106496); LAS float* SEGT = (LAS float*)(F.lds + 139264); LAS float* DEC = (LAS float*)(F.lds + 141312);
    const int tid = F.tid, lane = F.lane, wave = F.wave, fr = lane & 15, fq = lane >> 4;
    const int t0 = tid >> 4, c = tid & 15, tv = tid >> 3, cv = tid & 7;
    const bf16_t* px = (const bf16_t*)(F.ws + WS_PX0);
    bf16_t* og = (bf16_t*)(F.ws + WS_OG) + (size_t)dir * R * 512;
    float lbv[8], oml[8];
    { const float* lg = F.ka->in[I_EVLB] + h * 128 + 8 * c;
#pragma unroll
      for (int e = 0; e < 8; ++e) { lbv[e] = 1.0f / (1.0f + __expf(lg[512 + e] - lg[e])); oml[e] = 1.0f - lbv[e]; } }
    { u32x4 z = {0u, 0u, 0u, 0u};
#pragma unroll
      for (int i = 0; i < 4; ++i) *(LAS u32x4*)(ST + tid * 64 + 16 * i) = z; }
    f32x4 S[8];
#pragma unroll
    for (int i = 0; i < 8; ++i) S[i] = (f32x4){0.f, 0.f, 0.f, 0.f};
    auto chunk_p0 = [&](int j) { return dir == 0 ? 64 * j : (j < 4 ? 192 - 64 * j : PB - 64 * (j - 3)); };
    auto row_of = [&](int p0, int tau) { return b * PB + (dir == 0 ? p0 + tau : p0 + 63 - tau); };
    u32x4 rqA[2], rfA[2], rvA[2];
#define GLA_LOAD(j, RQ, RF, RV) do { const int p0_ = chunk_p0(j); \
        _Pragma("unroll") for (int i_ = 0; i_ < 2; ++i_) { const bf16_t* rp_ = px + (size_t)row_of(p0_, t0 + 32 * i_) * EVIN + h * 128 + 8 * c; RQ[i_] = *(const u32x4*)rp_; RF[i_] = *(const u32x4*)(rp_ + 512 * (1 + dir)); } \
        { const bf16_t* vp_ = px + (size_t)row_of(p0_, tv) * EVIN + 1536 + h * 128 + 8 * cv; RV[0] = *(const u32x4*)vp_; RV[1] = *(const u32x4*)(vp_ + 64); } } while (0)
    GLA_LOAD(0, rqA, rfA, rvA);
    __syncthreads();
    const int ti = wave & 3, sp = wave >> 2, ki = wave;
#define GLA_STEP(j, RQ, RF, RV) do { \
        const int p0 = chunk_p0(j); float qv[2][8], kv[2][8]; const u32x4 vraw0 = RV[0], vraw1 = RV[1]; \
        _Pragma("unroll") for (int i = 0; i < 2; ++i) { const int tau = t0 + 32 * i; float lf[8]; \
            _Pragma("unroll") for (int e = 0; e < 4; ++e) { const unsigned wq = RQ[i][e], wf = RF[i][e]; \
                qv[i][2 * e] = bflo(wq); qv[i][2 * e + 1] = bfhi(wq); \
                const float s0_ = sigmoidf_(bflo(wf)), s1_ = sigmoidf_(bfhi(wf)); \
                const float f0 = lbv[2 * e] + oml[2 * e] * s0_, f1 = lbv[2 * e + 1] + oml[2 * e + 1] * s1_; \
                kv[i][2 * e] = 1.0f - f0; kv[i][2 * e + 1] = 1.0f - f1; lf[2 * e] = lg2(f0); lf[2 * e + 1] = lg2(f1); } \
            *(LAS f32x4*)(LF + tau * 128 + 8 * c) = (f32x4){lf[0], lf[1], lf[2], lf[3]}; *(LAS f32x4*)(LF + tau * 128 + 8 * c + 4) = (f32x4){lf[4], lf[5], lf[6], lf[7]}; } \
        if ((j) + 1 < 36) GLA_LOAD((j) + 1, RQ, RF, RV); \
        __syncthreads(); \
        { const int k = tid & 127, sg = tid >> 7; float run = 0.f; \
          _Pragma("unroll") for (int i = 0; i < 16; ++i) { const int idx = (16 * sg + i) * 128 + k; run += LF[idx]; LF[idx] = run; } \
          SEGT[sg * 128 + k] = run; } \
        __syncthreads(); \
        { float seg[4][8]; float ebl[8]; \
          _Pragma("unroll") for (int s = 0; s < 4; ++s) { const f32x4 a0 = *(const LAS f32x4*)(SEGT + s * 128 + 8 * c), a1 = *(const LAS f32x4*)(SEGT + s * 128 + 8 * c + 4); \
              _Pragma("unroll") for (int e = 0; e < 4; ++e) { seg[s][e] = a0[e]; seg[s][4 + e] = a1[e]; } } \
          float offr[2][8]; const bool odd = (t0 >> 4) != 0; \
          _Pragma("unroll") for (int e = 0; e < 8; ++e) { ebl[e] = ex2((seg[0][e] + seg[1][e]) + (seg[2][e] + seg[3][e])); offr[0][e] = odd ? seg[0][e] : 0.f; offr[1][e] = (seg[0][e] + seg[1][e]) + (odd ? seg[2][e] : 0.f); } \
          _Pragma("unroll") for (int i = 0; i < 2; ++i) { const int tau = t0 + 32 * i; \
              const f32x4 c0 = *(const LAS f32x4*)(LF + tau * 128 + 8 * c), c1 = *(const LAS f32x4*)(LF + tau * 128 + 8 * c + 4); \
              float qd[8], kd[8], kt[8]; \
              _Pragma("unroll") for (int e = 0; e < 8; ++e) { \
                  const float bb = (e < 4 ? c0[e] : c1[e - 4]) + offr[i][e]; const float eb = ex2(bb); \
                  qd[e] = qv[i][e] * eb; kd[e] = kv[i][e] * __builtin_amdgcn_rcpf(eb); kt[e] = kd[e] * ebl[e]; } \
              u32x4 w; w.x = cvtpk(qd[0], qd[1]); w.y = cvtpk(qd[2], qd[3]); w.z = cvtpk(qd[4], qd[5]); w.w = cvtpk(qd[6], qd[7]); \
              *(LAS u32x4*)(QD + tau * 256 + ((c ^ (tau & 15)) << 4)) = w; \
              w.x = cvtpk(kd[0], kd[1]); w.y = cvtpk(kd[2], kd[3]); w.z = cvtpk(kd[4], kd[5]); w.w = cvtpk(kd[6], kd[7]); \
              *(LAS u32x4*)(KD + tau * 256 + ((c ^ (tau & 15)) << 4)) = w; \
              w.x = cvtpk(kt[0], kt[1]); w.y = cvtpk(kt[2], kt[3]); w.z = cvtpk(kt[4], kt[5]); w.w = cvtpk(kt[6], kt[7]); \
              *(LAS u32x4*)(KT + trswz256(tau, 16 * c)) = w; } \
          *(LAS u32x4*)(VR + trswz256(tv, 16 * cv)) = vraw0; *(LAS u32x4*)(VR + trswz256(tv, 16 * (cv + 8))) = vraw1; \
          if (tid < 128) DEC[tid] = ex2((SEGT[tid] + SEGT[128 + tid]) + (SEGT[256 + tid] + SEGT[384 + tid])); } \
        __syncthreads(); \
        bf16x8 bq[4]; \
        _Pragma("unroll") for (int ks = 0; ks < 4; ++ks) bq[ks] = lds_frag256(QD, 16 * ti + fr, ks * 4 + fq); \
        _Pragma("unroll") for (int u = 0; u < 2; ++u) { const int si = 2 * sp + u; f32x4 a = {0.f, 0.f, 0.f, 0.f}; \
            _Pragma("unroll") for (int ks = 0; ks < 4; ++ks) a = MFMA16(lds_frag256(KD, 16 * si + fr, ks * 4 + fq), bq[ks], a); \
            const int tt = 16 * ti + fr, s0 = 16 * si + 4 * fq; \
            u32x2 w; w.x = cvtpk(s0 <= tt ? a[0] : 0.f, s0 + 1 <= tt ? a[1] : 0.f); w.y = cvtpk(s0 + 2 <= tt ? a[2] : 0.f, s0 + 3 <= tt ? a[3] : 0.f); \
            *(LAS u32x2*)(PS + tt * 128 + ((2 * s0) ^ ((tt & 7) << 4))) = w; } \
        f32x4 oacc[4]; \
        _Pragma("unroll") for (int u = 0; u < 4; ++u) { const int vi = 4 * sp + u; f32x4 o = {0.f, 0.f, 0.f, 0.f}; \
            _Pragma("unroll") for (int ks = 0; ks < 4; ++ks) o = MFMA16(lds_frag256(ST, 16 * vi + fr, ks * 4 + fq), bq[ks], o); \
            oacc[u] = o; } \
        { const f32x4 dk = *(const LAS f32x4*)(DEC + 16 * ki + 4 * fq); \
          bf16x8 ak[2]; \
          _Pragma("unroll") for (int ks = 0; ks < 2; ++ks) ak[ks] = lds_trfrag<256>(KT, 32 * ks + 8 * fq, 16 * ki, lane); \
          _Pragma("unroll") for (int vi = 0; vi < 8; ++vi) { f32x4 s = S[vi] * dk; \
              _Pragma("unroll") for (int ks = 0; ks < 2; ++ks) s = MFMA16(ak[ks], lds_trfrag<256>(VR, 32 * ks + 8 * fq, 16 * vi, lane), s); \
              S[vi] = s; } } \
        __syncthreads(); \
        { bf16x8 bp[2]; \
          _Pragma("unroll") for (int ks = 0; ks < 2; ++ks) bp[ks] = lds_frag128(PS, 16 * ti + fr, ks * 4 + fq); \
          const int orow = row_of(p0, 16 * ti + fr); \
          _Pragma("unroll") for (int u = 0; u < 4; ++u) { const int vi = 4 * sp + u; f32x4 o = oacc[u]; \
              _Pragma("unroll") for (int ks = 0; ks < 2; ++ks) o = MFMA16(lds_trfrag<256>(VR, 32 * ks + 8 * fq, 16 * vi, lane), bp[ks], o); \
              u32x2 w; w.x = cvtpk(o[0], o[1]); w.y = cvtpk(o[2], o[3]); \
              *(u32x2*)(og + (size_t)orow * 512 + h * 128 + 16 * vi + 4 * fq) = w; } \
          _Pragma("unroll") for (int vi = 0; vi < 8; ++vi) { const int v = 16 * vi + fr, k0 = 16 * ki + 4 * fq; u32x2 w; w.x = cvtpk(S[vi][0], S[vi][1]); w.y = cvtpk(S[vi][2], S[vi][3]); \
              *(LAS u32x2*)(ST + v * 256 + ((2 * k0) ^ ((v & 15) << 4))) = w; } } \
    } while (0)
    for (int j = 0; j < 36; ++j) { GLA_STEP(j, rqA, rfA, rvA); }
    __syncthreads();
#undef GLA_LOAD
#undef GLA_STEP
}

__device__ __forceinline__ void sgu_item(Frame& F, int ci) {
    LAS unsigned char* VN = F.lds; LAS unsigned char* WS = F.lds + 32768;
    const int tid = F.tid, lane = F.lane, wave = F.wave, fr = lane & 15, fq = lane >> 4;
    const int r0 = ci * 128, row = tid >> 2, q = tid & 3;
    const bf16_t* px = (const bf16_t*)(F.ws + WS_PX0); unsigned char* mix = F.ws + WS_MIX;
    const bf16_t* vrow = px + (size_t)(r0 + row) * EVIN + 3072 + 32 * q;
    float sum = 0.f, sq = 0.f;
    { u32x4 vr[16];
#pragma unroll
      for (int j = 0; j < 4; ++j)
#pragma unroll
        for (int i = 0; i < 4; ++i) vr[4 * j + i] = *(const u32x4*)(vrow + 128 * j + 8 * i);
#pragma unroll
      for (int i = 0; i < 16; ++i) {
#pragma unroll
        for (int e = 0; e < 4; ++e) { const float a = geluf_(bflo(vr[i][e])), bb = geluf_(bfhi(vr[i][e])); sum += a + bb; sq += a * a + bb * bb; } } }
    sum += __shfl_xor(sum, 1); sum += __shfl_xor(sum, 2); sq += __shfl_xor(sq, 1); sq += __shfl_xor(sq, 2);
    const float mean = sum * (1.0f / 512.0f), rstd = __builtin_amdgcn_rsqf(fmaxf(sq * (1.0f / 512.0f) - mean * mean, 0.f) + RMS_EPS);
    u32x4 vg[4]; f32x4 wsr[8];
#define SGU_LOADG(g) do { const float* wsg_ = F.ka->in[I_EVWS] + (size_t)(g) * 128 * 128; _Pragma("unroll") for (int it_ = 0; it_ < 4; ++it_) { const int idx_ = tid + 512 * it_; \
        wsr[2 * it_] = *(const f32x4*)(wsg_ + (idx_ >> 4) * 128 + 8 * (idx_ & 15)); wsr[2 * it_ + 1] = *(const f32x4*)(wsg_ + (idx_ >> 4) * 128 + 8 * (idx_ & 15) + 4); } \
        _Pragma("unroll") for (int i_ = 0; i_ < 4; ++i_) vg[i_] = *(const u32x4*)(vrow + 128 * (g) + 8 * i_); } while (0)
    SGU_LOADG(0);
#pragma unroll 1
    for (int g = 0; g < 4; ++g) {
        const float* gain = F.ka->in[I_EVSGUG] + 128 * g + 32 * q;
#pragma unroll
        for (int i = 0; i < 4; ++i) { const u32x4 w = vg[i]; const f32x4 g0 = *(const f32x4*)(gain + 8 * i), g1 = *(const f32x4*)(gain + 8 * i + 4);
            u32x4 o;
            o.x = cvtpk((geluf_(bflo(w.x)) - mean) * rstd * g0[0], (geluf_(bfhi(w.x)) - mean) * rstd * g0[1]); o.y = cvtpk((geluf_(bflo(w.y)) - mean) * rstd * g0[2], (geluf_(bfhi(w.y)) - mean) * rstd * g0[3]);
            o.z = cvtpk((geluf_(bflo(w.z)) - mean) * rstd * g1[0], (geluf_(bfhi(w.z)) - mean) * rstd * g1[1]); o.w = cvtpk((geluf_(bflo(w.w)) - mean) * rstd * g1[2], (geluf_(bfhi(w.w)) - mean) * rstd * g1[3]);
            *(LAS u32x4*)(VN + trswz256(row, (32 * q + 8 * i) * 2)) = o; }
#pragma unroll
        for (int it = 0; it < 4; ++it) { const int idx = tid + 512 * it, t = idx >> 4, ch = idx & 15; const f32x4 a = wsr[2 * it], bb = wsr[2 * it + 1];
            u32x4 w; w.x = cvtpk(a[0], a[1]); w.y = cvtpk(a[2], a[3]); w.z = cvtpk(bb[0], bb[1]); w.w = cvtpk(bb[2], bb[3]);
            *(LAS u32x4*)(WS + t * 256 + ((ch ^ (t & 15)) << 4)) = w; }
        __syncthreads();
        if (g < 3) SGU_LOADG(g + 1);
        const int c0 = 128 * g + 16 * wave + 4 * fq;
        u32x2 uw[8]; float bsv[8];
#pragma unroll
        for (int tt = 0; tt < 8; ++tt) { const int t = 16 * tt + fr; uw[tt] = *(const u32x2*)(px + (size_t)(r0 + t) * EVIN + 2560 + c0); bsv[tt] = F.ka->in[I_EVBS][g * 128 + t]; }
        bf16x8 av[4];
#pragma unroll
        for (int ks = 0; ks < 4; ++ks) av[ks] = lds_trfrag<256>(VN, 32 * ks + 8 * fq, 16 * wave, lane);
#pragma unroll
        for (int tt = 0; tt < 8; ++tt) { f32x4 a = {0.f, 0.f, 0.f, 0.f};
#pragma unroll
            for (int ks = 0; ks < 4; ++ks) a = MFMA16(av[ks], lds_frag256(WS, 16 * tt + fr, ks * 4 + fq), a);
            const int t = 16 * tt + fr; const float bs = bsv[tt]; const u32x2 u2 = uw[tt];
            *(unsigned*)(mix + (size_t)(r0 + t) * DM + 512 + c0) = pk4_fp8(geluf_(bflo(u2.x)) * (a[0] + bs) * S8_M, geluf_(bfhi(u2.x)) * (a[1] + bs) * S8_M, geluf_(bflo(u2.y)) * (a[2] + bs) * S8_M, geluf_(bfhi(u2.y)) * (a[3] + bs) * S8_M); }
        __syncthreads();
    }
#undef SGU_LOADG
}
constexpr int MOE_L1_SPLIT = 3584;
__device__ __forceinline__ void p3_mixers(Frame& F) {
    const int half = F.G >> 1;
    if (F.vcu < half) { for (int rep_ = 0; rep_ < 1 + ((REPMASK >> 21) & 1); ++rep_) for (int it = F.vcu; it < 128; it += half) gla_item(F, it); }
    else { for (int rep_ = 0; rep_ < 1 + ((REPMASK >> 22) & 1); ++rep_) for (int ci = F.vcu - half; ci < R / 128; ci += F.G - half) sgu_item(F, ci);
        moe_l0_dn_convert(F, (F.vcu - half) * 8 + F.wave, (F.G - half) * 8);
        moe_l1_convert(F, 0, MOE_L1_SPLIT, (F.vcu - half) * 8 + F.wave, (F.G - half) * 8); }
}
__device__ __forceinline__ void p3b_hgrn_out(Frame& F) {
    const int gw = F.vcu * 8 + F.wave, NGW = F.G * 8; const bf16_t* og = (const bf16_t*)(F.ws + WS_OG); const bf16_t* px = (const bf16_t*)(F.ws + WS_PX0); unsigned char* mix = F.ws + WS_MIX;
    const int c0 = 8 * F.lane; float gn[8];
#pragma unroll
    for (int e = 0; e < 8; ++e) gn[e] = F.ka->in[I_EVONORM][(c0 & 127) + e] * S8_M;
    for (int row = gw; row < R; row += NGW) {
        const u32x4 a = *(const u32x4*)(og + (size_t)row * 512 + c0), bb = *(const u32x4*)(og + (size_t)(R + row) * 512 + c0), gg = *(const u32x4*)(px + (size_t)row * EVIN + 2048 + c0);
        float o[8]; float ss = 0.f;
#pragma unroll
        for (int e = 0; e < 4; ++e) { o[2 * e] = bflo(a[e]) + bflo(bb[e]); o[2 * e + 1] = bfhi(a[e]) + bfhi(bb[e]); ss += o[2 * e] * o[2 * e] + o[2 * e + 1] * o[2 * e + 1]; }
        ss += __shfl_xor(ss, 1); ss += __shfl_xor(ss, 2); ss += __shfl_xor(ss, 4); ss += __shfl_xor(ss, 8);
        const float rstd = __builtin_amdgcn_rsqf(ss * (1.0f / 128.0f) + RMS_EPS);
        float y[8];
#pragma unroll
        for (int e = 0; e < 4; ++e) { y[2 * e] = o[2 * e] * rstd * gn[2 * e] * siluf_(bflo(gg[e])); y[2 * e + 1] = o[2 * e + 1] * rstd * gn[2 * e + 1] * siluf_(bfhi(gg[e])); }
        u32x2 w; w.x = pk4_fp8(y[0], y[1], y[2], y[3]); w.y = pk4_fp8(y[4], y[5], y[6], y[7]);
        *(u32x2*)(mix + (size_t)row * DM + c0) = w;
    }
}

__device__ __forceinline__ void p10_kr(Frame& F) {
    int nf = (NTILE * 4) % F.G; if (4 * nf >= F.G) nf = 0;
    const int bx = (int)blockIdx.x; if (bx < nf || bx >= F.G - nf) return;
    const int gw = (bx - nf) * 8 + F.wave, NGW = (F.G - 2 * nf) * 8; const bf16_t* px1 = (const bf16_t*)(F.ws + WS_PX1); unsigned char* kb = F.ws + WS_KB;
    const int d = F.lane, i16 = d & 15; const float invf = __expf(-(float)i16 * (2.0f / 32.0f) * 9.210340371976184f);
    for (int row = gw; row < R; row += NGW) {
        const int pos = row % PB; float x = bf2f(px1[(size_t)row * CINP + 640 + d]);
        const float xo = __shfl_xor(x, 16);
        if (pos >= CTXL) { const int t = pos - CTXL; const float p = (d < 32) ? (float)(t >> 6) : (float)(t & 63); const float ang = p * invf, cs = __cosf(ang), sn = __sinf(ang);
            x = (d & 16) ? (xo * sn + x * cs) : (x * cs - xo * sn); }
        const unsigned char hb = (unsigned char)(pk4_fp8(x * S8_K, 0.f, 0.f, 0.f) & 0xffu);
#pragma unroll
        for (int h = 0; h < 8; ++h) kb[(size_t)row * NQ + h * 192 + 128 + d] = hb;
    }
}

namespace att {
constexpr int KVBLK = 64, SHM_V = 128 * 64, SHM_K = 64 * 192;
constexpr float THR = 8.0f;
#define KSWZ192(row, colB) ((row) * 384 + ((colB) ^ (((row) & 7) << 4)))
__device__ __forceinline__ int crow(int r, int hi) { return (r & 3) + 8 * (r >> 2) + 4 * hi; }
template <bool FIRST>
__device__ __forceinline__ void partialSM(f32x16& p0, f32x16& p1, float& m_reg, f32x16& negm, float& alpha) {
    float pmax = p0[0];
#pragma unroll
    for (int r = 1; r < 16; ++r) pmax = fmaxf(pmax, p0[r]);
#pragma unroll
    for (int r = 0; r < 16; ++r) pmax = fmaxf(pmax, p1[r]);
    { auto rr = __builtin_amdgcn_permlane32_swap(__float_as_uint(pmax), __float_as_uint(pmax), false, false); pmax = fmaxf(__uint_as_float(rr[0]), __uint_as_float(rr[1])); }
    if (!FIRST && __builtin_expect(__all(pmax <= THR), 1)) { alpha = 1.f; }
    else { const float d = FIRST ? pmax : fmaxf(pmax, 0.f); alpha = FIRST ? 1.f : __builtin_amdgcn_exp2f(-d); m_reg += d;
#pragma unroll
        for (int r = 0; r < 16; ++r) { p0[r] -= d; p1[r] -= d; negm[r] = -m_reg; } }
#pragma unroll
    for (int r = 0; r < 16; ++r) p0[r] = __builtin_amdgcn_exp2f(p0[r]);
}
__device__ __forceinline__ void finishSM(f32x16& p0, f32x16& p1, float alpha, float& l_reg, i32x8_t& pa) {
#pragma unroll
    for (int r = 0; r < 16; ++r) p1[r] = __builtin_amdgcn_exp2f(p1[r]);
    float ps = 0;
#pragma unroll
    for (int r = 0; r < 16; ++r) ps += p0[r];
#pragma unroll
    for (int r = 0; r < 16; ++r) ps += p1[r];
    { auto rr = __builtin_amdgcn_permlane32_swap(__float_as_uint(ps), __float_as_uint(ps), false, false); ps = __uint_as_float(rr[0]) + __uint_as_float(rr[1]); }
    l_reg = l_reg * alpha + ps;
#pragma unroll
    for (int k = 0; k < 4; ++k) { pa[k] = (int)pk4_fp8_nc(p0[4 * k], p0[4 * k + 1], p0[4 * k + 2], p0[4 * k + 3]); pa[4 + k] = (int)pk4_fp8_nc(p1[4 * k], p1[4 * k + 1], p1[4 * k + 2], p1[4 * k + 3]); }
}
__device__ __forceinline__ void kload1(i32x8_t (&a)[2], const LAS unsigned char* const (&kb)[3][2], const int boff, const int m) {
    a[0] = __builtin_shufflevector(*(const LAS i32x4_t*)(kb[m][0] + boff), *(const LAS i32x4_t*)(kb[m][1] + boff), 0, 1, 2, 3, 4, 5, 6, 7);
    a[1] = __builtin_shufflevector(*(const LAS i32x4_t*)(kb[m][0] + boff + 6144), *(const LAS i32x4_t*)(kb[m][1] + boff + 6144), 0, 1, 2, 3, 4, 5, 6, 7);
}
__device__ __forceinline__ void kload01(i32x8_t (&a0)[2], i32x8_t (&a1)[2], const LAS unsigned char* const (&kb)[3][2], const int boff) { kload1(a0, kb, boff, 0); kload1(a1, kb, boff, 1); }
__device__ __forceinline__ void qmma(f32x16& p0, f32x16& p1, i32x8_t (&a0)[2], i32x8_t (&a1)[2], const LAS unsigned char* const (&kb)[3][2], const int boff, const i32x8_t* qr, const f32x16& negm) {
    constexpr int SA = 0x7d7d7d7d, SB = 0x76767676;
    static_assert(S8_Q * S8_K == 2048.f, "block scales assume 2^11");
    p0 = __builtin_amdgcn_mfma_scale_f32_32x32x64_f8f6f4(a0[0], qr[0], negm, 0, 0, 0, SA, 0, SB);
    p1 = __builtin_amdgcn_mfma_scale_f32_32x32x64_f8f6f4(a0[1], qr[0], negm, 0, 0, 0, SA, 0, SB);
    i32x8_t a2[2]; kload1(a2, kb, boff, 2);
    p0 = __builtin_amdgcn_mfma_scale_f32_32x32x64_f8f6f4(a1[0], qr[1], p0, 0, 0, 0, SA, 0, SB);
    p1 = __builtin_amdgcn_mfma_scale_f32_32x32x64_f8f6f4(a1[1], qr[1], p1, 0, 0, 0, SA, 0, SB);
    p0 = __builtin_amdgcn_mfma_scale_f32_32x32x64_f8f6f4(a2[0], qr[2], p0, 0, 0, 0, SA, 0, SB);
    p1 = __builtin_amdgcn_mfma_scale_f32_32x32x64_f8f6f4(a2[1], qr[2], p1, 0, 0, 0, SA, 0, SB);
    asm volatile("" : "+v"(p0), "+v"(p1));
    SBAR();
}
__device__ __forceinline__ void qkt(f32x16& p0, f32x16& p1, const LAS unsigned char* const (&kb)[3][2], const int boff, const i32x8_t* qr, const f32x16& negm) {
    i32x8_t a0[2], a1[2]; kload01(a0, a1, kb, boff); qmma(p0, p1, a0, a1, kb, boff, qr, negm);
}
__device__ __forceinline__ void pv_d0(f32x16* o, const LAS unsigned char* vt, int vo0, int vo1, const i32x8_t pa) {
#pragma unroll
    for (int d0 = 0; d0 < 4; ++d0) {
        const i32x8_t vf = __builtin_shufflevector(*(const LAS i32x4_t*)(vt + vo0 + d0 * 2048), *(const LAS i32x4_t*)(vt + vo1 + d0 * 2048), 0, 1, 2, 3, 4, 5, 6, 7);
        o[d0] = __builtin_amdgcn_mfma_scale_f32_32x32x64_f8f6f4(pa, vf, o[d0], 0, 0, 0, 0x7d7d7d7d, 0, 0x7d7d7d7d);
        SBAR(); }
    static_assert(S8_V == 16.f, "block scale assumes 2^4");
}
constexpr int NSLOT = 3, LDS_KR = NSLOT * SHM_V  , LDS_WS = NSLOT * (SHM_V + SHM_K);
__device__ __forceinline__ void attn_unit(const int tid, const unsigned char* __restrict__ Qb, const unsigned char* __restrict__ Kh, const unsigned char* __restrict__ Vh, unsigned char* __restrict__ Ob, LAS unsigned char* lds) {
    const int wid = __builtin_amdgcn_readfirstlane(tid >> 6), lane = tid & 63, r32 = lane & 31, hi = lane >> 5;
    LAS unsigned char* V_lds = lds; LAS unsigned char* K_lds = lds + LDS_KR;
    LAS float* ws = (LAS float*)(lds + LDS_WS) + wid * 64; LAS float* li_l = ws; LAS float* al_l = ws + 32;
    float m_reg = 0.f, l_reg = 0; f32x16 negm = {}; f32x16 o[4] = {}; i32x8_t qr[3];
    const unsigned char* Qw = Qb + (size_t)(wid * 32 + r32) * NQ + hi * 32;
#pragma unroll
    for (int m = 0; m < 3; ++m) qr[m] = __builtin_shufflevector(*(const i32x4_t*)(Qw + 64 * m), *(const i32x4_t*)(Qw + 64 * m + 16), 0, 1, 2, 3, 4, 5, 6, 7);
    unsigned kgo[2], vgo;
#pragma unroll
    for (int i = 0; i < 2; ++i) { const int q = (8 * i + wid) * 64 + lane, row = q / 12, chp = q % 12, ch = (chp & ~3) | ((chp ^ (row >> 2)) & 3); kgo[i] = (unsigned)(row * NQ + ch * 16); }
    { const int q = wid * 64 + lane, d = q >> 2, ch = (q & 3) ^ ((d >> 2) & 3); vgo = (unsigned)d * (unsigned)R + 16u * (unsigned)ch; }
    const int vo0 = r32 * 64 + (((2 * hi) ^ ((r32 >> 2) & 3)) << 4), vo1 = r32 * 64 + (((2 * hi + 1) ^ ((r32 >> 2) & 3)) << 4);
    const LAS unsigned char* kb[3][2];
    { const LAS unsigned char* k0_ = K_lds + r32 * 192 + ((32 * hi) ^ (((r32 >> 2) & 3) << 4)); const LAS unsigned char* k1_ = K_lds + r32 * 192 + ((32 * hi + 16) ^ (((r32 >> 2) & 3) << 4));
#pragma unroll
      for (int m = 0; m < 3; ++m) { kb[m][0] = k0_ + 64 * m; kb[m][1] = k1_ + 64 * m; } }
    const __amdgpu_buffer_rsrc_t rsK = __builtin_amdgcn_make_buffer_rsrc((void*)Kh, 0, 0x7fffffff, 0x00020000), rsV = __builtin_amdgcn_make_buffer_rsrc((void*)Vh, 0, 0x7fffffff, 0x00020000);
#define DMA_K(t, slot) do { const int so_ = (t) * (KVBLK * NQ); \
    __builtin_amdgcn_raw_ptr_buffer_load_lds(rsK, (LAS unsigned*)(K_lds + (slot) * SHM_K + wid * 1024), 16, (int)kgo[0], so_, 0, 0); \
    if (wid < 4) __builtin_amdgcn_raw_ptr_buffer_load_lds(rsK, (LAS unsigned*)(K_lds + (slot) * SHM_K + (8 + wid) * 1024), 16, (int)kgo[1], so_, 0, 0); } while (0)
#define DMA_V(t, slot) do { __builtin_amdgcn_raw_ptr_buffer_load_lds(rsV, (LAS unsigned*)(V_lds + (slot) * SHM_V + wid * 1024), 16, (int)vgo, (t) * KVBLK, 0, 0); } while (0)
#define RESC(a) do { if (__any((a) < 1.f)) { int l_ = threadIdx.x & 63; asm volatile("" : "+v"(l_));              \
    LAS float* al_ = (LAS float*)(lds + LDS_WS) + wid * 64 + 32; if (l_ < 32) al_[l_] = (a); asm volatile("s_waitcnt lgkmcnt(0)" ::: "memory"); const LAS float* alh_ = al_ + 4 * (l_ >> 5); \
    _Pragma("unroll") for (int d_ = 0; d_ < 4; ++d_) _Pragma("unroll") for (int r_ = 0; r_ < 16; ++r_) o[d_][r_] *= alh_[crow(r_, 0)]; } } while (0)
#define WAITBAR() do { asm volatile("s_waitcnt vmcnt(0)" ::: "memory"); __syncthreads(); } while (0)
#define WAITBAR3() do { if (wid < 4) asm volatile("s_waitcnt vmcnt(2) lgkmcnt(0)" ::: "memory"); else asm volatile("s_waitcnt vmcnt(1) lgkmcnt(0)" ::: "memory"); __builtin_amdgcn_s_barrier(); asm volatile("" ::: "memory"); } while (0)
    f32x16 pA0, pA1, pB0, pB1; float mnA, mnB, alA, alB; i32x8_t pa; constexpr int NT = PB / KVBLK;
    int s0 = 0, s1 = 1, s2 = 2;
    DMA_K(0, 0); DMA_V(0, 0); DMA_K(1, 1); WAITBAR();
    DMA_K(2, 2); DMA_V(1, 1);
    qkt(pA0, pA1, kb, 0, qr, negm); partialSM<true>(pA0, pA1, m_reg, negm, alA); RESC(alA);
    WAITBAR();
#define STEP(PC0, PC1, mnC, alC, PP0, PP1, alP, t) do { \
        { const int tmp_ = s0; s0 = s1; s1 = s2; s2 = tmp_; }              \
        SBAR(); \
        if ((t) + 2 < NT) DMA_K((t) + 2, s2);                               \
        { i32x8_t ka0_[2], ka1_[2]; kload01(ka0_, ka1_, kb, s0 * SHM_K); SBAR();     \
          finishSM(PP0, PP1, alP, l_reg, pa); SBAR(); \
          qmma(PC0, PC1, ka0_, ka1_, kb, s0 * SHM_K, qr, negm); } \
        pv_d0(o, V_lds + s2 * SHM_V, vo0, vo1, pa);                        \
        partialSM<false>(PC0, PC1, m_reg, negm, alC); \
        RESC(alC); \
        if ((t) + 2 < NT) WAITBAR3(); else WAITBAR(); \
        if ((t) + 1 < NT) DMA_V((t) + 1, s1);                               \
    } while (0)
    for (int t = 1; t + 1 < NT; t += 2) {
        STEP(pB0, pB1, mnB, alB, pA0, pA1, alA, t);
        STEP(pA0, pA1, mnA, alA, pB0, pB1, alB, t + 1);
    }
    STEP(pB0, pB1, mnB, alB, pA0, pA1, alA, NT - 1);
    { const int tmp_ = s0; s0 = s1; s1 = s2; s2 = tmp_; }
    finishSM(pB0, pB1, alB, l_reg, pa); SBAR();
    pv_d0(o, V_lds + s2 * SHM_V, vo0, vo1, pa);
    { int l_ = threadIdx.x & 63; asm volatile("" : "+v"(l_)); if (l_ < 32) ((LAS float*)(lds + LDS_WS) + wid * 64)[l_] = l_reg; } asm volatile("s_waitcnt lgkmcnt(0)" ::: "memory");
    __syncthreads();
    int lane2 = threadIdx.x & 63; asm volatile("" : "+v"(lane2));
    const int hi2 = lane2 >> 5, r322 = lane2 & 31;
    LAS unsigned char* stg = lds + wid * 4096;
    LAS unsigned char* stg_l = stg + 4 * hi2 * 128 + r322; const LAS float* li_hi = li_l + 4 * hi2;
#pragma unroll
    for (int r = 0; r < 16; ++r) { const float rl = __builtin_amdgcn_rcpf(li_hi[crow(r, 0)]) * S8_O;
        const unsigned pk = pk4_fp8(o[0][r] * rl, o[1][r] * rl, o[2][r] * rl, o[3][r] * rl);
#pragma unroll
        for (int d0 = 0; d0 < 4; ++d0) stg_l[crow(r, 0) * 128 + d0 * 32] = (unsigned char)(pk >> (8 * d0)); }
    asm volatile("s_waitcnt lgkmcnt(0)" ::: "memory");
    unsigned char* Ow = Ob + (size_t)(wid * 32 + (lane2 >> 3)) * DM + (lane2 & 7) * 16; const LAS unsigned char* stg_r = stg + (lane2 >> 3) * 128 + (lane2 & 7) * 16;
#pragma unroll
    for (int i = 0; i < 4; ++i) { const u32x4 v = *(const LAS u32x4*)(stg_r + i * 8 * 128); *(u32x4*)(Ow + (size_t)(i * 8) * DM) = v; }
    __syncthreads();
#undef DMA_K
#undef DMA_V
#undef RESC
#undef WAITBAR
#undef WAITBAR3
#undef STEP
}
}
__device__ __forceinline__ void p11_attention(Frame& F) {
    const unsigned char* Q = F.ws + WS_Q; const unsigned char* K = F.ws + WS_KB; const unsigned char* V = F.ws + WS_VB; unsigned char* O = F.ws + WS_MIX;
    for (int i = 0; i < 4; ++i) {
        const int bh = (F.vcu >> 3) + 32 * i, qb = F.vcu & 7, b = bh >> 3, h = bh & 7;
        const size_t qrow = (size_t)b * PB + CTXL + qb * 256, krow = (size_t)b * PB;
        int t_ = threadIdx.x; asm volatile("" : "+v"(t_));
        att::attn_unit(t_, Q + qrow * NQ + h * 192, K + krow * NQ + h * 192, V + (size_t)(h * 128) * R + krow, O + qrow * DM + h * 128, F.lds);
    }
}

__device__ __forceinline__ void ka_launder(Frame& F) { asm volatile("" : "+s"(F.ka)); int t = threadIdx.x; asm volatile("" : "+v"(t)); F.tid = t; F.lane = t & 63; F.wave = __builtin_amdgcn_readfirstlane(t >> 6); }
#ifndef DBG_MODE
#define DBG_MODE 0
#endif
constexpr int NPH = 21;
__device__ __forceinline__ void moe_gemms(Frame& F, int layer, int which) {
    LAS int* pfx = (LAS int*)(F.lds + LDSCTL_OFF + 512); LAS unsigned char* tab = (LAS unsigned char*)(F.lds + LDSCTL_OFF + 768);
    { const unsigned* gc = (const unsigned*)(F.ws + WS_CTL) + CW_GC + 64 * layer;
      if (F.tid < 32) { int cnt = (int)gc[F.tid]; cnt = cnt > ECAP ? ECAP : cnt; pfx[F.tid + 1] = (cnt + 255) >> 8; }
      __syncthreads();
      if (F.tid == 0) { int sacc = 0; pfx[0] = 0; for (int e = 0; e < 32; ++e) { sacc += pfx[e + 1]; pfx[e + 1] = sacc; } }
      __syncthreads();
      { const int blk = F.tid; if (blk < pfx[32]) { int e = 0; while (pfx[e + 1] <= blk) ++e; tab[blk] = (unsigned char)e; } }
      __syncthreads(); }
    MoeSched S; S.pfx = pfx; S.tab = tab; S.nwg = __builtin_amdgcn_readfirstlane(pfx[32]) * 4; S.G = F.G; S.c = (int)blockIdx.x;
    const int* perm = (const int*)(F.ws + WS_ROUTE + RT_PERM);
    if (which == 0) {
        pg8::Gemm g{(const bf16_t*)(F.ws + WS_HX), (const bf16_t*)(F.ws + WS_WGU + (size_t)layer * 32 * 1024 * DM), DM / 2, DM / 2, DM / 2, perm};
        EpiSwiglu E{F.ws + WS_ACT};
        pg8::gemm_phase<EpiSwiglu, MoeSched, true, true>(F.lds, g, S, E);
    } else {
        pg8::Gemm g{(const bf16_t*)(F.ws + WS_ACT), (const bf16_t*)(F.ws + WS_WDN + (size_t)layer * 32 * DM * MFF), MFF / 2, MFF / 2, MFF / 2, nullptr};
        EpiScatter E{F.ws + WS_YS, perm};
        pg8::gemm_phase<EpiScatter, MoeSched, false, true>(F.lds, g, S, E);
    }
}
__global__ void __launch_bounds__(512, 2) mega_fwd(Args args) {
    extern __shared__ __attribute__((aligned(16))) unsigned char lds_raw[];
    Frame F;
    F.lds = (LAS unsigned char*)lds_raw;
    F.tid = threadIdx.x; F.lane = F.tid & 63; F.wave = __builtin_amdgcn_readfirstlane(F.tid >> 6);
    F.G = gridDim.x; { const int bx = blockIdx.x; F.vcu = (F.G % 8 == 0) ? (bx % 8) * (F.G / 8) + bx / 8 : bx; }
    F.ws = args.ws; F.out = args.out;
    F.ka = (const __attribute__((address_space(4))) Args*)__builtin_amdgcn_kernarg_segment_ptr();
    for (int u = F.tid; u < (LDS_BYTES - LDSCTL_OFF) / 4; u += 512) ((LAS unsigned*)(F.lds + LDSCTL_OFF))[u] = 0u;
    __syncthreads();
    volatile LAS unsigned* MISC = (volatile LAS unsigned*)(F.lds + MISC_OFF);
    unsigned* ctl = (unsigned*)(F.ws + WS_CTL);
    XcdBarrier bar; bar.bar = ctl + CW_BAR; bar.x = 0; bar.st = nullptr;
    if (!args.nobar) bar = xcd_barrier_post(ctl + CW_BAR, MISC + 8);
    const int lo = args.ph_lo, hi = args.ph_hi;
    const unsigned long long t_start = (STAMP_PHASE >= 0) ? __builtin_amdgcn_s_memrealtime() : 0ull;
#define IN(k) (lo <= (k) && (k) < hi)
#define SEAM(k) do { if (IN(k) && IN((k) + 1)) xcd_barrier(bar); \
    if (STAMP_PHASE == (k) && blockIdx.x == 0 && threadIdx.x == 0) { const unsigned long long t1_ = __builtin_amdgcn_s_memrealtime(); ((float*)(F.ws + WS_CTL))[2048] = (float)(t1_ - t_start) * 0.01f; } } while (0)
    constexpr int LAST = DBG_MODE == 0 ? 20 : DBG_MODE == 1 ? -1 : DBG_MODE == 2 ? 6 : DBG_MODE == 3 ? 11 : DBG_MODE == 4 ? 15 : DBG_MODE == 10 ? 2 : DBG_MODE == 11 ? 3 : 5;
#ifndef PHMASK
#define PHMASK 0x1fffff
#endif
#define RUN(k) (ka_launder(F), IN(k) && (k) <= LAST && ((PHMASK >> (k)) & 1))

    if (RUN(0)) for (int rep_ = 0; rep_ < 1 + ((REPMASK >> 0) & 1); ++rep_) p0_prologue(F);
    SEAM(0);
    if (RUN(1)) for (int rep_ = 0; rep_ < 1 + ((REPMASK >> 1) & 1); ++rep_) p0b_mod(F);
    SEAM(1);
    if (RUN(2)) for (int rep_ = 0; rep_ < 1 + ((REPMASK >> 2) & 1); ++rep_) p1_norm_input(F);
    SEAM(2);
    if (RUN(3)) for (int rep_ = 0; rep_ < 1 + ((REPMASK >> 3) & 1); ++rep_) { pg8::Gemm g{(const bf16_t*)(F.ws + WS_HX), (const bf16_t*)(F.ws + WS_WIN0), DM, DM, DM, nullptr}; TileSched<false> S; S.init(EVIN / 256, F.G, (int)blockIdx.x);
        EpiStoreBf16 E{(bf16_t*)(F.ws + WS_PX0), EVIN}; pg8::gemm_phase<EpiStoreBf16, TileSched<false>, false>(F.lds, g, S, E); }
    SEAM(3);
    if (RUN(4)) for (int rep_ = 0; rep_ < 1 + ((REPMASK >> 4) & 1); ++rep_) p3_mixers(F);
    SEAM(4);
    if (RUN(5)) for (int rep_ = 0; rep_ < 1 + ((REPMASK >> 5) & 1); ++rep_) { p3b_hgrn_out(F); perm_clear(F); }
    SEAM(5);
    if (RUN(6)) for (int rep_ = 0; rep_ < 1 + ((REPMASK >> 6) & 1); ++rep_) { pg8::Gemm g{(const bf16_t*)(F.ws + WS_MIX), (const bf16_t*)(F.ws + WS_WOUT0), DM / 2, DM / 2, DM / 2, nullptr}; TileSched<false> S; S.init(DM / 256, F.G, (int)blockIdx.x);
        EpiResidual E{&F, (bf16_t*)(F.ws + WS_XS), 0, true, 1.0f / (S8_M * S8_W1)}; pg8::gemm_phase<EpiResidual, TileSched<false>, false, true>(F.lds, g, S, E);
        { const int n3 = (NTILE * 4) % F.G;
          if (rep_ == 0 && (int)blockIdx.x >= n3) { ka_launder(F); moe_l1_convert(F, MOE_L1_SPLIT, MOE_W_ITEMS, ((int)blockIdx.x - n3) * 8 + F.wave, (F.G - n3) * 8); } } }
    SEAM(6);
    if (RUN(7)) for (int rep_ = 0; rep_ < 1 + ((REPMASK >> 7) & 1); ++rep_) p5_norm_route<false>(F, 0);
    SEAM(7);
    if (RUN(9)) for (int rep_ = 0; rep_ < 1 + ((REPMASK >> 9) & 1); ++rep_) moe_gemms(F, 0, 0);
    SEAM(9);
    if (RUN(10)) for (int rep_ = 0; rep_ < 1 + ((REPMASK >> 10) & 1); ++rep_) moe_gemms(F, 0, 1);
    SEAM(10);
    if (RUN(11)) for (int rep_ = 0; rep_ < 1 + ((REPMASK >> 11) & 1); ++rep_) { p8_combine_norm(F); perm_clear(F); }
    SEAM(11);
    if (RUN(12)) for (int rep_ = 0; rep_ < 1 + ((REPMASK >> 12) & 1); ++rep_) { pg8::Gemm g{(const bf16_t*)(F.ws + WS_HX), (const bf16_t*)(F.ws + WS_WIN1), DM / 2, DM / 2, DM / 2, nullptr}; TileSched<false> S; S.init(CINP / 256, F.G, (int)blockIdx.x);
        EpiStoreStats E{(bf16_t*)(F.ws + WS_PX1), CINP, (float*)(F.ws + WS_STATS), 1.0f / (S8_X * S8_W1)}; pg8::gemm_phase<EpiStoreStats, TileSched<false>, false, true>(F.lds, g, S, E); }
    SEAM(12);
    if (RUN(13)) for (int rep_ = 0; rep_ < 1 + ((REPMASK >> 13) & 1); ++rep_) {
        { pg8::Gemm g{(const bf16_t*)(F.ws + WS_PX1), (const bf16_t*)(F.ws + WS_WUQ), CINP, QRANK, QRANK, nullptr}; TileSched<true> S; S.init(NQ / 256, F.G, (int)blockIdx.x);
          EpiQ E{F.ws + WS_Q, (const float*)(F.ws + WS_STATS)}; pg8::gemm_phase<EpiQ, TileSched<true>, false>(F.lds, g, S, E); }
        { pg8::Gemm g{(const bf16_t*)(F.ws + WS_PX1) + QRANK, (const bf16_t*)(F.ws + WS_WUKV), CINP, KVRANK, KVRANK, nullptr}; TileSched<false> S; S.init(1024 / 256, F.G, (int)blockIdx.x);
          EpiK E{F.ws + WS_KB, (const float*)(F.ws + WS_STATS)}; pg8::gemm_phase<EpiK, TileSched<false>, false>(F.lds, g, S, E); }
        { pg8::Gemm g{(const bf16_t*)(F.ws + WS_WUKV) + (size_t)1024 * KVRANK, (const bf16_t*)(F.ws + WS_PX1) + QRANK, KVRANK, CINP, KVRANK, nullptr};
          TileSched<false> S; S.init_mn(1024 / 256, NTILE, F.G, F.G - 1 - (int)blockIdx.x);
          EpiVT E{F.ws + WS_VB, (const float*)(F.ws + WS_STATS)}; pg8::gemm_phase<EpiVT, TileSched<false>, false>(F.lds, g, S, E); }
        ka_launder(F);
        p10_kr(F);
    }
    SEAM(13);
    if (RUN(14)) for (int rep_ = 0; rep_ < 1 + ((REPMASK >> 14) & 1); ++rep_) p11_attention(F);
    SEAM(14);
    if (RUN(15)) for (int rep_ = 0; rep_ < 1 + ((REPMASK >> 15) & 1); ++rep_) { pg8::Gemm g{(const bf16_t*)(F.ws + WS_MIX), (const bf16_t*)(F.ws + WS_WOUT1), DM / 2, DM / 2, DM / 2, nullptr}; TileSched<true> S; S.init(DM / 256, F.G, (int)blockIdx.x);
        EpiResidual E{&F, (bf16_t*)(F.ws + WS_XS), 1, false, 1.0f / (S8_O * S8_W1)}; pg8::gemm_phase<EpiResidual, TileSched<true>, false, true>(F.lds, g, S, E); }
    SEAM(15);
    if (RUN(16)) for (int rep_ = 0; rep_ < 1 + ((REPMASK >> 16) & 1); ++rep_) p5_norm_route<true>(F, 1);
    SEAM(16);
    if (RUN(18)) for (int rep_ = 0; rep_ < 1 + ((REPMASK >> 18) & 1); ++rep_) moe_gemms(F, 1, 0);
    SEAM(18);
    if (RUN(19)) for (int rep_ = 0; rep_ < 1 + ((REPMASK >> 19) & 1); ++rep_) moe_gemms(F, 1, 1);
    SEAM(19);
    ka_launder(F);
    if (IN(20) && ((PHMASK >> 20) & 1)) p16_final(F);
#undef IN
#undef SEAM
#undef RUN
}

#ifndef MK_N_LAUNCHES
#define MK_N_LAUNCHES 1
#endif
extern "C" void kernel_launch(void* const* d_in, const int* in_sizes, int n_in, void* d_out, int out_size, void* d_ws, size_t ws_size, hipStream_t stream) {
    static int grid = 0;
    if (grid == 0) {
        if (n_in != 28 || out_size != NB * SEQ * DM || ws_size < WS_END) { fprintf(stderr, "kernel_launch: unexpected shapes (n_in %d out %d ws %zu)\n", n_in, out_size, ws_size); grid = -1; return; }
        int dev = 0, cus = 0, per_cu = 0;
        if (hipGetDevice(&dev) != hipSuccess || hipDeviceGetAttribute(&cus, hipDeviceAttributeMultiprocessorCount, dev) != hipSuccess) { grid = -1; return; }
        if (hipFuncSetAttribute((const void*)mega_fwd, hipFuncAttributeMaxDynamicSharedMemorySize, LDS_BYTES) != hipSuccess) { fprintf(stderr, "kernel_launch: hipFuncSetAttribute failed\n"); grid = -1; return; }
        if (hipOccupancyMaxActiveBlocksPerMultiprocessor(&per_cu, (const void*)mega_fwd, 512, LDS_BYTES) != hipSuccess || per_cu < 1) { fprintf(stderr, "kernel_launch: occupancy query says %d blocks/CU\n", per_cu); per_cu = 1; }
        (void)hipGetLastError();
        grid = cus;
    }
    if (grid < 0) return;
    (void)hipMemsetAsync((char*)d_ws + WS_CTL, 0, CTL_ZERO_BYTES, stream);
    Args a{};
    for (int i = 0; i < 28; ++i) a.in[i] = (const float*)d_in[i];
    a.out = (float*)d_out; a.ws = (unsigned char*)d_ws;
    if (MK_N_LAUNCHES == 1) {
        a.ph_lo = 0; a.ph_hi = NPH; a.nobar = 0;
        void* kargs[] = {&a};
        hipError_t e = hipLaunchCooperativeKernel((const void*)mega_fwd, dim3(grid), dim3(512), kargs, LDS_BYTES, stream);
        if (e != hipSuccess) { (void)hipGetLastError(); fprintf(stderr, "kernel_launch: cooperative launch failed (%s), plain launch instead\n", hipGetErrorString(e)); hipLaunchKernelGGL(mega_fwd, dim3(grid), dim3(512), LDS_BYTES, stream, a); }
    } else {
        for (int p = 0; p < NPH; ++p) { a.ph_lo = p; a.ph_hi = p + 1; a.nobar = 1; hipLaunchKernelGGL(mega_fwd, dim3(grid), dim3(512), LDS_BYTES, stream, a); }
    }
}
```

```cpp
#include <hip/hip_runtime.h>
#include <cstdio>
#include <cstdint>
#define MK_N_LAUNCHES 1
#define DBG_MODE 0
#define STAMP_PHASE -1
#define EPI_TWICE 0
#define REPMASK 0x0

#define LAS __attribute__((address_space(3)))
#define GAS __attribute__((address_space(1)))
typedef unsigned short bf16_t;
typedef short bf16x8 __attribute__((ext_vector_type(8)));
typedef short s16x4 __attribute__((ext_vector_type(4)));
typedef float f32x2 __attribute__((ext_vector_type(2)));
typedef float f32x4 __attribute__((ext_vector_type(4)));
typedef float f32x16 __attribute__((ext_vector_type(16)));
typedef unsigned u32x2 __attribute__((ext_vector_type(2)));
typedef unsigned u32x4 __attribute__((ext_vector_type(4)));
typedef int i32x4_t __attribute__((ext_vector_type(4)));
typedef int i32x8_t __attribute__((ext_vector_type(8)));

constexpr int DM = 1024, NB = 16, SEQ = 2048, CTXL = 256, PB = SEQ + CTXL  , R = NB * PB  ;
constexpr int NTILE = R / 256  , NXTILE = NB * SEQ / 256  ;
constexpr int EVIN = 3584;
constexpr int CIN = 704, CINP = 768, QRANK = 384, KVRANK = 256, NQ = 1536, NKV = 2048;
constexpr int NEXP = 32, MFF = 512;
constexpr int ECAP = 6144, MAXSLOT = NEXP * ECAP;
constexpr float RMS_EPS = 1e-6f;
constexpr float ATT_C2 = 0.07216878364870322f * 1.4426950408889634f;

constexpr size_t MiB = 1u << 20;
constexpr size_t WS_CTL = 0, CTL_ZERO_BYTES = 1 * MiB;
constexpr size_t WS_MOD = 1 * MiB;
constexpr size_t WS_PART = 2 * MiB;
constexpr size_t WS_STATS = 9 * MiB;
constexpr size_t WS_ROUTE = 13 * MiB;
constexpr size_t WS_WIN0 = 16 * MiB, WS_WOUT0 = 23 * MiB, WS_WIN1 = 25 * MiB, WS_WUQ = 27 * MiB, WS_WUKV = 29 * MiB, WS_WOUT1 = 30 * MiB;
constexpr size_t WS_WGU = 32 * MiB;
constexpr size_t WS_WDN = 160 * MiB;
constexpr size_t WS_XS = 224 * MiB;
constexpr size_t WS_HX = 368 * MiB;
constexpr size_t WS_MIX = 440 * MiB;
constexpr size_t WS_RA = 512 * MiB;
constexpr size_t WS_PX0 = WS_RA, WS_Q = WS_RA, WS_KB = WS_RA + 108 * MiB, WS_ACT = WS_RA;
constexpr size_t WS_RB = 764 * MiB;
constexpr size_t WS_YS = WS_RB, WS_PX1 = WS_RB, WS_VB = WS_RB + 54 * MiB, WS_OG = WS_RB;
constexpr size_t WS_QL8 = WS_RB + 106 * MiB;
constexpr size_t WS_KVL8 = WS_RB + 96 * MiB;
constexpr size_t WS_END = 908 * MiB;
constexpr size_t RT_AE = 0, RT_AP = 512 * 1024, RT_AW = 1024 * 1024, RT_PERM = 2304 * 1024  , RT_CNTB = 2048 * 1024, RT_BLKE = 2048 * 1024 + 64 * 1024, RT_NBLK = RT_BLKE + 4096;
constexpr int CW_BAR = 4096, CW_GC = 8192;

constexpr int RING_BYTES = 131072;
constexpr int LDSCTL_OFF = 147456, MISC_OFF = LDSCTL_OFF + 320;
constexpr int LDS_BYTES = 149504;

#define LDS_WAIT() asm volatile("s_waitcnt lgkmcnt(0)" ::: "memory")
#define VM_WAIT() asm volatile("s_waitcnt vmcnt(0)" ::: "memory")
#define SBAR() __builtin_amdgcn_sched_barrier(0)
__device__ __forceinline__ unsigned f2bf(float f) { unsigned u = __builtin_bit_cast(unsigned, f); return (u + 0x7fffu + ((u >> 16) & 1u)) >> 16; }
__device__ __forceinline__ unsigned pk2(float lo, float hi) { return f2bf(lo) | (f2bf(hi) << 16); }
typedef __bf16 bf16x2_t __attribute__((ext_vector_type(2)));
__device__ __forceinline__ unsigned cvtpk(float lo, float hi) { f32x2 v = {lo, hi}; bf16x2_t b = __builtin_convertvector(v, bf16x2_t); return __builtin_bit_cast(unsigned, b); }
__device__ __forceinline__ unsigned pk4_fp8(float a, float b, float c, float d) {
    a = __builtin_amdgcn_fmed3f(a, -448.f, 448.f); b = __builtin_amdgcn_fmed3f(b, -448.f, 448.f); c = __builtin_amdgcn_fmed3f(c, -448.f, 448.f); d = __builtin_amdgcn_fmed3f(d, -448.f, 448.f);
    int p = __builtin_amdgcn_cvt_pk_fp8_f32(a, b, 0, false); p = __builtin_amdgcn_cvt_pk_fp8_f32(c, d, p, true); return (unsigned)p;
}
__device__ __forceinline__ unsigned pk4_fp8_nc(float a, float b, float c, float d) { int p = __builtin_amdgcn_cvt_pk_fp8_f32(a, b, 0, false); p = __builtin_amdgcn_cvt_pk_fp8_f32(c, d, p, true); return (unsigned)p; }
constexpr float S8_Q = 128.f, S8_K = 16.f, S8_V = 16.f, S8_L = 16.f, S8_WKV = 256.f;
constexpr float S8_W1 = 512.f, S8_O = 16.f, S8_M = 2.f;
constexpr float S8_X = 16.f, S8_WGU = 512.f, S8_H = 16.f, S8_WDN = 256.f, S8_Y = 16.f;
__device__ __forceinline__ float bf2f(unsigned short h) { return __builtin_bit_cast(float, (unsigned)h << 16); }
__device__ __forceinline__ float bflo(unsigned w) { return __builtin_bit_cast(float, w << 16); }
__device__ __forceinline__ float bfhi(unsigned w) { return __builtin_bit_cast(float, w & 0xffff0000u); }
__device__ __forceinline__ float dpp_add(float v, const int ctrl) { return v; }
#define DPP_ADD(v, ctrl) ((v) + __builtin_bit_cast(float, __builtin_amdgcn_update_dpp(0, __builtin_bit_cast(int, (v)), (ctrl), 0xf, 0xf, true)))
__device__ __forceinline__ float fold32(float a, float b) { const auto r = __builtin_amdgcn_permlane32_swap(__builtin_bit_cast(unsigned, a), __builtin_bit_cast(unsigned, b), false, false);
    return __builtin_bit_cast(float, (unsigned)r[0]) + __builtin_bit_cast(float, (unsigned)r[1]); }
__device__ __forceinline__ float fold16(float a, float b) { const auto r = __builtin_amdgcn_permlane16_swap(__builtin_bit_cast(unsigned, a), __builtin_bit_cast(unsigned, b), false, false);
    return __builtin_bit_cast(float, (unsigned)r[0]) + __builtin_bit_cast(float, (unsigned)r[1]); }
__device__ __forceinline__ float rdlane(float v, int l) { return __builtin_bit_cast(float, __builtin_amdgcn_readlane(__builtin_bit_cast(int, v), l)); }
__device__ __forceinline__ void wave_sum4(const f32x4 x, float& s0, float& s1, float& s2, float& s3) {
    float t = fold16(fold32(x[0], x[1]), fold32(x[2], x[3]));
    t = DPP_ADD(t, 0xB1); t = DPP_ADD(t, 0x4E); t = DPP_ADD(t, 0x141); t = DPP_ADD(t, 0x140);
    s0 = rdlane(t, 0); s2 = rdlane(t, 16); s1 = rdlane(t, 32); s3 = rdlane(t, 48);
}
__device__ __forceinline__ void wave_sum8(const f32x4 x, const f32x4 y, int lane, float (&s)[8]) {
    const float q0 = fold16(fold32(x[0], x[1]), fold32(x[2], x[3])), q1 = fold16(fold32(y[0], y[1]), fold32(y[2], y[3]));
    const bool up = (lane & 8) != 0; const float keep = up ? q1 : q0, give = up ? q0 : q1;
    float t = keep + __builtin_bit_cast(float, __builtin_amdgcn_update_dpp(0, __builtin_bit_cast(int, give), 0x128  , 0xf, 0xf, true));
    t = DPP_ADD(t, 0xB1); t = DPP_ADD(t, 0x4E); t = DPP_ADD(t, 0x141);
    s[0] = rdlane(t, 0); s[4] = rdlane(t, 8); s[2] = rdlane(t, 16); s[6] = rdlane(t, 24); s[1] = rdlane(t, 32); s[5] = rdlane(t, 40); s[3] = rdlane(t, 48); s[7] = rdlane(t, 56);
}
__device__ __forceinline__ float wave_sum(float v) {
    v = DPP_ADD(v, 0xB1);
    v = DPP_ADD(v, 0x4E);
    v = DPP_ADD(v, 0x141);
    v = DPP_ADD(v, 0x140);
    const int iv = __builtin_bit_cast(int, v);
    return (__builtin_bit_cast(float, __builtin_amdgcn_readlane(iv, 0)) + __builtin_bit_cast(float, __builtin_amdgcn_readlane(iv, 16))) +
           (__builtin_bit_cast(float, __builtin_amdgcn_readlane(iv, 32)) + __builtin_bit_cast(float, __builtin_amdgcn_readlane(iv, 48)));
}
constexpr float LOG2E = 1.4426950408889634f, LN2 = 0.6931471805599453f;
__device__ __forceinline__ float ex2(float x) { return __builtin_amdgcn_exp2f(x); }
__device__ __forceinline__ float lg2(float x) { return __builtin_amdgcn_logf(x); }
__device__ __forceinline__ float sigmoidf_(float x) { return __builtin_amdgcn_rcpf(1.0f + ex2(-LOG2E * x)); }
__device__ __forceinline__ float siluf_(float x) { return x * __builtin_amdgcn_rcpf(1.0f + ex2(-LOG2E * x)); }
__device__ __forceinline__ float geluf_(float x) { const float z = (-1.5957691216057308f * LOG2E) * (x + 0.044715f * x * x * x); return x * __builtin_amdgcn_rcpf(1.0f + ex2(z)); }

#define XB_TMO      128
#define XB_XCNT(j)  (256  + 64 * (j))
#define XB_XSUB(j)  (1280 + 64 * (j))
#define XB_XGEN(j)  (2304 + 64 * (j))
#define XB_TOP      3328
#define XB_TOPGEN   3392
#define XCD_BAR_WORDS 3456
#define XB_SPIN_CAP (1u << 22)
__device__ __forceinline__ unsigned xb_ld(unsigned* p)              { return __hip_atomic_load(p, __ATOMIC_RELAXED, __HIP_MEMORY_SCOPE_AGENT); }
__device__ __forceinline__ unsigned xb_add(unsigned* p, unsigned v) { return __hip_atomic_fetch_add(p, v, __ATOMIC_RELAXED, __HIP_MEMORY_SCOPE_AGENT); }
__device__ __forceinline__ unsigned xb_xcc_id() { return (unsigned)__builtin_amdgcn_s_getreg((3 << 11) | 20) & 0xFu; }
#define XB_SPIN(cond, bar) do { unsigned _sp = 0; while (cond) { __builtin_amdgcn_s_sleep(1); \
    if ((++_sp & 255u) == 0u) { if (xb_ld(&(bar)[XB_TMO])) break; if (_sp > XB_SPIN_CAP) { atomicAdd(&(bar)[XB_TMO], 1u); break; } } } } while (0)
struct XcdBarrier { unsigned* bar; unsigned x; volatile LAS unsigned* st; };
__device__ __forceinline__ XcdBarrier xcd_barrier_post(unsigned* bar, volatile LAS unsigned* st) {
    XcdBarrier b; b.bar = bar; b.x = xb_xcc_id(); b.st = st;
    if (threadIdx.x == 0) (void)xb_add(&bar[XB_XCNT(b.x)], 1u);
    return b;
}
__device__ __forceinline__ void xcd_barrier_complete(unsigned* bar, unsigned x, unsigned& nloc, unsigned& nx) {
    const unsigned G = gridDim.x * gridDim.y * gridDim.z;
    unsigned sum, cnt, mine, sp = 0u;
    for (;;) {
        sum = 0u; cnt = 0u; mine = 0u;
#pragma unroll
        for (unsigned j = 0; j < 16; ++j) { const unsigned c = xb_ld(&bar[XB_XCNT(j)]); sum += c; cnt += (c > 0u) ? 1u : 0u; mine = (j == x) ? c : mine; }
        if (sum == G) break;
        __builtin_amdgcn_s_sleep(1);
        if ((++sp & 255u) == 0u) { if (xb_ld(&bar[XB_TMO])) break; if (sp > XB_SPIN_CAP) { atomicAdd(&bar[XB_TMO], 1u); break; } }
    }
    nloc = mine > 0u ? mine : 1u; nx = cnt > 0u ? cnt : 1u;
}
__device__ __forceinline__ void xcd_barrier(const XcdBarrier& b) {
    asm volatile("s_waitcnt vmcnt(0)" ::: "memory");
    __syncthreads();
    if (threadIdx.x == 0) {
        unsigned* bar = b.bar;
        __builtin_amdgcn_s_waitcnt(0);
        unsigned nloc = b.st[0], nx = b.st[1];
        if (nloc == 0u) { xcd_barrier_complete(bar, b.x, nloc, nx); b.st[0] = nloc; b.st[1] = nx; }
        const unsigned old = xb_add(&bar[XB_XSUB(b.x)], 1u);
        const unsigned gen = old / nloc;
        if (old + 1u == (gen + 1u) * nloc) {
            __builtin_amdgcn_fence(__ATOMIC_RELEASE, "agent");
            asm volatile("s_waitcnt vmcnt(0)" ::: "memory");
            const unsigned og = xb_add(&bar[XB_TOP], 1u);
            const unsigned tg = og / nx;
            if (og + 1u == (tg + 1u) * nx) xb_add(&bar[XB_TOPGEN], 1u);
            else XB_SPIN(xb_ld(&bar[XB_TOPGEN]) == tg, bar);
            __builtin_amdgcn_fence(__ATOMIC_ACQUIRE, "agent");
            xb_add(&bar[XB_XGEN(b.x)], 1u);
            asm volatile("s_waitcnt vmcnt(0)" ::: "memory");
        } else {
            XB_SPIN(xb_ld(&bar[XB_XGEN(b.x)]) == gen, bar);
            __builtin_amdgcn_fence(__ATOMIC_ACQUIRE, "agent");
            asm volatile("s_waitcnt vmcnt(0)" ::: "memory");
        }
    }
    __syncthreads();
}

namespace pg8 {
constexpr int BM = 256, BK = 64, HALF = 128, HTB = HALF * BK * 2, STAGE_BYTES = 8 * HTB, NXCD = 8, WGM = 8;
__host__ __device__ __forceinline__ int lds_byte(int r, int c) { const int st = (r >> 4) * 2 + (c >> 5), rr = r & 15, cc = c & 31, ob = rr * 64 + cc * 2; return st * 1024 + (ob ^ (((ob >> 9) & 1) << 5)); }
__host__ __device__ __forceinline__ void stage_rc(int b, int& Rr, int& C) { const int st = b / 1024, sb = b % 1024, swz = sb ^ (((sb >> 9) & 1) << 5); Rr = (st >> 1) * 16 + swz / 64; C = (st & 1) * 32 + (swz % 64) / 2; }
__host__ __device__ __forceinline__ int keyperm64(int b) { const int hi = b >> 5, j = b & 31, half = j >> 4, jj = j & 15; return 32 * half + (jj & 3) + 8 * (jj >> 2) + 4 * hi; }
__host__ __device__ __forceinline__ int perm32(int rho) { const int n = rho >> 4, i = rho & 15; return 8 * (i >> 2) + 4 * n + (i & 3); }

struct Unit { int arow0, brow0, pm, pn, ex; };
struct Gemm { const bf16_t* A; const bf16_t* Bt; int lda, ldb, K; const int* rowidx; };

template <class Epi, class Sched, bool GATHER, bool FP8 = false>
__device__ __forceinline__ void gemm_phase(LAS unsigned char* lds, const Gemm g, const Sched& S, const Epi& E) {
    int tidl = threadIdx.x; asm volatile("" : "+v"(tidl));
    const int tid = tidl, wid = __builtin_amdgcn_readfirstlane(tid >> 6), lane = tid & 63, wr = wid >> 2, wc = wid & 3, fr = lane & 15, fq = lane >> 4;
    const int K = g.K, nt = K / BK;
    int sR[2], sC[2]; unsigned voffB[2], voffA[2];
#pragma unroll
    for (int i = 0; i < 2; ++i) { stage_rc(tid * 16 + i * 8192, sR[i], sC[i]); int Rb = Epi::PERM ? ((sR[i] & ~31) + perm32(sR[i] & 31)) : sR[i];
        if constexpr (Epi::KEYPERM) Rb = (Rb & ~63) + keyperm64(Rb & 63);
        voffB[i] = (unsigned)(Rb * g.ldb + sC[i]) * 2u; voffA[i] = (unsigned)(sR[i] * g.lda + sC[i]) * 2u; }
    const unsigned kstep = BK * 2;
    const unsigned hstepB = (unsigned)(HALF * g.ldb * 2), hstepA = (unsigned)(HALF * g.lda * 2);
    const unsigned ldsw = (unsigned)wid * 1024u;
    const int aoff = lds_byte(wr * 64 + fr, fq * 8), boff = lds_byte(wc * 32 + fr, fq * 8);
#define PG8_SA(b, h) (((b) * 2 + (h)) * HTB)
#define PG8_SB(b, h) ((4 + (b) * 2 + (h)) * HTB)
    const __amdgpu_buffer_rsrc_t rsA = __builtin_amdgcn_make_buffer_rsrc((void*)g.A, 0, 0x7fffffff, 0x00020000), rsB = __builtin_amdgcn_make_buffer_rsrc((void*)g.Bt, 0, 0x7fffffff, 0x00020000);
#define PG8_GLDS(rs, voff, soff, bufoff, i) __builtin_amdgcn_raw_ptr_buffer_load_lds((rs), (LAS unsigned*)(lds + (bufoff) + ldsw + (i) * 8192), 16, (int)(voff), (int)(soff), 0, 0)
#define PG8_STAGEB(bufoff, sbase) do { _Pragma("unroll") for (int _i = 0; _i < 2; ++_i) PG8_GLDS(rsB, voffB[_i], (sbase), bufoff, _i); } while (0)
#define PG8_STAGEA(bufoff, h, isnext, kb) do { \
        if constexpr (GATHER) { _Pragma("unroll") for (int _i = 0; _i < 2; ++_i) PG8_GLDS(rsA, ((isnext) ? nvo[h][_i] : cvo[h][_i]), (kb), bufoff, _i); } \
        else { const unsigned _b = ((isnext) ? nA : cA) + (unsigned)((h) * hstepA + (kb)); _Pragma("unroll") for (int _i = 0; _i < 2; ++_i) PG8_GLDS(rsA, voffA[_i], _b, bufoff, _i); } } while (0)
#define PG8_LD16(p) (*(const LAS i32x4_t*)(p))
#define PG8_LDA(dst, b, h) do { if constexpr (FP8) { _Pragma("unroll") for (int m = 0; m < 4; ++m) dst##8[m] = __builtin_shufflevector(PG8_LD16(lds + PG8_SA(b, h) + aoff + m * 2048), PG8_LD16(lds + PG8_SA(b, h) + aoff + m * 2048 + 1024), 0, 1, 2, 3, 4, 5, 6, 7); } \
        else { _Pragma("unroll") for (int m = 0; m < 4; ++m) _Pragma("unroll") for (int k = 0; k < 2; ++k) dst[m][k] = *(const LAS bf16x8*)(lds + PG8_SA(b, h) + aoff + m * 2048 + k * 1024); } } while (0)
#define PG8_LDB(dst, b, h) do { if constexpr (FP8) { _Pragma("unroll") for (int n = 0; n < 2; ++n) dst##8[n] = __builtin_shufflevector(PG8_LD16(lds + PG8_SB(b, h) + boff + n * 2048), PG8_LD16(lds + PG8_SB(b, h) + boff + n * 2048 + 1024), 0, 1, 2, 3, 4, 5, 6, 7); } \
        else { _Pragma("unroll") for (int n = 0; n < 2; ++n) _Pragma("unroll") for (int k = 0; k < 2; ++k) dst[n][k] = *(const LAS bf16x8*)(lds + PG8_SB(b, h) + boff + n * 2048 + k * 1024); } } while (0)
#define PG8_CAT(x) __builtin_shufflevector(__builtin_bit_cast(i32x4_t, (x)[0]), __builtin_bit_cast(i32x4_t, (x)[1]), 0, 1, 2, 3, 4, 5, 6, 7)
#define PG8_MMA(ai, bj, At, Bt) do { __builtin_amdgcn_s_setprio(1); \
        if constexpr (FP8) { _Pragma("unroll") for (int m = 0; m < 4; ++m) _Pragma("unroll") for (int n = 0; n < 2; ++n) \
            acc[ai][bj][m][n] = __builtin_amdgcn_mfma_scale_f32_16x16x128_f8f6f4(Bt##8[n], At##8[m], acc[ai][bj][m][n], 0, 0, 0, 0x7f7f7f7f, 0, 0x7f7f7f7f); \
            _Pragma("unroll") for (int m = 0; m < 4; ++m) _Pragma("unroll") for (int n = 0; n < 2; ++n) asm volatile("" : "+v"(acc[ai][bj][m][n])); }     \
        else { _Pragma("unroll") for (int m = 0; m < 4; ++m) _Pragma("unroll") for (int n = 0; n < 2; ++n) _Pragma("unroll") for (int k = 0; k < 2; ++k) \
            acc[ai][bj][m][n] = __builtin_amdgcn_mfma_f32_16x16x32_bf16(Bt[n][k], At[m][k], acc[ai][bj][m][n], 0, 0, 0); } \
        __builtin_amdgcn_s_setprio(0); } while (0)
#define PG8_WAIT_V(n) asm volatile("s_waitcnt vmcnt(" #n ")" ::: "memory")
#define PG8_WAIT_L(n) asm volatile("s_waitcnt lgkmcnt(" #n ")" ::: "memory")
#define PG8_BAR __builtin_amdgcn_s_barrier()
#define PG8_SCHED __builtin_amdgcn_sched_barrier(0)
    unsigned cvo[2][2], nvo[2][2];
    auto a_offsets = [&](const Unit& u, unsigned (&vo)[2][2]) {
#pragma unroll
        for (int h = 0; h < 2; ++h)
#pragma unroll
            for (int i = 0; i < 2; ++i) { const int a = g.rowidx[u.arow0 + h * HALF + sR[i]]; const int row = a < 0 ? 0 : (a >> 1); vo[h][i] = (unsigned)((size_t)row * g.lda + sC[i]) * 2u; }
    };
    Unit cur, nxt; int ui = 0;
    if (!S.next(0, cur)) return;
    f32x4 acc[2][2][4][2];
#pragma unroll
    for (int a = 0; a < 2; ++a)
#pragma unroll
        for (int b = 0; b < 2; ++b)
#pragma unroll
            for (int m = 0; m < 4; ++m)
#pragma unroll
                for (int n = 0; n < 2; ++n) acc[a][b][m][n] = (f32x4){0.f, 0.f, 0.f, 0.f};
    bf16x8 At[4][2], B0[2][2], B1[2][2]; i32x8_t At8[4], B08[2], B18[2];
    unsigned cA = (unsigned)((size_t)cur.arow0 * g.lda * 2), nA = cA;
    unsigned cB = (unsigned)((size_t)cur.brow0 * g.ldb * 2);
    if constexpr (GATHER) { a_offsets(cur, cvo);
#pragma unroll
        for (int h = 0; h < 2; ++h)
#pragma unroll
            for (int i = 0; i < 2; ++i) nvo[h][i] = cvo[h][i]; }
    PG8_STAGEB(PG8_SB(0, 0), cB); PG8_STAGEB(PG8_SB(0, 1), cB + hstepB); PG8_STAGEA(PG8_SA(0, 0), 0, false, 0); PG8_STAGEA(PG8_SA(0, 1), 1, false, 0);
    if (wr == 1) PG8_BAR;
    PG8_WAIT_V(2); PG8_BAR;
    PG8_STAGEB(PG8_SB(1, 0), cB + kstep); PG8_STAGEA(PG8_SA(1, 0), 0, false, kstep); PG8_STAGEB(PG8_SB(1, 1), cB + hstepB + kstep);
    PG8_WAIT_V(6); PG8_BAR;
    for (;;) {
        const bool has_next = S.next(ui + 1, nxt);
        const unsigned nB = has_next ? (unsigned)((size_t)nxt.brow0 * g.ldb * 2) : cB;
        nA = has_next ? (unsigned)((size_t)nxt.arow0 * g.lda * 2) : cA;
        if constexpr (GATHER) { if (has_next) a_offsets(nxt, nvo); }
        for (int t = 0; t < nt; t += 2) {
            const bool last = (t == nt - 2);
            const unsigned k1 = (unsigned)((t + 1) * kstep), k2 = last ? 0u : (unsigned)((t + 2) * kstep), k3 = k2 + (unsigned)kstep;
            const unsigned b2 = last ? nB : cB + (unsigned)((t + 2) * kstep); const unsigned b3 = b2 + (unsigned)kstep;
            PG8_LDB(B0, 0, 0); PG8_LDB(B1, 0, 1); PG8_SCHED; PG8_LDA(At, 0, 0); PG8_STAGEA(PG8_SA(1, 1), 1, false, k1);
            PG8_WAIT_V(8); PG8_WAIT_L(0); PG8_BAR; PG8_MMA(0, 0, At, B0); PG8_MMA(0, 1, At, B1); PG8_BAR; PG8_SCHED;
            PG8_LDA(At, 0, 1); PG8_STAGEB(PG8_SB(0, 0), b2); PG8_STAGEB(PG8_SB(0, 1), b2 + hstepB); PG8_STAGEA(PG8_SA(0, 0), 0, last, k2);
            PG8_WAIT_V(8); PG8_WAIT_L(0); PG8_BAR; PG8_MMA(1, 0, At, B0); PG8_MMA(1, 1, At, B1); PG8_BAR; PG8_SCHED;
            PG8_LDB(B0, 1, 0); PG8_LDB(B1, 1, 1); PG8_SCHED; PG8_LDA(At, 1, 0); PG8_STAGEA(PG8_SA(0, 1), 1, last, k2);
            PG8_WAIT_V(8); PG8_WAIT_L(0); PG8_BAR; PG8_MMA(0, 0, At, B0); PG8_MMA(0, 1, At, B1); PG8_BAR; PG8_SCHED;
            PG8_LDA(At, 1, 1); PG8_STAGEB(PG8_SB(1, 0), b3); PG8_STAGEB(PG8_SB(1, 1), b3 + hstepB); PG8_STAGEA(PG8_SA(1, 0), 0, last, k3);
            PG8_WAIT_V(8); PG8_WAIT_L(0); PG8_BAR; PG8_MMA(1, 0, At, B0); PG8_MMA(1, 1, At, B1); PG8_BAR; PG8_SCHED;
        }
        if (wr == 0) PG8_BAR;
        cur.ex = ui;
        { int l2 = threadIdx.x; asm volatile("" : "+v"(l2)); E(acc, cur, wr, wc, l2 & 15, (l2 >> 4) & 3); if (EPI_TWICE && Epi::IDEM) { asm volatile("" : "+v"(l2)); E(acc, cur, wr, wc, l2 & 15, (l2 >> 4) & 3); } }
        if (!has_next) break;
#pragma unroll
        for (int a = 0; a < 2; ++a)
#pragma unroll
            for (int b = 0; b < 2; ++b)
#pragma unroll
                for (int m = 0; m < 4; ++m)
#pragma unroll
                    for (int n = 0; n < 2; ++n) acc[a][b][m][n] = (f32x4){0.f, 0.f, 0.f, 0.f};
        cur = nxt; cB = nB; cA = nA; ++ui;
        if constexpr (GATHER) {
#pragma unroll
            for (int h = 0; h < 2; ++h)
#pragma unroll
                for (int i = 0; i < 2; ++i) cvo[h][i] = nvo[h][i]; }
        if (wr == 1) PG8_BAR;
    }
    PG8_WAIT_V(0);
    PG8_BAR;
#undef PG8_SA
#undef PG8_SB
#undef PG8_GLDS
#undef PG8_STAGEA
#undef PG8_STAGEB
#undef PG8_LDA
#undef PG8_LD16
#undef PG8_LDB
#undef PG8_MMA
#undef PG8_CAT
#undef PG8_WAIT_V
#undef PG8_WAIT_L
#undef PG8_BAR
#undef PG8_SCHED
}
}

struct Args {
    const float* in[28]; float* out; unsigned char* ws; int ph_lo, ph_hi, nobar, pad;
};
enum In { I_X = 0, I_C, I_CTX, I_CCTX, I_ADAW, I_ADAB, I_NMIXG, I_NFFNG, I_EVWIN, I_EVLB, I_EVONORM, I_EVSGUG, I_EVWS, I_EVBS, I_EVWOUT,
          I_ODWIN, I_ODQG, I_ODWUQ, I_ODKVG, I_ODWUKV, I_ODWOUT, I_MR1W, I_MR1B, I_MR2W, I_MR2B, I_MGU, I_MDN, I_FING };
struct Frame {
    LAS unsigned char* lds;
    const __attribute__((address_space(4))) Args* ka;
    float* out;
    int tid, lane, wave, vcu, G;
    unsigned char* ws;
};
__device__ __forceinline__ const float* mod_ptr(const Frame& F, int layer, int mrow, int which) { return (const float*)(F.ws + WS_MOD) + ((size_t)(layer * 17 + mrow) * 6 + which) * DM; }
__device__ __forceinline__ int row_b(int row) { return row / PB; }
__device__ __forceinline__ const float* input_row(const Frame& F, int row) {
    const int b = row / PB, pos = row - b * PB;
    return pos < CTXL ? F.ka->in[I_CTX] + ((size_t)b * CTXL + pos) * DM : F.ka->in[I_X] + ((size_t)b * SEQ + (pos - CTXL)) * DM;
}

template <bool XONLY> struct TileSched {
    int nM, nN, nwg, G, c;
    __device__ __forceinline__ void init(int nN_, int G_, int c_) { nM = XONLY ? NXTILE : NTILE; nN = nN_; nwg = nM * nN; G = G_; c = c_; }
    __device__ __forceinline__ void init_mn(int nM_, int nN_, int G_, int c_) { nM = nM_; nN = nN_; nwg = nM * nN; G = G_; c = c_; }
    __device__ __forceinline__ bool next(int i, pg8::Unit& u) const {
        const int L = i * G + c; if (L >= nwg) return false;
        int wgid = L; { const int q = nwg / 8, r = nwg % 8, xcd = wgid % 8, off = wgid / 8; wgid = (xcd < r ? xcd * (q + 1) : r * (q + 1) + (xcd - r) * q) + off; }
        const int nig = 8 * nN, gid = wgid / nig, fm = gid * 8, gsz = (nM - fm) < 8 ? (nM - fm) : 8;
        int pm = fm + ((wgid % nig) % gsz); const int pn = (wgid % nig) / gsz;
        if (XONLY) pm = (pm >> 3) * 9 + 1 + (pm & 7);
        u.pm = pm; u.pn = pn; u.ex = 0; u.arow0 = pm * 256; u.brow0 = pn * 256; return true;
    }
};
struct MoeSched {
    const LAS int* pfx; const LAS unsigned char* tab; int nwg, G, c;
    __device__ __forceinline__ bool next(int i, pg8::Unit& u) const {
        const int L = i * G + c; if (L >= nwg) return false;
        int wgid = L; { const int q = nwg / 8, r = nwg % 8, xcd = wgid % 8, off = wgid / 8; wgid = (xcd < r ? xcd * (q + 1) : r * (q + 1) + (xcd - r) * q) + off; }
        const int blk = wgid >> 2, pn = wgid & 3; const int e = __builtin_amdgcn_readfirstlane((int)tab[blk]); const int j = blk - __builtin_amdgcn_readfirstlane(pfx[e]);
        u.pm = blk; u.pn = pn; u.ex = e; u.arow0 = e * ECAP + j * 256; u.brow0 = e * 1024 + pn * 256; return true;
    }
};
__device__ __forceinline__ u32x4 widen16(u32x2 w0, u32x2 w1) {
    const auto rx = __builtin_amdgcn_permlane16_swap(w0.x, w1.x, false, false), ry = __builtin_amdgcn_permlane16_swap(w0.y, w1.y, false, false);
    return (u32x4){(unsigned)rx[0], (unsigned)ry[0], (unsigned)rx[1], (unsigned)ry[1]};
}
struct EpiStoreBf16 {
    static constexpr bool PERM = true; static constexpr bool IDEM = true; static constexpr bool KEYPERM = false;
    bf16_t* O; int ldc;
    __device__ __forceinline__ void operator()(const f32x4 (&acc)[2][2][4][2], const pg8::Unit& u, int wr, int wc, int fr, int fq) const {
        const int row0 = u.arow0 + wr * 64 + fr, col0 = u.pn * 256 + wc * 32 + 8 * fq;
#pragma unroll
        for (int ai = 0; ai < 2; ++ai)
#pragma unroll
            for (int m = 0; m < 4; ++m) { bf16_t* rowp = O + (size_t)(row0 + ai * 128 + m * 16) * ldc + col0;
#pragma unroll
                for (int bj = 0; bj < 2; ++bj) { const f32x4 v0 = acc[ai][bj][m][0], v1 = acc[ai][bj][m][1];
                    u32x4 w; w.x = cvtpk(v0[0], v0[1]); w.y = cvtpk(v0[2], v0[3]); w.z = cvtpk(v1[0], v1[1]); w.w = cvtpk(v1[2], v1[3]);
                    *(u32x4*)(rowp + bj * 128) = w; } }
    }
};
struct EpiStoreStats {
    static constexpr bool PERM = true; static constexpr bool IDEM = true; static constexpr bool KEYPERM = false;
    bf16_t* O; int ldc; float* stats; float sc;
    __device__ __forceinline__ void operator()(const f32x4 (&acc)[2][2][4][2], const pg8::Unit& u, int wr, int wc, int fr, int fq) const {
        const int row0 = u.arow0 + wr * 64 + fr, col0 = u.pn * 256 + wc * 32 + 8 * fq;
#pragma unroll
        for (int ai = 0; ai < 2; ++ai)
#pragma unroll
            for (int m = 0; m < 4; ++m) { const int row = row0 + ai * 128 + m * 16; bf16_t* rowp = O + (size_t)row * ldc + col0;
#pragma unroll
                for (int bj = 0; bj < 2; ++bj) { const f32x4 v0 = acc[ai][bj][m][0] * sc, v1 = acc[ai][bj][m][1] * sc;
                    if (u.pn * 8 + bj * 4 + wc >= 20) { u32x4 w; w.x = cvtpk(v0[0], v0[1]); w.y = cvtpk(v0[2], v0[3]); w.z = cvtpk(v1[0], v1[1]); w.w = cvtpk(v1[2], v1[3]);
                        *(u32x4*)(rowp + bj * 128) = w; }
                    { const int G = u.pn * 8 + bj * 4 + wc;
                      if (G < 20) { u32x2 w8; w8.x = pk4_fp8(v0[0] * S8_L, v0[1] * S8_L, v0[2] * S8_L, v0[3] * S8_L); w8.y = pk4_fp8(v1[0] * S8_L, v1[1] * S8_L, v1[2] * S8_L, v1[3] * S8_L);
                          unsigned char* d8 = G < 12 ? (unsigned char*)O + (WS_QL8 - WS_PX1) + (size_t)row * 512 + 32 * G : (unsigned char*)O + (WS_KVL8 - WS_PX1) + (size_t)row * KVRANK + 32 * (G - 12);
                          *(u32x2*)(d8 + 8 * fq) = w8; } }
                    float s = (v0[0] * v0[0] + v0[1] * v0[1]) + (v0[2] * v0[2] + v0[3] * v0[3]) + (v1[0] * v1[0] + v1[1] * v1[1]) + (v1[2] * v1[2] + v1[3] * v1[3]);
                    s += __shfl_xor(s, 16); s += __shfl_xor(s, 32);
                    if (fq == 0) stats[(size_t)row * 24 + u.pn * 8 + bj * 4 + wc] = s; } }
    }
};
struct EpiResidual {
    static constexpr bool PERM = true; static constexpr bool IDEM = false; static constexpr bool KEYPERM = false;
    const Frame* F; bf16_t* dst; int layer; bool from_input; float sc;
    __device__ __forceinline__ void operator()(const f32x4 (&acc)[2][2][4][2], const pg8::Unit& u, int wr, int wc, int fr, int fq) const {
        const int b = u.pm / 9, isctx = (u.pm % 9) == 0, mrow = isctx ? 16 : b;
        const float* gate = mod_ptr(*F, layer, mrow, 2);
        const int col0 = u.pn * 256 + wc * 32 + 8 * fq;
        f32x4 gv[2][2];
#pragma unroll
        for (int bj = 0; bj < 2; ++bj)
#pragma unroll
            for (int n = 0; n < 2; ++n) gv[bj][n] = *(const f32x4*)(gate + col0 + bj * 128 + n * 4) * sc;
#pragma unroll
        for (int ai = 0; ai < 2; ++ai)
#pragma unroll
            for (int m = 0; m < 4; ++m) { const int row = u.arow0 + ai * 128 + wr * 64 + m * 16 + fr;
                const float* bp = input_row(*F, row); bf16_t* dp = dst + (size_t)row * DM;
#pragma unroll
                for (int bj = 0; bj < 2; ++bj) { const int c = col0 + bj * 128; f32x4 b0, b1;
                    if (from_input) { b0 = *(const f32x4*)(bp + c); b1 = *(const f32x4*)(bp + c + 4); }
                    else { const u32x4 w = *(const u32x4*)(dp + c); b0 = (f32x4){bflo(w.x), bfhi(w.x), bflo(w.y), bfhi(w.y)}; b1 = (f32x4){bflo(w.z), bfhi(w.z), bflo(w.w), bfhi(w.w)}; }
                    const f32x4 r0 = b0 + gv[bj][0] * acc[ai][bj][m][0], r1 = b1 + gv[bj][1] * acc[ai][bj][m][1];
                    u32x4 o; o.x = cvtpk(r0[0], r0[1]); o.y = cvtpk(r0[2], r0[3]); o.z = cvtpk(r1[0], r1[1]); o.w = cvtpk(r1[2], r1[3]); *(u32x4*)(dp + c) = o; } }
    }
};
struct EpiSwiglu {
    static constexpr bool PERM = true; static constexpr bool IDEM = true; static constexpr bool KEYPERM = false;
    unsigned char* O;
    __device__ __forceinline__ void operator()(const f32x4 (&acc)[2][2][4][2], const pg8::Unit& u, int wr, int wc, int fr, int fq) const {
        const int row0 = u.arow0 + wr * 64 + fr + 16 * (fq & 1), col0 = u.pn * 128 + wc * 32 + 16 * (fq >> 1); constexpr float SI = 1.0f / (S8_X * S8_WGU);
#pragma unroll
        for (int ai = 0; ai < 2; ++ai)
#pragma unroll
            for (int mp = 0; mp < 4; mp += 2) { u32x2 w[2];
#pragma unroll
                for (int mm = 0; mm < 2; ++mm) { const int m = mp + mm; float h[8];
#pragma unroll
                    for (int n = 0; n < 2; ++n)
#pragma unroll
                        for (int j = 0; j < 4; ++j) h[n * 4 + j] = siluf_(acc[ai][0][m][n][j] * SI) * (acc[ai][1][m][n][j] * (SI * S8_H));
                    w[mm].x = pk4_fp8(h[0], h[1], h[2], h[3]); w[mm].y = pk4_fp8(h[4], h[5], h[6], h[7]); }
                *(u32x4*)(O + (size_t)(row0 + ai * 128 + mp * 16) * MFF + col0) = widen16(w[0], w[1]); }
    }
};
struct EpiScatter {
    static constexpr bool PERM = true; static constexpr bool IDEM = true; static constexpr bool KEYPERM = false;
    unsigned char* O; const int* perm;
    __device__ __forceinline__ void operator()(const f32x4 (&acc)[2][2][4][2], const pg8::Unit& u, int wr, int wc, int fr, int fq) const {
        const int row0 = u.arow0 + wr * 64 + fr + 16 * (fq & 1), col0 = u.pn * 256 + wc * 32 + 16 * (fq >> 1); constexpr float SI = S8_Y / (S8_H * S8_WDN);
#pragma unroll
        for (int ai = 0; ai < 2; ++ai)
#pragma unroll
            for (int mp = 0; mp < 4; mp += 2) { const int a = perm[row0 + ai * 128 + mp * 16];
                unsigned char* rowp = O + (size_t)(a < 0 ? 0 : a) * DM + col0;
#pragma unroll
                for (int bj = 0; bj < 2; ++bj) { u32x2 w[2];
#pragma unroll
                    for (int mm = 0; mm < 2; ++mm) { const f32x4 v0 = acc[ai][bj][mp + mm][0] * SI, v1 = acc[ai][bj][mp + mm][1] * SI;
                        w[mm].x = pk4_fp8_nc(v0[0], v0[1], v0[2], v0[3]); w[mm].y = pk4_fp8_nc(v1[0], v1[1], v1[2], v1[3]); }
                    const u32x4 o = widen16(w[0], w[1]);
                    if (a >= 0) *(u32x4*)(rowp + bj * 128) = o; }
                asm volatile("" ::: "memory"); }
    }
};
struct EpiQ {
    static constexpr bool PERM = true; static constexpr bool IDEM = true; static constexpr bool KEYPERM = false;
    unsigned char* O; const LAS float* tab; const LAS float* rope;
    __device__ __forceinline__ void operator()(const f32x4 (&acc)[2][2][4][2], const pg8::Unit& u, int wr, int wc, int fr, int fq) const {
        int fq2 = fq; asm volatile("" : "+v"(fq2));
        const bool lowhalf = fq2 < 2;
#pragma unroll
        for (int ai = 0; ai < 2; ++ai)
#pragma unroll
            for (int mp = 0; mp < 4; mp += 2) { u32x2 w[2][2];
#pragma unroll
                for (int mm = 0; mm < 2; ++mm) { const int m = mp + mm; const int row = u.arow0 + ai * 128 + wr * 64 + m * 16 + fr;
                    const float sc = tab[u.ex * 256 + (row - u.arow0)] * (ATT_C2 * S8_Q / (S8_L * S8_WKV));
                    const int t = (row % PB) - CTXL; const int gr = t >> 6, gc = t & 63;
#pragma unroll
                    for (int bj = 0; bj < 2; ++bj) { const int cg = u.pn * 256 + bj * 128 + wc * 32; const int within = cg % 192;
                        f32x4 v[2] = {acc[ai][bj][m][0] * sc, acc[ai][bj][m][1] * sc};
                        if (within >= 128) { const int p = (within == 128) ? gr : gc;
                            const LAS f32x4* tp = (const LAS f32x4*)(rope + (p * 16 + 8 * (fq2 & 1)) * 2);
#pragma unroll
                            for (int n = 0; n < 2; ++n) { const f32x4 ta = tp[2 * n], tb = tp[2 * n + 1];
#pragma unroll
                                for (int j = 0; j < 4; ++j) { const float x = v[n][j], xo = __shfl_xor(x, 32); const float cs = j < 2 ? ta[2 * j] : tb[2 * (j - 2)], sn = j < 2 ? ta[2 * j + 1] : tb[2 * (j - 2) + 1];
                                    v[n][j] = lowhalf ? (x * cs - xo * sn) : (xo * sn + x * cs); } } }
                        w[mm][bj].x = pk4_fp8(v[0][0], v[0][1], v[0][2], v[0][3]); w[mm][bj].y = pk4_fp8(v[1][0], v[1][1], v[1][2], v[1][3]); } }
                const int srow = u.arow0 + ai * 128 + wr * 64 + (mp + (fq2 & 1)) * 16 + fr;
#pragma unroll
                for (int bj = 0; bj < 2; ++bj) *(u32x4*)(O + (size_t)srow * NQ + u.pn * 256 + bj * 128 + wc * 32 + 16 * (fq2 >> 1)) = widen16(w[0][bj], w[1][bj]); }
    }
};
struct EpiK {
    static constexpr bool PERM = true; static constexpr bool IDEM = true; static constexpr bool KEYPERM = false;
    unsigned char* KBp; const LAS float* tab;
    __device__ __forceinline__ void operator()(const f32x4 (&acc)[2][2][4][2], const pg8::Unit& u, int wr, int wc, int fr, int fq) const {
#pragma unroll
        for (int ai = 0; ai < 2; ++ai)
#pragma unroll
            for (int mp = 0; mp < 4; mp += 2) { u32x2 wk[2][2];
#pragma unroll
                for (int mm = 0; mm < 2; ++mm) { const int m = mp + mm;
                    const float sc = tab[u.ex * 256 + ai * 128 + wr * 64 + m * 16 + fr] * (S8_K / (S8_L * S8_WKV));
#pragma unroll
                    for (int bj = 0; bj < 2; ++bj) { const f32x4 v0 = acc[ai][bj][m][0] * sc, v1 = acc[ai][bj][m][1] * sc;
                        wk[mm][bj].x = pk4_fp8(v0[0], v0[1], v0[2], v0[3]); wk[mm][bj].y = pk4_fp8(v1[0], v1[1], v1[2], v1[3]); } }
                const int srow = u.arow0 + ai * 128 + wr * 64 + (mp + (fq & 1)) * 16 + fr;
#pragma unroll
                for (int bj = 0; bj < 2; ++bj) *(u32x4*)(KBp + (size_t)srow * NQ + (2 * u.pn + bj) * 192 + wc * 32 + 16 * (fq >> 1)) = widen16(wk[0][bj], wk[1][bj]); }
    }
};
struct EpiVT {
    static constexpr bool PERM = true; static constexpr bool IDEM = true; static constexpr bool KEYPERM = true;
    unsigned char* VT; const LAS float* tab;
    __device__ __forceinline__ void operator()(const f32x4 (&acc)[2][2][4][2], const pg8::Unit& u, int wr, int wc, int fr, int fq) const {
        int fq2 = fq; asm volatile("" : "+v"(fq2));
#pragma unroll
        for (int bj = 0; bj < 2; ++bj) { float sc[8]; const int cm0 = 128 * bj + 32 * wc + 8 * fq2;
#pragma unroll
            for (int e = 0; e < 8; ++e) { const int cm = cm0 + e; sc[e] = tab[u.ex * 256 + (cm & ~63) + pg8::keyperm64(cm & 63)] * (S8_V / (S8_L * S8_WKV)); }
#pragma unroll
            for (int ai = 0; ai < 2; ++ai)
#pragma unroll
                for (int mp = 0; mp < 4; mp += 2) { u32x2 w[2];
#pragma unroll
                    for (int mm = 0; mm < 2; ++mm) { const f32x4 v0 = acc[ai][bj][mp + mm][0], v1 = acc[ai][bj][mp + mm][1];
                        w[mm].x = pk4_fp8(v0[0] * sc[0], v0[1] * sc[1], v0[2] * sc[2], v0[3] * sc[3]); w[mm].y = pk4_fp8(v1[0] * sc[4], v1[1] * sc[5], v1[2] * sc[6], v1[3] * sc[7]); }
                    const int srow = u.arow0 + ai * 128 + wr * 64 + (mp + (fq2 & 1)) * 16 + fr;
                    *(u32x4*)(VT + (size_t)srow * R + u.brow0 + 128 * bj + 32 * wc + 16 * (fq2 >> 1)) = widen16(w[0], w[1]); } }
    }
};

__device__ __forceinline__ void tr_item(const float* W, int K, int N, bf16_t* WT, int gu, const float* kscale, LAS float* scr, int item, int lane) {
    const int nblk = N / 64, kb = item / nblk, nb = item % nblk, k0 = 64 * kb, n0 = 64 * nb;
    f32x4 v[16];
#pragma unroll
    for (int i = 0; i < 16; ++i) v[i] = __builtin_nontemporal_load((const f32x4*)(W + (size_t)(k0 + 4 * i + (lane >> 4)) * N + n0 + 4 * (lane & 15)));
#pragma unroll
    for (int i = 0; i < 16; ++i) { const int kk = 4 * i + (lane >> 4); f32x4 w = v[i]; if (kscale) w = w * kscale[k0 + kk]; LAS float* p = scr + kk * 65 + 4 * (lane & 15); p[0] = w[0]; p[1] = w[1]; p[2] = w[2]; p[3] = w[3]; }
    LDS_WAIT(); asm volatile("" ::: "memory");
    int d0 = n0;
    if (gu == 1) { const int i0 = n0 & 511; d0 = 256 * (i0 >> 7) + (n0 >= 512 ? 128 : 0) + (i0 & 127); }
    if (gu == 2) { const int hh = n0 >> 8, jj = n0 & 255; d0 = jj < 128 ? hh * 128 + jj : 1024 + hh * 128 + (jj - 128); }
    const int c = lane & 7;
#pragma unroll
    for (int j = 0; j < 8; ++j) { const int n = (lane >> 3) + 8 * j; const LAS float* sp = scr + (8 * c) * 65 + n;
        u32x4 o; o.x = pk2(sp[0 * 65], sp[1 * 65]); o.y = pk2(sp[2 * 65], sp[3 * 65]); o.z = pk2(sp[4 * 65], sp[5 * 65]); o.w = pk2(sp[6 * 65], sp[7 * 65]);
        *(u32x4*)(WT + (size_t)(d0 + n) * K + k0 + 8 * c) = o; }
    LDS_WAIT(); asm volatile("" ::: "memory");
}
__device__ __forceinline__ void tr_item8(const float* W, int K, int N, unsigned char* WT, bool gu, float scale, LAS float* scr, int item, int lane) {
    const int nblk = N / 64, kb = item / nblk, nb = item % nblk, k0 = 64 * kb, n0 = 64 * nb;
    f32x4 v[16];
#pragma unroll
    for (int i = 0; i < 16; ++i) v[i] = __builtin_nontemporal_load((const f32x4*)(W + (size_t)(k0 + 4 * i + (lane >> 4)) * N + n0 + 4 * (lane & 15)));
#pragma unroll
    for (int i = 0; i < 16; ++i) { const int kk = 4 * i + (lane >> 4); const f32x4 w = v[i] * scale; LAS float* p = scr + kk * 65 + 4 * (lane & 15); p[0] = w[0]; p[1] = w[1]; p[2] = w[2]; p[3] = w[3]; }
    LDS_WAIT(); asm volatile("" ::: "memory");
    int d0 = n0;
    if (gu) { const int i0 = n0 & 511; d0 = 256 * (i0 >> 7) + (n0 >= 512 ? 128 : 0) + (i0 & 127); }
    const int c = lane & 7;
#pragma unroll
    for (int j = 0; j < 8; ++j) { const int n = (lane >> 3) + 8 * j; const LAS float* sp = scr + (8 * c) * 65 + n;
        u32x2 o; o.x = pk4_fp8(sp[0 * 65], sp[1 * 65], sp[2 * 65], sp[3 * 65]); o.y = pk4_fp8(sp[4 * 65], sp[5 * 65], sp[6 * 65], sp[7 * 65]);
        __builtin_nontemporal_store(o, (u32x2*)(WT + (size_t)(d0 + n) * K + k0 + 8 * c)); }
    LDS_WAIT(); asm volatile("" ::: "memory");
}
__device__ __forceinline__ void tr_item8k(const float* W, int K, int N, unsigned char* WT, int ldk, int mode, float scale, const float* kscale, LAS float* scr, int item, int lane) {
    const int nblk = N / 64, kb = item / nblk, nb = item % nblk, k0 = 64 * kb, n0 = 64 * nb; const bool real = k0 < K;
    f32x4 v[16];
#pragma unroll
    for (int i = 0; i < 16; ++i) v[i] = real ? __builtin_nontemporal_load((const f32x4*)(W + (size_t)(k0 + 4 * i + (lane >> 4)) * N + n0 + 4 * (lane & 15))) : (f32x4){0.f, 0.f, 0.f, 0.f};
#pragma unroll
    for (int i = 0; i < 16; ++i) { const int kk = 4 * i + (lane >> 4); const f32x4 w = v[i] * (real ? scale * kscale[k0 + kk] : 0.f); LAS float* p = scr + kk * 65 + 4 * (lane & 15); p[0] = w[0]; p[1] = w[1]; p[2] = w[2]; p[3] = w[3]; }
    LDS_WAIT(); asm volatile("" ::: "memory");
    int d0 = n0;
    if (mode == 2) { const int hh = n0 >> 8, jj = n0 & 255; d0 = jj < 128 ? hh * 128 + jj : 1024 + hh * 128 + (jj - 128); }
    const int c = lane & 7;
#pragma unroll
    for (int j = 0; j < 8; ++j) { const int n = (lane >> 3) + 8 * j; const LAS float* sp = scr + (8 * c) * 65 + n;
        u32x2 o; o.x = pk4_fp8(sp[0 * 65], sp[1 * 65], sp[2 * 65], sp[3 * 65]); o.y = pk4_fp8(sp[4 * 65], sp[5 * 65], sp[6 * 65], sp[7 * 65]);
        *(u32x2*)(WT + (size_t)(d0 + n) * ldk + k0 + 8 * c) = o; }
    LDS_WAIT(); asm volatile("" ::: "memory");
}
constexpr int MOE_W_ITEMS = 32 * 256 + 32 * 128;
__device__ __forceinline__ void moe_w_item(Frame& F, int layer, int it, LAS float* scr) {
    if (it < 32 * 256) { const int e = layer * 32 + it / 256; tr_item8(F.ka->in[I_MGU] + (size_t)e * DM * 1024, DM, 1024, F.ws + WS_WGU + (size_t)e * 1024 * DM, true, S8_WGU, scr, it % 256, F.lane); }
    else { it -= 32 * 256; const int e = layer * 32 + it / 128; tr_item8(F.ka->in[I_MDN] + (size_t)e * MFF * DM, MFF, DM, F.ws + WS_WDN + (size_t)e * DM * MFF, false, S8_WDN, scr, it % 128, F.lane); }
}
__device__ __forceinline__ void p0_prologue(Frame& F) {
    __syncthreads();

    LAS float* S = (LAS float*)F.lds;
    for (int idx = F.tid; idx < 17 * DM; idx += 512) { const int r = idx >> 10, k = idx & 1023; const float cv = r < 16 ? F.ka->in[I_C][r * DM + k] : F.ka->in[I_CCTX][k]; S[k * 20 + r] = siluf_(cv); }
    __syncthreads();
    const int gw = F.vcu * 8 + F.wave, NGW = F.G * 8;
    float* part = (float*)(F.ws + WS_PART);
    for (int it = gw; it < 2 * 8 * 96; it += NGW) {
        const int l = it / 768, rem = it % 768, kc = rem / 96, slab = rem % 96, n0 = slab * 64;
        const float* w = F.ka->in[I_ADAW] + ((size_t)l * DM + kc * 128) * 6144 + n0 + F.lane;
        float acc[17];
#pragma unroll
        for (int r = 0; r < 17; ++r) acc[r] = 0.f;
#pragma unroll 4
        for (int kk = 0; kk < 128; ++kk) {
            const float wv = __builtin_nontemporal_load(w + (size_t)kk * 6144);
            const LAS float* s = S + (kc * 128 + kk) * 20;
            const f32x4 s0 = *(const LAS f32x4*)s, s1 = *(const LAS f32x4*)(s + 4), s2 = *(const LAS f32x4*)(s + 8), s3 = *(const LAS f32x4*)(s + 12); const float s4 = s[16];
            acc[0] += s0[0] * wv; acc[1] += s0[1] * wv; acc[2] += s0[2] * wv; acc[3] += s0[3] * wv;
            acc[4] += s1[0] * wv; acc[5] += s1[1] * wv; acc[6] += s1[2] * wv; acc[7] += s1[3] * wv;
            acc[8] += s2[0] * wv; acc[9] += s2[1] * wv; acc[10] += s2[2] * wv; acc[11] += s2[3] * wv;
            acc[12] += s3[0] * wv; acc[13] += s3[1] * wv; acc[14] += s3[2] * wv; acc[15] += s3[3] * wv; acc[16] += s4 * wv;
        }
#pragma unroll
        for (int r = 0; r < 17; ++r) part[((size_t)(l * 8 + kc) * 17 + r) * 6144 + n0 + F.lane] = acc[r];
    }
    __syncthreads();
    LAS float* scr = (LAS float*)(F.lds + F.wave * 16640);
    constexpr int I_A = 16 * 56, I_B = 16 * 16, I_C2 = 16 * 11, I_D = 8 * 24, I_E = 4 * 32, I_F = 16 * 16, I_GU = 16 * 16, I_DN = 8 * 16;
    constexpr int NITEMS = I_A + I_B + I_C2 + I_D + I_E + I_F + 32 * 256;
    for (int it = gw; it < NITEMS; it += NGW) {
        int r = it;
        if (r < I_A) { tr_item(F.ka->in[I_EVWIN], DM, EVIN, (bf16_t*)(F.ws + WS_WIN0), false, nullptr, scr, r, F.lane); continue; } r -= I_A;
        if (r < I_B) { tr_item8(F.ka->in[I_EVWOUT], DM, DM, F.ws + WS_WOUT0, false, S8_W1, scr, r, F.lane); continue; } r -= I_B;
        if (r < I_C2) { tr_item8(F.ka->in[I_ODWIN], DM, CIN, F.ws + WS_WIN1, false, S8_W1, scr, r, F.lane); continue; } r -= I_C2;
        if (r < I_D) { tr_item8k(F.ka->in[I_ODWUQ], QRANK, NQ, F.ws + WS_WUQ, 512, 0, S8_WKV, F.ka->in[I_ODQG], scr, r, F.lane); continue; } r -= I_D;
        if (r < I_E) { tr_item8k(F.ka->in[I_ODWUKV], KVRANK, NKV, F.ws + WS_WUKV, KVRANK, 2, S8_WKV, F.ka->in[I_ODKVG], scr, r, F.lane); continue; } r -= I_E;
        if (r < I_F) { tr_item8(F.ka->in[I_ODWOUT], DM, DM, F.ws + WS_WOUT1, false, S8_W1, scr, r, F.lane); continue; } r -= I_F;
        moe_w_item(F, 0, r, scr);
    }
}
__device__ __forceinline__ void moe_l1_convert(Frame& F, int lo, int hi, int w0, int nw) {
    LAS float* scr = (LAS float*)(F.lds + F.wave * 16640);
    for (int it = lo + w0; it < hi; it += nw) moe_w_item(F, 1, it, scr);
}
__device__ __forceinline__ void moe_l0_dn_convert(Frame& F, int w0, int nw) {
    LAS float* scr = (LAS float*)(F.lds + F.wave * 16640);
    for (int it = 32 * 256 + w0; it < MOE_W_ITEMS; it += nw) moe_w_item(F, 0, it, scr);
}
__device__ __forceinline__ void p0b_mod(Frame& F) {
    const float* part = (const float*)(F.ws + WS_PART); float* mod = (float*)(F.ws + WS_MOD);
    const int gt = F.vcu * 512 + F.tid, NGT = F.G * 512;
    for (int idx = gt; idx < 2 * 17 * 6144; idx += NGT) {
        const int l = idx / (17 * 6144), rem = idx % (17 * 6144), r = rem / 6144, n = rem % 6144;
        float s = F.ka->in[I_ADAB][l * 6144 + n];
#pragma unroll
        for (int kc = 0; kc < 8; ++kc) s += part[((size_t)(l * 8 + kc) * 17 + r) * 6144 + n];
        const int which = n >> 10, c = n & 1023;
        if (which == 1) s = F.ka->in[I_NMIXG][l * DM + c] * (1.0f + s);
        if (which == 4) s = F.ka->in[I_NFFNG][l * DM + c] * (1.0f + s);
        mod[idx] = s;
    }
}

__device__ __forceinline__ void load_row4(const float* p, int lane, f32x4 (&v)[4]) {
#pragma unroll
    for (int j = 0; j < 4; ++j) v[j] = __builtin_nontemporal_load((const f32x4*)(p + 4 * lane + 256 * j));
}
__device__ __forceinline__ void load_row4_bf16(const bf16_t* p, int lane, f32x4 (&v)[4]) {
#pragma unroll
    for (int j = 0; j < 4; ++j) { const u32x2 w = __builtin_nontemporal_load((const u32x2*)(p + 4 * lane + 256 * j)); v[j] = (f32x4){bflo(w.x), bfhi(w.x), bflo(w.y), bfhi(w.y)}; }
}
__device__ __forceinline__ float sumsq4(const f32x4 (&v)[4]) {
    float s = 0.f;
#pragma unroll
    for (int j = 0; j < 4; ++j) s += (v[j][0] * v[j][0] + v[j][1] * v[j][1]) + (v[j][2] * v[j][2] + v[j][3] * v[j][3]);
    return wave_sum(s);
}
__device__ __forceinline__ void norm_mod4(f32x4 (&v)[4], const float* shift, const float* gscale, int lane) {
    const float rstd = __builtin_amdgcn_rsqf(sumsq4(v) * (1.0f / DM) + RMS_EPS);
#pragma unroll
    for (int j = 0; j < 4; ++j) { const int c = 4 * lane + 256 * j; const f32x4 sh = *(const f32x4*)(shift + c), gs = *(const f32x4*)(gscale + c);
        v[j] = (v[j] * rstd) * gs + sh; }
}
__device__ __forceinline__ void load_vec4(const float* p, int lane, f32x4 (&v)[4]) {
#pragma unroll
    for (int j = 0; j < 4; ++j) v[j] = *(const f32x4*)(p + 4 * lane + 256 * j);
}
__device__ __forceinline__ void norm_mod4c(f32x4 (&v)[4], const f32x4 (&sh)[4], const f32x4 (&gs)[4]) {
    const float rstd = __builtin_amdgcn_rsqf(sumsq4(v) * (1.0f / DM) + RMS_EPS);
#pragma unroll
    for (int j = 0; j < 4; ++j) v[j] = (v[j] * rstd) * gs[j] + sh[j];
}
__device__ __forceinline__ int rows_per_wave(int n, int nw) { return (n + nw - 1) / nw; }
__device__ __forceinline__ void store_row_bf16(bf16_t* p, int lane, const f32x4 (&v)[4]) {
#pragma unroll
    for (int j = 0; j < 4; ++j) { u32x2 w; w.x = cvtpk(v[j][0], v[j][1]); w.y = cvtpk(v[j][2], v[j][3]); *(u32x2*)(p + 4 * lane + 256 * j) = w; }
}
__device__ __forceinline__ void load_ys(Frame& F, int row, unsigned (&ya)[4], unsigned (&yb)[4]) {
    const unsigned char* ys = F.ws + WS_YS + (size_t)(2 * row) * DM;
#pragma unroll
    for (int j = 0; j < 4; ++j) { const int c = 4 * F.lane + 256 * j; ya[j] = __builtin_nontemporal_load((const unsigned*)(ys + c)); yb[j] = __builtin_nontemporal_load((const unsigned*)(ys + DM + c)); }
}
__device__ __forceinline__ void moe_combine4(Frame& F, int row, const unsigned (&ya)[4], const unsigned (&yb)[4], const f32x4 (&gate)[4], f32x4 (&v)[4]) {
    const float* aw = (const float*)(F.ws + WS_ROUTE + RT_AW);
    const float w0 = aw[2 * row] * (1.0f / S8_Y), w1 = aw[2 * row + 1] * (1.0f / S8_Y);
#pragma unroll
    for (int j = 0; j < 4; ++j) { const unsigned y0 = ya[j], y1 = yb[j]; const f32x4 gg = gate[j];
        const f32x2 a0 = __builtin_amdgcn_cvt_pk_f32_fp8((int)y0, false), a1 = __builtin_amdgcn_cvt_pk_f32_fp8((int)y0, true), b0 = __builtin_amdgcn_cvt_pk_f32_fp8((int)y1, false), b1 = __builtin_amdgcn_cvt_pk_f32_fp8((int)y1, true);
        f32x4 y; y[0] = w0 * a0[0] + w1 * b0[0]; y[1] = w0 * a0[1] + w1 * b0[1]; y[2] = w0 * a1[0] + w1 * b1[0]; y[3] = w0 * a1[1] + w1 * b1[1];
        v[j] = v[j] + gg * y; }
}
__device__ __forceinline__ void p1_norm_input(Frame& F) {
    const int gw = F.vcu * 8 + F.wave, NGW = F.G * 8, RPW = rows_per_wave(R, NGW); bf16_t* hx = (bf16_t*)(F.ws + WS_HX);
    f32x4 sh[4], gs[4], nx[4]; int cur = -1;
    load_row4(input_row(F, gw * RPW < R ? gw * RPW : 0), F.lane, nx);
    for (int i = 0; i < RPW; ++i) { const int row = gw * RPW + i; if (row >= R) break;
        const int b = row / PB, pos = row - b * PB, mrow = pos < CTXL ? 16 : b;
        if (mrow != cur) { cur = mrow; load_vec4(mod_ptr(F, 0, mrow, 0), F.lane, sh); load_vec4(mod_ptr(F, 0, mrow, 1), F.lane, gs); }
        f32x4 v[4];
#pragma unroll
        for (int j = 0; j < 4; ++j) v[j] = nx[j];
        load_row4(input_row(F, (i + 1 < RPW && row + 1 < R) ? row + 1 : row), F.lane, nx);
        norm_mod4c(v, sh, gs);
        store_row_bf16(hx + (size_t)row * DM, F.lane, v);
    }
}
__device__ __forceinline__ void p8_combine_norm(Frame& F) {
    const int gw = F.vcu * 8 + F.wave, NGW = F.G * 8, RPW = rows_per_wave(R, NGW); bf16_t* hx = (bf16_t*)(F.ws + WS_HX); bf16_t* xs = (bf16_t*)(F.ws + WS_XS);
    f32x4 sh[4], gs[4], gt[4]; int cur = -1;
    u32x2 nx[4]; unsigned nya[4], nyb[4];
    { const int r0 = gw * RPW < R ? gw * RPW : 0;
#pragma unroll
      for (int j = 0; j < 4; ++j) nx[j] = __builtin_nontemporal_load((const u32x2*)(xs + (size_t)r0 * DM + 4 * F.lane + 256 * j));
      load_ys(F, r0, nya, nyb); }
    for (int i = 0; i < RPW; ++i) { const int row = gw * RPW + i; if (row >= R) break;
        const int b = row / PB, pos = row - b * PB, mrow = pos < CTXL ? 16 : b;
        if (mrow != cur) { cur = mrow; load_vec4(mod_ptr(F, 1, mrow, 0), F.lane, sh); load_vec4(mod_ptr(F, 1, mrow, 1), F.lane, gs); load_vec4(mod_ptr(F, 0, mrow, 5), F.lane, gt); }
        f32x4 v[4]; unsigned ya[4], yb[4];
#pragma unroll
        for (int j = 0; j < 4; ++j) { v[j] = (f32x4){bflo(nx[j].x), bfhi(nx[j].x), bflo(nx[j].y), bfhi(nx[j].y)}; ya[j] = nya[j]; yb[j] = nyb[j]; }
        { const int rn = (i + 1 < RPW && row + 1 < R) ? row + 1 : row;
#pragma unroll
          for (int j = 0; j < 4; ++j) nx[j] = __builtin_nontemporal_load((const u32x2*)(xs + (size_t)rn * DM + 4 * F.lane + 256 * j));
          load_ys(F, rn, nya, nyb); }
        moe_combine4(F, row, ya, yb, gt, v);
#pragma unroll
        for (int j = 0; j < 4; ++j) { u32x2 w; w.x = cvtpk(v[j][0], v[j][1]); w.y = cvtpk(v[j][2], v[j][3]); __builtin_nontemporal_store(w, (u32x2*)(xs + (size_t)row * DM + 4 * F.lane + 256 * j)); }
        norm_mod4c(v, sh, gs);
#pragma unroll
        for (int j = 0; j < 4; ++j) *(unsigned*)((unsigned char*)hx + (size_t)row * DM + 4 * F.lane + 256 * j) = pk4_fp8(v[j][0] * S8_X, v[j][1] * S8_X, v[j][2] * S8_X, v[j][3] * S8_X);
        if (F.lane < 32) *(unsigned*)(F.ws + WS_QL8 + (size_t)row * 512 + 384 + 4 * F.lane) = 0u;
    }
}
__device__ __forceinline__ void p16_final(Frame& F) {
    const int gw = F.vcu * 8 + F.wave, NGW = F.G * 8, XPW = rows_per_wave(NB * SEQ, NGW); const bf16_t* xs = (const bf16_t*)(F.ws + WS_XS);
    f32x4 gt[4], fg[4]; int cur = -1; load_vec4(F.ka->in[I_FING], F.lane, fg);
    for (int i = 0; i < XPW; ++i) { const int xr = gw * XPW + i; if (xr >= NB * SEQ) break;
        const int b = xr / SEQ, pos = CTXL + (xr - b * SEQ), row = b * PB + pos;
        if (b != cur) { cur = b; load_vec4(mod_ptr(F, 1, b, 5), F.lane, gt); }
        f32x4 v[4];
        if (DBG_MODE >= 10) {
            const bf16_t* hx = (const bf16_t*)(F.ws + WS_HX) + (size_t)row * DM; const bf16_t* px = (const bf16_t*)(F.ws + WS_PX0) + (size_t)row * EVIN; const bf16_t* mx = (const bf16_t*)(F.ws + WS_MIX) + (size_t)row * DM;
#pragma unroll
            for (int j = 0; j < 4; ++j)
#pragma unroll
                for (int e = 0; e < 4; ++e) { const int c = 4 * F.lane + 256 * j + e;
                    v[j][e] = DBG_MODE == 10 ? bf2f(hx[c]) : DBG_MODE == 11 ? bf2f(px[c]) + bf2f(px[1024 + c]) + bf2f(px[2048 + c]) + bf2f(px[3072 + (c & 511)]) : bf2f(mx[c]); }
        } else if (DBG_MODE == 1) load_row4(input_row(F, row), F.lane, v); else load_row4_bf16(xs + (size_t)row * DM, F.lane, v);
        if (DBG_MODE == 0) { unsigned ya[4], yb[4]; load_ys(F, row, ya, yb); moe_combine4(F, row, ya, yb, gt, v); }
        const float rstd = __builtin_amdgcn_rsqf(sumsq4(v) * (1.0f / DM) + RMS_EPS);
        float* o = F.out + ((size_t)b * SEQ + (pos - CTXL)) * DM;
#pragma unroll
        for (int j = 0; j < 4; ++j) { const int c = 4 * F.lane + 256 * j; *(f32x4*)(o + c) = v[j] * rstd * fg[j]; }
        if (STAMP_PHASE >= 0 && row == CTXL && F.lane == 0) o[0] = ((const float*)(F.ws + WS_CTL))[2048];
    }
}

template <bool XONLY>
__device__ __forceinline__ void p5_norm_route(Frame& F, int layer) {

    LAS float* W1L = (LAS float*)F.lds; LAS float* W2L = W1L + 4096;
    volatile LAS int* lcnt = (volatile LAS int*)(F.lds + LDSCTL_OFF + 64);
    volatile LAS int* gbase = (volatile LAS int*)(F.lds + LDSCTL_OFF + 192);
    LAS int* wrec = (LAS int*)(F.lds + LDSCTL_OFF + 512) + F.wave * 40; int ri = 0;
    const float* wr1 = F.ka->in[I_MR1W] + (size_t)layer * DM * 4; const float* wr2 = F.ka->in[I_MR2W] + (size_t)layer * 4 * DM * 8;
    f32x4 w1r[16];
#pragma unroll
    for (int je = 0; je < 16; ++je) w1r[je] = *(const f32x4*)(wr1 + (4 * F.lane + 256 * (je >> 2) + (je & 3)) * 4);
    for (int idx = F.tid; idx < 4 * DM * 2; idx += 512) { const int half = idx & 1, k = (idx >> 1) & 1023, g = idx >> 11; const int l = (k & 255) >> 2, j = k >> 8, e = k & 3;
        *(LAS f32x4*)(W2L + ((((g * 16 + j * 4 + e) * 2 + half) * 64) + l) * 4) = *(const f32x4*)(wr2 + ((size_t)g * DM + k) * 8 + half * 4); }
    if (F.tid < 32) lcnt[F.tid] = 0;
    __syncthreads();
    const int gw = F.vcu * 8 + F.wave, NGW = F.G * 8; unsigned char* hx8 = F.ws + WS_HX; const bf16_t* xs = (const bf16_t*)(F.ws + WS_XS);
    float* aw = (float*)(F.ws + WS_ROUTE + RT_AW);
    const float* b1 = F.ka->in[I_MR1B] + layer * 4; const float* b2 = F.ka->in[I_MR2B] + layer * 32;
    const int NROW = XONLY ? NB * SEQ : R, RPW = rows_per_wave(NROW, NGW);
    f32x4 sh[4], gs[4]; int cur = -1;
    auto row_of = [&](int rr) { int b, pos; if (XONLY) { b = rr / SEQ; pos = CTXL + (rr - b * SEQ); } else { b = rr / PB; pos = rr - b * PB; } return b * PB + pos; };
    u32x2 nx[4];
    { const int r0 = gw * RPW < NROW ? row_of(gw * RPW) : 0;
#pragma unroll
      for (int j = 0; j < 4; ++j) nx[j] = __builtin_nontemporal_load((const u32x2*)(xs + (size_t)r0 * DM + 4 * F.lane + 256 * j)); }
    for (int i = 0; i < RPW; ++i) { const int rr = gw * RPW + i; if (rr >= NROW) break;
        int b, pos; if (XONLY) { b = rr / SEQ; pos = CTXL + (rr - b * SEQ); } else { b = rr / PB; pos = rr - b * PB; }
        const int row = b * PB + pos, mrow = pos < CTXL ? 16 : b;
        if (mrow != cur) { cur = mrow; load_vec4(mod_ptr(F, layer, mrow, 3), F.lane, sh); load_vec4(mod_ptr(F, layer, mrow, 4), F.lane, gs); }
        f32x4 v[4];
#pragma unroll
        for (int j = 0; j < 4; ++j) v[j] = (f32x4){bflo(nx[j].x), bfhi(nx[j].x), bflo(nx[j].y), bfhi(nx[j].y)};
        { const int rn = (i + 1 < RPW && rr + 1 < NROW) ? row_of(rr + 1) : row;
#pragma unroll
          for (int j = 0; j < 4; ++j) nx[j] = __builtin_nontemporal_load((const u32x2*)(xs + (size_t)rn * DM + 4 * F.lane + 256 * j)); }
        norm_mod4c(v, sh, gs);
#pragma unroll
        for (int j = 0; j < 4; ++j) *(unsigned*)(hx8 + (size_t)row * DM + 4 * F.lane + 256 * j) = pk4_fp8(v[j][0] * S8_X, v[j][1] * S8_X, v[j][2] * S8_X, v[j][3] * S8_X);
        f32x4 l1 = {0.f, 0.f, 0.f, 0.f};
#pragma unroll
        for (int j = 0; j < 4; ++j)
#pragma unroll
            for (int e = 0; e < 4; ++e) l1 += w1r[j * 4 + e] * v[j][e];
        float g0, g1, g2, g3; wave_sum4(l1, g0, g1, g2, g3); g0 += b1[0]; g1 += b1[1]; g2 += b1[2]; g3 += b1[3];
        int grp = 0; float gm = g0;
        if (g1 > gm) { gm = g1; grp = 1; } if (g2 > gm) { gm = g2; grp = 2; } if (g3 > gm) { gm = g3; grp = 3; }
        grp = __builtin_amdgcn_readfirstlane(grp);
        const float pg = 1.0f / (__expf(g0 - gm) + __expf(g1 - gm) + __expf(g2 - gm) + __expf(g3 - gm));
        f32x4 la = {0.f, 0.f, 0.f, 0.f}, lb = {0.f, 0.f, 0.f, 0.f};
        const LAS float* w2 = W2L + grp * 16 * 2 * 64 * 4;
#pragma unroll
        for (int j = 0; j < 4; ++j)
#pragma unroll
            for (int e = 0; e < 4; ++e) { const LAS float* p = w2 + (((j * 4 + e) * 2) * 64 + F.lane) * 4; la += *(const LAS f32x4*)p * v[j][e]; lb += *(const LAS f32x4*)(p + 256) * v[j][e]; }
        float lg[8]; wave_sum8(la, lb, F.lane, lg);
#pragma unroll
        for (int q = 0; q < 8; ++q) lg[q] += b2[grp * 8 + q];
        int e0 = 0; float m0 = lg[0];
#pragma unroll
        for (int q = 1; q < 8; ++q) if (lg[q] > m0) { m0 = lg[q]; e0 = q; }
        int e1 = -1; float m1 = -3.0e38f;
#pragma unroll
        for (int q = 0; q < 8; ++q) if (q != e0 && lg[q] > m1) { m1 = lg[q]; e1 = q; }
        const float pb = __expf(m1 - m0), inv = pg / (1.0f + pb);
        if (F.lane < 2) {
            const int ex = grp * 8 + (F.lane == 0 ? e0 : e1);
            const int lp = __hip_atomic_fetch_add((LAS int*)lcnt + ex, 1, __ATOMIC_RELAXED, __HIP_MEMORY_SCOPE_WORKGROUP);
            const int a = 2 * row + F.lane; aw[a] = F.lane == 0 ? inv : inv * pb; wrec[2 * ri + F.lane] = ex | (lp << 8);
        }
        ++ri;
    }
    __syncthreads();
    if (F.tid < 32) gbase[F.tid] = (int)__hip_atomic_fetch_add((unsigned*)(F.ws + WS_CTL) + CW_GC + 64 * layer + F.tid, (unsigned)lcnt[F.tid], __ATOMIC_RELAXED, __HIP_MEMORY_SCOPE_AGENT);
    __syncthreads();
    int* perm = (int*)(F.ws + WS_ROUTE + RT_PERM); ri = 0;
    for (int i = 0; i < RPW; ++i) { const int rr = gw * RPW + i; if (rr >= NROW) break;
        int b, pos; if (XONLY) { b = rr / SEQ; pos = CTXL + (rr - b * SEQ); } else { b = rr / PB; pos = rr - b * PB; }
        const int row = b * PB + pos;
        if (F.lane < 2) { const int rec = wrec[2 * ri + F.lane], e = rec & 255, p = gbase[e] + (rec >> 8); const int a = 2 * row + F.lane;
            if (p < ECAP) perm[e * ECAP + p] = a;
            else { aw[a] = 0.f; u32x4* yz = (u32x4*)(F.ws + WS_YS + (size_t)a * DM); for (int q = 0; q < DM / 16; ++q) yz[q] = (u32x4){0u, 0u, 0u, 0u}; } }
        ++ri;
    }
}
__device__ __forceinline__ void perm_clear(Frame& F) {
    int* perm = (int*)(F.ws + WS_ROUTE + RT_PERM);
    for (int i = F.vcu * 512 + F.tid; i < MAXSLOT; i += F.G * 512) perm[i] = -1;
}

__device__ __forceinline__ bf16x8 lds_frag256(const LAS unsigned char* base, int row, int chunk) { return *(const LAS bf16x8*)(base + row * 256 + ((chunk ^ (row & 15)) << 4)); }
__device__ __forceinline__ bf16x8 lds_frag128(const LAS unsigned char* base, int row, int chunk) { return *(const LAS bf16x8*)(base + row * 128 + ((chunk ^ (row & 7)) << 4)); }
#define MFMA16(a, b, c) __builtin_amdgcn_mfma_f32_16x16x32_bf16((a), (b), (c), 0, 0, 0)

typedef short v4i16_t __attribute__((ext_vector_type(4)));
__device__ __forceinline__ int trswz256(int r, int cb) { return r * 256 + (cb ^ (((r & 3) | ((r >> 1) & 4)) << 5)); }
__device__ __forceinline__ int trswz128(int r, int cb) { return r * 128 + (cb ^ ((((r >> 1) & 1) | ((r >> 2) & 2)) << 5)); }
template <int ROWB> __device__ __forceinline__ bf16x8 lds_trfrag(const LAS unsigned char* tile, int s0, int c0, int lane) {
    const int i = lane & 15, r0 = s0 + (i >> 2), r1 = r0 + 4, cb = (c0 + 4 * (i & 3)) * 2;
    const int a0 = ROWB == 256 ? trswz256(r0, cb) : trswz128(r0, cb), a1 = ROWB == 256 ? trswz256(r1, cb) : trswz128(r1, cb);
    const v4i16_t lo = __builtin_amdgcn_ds_read_tr16_b64_v4i16((LAS v4i16_t*)(tile + a0)), hi = __builtin_amdgcn_ds_read_tr16_b64_v4i16((LAS v4i16_t*)(tile + a1));
    return (bf16x8){lo[0], lo[1], lo[2], lo[3], hi[0], hi[1], hi[2], hi[3]};
}
__device__ __forceinline__ void gla_item(Frame& F, int item) {
    const int b = item >> 3, h = (item >> 1) & 3, dir = item & 1;
    LAS unsigned char* QD = F.lds; LAS unsigned char* KD = F.lds + 16384; LAS unsigned char* KT = F.lds + 32768  ; LAS unsigned char* VR = F.lds + 49152  ;
    LAS unsigned char* PS = F.lds + 65536; LAS unsigned char* ST = F.lds + 73728  ; LAS float* LF = (LAS float*)(F.lds + 106496); LAS float* SEGT = (LAS float*)(F.lds + 139264); LAS float* DEC = (LAS float*)(F.lds + 141312);
    const int tid = F.tid, lane = F.lane, wave = F.wave, fr = lane & 15, fq = lane >> 4;
    const int t0 = tid >> 4, c = tid & 15, tv = tid >> 3, cv = tid & 7;
    const bf16_t* px = (const bf16_t*)(F.ws + WS_PX0);
    bf16_t* og = (bf16_t*)(F.ws + WS_OG) + (size_t)dir * R * 512;
    float lbv[8], oml[8];
    { const float* lg = F.ka->in[I_EVLB] + h * 128 + 8 * c;
#pragma unroll
      for (int e = 0; e < 8; ++e) { lbv[e] = 1.0f / (1.0f + __expf(lg[512 + e] - lg[e])); oml[e] = 1.0f - lbv[e]; } }
    { u32x4 z = {0u, 0u, 0u, 0u};
#pragma unroll
      for (int i = 0; i < 4; ++i) *(LAS u32x4*)(ST + tid * 64 + 16 * i) = z; }
    f32x4 S[8];
#pragma unroll
    for (int i = 0; i < 8; ++i) S[i] = (f32x4){0.f, 0.f, 0.f, 0.f};
    auto chunk_p0 = [&](int j) { return dir == 0 ? 64 * j : (j < 4 ? 192 - 64 * j : PB - 64 * (j - 3)); };
    auto row_of = [&](int p0, int tau) { return b * PB + (dir == 0 ? p0 + tau : p0 + 63 - tau); };
    u32x4 rqA[2], rfA[2], rvA[2];
#define GLA_LOAD(j, RQ, RF, RV) do { const int p0_ = chunk_p0(j); \
        _Pragma("unroll") for (int i_ = 0; i_ < 2; ++i_) { const bf16_t* rp_ = px + (size_t)row_of(p0_, t0 + 32 * i_) * EVIN + h * 128 + 8 * c; RQ[i_] = *(const u32x4*)rp_; RF[i_] = *(const u32x4*)(rp_ + 512 * (1 + dir)); } \
        { const bf16_t* vp_ = px + (size_t)row_of(p0_, tv) * EVIN + 1536 + h * 128 + 8 * cv; RV[0] = *(const u32x4*)vp_; RV[1] = *(const u32x4*)(vp_ + 64); } } while (0)
    GLA_LOAD(0, rqA, rfA, rvA);
    __syncthreads();
    const int ti = wave & 3, sp = wave >> 2, ki = wave;
#define GLA_STEP(j, RQ, RF, RV) do { \
        const int p0 = chunk_p0(j); float qv[2][8], kv[2][8]; const u32x4 vraw0 = RV[0], vraw1 = RV[1]; \
        _Pragma("unroll") for (int i = 0; i < 2; ++i) { const int tau = t0 + 32 * i; float lf[8]; \
            _Pragma("unroll") for (int e = 0; e < 4; ++e) { const unsigned wq = RQ[i][e], wf = RF[i][e]; \
                qv[i][2 * e] = bflo(wq); qv[i][2 * e + 1] = bfhi(wq); \
                const float s0_ = sigmoidf_(bflo(wf)), s1_ = sigmoidf_(bfhi(wf)); \
                const float f0 = lbv[2 * e] + oml[2 * e] * s0_, f1 = lbv[2 * e + 1] + oml[2 * e + 1] * s1_; \
                kv[i][2 * e] = 1.0f - f0; kv[i][2 * e + 1] = 1.0f - f1; lf[2 * e] = lg2(f0); lf[2 * e + 1] = lg2(f1); } \
            *(LAS f32x4*)(LF + tau * 128 + 8 * c) = (f32x4){lf[0], lf[1], lf[2], lf[3]}; *(LAS f32x4*)(LF + tau * 128 + 8 * c + 4) = (f32x4){lf[4], lf[5], lf[6], lf[7]}; } \
        if ((j) + 1 < 36) GLA_LOAD((j) + 1, RQ, RF, RV); \
        __syncthreads(); \
        { const int k = tid & 127, sg = tid >> 7; float run = 0.f; \
          _Pragma("unroll") for (int i = 0; i < 16; ++i) { const int idx = (16 * sg + i) * 128 + k; run += LF[idx]; LF[idx] = run; } \
          SEGT[sg * 128 + k] = run; } \
        __syncthreads(); \
        { float seg[4][8]; float ebl[8]; \
          _Pragma("unroll") for (int s = 0; s < 4; ++s) { const f32x4 a0 = *(const LAS f32x4*)(SEGT + s * 128 + 8 * c), a1 = *(const LAS f32x4*)(SEGT + s * 128 + 8 * c + 4); \
              _Pragma("unroll") for (int e = 0; e < 4; ++e) { seg[s][e] = a0[e]; seg[s][4 + e] = a1[e]; } } \
          float offr[2][8]; const bool odd = (t0 >> 4) != 0; \
          _Pragma("unroll") for (int e = 0; e < 8; ++e) { ebl[e] = ex2((seg[0][e] + seg[1][e]) + (seg[2][e] + seg[3][e])); offr[0][e] = odd ? seg[0][e] : 0.f; offr[1][e] = (seg[0][e] + seg[1][e]) + (odd ? seg[2][e] : 0.f); } \
          _Pragma("unroll") for (int i = 0; i < 2; ++i) { const int tau = t0 + 32 * i; \
              const f32x4 c0 = *(const LAS f32x4*)(LF + tau * 128 + 8 * c), c1 = *(const LAS f32x4*)(LF + tau * 128 + 8 * c + 4); \
              float qd[8], kd[8], kt[8]; \
              _Pragma("unroll") for (int e = 0; e < 8; ++e) { \
                  const float bb = (e < 4 ? c0[e] : c1[e - 4]) + offr[i][e]; const float eb = ex2(bb); \
                  qd[e] = qv[i][e] * eb; kd[e] = kv[i][e] * __builtin_amdgcn_rcpf(eb); kt[e] = kd[e] * ebl[e]; } \
              u32x4 w; w.x = cvtpk(qd[0], qd[1]); w.y = cvtpk(qd[2], qd[3]); w.z = cvtpk(qd[4], qd[5]); w.w = cvtpk(qd[6], qd[7]); \
              *(LAS u32x4*)(QD + tau * 256 + ((c ^ (tau & 15)) << 4)) = w; \
              w.x = cvtpk(kd[0], kd[1]); w.y = cvtpk(kd[2], kd[3]); w.z = cvtpk(kd[4], kd[5]); w.w = cvtpk(kd[6], kd[7]); \
              *(LAS u32x4*)(KD + tau * 256 + ((c ^ (tau & 15)) << 4)) = w; \
              w.x = cvtpk(kt[0], kt[1]); w.y = cvtpk(kt[2], kt[3]); w.z = cvtpk(kt[4], kt[5]); w.w = cvtpk(kt[6], kt[7]); \
              *(LAS u32x4*)(KT + trswz256(tau, 16 * c)) = w; } \
          *(LAS u32x4*)(VR + trswz256(tv, 16 * cv)) = vraw0; *(LAS u32x4*)(VR + trswz256(tv, 16 * (cv + 8))) = vraw1; \
          if (tid < 128) DEC[tid] = ex2((SEGT[tid] + SEGT[128 + tid]) + (SEGT[256 + tid] + SEGT[384 + tid])); } \
        __syncthreads(); \
        bf16x8 bq[4]; \
        _Pragma("unroll") for (int ks = 0; ks < 4; ++ks) bq[ks] = lds_frag256(QD, 16 * ti + fr, ks * 4 + fq); \
        _Pragma("unroll") for (int u = 0; u < 2; ++u) { const int si = 2 * sp + u; f32x4 a = {0.f, 0.f, 0.f, 0.f}; \
            _Pragma("unroll") for (int ks = 0; ks < 4; ++ks) a = MFMA16(lds_frag256(KD, 16 * si + fr, ks * 4 + fq), bq[ks], a); \
            const int tt = 16 * ti + fr, s0 = 16 * si + 4 * fq; \
            u32x2 w; w.x = cvtpk(s0 <= tt ? a[0] : 0.f, s0 + 1 <= tt ? a[1] : 0.f); w.y = cvtpk(s0 + 2 <= tt ? a[2] : 0.f, s0 + 3 <= tt ? a[3] : 0.f); \
            *(LAS u32x2*)(PS + tt * 128 + ((2 * s0) ^ ((tt & 7) << 4))) = w; } \
        f32x4 oacc[4]; \
        _Pragma("unroll") for (int u = 0; u < 4; ++u) { const int vi = 4 * sp + u; f32x4 o = {0.f, 0.f, 0.f, 0.f}; \
            _Pragma("unroll") for (int ks = 0; ks < 4; ++ks) o = MFMA16(lds_frag256(ST, 16 * vi + fr, ks * 4 + fq), bq[ks], o); \
            oacc[u] = o; } \
        { const f32x4 dk = *(const LAS f32x4*)(DEC + 16 * ki + 4 * fq); \
          bf16x8 ak[2]; \
          _Pragma("unroll") for (int ks = 0; ks < 2; ++ks) ak[ks] = lds_trfrag<256>(KT, 32 * ks + 8 * fq, 16 * ki, lane); \
          _Pragma("unroll") for (int vi = 0; vi < 8; ++vi) { f32x4 s = S[vi] * dk; \
              _Pragma("unroll") for (int ks = 0; ks < 2; ++ks) s = MFMA16(ak[ks], lds_trfrag<256>(VR, 32 * ks + 8 * fq, 16 * vi, lane), s); \
              S[vi] = s; } } \
        __syncthreads(); \
        { bf16x8 bp[2]; \
          _Pragma("unroll") for (int ks = 0; ks < 2; ++ks) bp[ks] = lds_frag128(PS, 16 * ti + fr, ks * 4 + fq); \
          const int orow = row_of(p0, 16 * ti + fr); \
          _Pragma("unroll") for (int u = 0; u < 4; ++u) { const int vi = 4 * sp + u; f32x4 o = oacc[u]; \
              _Pragma("unroll") for (int ks = 0; ks < 2; ++ks) o = MFMA16(lds_trfrag<256>(VR, 32 * ks + 8 * fq, 16 * vi, lane), bp[ks], o); \
              u32x2 w; w.x = cvtpk(o[0], o[1]); w.y = cvtpk(o[2], o[3]); \
              *(u32x2*)(og + (size_t)orow * 512 + h * 128 + 16 * vi + 4 * fq) = w; } \
          _Pragma("unroll") for (int vi = 0; vi < 8; ++vi) { const int v = 16 * vi + fr, k0 = 16 * ki + 4 * fq; u32x2 w; w.x = cvtpk(S[vi][0], S[vi][1]); w.y = cvtpk(S[vi][2], S[vi][3]); \
              *(LAS u32x2*)(ST + v * 256 + ((2 * k0) ^ ((v & 15) << 4))) = w; } } \
    } while (0)
    for (int j = 0; j < 36; ++j) { GLA_STEP(j, rqA, rfA, rvA); }
    __syncthreads();
#undef GLA_LOAD
#undef GLA_STEP
}

__device__ __forceinline__ void sgu_item(Frame& F, int ci) {
    LAS unsigned char* VN = F.lds; LAS unsigned char* WS = F.lds + 32768;
    const int tid = F.tid, lane = F.lane, wave = F.wave, fr = lane & 15, fq = lane >> 4;
    const int r0 = ci * 128, row = tid >> 2, q = tid & 3;
    const bf16_t* px = (const bf16_t*)(F.ws + WS_PX0); unsigned char* mix = F.ws + WS_MIX;
    const bf16_t* vrow = px + (size_t)(r0 + row) * EVIN + 3072 + 32 * q;
    float sum = 0.f, sq = 0.f;
    { u32x4 vr[16];
#pragma unroll
      for (int j = 0; j < 4; ++j)
#pragma unroll
        for (int i = 0; i < 4; ++i) vr[4 * j + i] = *(const u32x4*)(vrow + 128 * j + 8 * i);
#pragma unroll
      for (int i = 0; i < 16; ++i) {
#pragma unroll
        for (int e = 0; e < 4; ++e) { const float a = geluf_(bflo(vr[i][e])), bb = geluf_(bfhi(vr[i][e])); sum += a + bb; sq += a * a + bb * bb; } } }
    sum += __shfl_xor(sum, 1); sum += __shfl_xor(sum, 2); sq += __shfl_xor(sq, 1); sq += __shfl_xor(sq, 2);
    const float mean = sum * (1.0f / 512.0f), rstd = __builtin_amdgcn_rsqf(fmaxf(sq * (1.0f / 512.0f) - mean * mean, 0.f) + RMS_EPS);
    u32x4 vg[4]; f32x4 wsr[8];
#define SGU_LOADG(g) do { const float* wsg_ = F.ka->in[I_EVWS] + (size_t)(g) * 128 * 128; _Pragma("unroll") for (int it_ = 0; it_ < 4; ++it_) { const int idx_ = tid + 512 * it_; \
        wsr[2 * it_] = *(const f32x4*)(wsg_ + (idx_ >> 4) * 128 + 8 * (idx_ & 15)); wsr[2 * it_ + 1] = *(const f32x4*)(wsg_ + (idx_ >> 4) * 128 + 8 * (idx_ & 15) + 4); } \
        _Pragma("unroll") for (int i_ = 0; i_ < 4; ++i_) vg[i_] = *(const u32x4*)(vrow + 128 * (g) + 8 * i_); } while (0)
    SGU_LOADG(0);
#pragma unroll 1
    for (int g = 0; g < 4; ++g) {
        const float* gain = F.ka->in[I_EVSGUG] + 128 * g + 32 * q;
#pragma unroll
        for (int i = 0; i < 4; ++i) { const u32x4 w = vg[i]; const f32x4 g0 = *(const f32x4*)(gain + 8 * i), g1 = *(const f32x4*)(gain + 8 * i + 4);
            u32x4 o;
            o.x = cvtpk((geluf_(bflo(w.x)) - mean) * rstd * g0[0], (geluf_(bfhi(w.x)) - mean) * rstd * g0[1]); o.y = cvtpk((geluf_(bflo(w.y)) - mean) * rstd * g0[2], (geluf_(bfhi(w.y)) - mean) * rstd * g0[3]);
            o.z = cvtpk((geluf_(bflo(w.z)) - mean) * rstd * g1[0], (geluf_(bfhi(w.z)) - mean) * rstd * g1[1]); o.w = cvtpk((geluf_(bflo(w.w)) - mean) * rstd * g1[2], (geluf_(bfhi(w.w)) - mean) * rstd * g1[3]);
            *(LAS u32x4*)(VN + trswz256(row, (32 * q + 8 * i) * 2)) = o; }
#pragma unroll
        for (int it = 0; it < 4; ++it) { const int idx = tid + 512 * it, t = idx >> 4, ch = idx & 15; const f32x4 a = wsr[2 * it], bb = wsr[2 * it + 1];
            u32x4 w; w.x = cvtpk(a[0], a[1]); w.y = cvtpk(a[2], a[3]); w.z = cvtpk(bb[0], bb[1]); w.w = cvtpk(bb[2], bb[3]);
            *(LAS u32x4*)(WS + t * 256 + ((ch ^ (t & 15)) << 4)) = w; }
        __syncthreads();
        if (g < 3) SGU_LOADG(g + 1);
        const int c0 = 128 * g + 16 * wave + 4 * fq;
        u32x2 uw[8]; float bsv[8];
#pragma unroll
        for (int tt = 0; tt < 8; ++tt) { const int t = 16 * tt + fr; uw[tt] = *(const u32x2*)(px + (size_t)(r0 + t) * EVIN + 2560 + c0); bsv[tt] = F.ka->in[I_EVBS][g * 128 + t]; }
        bf16x8 av[4];
#pragma unroll
        for (int ks = 0; ks < 4; ++ks) av[ks] = lds_trfrag<256>(VN, 32 * ks + 8 * fq, 16 * wave, lane);
#pragma unroll
        for (int tt = 0; tt < 8; ++tt) { f32x4 a = {0.f, 0.f, 0.f, 0.f};
#pragma unroll
            for (int ks = 0; ks < 4; ++ks) a = MFMA16(av[ks], lds_frag256(WS, 16 * tt + fr, ks * 4 + fq), a);
            const int t = 16 * tt + fr; const float bs = bsv[tt]; const u32x2 u2 = uw[tt];
            *(unsigned*)(mix + (size_t)(r0 + t) * DM + 512 + c0) = pk4_fp8(geluf_(bflo(u2.x)) * (a[0] + bs) * S8_M, geluf_(bfhi(u2.x)) * (a[1] + bs) * S8_M, geluf_(bflo(u2.y)) * (a[2] + bs) * S8_M, geluf_(bfhi(u2.y)) * (a[3] + bs) * S8_M); }
        __syncthreads();
    }
#undef SGU_LOADG
}
constexpr int MOE_L1_SPLIT = 3584;
__device__ __forceinline__ void p3_mixers(Frame& F) {
    const int half = F.G >> 1;
    if (F.vcu < half) { for (int rep_ = 0; rep_ < 1 + ((REPMASK >> 21) & 1); ++rep_) for (int it = F.vcu; it < 128; it += half) gla_item(F, it); }
    else { for (int rep_ = 0; rep_ < 1 + ((REPMASK >> 22) & 1); ++rep_) for (int ci = F.vcu - half; ci < R / 128; ci += F.G - half) sgu_item(F, ci);
        moe_l0_dn_convert(F, (F.vcu - half) * 8 + F.wave, (F.G - half) * 8);
        moe_l1_convert(F, 0, MOE_L1_SPLIT, (F.vcu - half) * 8 + F.wave, (F.G - half) * 8); }
}
__device__ __forceinline__ void p3b_hgrn_out(Frame& F) {
    const int gw = F.vcu * 8 + F.wave, NGW = F.G * 8; const bf16_t* og = (const bf16_t*)(F.ws + WS_OG); const bf16_t* px = (const bf16_t*)(F.ws + WS_PX0); unsigned char* mix = F.ws + WS_MIX;
    const int c0 = 8 * F.lane; float gn[8];
#pragma unroll
    for (int e = 0; e < 8; ++e) gn[e] = F.ka->in[I_EVONORM][(c0 & 127) + e] * S8_M;
    for (int row = gw; row < R; row += NGW) {
        const u32x4 a = __builtin_nontemporal_load((const u32x4*)(og + (size_t)row * 512 + c0)), bb = __builtin_nontemporal_load((const u32x4*)(og + (size_t)(R + row) * 512 + c0)), gg = __builtin_nontemporal_load((const u32x4*)(px + (size_t)row * EVIN + 2048 + c0));
        float o[8]; float ss = 0.f;
#pragma unroll
        for (int e = 0; e < 4; ++e) { o[2 * e] = bflo(a[e]) + bflo(bb[e]); o[2 * e + 1] = bfhi(a[e]) + bfhi(bb[e]); ss += o[2 * e] * o[2 * e] + o[2 * e + 1] * o[2 * e + 1]; }
        ss += __shfl_xor(ss, 1); ss += __shfl_xor(ss, 2); ss += __shfl_xor(ss, 4); ss += __shfl_xor(ss, 8);
        const float rstd = __builtin_amdgcn_rsqf(ss * (1.0f / 128.0f) + RMS_EPS);
        float y[8];
#pragma unroll
        for (int e = 0; e < 4; ++e) { y[2 * e] = o[2 * e] * rstd * gn[2 * e] * siluf_(bflo(gg[e])); y[2 * e + 1] = o[2 * e + 1] * rstd * gn[2 * e + 1] * siluf_(bfhi(gg[e])); }
        u32x2 w; w.x = pk4_fp8(y[0], y[1], y[2], y[3]); w.y = pk4_fp8(y[4], y[5], y[6], y[7]);
        *(u32x2*)(mix + (size_t)row * DM + c0) = w;
    }
}

__device__ __forceinline__ void p10_kr(Frame& F) {
    int nf = (NTILE * 4) % F.G; if (4 * nf >= F.G) nf = 0;
    const int bx = (int)blockIdx.x; if (bx < nf || bx >= F.G - nf) return;
    const int gw = (bx - nf) * 8 + F.wave, NGW = (F.G - 2 * nf) * 8; const bf16_t* px1 = (const bf16_t*)(F.ws + WS_PX1); unsigned char* kb = F.ws + WS_KB;
    const int d = F.lane, i16 = d & 15; const float invf = __expf(-(float)i16 * (2.0f / 32.0f) * 9.210340371976184f);
    for (int row = gw; row < R; row += NGW) {
        const int pos = row % PB; float x = bf2f(px1[(size_t)row * CINP + 640 + d]);
        const float xo = __shfl_xor(x, 16);
        if (pos >= CTXL) { const int t = pos - CTXL; const float p = (d < 32) ? (float)(t >> 6) : (float)(t & 63); const float ang = p * invf, cs = __cosf(ang), sn = __sinf(ang);
            x = (d & 16) ? (xo * sn + x * cs) : (x * cs - xo * sn); }
        const unsigned char hb = (unsigned char)(pk4_fp8(x * S8_K, 0.f, 0.f, 0.f) & 0xffu);
#pragma unroll
        for (int h = 0; h < 8; ++h) kb[(size_t)row * NQ + h * 192 + 128 + d] = hb;
    }
}

namespace att {
constexpr int KVBLK = 64, SHM_V = 128 * 64, SHM_K = 64 * 192;
constexpr float THR = 8.0f;
#define KSWZ192(row, colB) ((row) * 384 + ((colB) ^ (((row) & 7) << 4)))
__device__ __forceinline__ int crow(int r, int hi) { return (r & 3) + 8 * (r >> 2) + 4 * hi; }
template <bool FIRST>
__device__ __forceinline__ void partialSM(f32x16& p0, f32x16& p1, float& m_reg, f32x16& negm, float& alpha) {
    float pmax = p0[0];
#pragma unroll
    for (int r = 1; r < 16; ++r) pmax = fmaxf(pmax, p0[r]);
#pragma unroll
    for (int r = 0; r < 16; ++r) pmax = fmaxf(pmax, p1[r]);
    { auto rr = __builtin_amdgcn_permlane32_swap(__float_as_uint(pmax), __float_as_uint(pmax), false, false); pmax = fmaxf(__uint_as_float(rr[0]), __uint_as_float(rr[1])); }
    if (!FIRST && __builtin_expect(__all(pmax <= THR), 1)) { alpha = 1.f; }
    else { const float d = FIRST ? pmax : fmaxf(pmax, 0.f); alpha = FIRST ? 1.f : __builtin_amdgcn_exp2f(-d); m_reg += d;
#pragma unroll
        for (int r = 0; r < 16; ++r) { p0[r] -= d; p1[r] -= d; negm[r] = -m_reg; } }
#pragma unroll
    for (int r = 0; r < 16; ++r) p0[r] = __builtin_amdgcn_exp2f(p0[r]);
}
__device__ __forceinline__ void finishSM(f32x16& p0, f32x16& p1, float alpha, float& l_reg, i32x8_t& pa) {
#pragma unroll
    for (int r = 0; r < 16; ++r) p1[r] = __builtin_amdgcn_exp2f(p1[r]);
    float ps = 0;
#pragma unroll
    for (int r = 0; r < 16; ++r) ps += p0[r];
#pragma unroll
    for (int r = 0; r < 16; ++r) ps += p1[r];
    { auto rr = __builtin_amdgcn_permlane32_swap(__float_as_uint(ps), __float_as_uint(ps), false, false); ps = __uint_as_float(rr[0]) + __uint_as_float(rr[1]); }
    l_reg = l_reg * alpha + ps;
#pragma unroll
    for (int k = 0; k < 4; ++k) { pa[k] = (int)pk4_fp8_nc(p0[4 * k], p0[4 * k + 1], p0[4 * k + 2], p0[4 * k + 3]); pa[4 + k] = (int)pk4_fp8_nc(p1[4 * k], p1[4 * k + 1], p1[4 * k + 2], p1[4 * k + 3]); }
}
__device__ __forceinline__ void kload1(i32x8_t (&a)[2], const LAS unsigned char* const (&kb)[3][2], const int boff, const int m) {
    a[0] = __builtin_shufflevector(*(const LAS i32x4_t*)(kb[m][0] + boff), *(const LAS i32x4_t*)(kb[m][1] + boff), 0, 1, 2, 3, 4, 5, 6, 7);
    a[1] = __builtin_shufflevector(*(const LAS i32x4_t*)(kb[m][0] + boff + 6144), *(const LAS i32x4_t*)(kb[m][1] + boff + 6144), 0, 1, 2, 3, 4, 5, 6, 7);
}
__device__ __forceinline__ void kload01(i32x8_t (&a0)[2], i32x8_t (&a1)[2], const LAS unsigned char* const (&kb)[3][2], const int boff) { kload1(a0, kb, boff, 0); kload1(a1, kb, boff, 1); }
__device__ __forceinline__ void qmma(f32x16& p0, f32x16& p1, i32x8_t (&a0)[2], i32x8_t (&a1)[2], const LAS unsigned char* const (&kb)[3][2], const int boff, const i32x8_t* qr, const f32x16& negm) {
    constexpr int SA = 0x7d7d7d7d, SB = 0x76767676;
    static_assert(S8_Q * S8_K == 2048.f, "block scales assume 2^11");
    p0 = __builtin_amdgcn_mfma_scale_f32_32x32x64_f8f6f4(a0[0], qr[0], negm, 0, 0, 0, SA, 0, SB);
    p1 = __builtin_amdgcn_mfma_scale_f32_32x32x64_f8f6f4(a0[1], qr[0], negm, 0, 0, 0, SA, 0, SB);
    i32x8_t a2[2]; kload1(a2, kb, boff, 2);
    p0 = __builtin_amdgcn_mfma_scale_f32_32x32x64_f8f6f4(a1[0], qr[1], p0, 0, 0, 0, SA, 0, SB);
    p1 = __builtin_amdgcn_mfma_scale_f32_32x32x64_f8f6f4(a1[1], qr[1], p1, 0, 0, 0, SA, 0, SB);
    p0 = __builtin_amdgcn_mfma_scale_f32_32x32x64_f8f6f4(a2[0], qr[2], p0, 0, 0, 0, SA, 0, SB);
    p1 = __builtin_amdgcn_mfma_scale_f32_32x32x64_f8f6f4(a2[1], qr[2], p1, 0, 0, 0, SA, 0, SB);
    asm volatile("" : "+v"(p0), "+v"(p1));
    SBAR();
}
__device__ __forceinline__ void qkt(f32x16& p0, f32x16& p1, const LAS unsigned char* const (&kb)[3][2], const int boff, const i32x8_t* qr, const f32x16& negm) {
    i32x8_t a0[2], a1[2]; kload01(a0, a1, kb, boff); qmma(p0, p1, a0, a1, kb, boff, qr, negm);
}
__device__ __forceinline__ void pv_d0(f32x16* o, const LAS unsigned char* vt, int vo0, int vo1, const i32x8_t pa) {
#pragma unroll
    for (int d0 = 0; d0 < 4; ++d0) {
        const i32x8_t vf = __builtin_shufflevector(*(const LAS i32x4_t*)(vt + vo0 + d0 * 2048), *(const LAS i32x4_t*)(vt + vo1 + d0 * 2048), 0, 1, 2, 3, 4, 5, 6, 7);
        o[d0] = __builtin_amdgcn_mfma_scale_f32_32x32x64_f8f6f4(pa, vf, o[d0], 0, 0, 0, 0x7d7d7d7d, 0, 0x7d7d7d7d);
        SBAR(); }
    static_assert(S8_V == 16.f, "block scale assumes 2^4");
}
constexpr int NSLOT = 3, LDS_KR = NSLOT * SHM_V  , LDS_WS = NSLOT * (SHM_V + SHM_K);
__device__ __forceinline__ void attn_unit(const int tid, const unsigned char* __restrict__ Qb, const unsigned char* __restrict__ Kh, const unsigned char* __restrict__ Vh, unsigned char* __restrict__ Ob, LAS unsigned char* lds) {
    const int wid = __builtin_amdgcn_readfirstlane(tid >> 6), lane = tid & 63, r32 = lane & 31, hi = lane >> 5;
    LAS unsigned char* V_lds = lds; LAS unsigned char* K_lds = lds + LDS_KR;
    LAS float* ws = (LAS float*)(lds + LDS_WS) + wid * 64; LAS float* li_l = ws; LAS float* al_l = ws + 32;
    float m_reg = 0.f, l_reg = 0; f32x16 negm = {}; f32x16 o[4] = {}; i32x8_t qr[3];
    const unsigned char* Qw = Qb + (size_t)(wid * 32 + r32) * NQ + hi * 32;
#pragma unroll
    for (int m = 0; m < 3; ++m) qr[m] = __builtin_shufflevector(*(const i32x4_t*)(Qw + 64 * m), *(const i32x4_t*)(Qw + 64 * m + 16), 0, 1, 2, 3, 4, 5, 6, 7);
    unsigned kgo[2], vgo;
#pragma unroll
    for (int i = 0; i < 2; ++i) { const int q = (8 * i + wid) * 64 + lane, row = q / 12, chp = q % 12, ch = (chp & ~3) | ((chp ^ (row >> 2)) & 3); kgo[i] = (unsigned)(row * NQ + ch * 16); }
    { const int q = wid * 64 + lane, d = q >> 2, ch = (q & 3) ^ ((d >> 2) & 3); vgo = (unsigned)d * (unsigned)R + 16u * (unsigned)ch; }
    const int vo0 = r32 * 64 + (((2 * hi) ^ ((r32 >> 2) & 3)) << 4), vo1 = r32 * 64 + (((2 * hi + 1) ^ ((r32 >> 2) & 3)) << 4);
    const LAS unsigned char* kb[3][2];
    { const LAS unsigned char* k0_ = K_lds + r32 * 192 + ((32 * hi) ^ (((r32 >> 2) & 3) << 4)); const LAS unsigned char* k1_ = K_lds + r32 * 192 + ((32 * hi + 16) ^ (((r32 >> 2) & 3) << 4));
#pragma unroll
      for (int m = 0; m < 3; ++m) { kb[m][0] = k0_ + 64 * m; kb[m][1] = k1_ + 64 * m; } }
    const __amdgpu_buffer_rsrc_t rsK = __builtin_amdgcn_make_buffer_rsrc((void*)Kh, 0, 0x7fffffff, 0x00020000), rsV = __builtin_amdgcn_make_buffer_rsrc((void*)Vh, 0, 0x7fffffff, 0x00020000);
#define DMA_K(t, slot) do { const int so_ = (t) * (KVBLK * NQ); \
    __builtin_amdgcn_raw_ptr_buffer_load_lds(rsK, (LAS unsigned*)(K_lds + (slot) * SHM_K + wid * 1024), 16, (int)kgo[0], so_, 0, 0); \
    if (wid < 4) __builtin_amdgcn_raw_ptr_buffer_load_lds(rsK, (LAS unsigned*)(K_lds + (slot) * SHM_K + (8 + wid) * 1024), 16, (int)kgo[1], so_, 0, 0); } while (0)
#define DMA_V(t, slot) do { __builtin_amdgcn_raw_ptr_buffer_load_lds(rsV, (LAS unsigned*)(V_lds + (slot) * SHM_V + wid * 1024), 16, (int)vgo, (t) * KVBLK, 0, 0); } while (0)
#define RESC(a) do { if (__any((a) < 1.f)) { int l_ = threadIdx.x & 63; asm volatile("" : "+v"(l_));              \
    LAS float* al_ = (LAS float*)(lds + LDS_WS) + wid * 64 + 32; if (l_ < 32) al_[l_] = (a); asm volatile("s_waitcnt lgkmcnt(0)" ::: "memory"); const LAS float* alh_ = al_ + 4 * (l_ >> 5); \
    _Pragma("unroll") for (int d_ = 0; d_ < 4; ++d_) _Pragma("unroll") for (int r_ = 0; r_ < 16; ++r_) o[d_][r_] *= alh_[crow(r_, 0)]; } } while (0)
#define WAITBAR() do { asm volatile("s_waitcnt vmcnt(0)" ::: "memory"); __syncthreads(); } while (0)
#define WAITBAR3() do { if (wid < 4) asm volatile("s_waitcnt vmcnt(2) lgkmcnt(0)" ::: "memory"); else asm volatile("s_waitcnt vmcnt(1) lgkmcnt(0)" ::: "memory"); __builtin_amdgcn_s_barrier(); asm volatile("" ::: "memory"); } while (0)
    f32x16 pA0, pA1, pB0, pB1; float mnA, mnB, alA, alB; i32x8_t pa; constexpr int NT = PB / KVBLK;
    int s0 = 0, s1 = 1, s2 = 2;
    DMA_K(0, 0); DMA_V(0, 0); DMA_K(1, 1); WAITBAR();
    DMA_K(2, 2); DMA_V(1, 1);
    qkt(pA0, pA1, kb, 0, qr, negm); partialSM<true>(pA0, pA1, m_reg, negm, alA); RESC(alA);
    WAITBAR();
#define STEP(PC0, PC1, mnC, alC, PP0, PP1, alP, t) do { \
        { const int tmp_ = s0; s0 = s1; s1 = s2; s2 = tmp_; }              \
        SBAR(); \
        if ((t) + 2 < NT) DMA_K((t) + 2, s2);                               \
        { i32x8_t ka0_[2], ka1_[2]; kload01(ka0_, ka1_, kb, s0 * SHM_K); SBAR();     \
          finishSM(PP0, PP1, alP, l_reg, pa); SBAR(); \
          qmma(PC0, PC1, ka0_, ka1_, kb, s0 * SHM_K, qr, negm); } \
        pv_d0(o, V_lds + s2 * SHM_V, vo0, vo1, pa);                        \
        partialSM<false>(PC0, PC1, m_reg, negm, alC); \
        RESC(alC); \
        if ((t) + 2 < NT) WAITBAR3(); else WAITBAR(); \
        if ((t) + 1 < NT) DMA_V((t) + 1, s1);                               \
    } while (0)
    for (int t = 1; t + 1 < NT; t += 2) {
        STEP(pB0, pB1, mnB, alB, pA0, pA1, alA, t);
        STEP(pA0, pA1, mnA, alA, pB0, pB1, alB, t + 1);
    }
    STEP(pB0, pB1, mnB, alB, pA0, pA1, alA, NT - 1);
    { const int tmp_ = s0; s0 = s1; s1 = s2; s2 = tmp_; }
    finishSM(pB0, pB1, alB, l_reg, pa); SBAR();
    pv_d0(o, V_lds + s2 * SHM_V, vo0, vo1, pa);
    { int l_ = threadIdx.x & 63; asm volatile("" : "+v"(l_)); if (l_ < 32) ((LAS float*)(lds + LDS_WS) + wid * 64)[l_] = l_reg; } asm volatile("s_waitcnt lgkmcnt(0)" ::: "memory");
    __syncthreads();
    int lane2 = threadIdx.x & 63; asm volatile("" : "+v"(lane2));
    const int hi2 = lane2 >> 5, r322 = lane2 & 31;
    LAS unsigned char* stg = lds + wid * 4096;
    LAS unsigned char* stg_l = stg + 4 * hi2 * 128 + r322; const LAS float* li_hi = li_l + 4 * hi2;
#pragma unroll
    for (int r = 0; r < 16; ++r) { const float rl = __builtin_amdgcn_rcpf(li_hi[crow(r, 0)]) * S8_O;
        const unsigned pk = pk4_fp8(o[0][r] * rl, o[1][r] * rl, o[2][r] * rl, o[3][r] * rl);
#pragma unroll
        for (int d0 = 0; d0 < 4; ++d0) stg_l[crow(r, 0) * 128 + d0 * 32] = (unsigned char)(pk >> (8 * d0)); }
    asm volatile("s_waitcnt lgkmcnt(0)" ::: "memory");
    unsigned char* Ow = Ob + (size_t)(wid * 32 + (lane2 >> 3)) * DM + (lane2 & 7) * 16; const LAS unsigned char* stg_r = stg + (lane2 >> 3) * 128 + (lane2 & 7) * 16;
#pragma unroll
    for (int i = 0; i < 4; ++i) { const u32x4 v = *(const LAS u32x4*)(stg_r + i * 8 * 128); *(u32x4*)(Ow + (size_t)(i * 8) * DM) = v; }
    __syncthreads();
#undef DMA_K
#undef DMA_V
#undef RESC
#undef WAITBAR
#undef WAITBAR3
#undef STEP
}
}
__device__ __forceinline__ void p11_attention(Frame& F) {
    const unsigned char* Q = F.ws + WS_Q; const unsigned char* K = F.ws + WS_KB; const unsigned char* V = F.ws + WS_VB; unsigned char* O = F.ws + WS_MIX;
    for (int i = 0; i < 4; ++i) {
        const int bh = (F.vcu >> 3) + 32 * i, qb = F.vcu & 7, b = bh >> 3, h = bh & 7;
        const size_t qrow = (size_t)b * PB + CTXL + qb * 256, krow = (size_t)b * PB;
        int t_ = threadIdx.x; asm volatile("" : "+v"(t_));
        att::attn_unit(t_, Q + qrow * NQ + h * 192, K + krow * NQ + h * 192, V + (size_t)(h * 128) * R + krow, O + qrow * DM + h * 128, F.lds);
    }
}

__device__ __forceinline__ void ka_launder(Frame& F) { asm volatile("" : "+s"(F.ka)); int t = threadIdx.x; asm volatile("" : "+v"(t)); F.tid = t; F.lane = t & 63; F.wave = __builtin_amdgcn_readfirstlane(t >> 6); }
#ifndef DBG_MODE
#define DBG_MODE 0
#endif
constexpr int NPH = 21;
template <class Sched>
__device__ __forceinline__ void fill_rstd(Frame& F, const Sched& S, LAS float* rt, bool cols, int off, int nfl, float invdim) {
    const float* stats = (const float*)(F.ws + WS_STATS);
    for (int idx = F.tid; idx < 4 * 256; idx += 512) { const int i = idx >> 8, r = idx & 255; pg8::Unit u;
        if (S.next(i, u)) { const float* st = stats + (size_t)((cols ? u.brow0 : u.arow0) + r) * 24 + off; float ss = 0.f;
            for (int q = 0; q < nfl; q += 4) { const f32x4 s4 = *(const f32x4*)(st + q); ss += (s4[0] + s4[1]) + (s4[2] + s4[3]); }
            rt[idx] = __builtin_amdgcn_rsqf(ss * invdim + RMS_EPS); } }
    __syncthreads();
}
__device__ __forceinline__ void moe_gemms(Frame& F, int layer, int which) {
    LAS int* pfx = (LAS int*)(F.lds + LDSCTL_OFF + 512); LAS unsigned char* tab = (LAS unsigned char*)(F.lds + LDSCTL_OFF + 768);
    if (which == 0 || MK_N_LAUNCHES > 1) {
      const unsigned* gc = (const unsigned*)(F.ws + WS_CTL) + CW_GC + 64 * layer;
      if (F.tid < 64) { int c = 0; if (F.tid < 32) { int cnt = (int)gc[F.tid]; cnt = cnt > ECAP ? ECAP : cnt; c = (cnt + 255) >> 8; }
#pragma unroll
          for (int d = 1; d < 32; d <<= 1) { const int t = __shfl_up(c, d); if ((F.tid & 63) >= d) c += t; }
          if (F.tid < 32) pfx[F.tid + 1] = c; if (F.tid == 0) pfx[0] = 0; }
      __syncthreads();
      { const int blk = F.tid; if (blk < pfx[32]) { int e = 0; while (pfx[e + 1] <= blk) ++e; tab[blk] = (unsigned char)e; } }
      __syncthreads(); }
    MoeSched S; S.pfx = pfx; S.tab = tab; S.nwg = __builtin_amdgcn_readfirstlane(pfx[32]) * 4; S.G = F.G; S.c = (int)blockIdx.x;
    const int* perm = (const int*)(F.ws + WS_ROUTE + RT_PERM);
    if (which == 0) {
        pg8::Gemm g{(const bf16_t*)(F.ws + WS_HX), (const bf16_t*)(F.ws + WS_WGU + (size_t)layer * 32 * 1024 * DM), DM / 2, DM / 2, DM / 2, perm};
        EpiSwiglu E{F.ws + WS_ACT};
        pg8::gemm_phase<EpiSwiglu, MoeSched, true, true>(F.lds, g, S, E);
    } else {
        pg8::Gemm g{(const bf16_t*)(F.ws + WS_ACT), (const bf16_t*)(F.ws + WS_WDN + (size_t)layer * 32 * DM * MFF), MFF / 2, MFF / 2, MFF / 2, nullptr};
        EpiScatter E{F.ws + WS_YS, perm};
        pg8::gemm_phase<EpiScatter, MoeSched, false, true>(F.lds, g, S, E);
    }
}
__global__ void __launch_bounds__(512, 2) mega_fwd(Args args) {
    extern __shared__ __attribute__((aligned(16))) unsigned char lds_raw[];
    Frame F;
    F.lds = (LAS unsigned char*)lds_raw;
    F.tid = threadIdx.x; F.lane = F.tid & 63; F.wave = __builtin_amdgcn_readfirstlane(F.tid >> 6);
    F.G = gridDim.x; { const int bx = blockIdx.x; F.vcu = (F.G % 8 == 0) ? (bx % 8) * (F.G / 8) + bx / 8 : bx; }
    F.ws = args.ws; F.out = args.out;
    F.ka = (const __attribute__((address_space(4))) Args*)__builtin_amdgcn_kernarg_segment_ptr();
    for (int u = F.tid; u < (LDS_BYTES - LDSCTL_OFF) / 4; u += 512) ((LAS unsigned*)(F.lds + LDSCTL_OFF))[u] = 0u;
    __syncthreads();
    volatile LAS unsigned* MISC = (volatile LAS unsigned*)(F.lds + MISC_OFF);
    unsigned* ctl = (unsigned*)(F.ws + WS_CTL);
    XcdBarrier bar; bar.bar = ctl + CW_BAR; bar.x = 0; bar.st = nullptr;
    if (!args.nobar) bar = xcd_barrier_post(ctl + CW_BAR, MISC + 8);
    const int lo = args.ph_lo, hi = args.ph_hi;
    const unsigned long long t_start = (STAMP_PHASE >= 0) ? __builtin_amdgcn_s_memrealtime() : 0ull;
#define IN(k) (lo <= (k) && (k) < hi)
#define SEAM(k) do { if (IN(k) && IN((k) + 1)) xcd_barrier(bar); \
    if (STAMP_PHASE == (k) && blockIdx.x == 0 && threadIdx.x == 0) { const unsigned long long t1_ = __builtin_amdgcn_s_memrealtime(); ((float*)(F.ws + WS_CTL))[2048] = (float)(t1_ - t_start) * 0.01f; } } while (0)
    constexpr int LAST = DBG_MODE == 0 ? 20 : DBG_MODE == 1 ? -1 : DBG_MODE == 2 ? 6 : DBG_MODE == 3 ? 11 : DBG_MODE == 4 ? 15 : DBG_MODE == 10 ? 2 : DBG_MODE == 11 ? 3 : 5;
#ifndef PHMASK
#define PHMASK 0x1fffff
#endif
#define RUN(k) (ka_launder(F), IN(k) && (k) <= LAST && ((PHMASK >> (k)) & 1))

    if (RUN(0)) for (int rep_ = 0; rep_ < 1 + ((REPMASK >> 0) & 1); ++rep_) p0_prologue(F);
    SEAM(0);
    if (RUN(1)) for (int rep_ = 0; rep_ < 1 + ((REPMASK >> 1) & 1); ++rep_) p0b_mod(F);
    SEAM(1);
    if (RUN(2)) for (int rep_ = 0; rep_ < 1 + ((REPMASK >> 2) & 1); ++rep_) p1_norm_input(F);
    SEAM(2);
    if (RUN(3)) for (int rep_ = 0; rep_ < 1 + ((REPMASK >> 3) & 1); ++rep_) { pg8::Gemm g{(const bf16_t*)(F.ws + WS_HX), (const bf16_t*)(F.ws + WS_WIN0), DM, DM, DM, nullptr}; TileSched<false> S; S.init(EVIN / 256, F.G, (int)blockIdx.x);
        EpiStoreBf16 E{(bf16_t*)(F.ws + WS_PX0), EVIN}; pg8::gemm_phase<EpiStoreBf16, TileSched<false>, false>(F.lds, g, S, E); }
    SEAM(3);
    if (RUN(4)) for (int rep_ = 0; rep_ < 1 + ((REPMASK >> 4) & 1); ++rep_) p3_mixers(F);
    SEAM(4);
    if (RUN(5)) for (int rep_ = 0; rep_ < 1 + ((REPMASK >> 5) & 1); ++rep_) { p3b_hgrn_out(F); perm_clear(F); }
    SEAM(5);
    if (RUN(6)) for (int rep_ = 0; rep_ < 1 + ((REPMASK >> 6) & 1); ++rep_) { pg8::Gemm g{(const bf16_t*)(F.ws + WS_MIX), (const bf16_t*)(F.ws + WS_WOUT0), DM / 2, DM / 2, DM / 2, nullptr}; TileSched<false> S; S.init(DM / 256, F.G, (int)blockIdx.x);
        EpiResidual E{&F, (bf16_t*)(F.ws + WS_XS), 0, true, 1.0f / (S8_M * S8_W1)}; pg8::gemm_phase<EpiResidual, TileSched<false>, false, true>(F.lds, g, S, E);
        { const int n3 = (NTILE * 4) % F.G;
          if (rep_ == 0 && (int)blockIdx.x >= n3) { ka_launder(F); moe_l1_convert(F, MOE_L1_SPLIT, MOE_W_ITEMS, ((int)blockIdx.x - n3) * 8 + F.wave, (F.G - n3) * 8); } } }
    SEAM(6);
    if (RUN(7)) for (int rep_ = 0; rep_ < 1 + ((REPMASK >> 7) & 1); ++rep_) p5_norm_route<false>(F, 0);
    SEAM(7);
    if (RUN(9)) for (int rep_ = 0; rep_ < 1 + ((REPMASK >> 9) & 1); ++rep_) moe_gemms(F, 0, 0);
    SEAM(9);
    if (RUN(10)) for (int rep_ = 0; rep_ < 1 + ((REPMASK >> 10) & 1); ++rep_) moe_gemms(F, 0, 1);
    SEAM(10);
    if (RUN(11)) for (int rep_ = 0; rep_ < 1 + ((REPMASK >> 11) & 1); ++rep_) { p8_combine_norm(F); perm_clear(F); }
    SEAM(11);
    if (RUN(12)) for (int rep_ = 0; rep_ < 1 + ((REPMASK >> 12) & 1); ++rep_) { pg8::Gemm g{(const bf16_t*)(F.ws + WS_HX), (const bf16_t*)(F.ws + WS_WIN1), DM / 2, DM / 2, DM / 2, nullptr}; TileSched<false> S; S.init(CINP / 256, F.G, (int)blockIdx.x);
        EpiStoreStats E{(bf16_t*)(F.ws + WS_PX1), CINP, (float*)(F.ws + WS_STATS), 1.0f / (S8_X * S8_W1)}; pg8::gemm_phase<EpiStoreStats, TileSched<false>, false, true>(F.lds, g, S, E); }
    SEAM(12);
    if (RUN(13)) for (int rep_ = 0; rep_ < 1 + ((REPMASK >> 13) & 1); ++rep_) {
        { pg8::Gemm g{(const bf16_t*)(F.ws + WS_QL8), (const bf16_t*)(F.ws + WS_WUQ), 256, 256, 256, nullptr}; TileSched<true> S; S.init(NQ / 256, F.G, (int)blockIdx.x);
          LAS float* rt = (LAS float*)(F.lds + pg8::STAGE_BYTES); LAS float* rtab = rt + 1024;
          for (int idx = F.tid; idx < 64 * 16; idx += 512) { const int pp = idx >> 4, ii = idx & 15; const float ang = (float)pp * __expf(-(float)ii * (2.0f / 32.0f) * 9.210340371976184f);
              rtab[2 * idx] = __cosf(ang); rtab[2 * idx + 1] = __sinf(ang); }
          fill_rstd(F, S, rt, false, 0, 12, 1.0f / QRANK);
          EpiQ E{F.ws + WS_Q, rt, rtab}; pg8::gemm_phase<EpiQ, TileSched<true>, false, true>(F.lds, g, S, E); }
        { pg8::Gemm g{(const bf16_t*)(F.ws + WS_KVL8), (const bf16_t*)(F.ws + WS_WUKV), KVRANK / 2, KVRANK / 2, KVRANK / 2, nullptr}; TileSched<false> S; S.init(1024 / 256, F.G, (int)blockIdx.x);
          LAS float* rt = (LAS float*)(F.lds + pg8::STAGE_BYTES) + 3072; fill_rstd(F, S, rt, false, 12, 8, 1.0f / KVRANK);
          EpiK E{F.ws + WS_KB, rt}; pg8::gemm_phase<EpiK, TileSched<false>, false, true>(F.lds, g, S, E); }
        { pg8::Gemm g{(const bf16_t*)(F.ws + WS_WUKV + (size_t)1024 * KVRANK), (const bf16_t*)(F.ws + WS_KVL8), KVRANK / 2, KVRANK / 2, KVRANK / 2, nullptr};
          TileSched<false> S; S.init_mn(1024 / 256, NTILE, F.G, F.G - 1 - (int)blockIdx.x);
          LAS float* rt = (LAS float*)(F.lds + pg8::STAGE_BYTES); fill_rstd(F, S, rt, true, 12, 8, 1.0f / KVRANK);
          EpiVT E{F.ws + WS_VB, rt}; pg8::gemm_phase<EpiVT, TileSched<false>, false, true>(F.lds, g, S, E); }
        ka_launder(F);
        p10_kr(F);
    }
    SEAM(13);
    if (RUN(14)) for (int rep_ = 0; rep_ < 1 + ((REPMASK >> 14) & 1); ++rep_) p11_attention(F);
    SEAM(14);
    if (RUN(15)) for (int rep_ = 0; rep_ < 1 + ((REPMASK >> 15) & 1); ++rep_) { pg8::Gemm g{(const bf16_t*)(F.ws + WS_MIX), (const bf16_t*)(F.ws + WS_WOUT1), DM / 2, DM / 2, DM / 2, nullptr}; TileSched<true> S; S.init(DM / 256, F.G, (int)blockIdx.x);
        EpiResidual E{&F, (bf16_t*)(F.ws + WS_XS), 1, false, 1.0f / (S8_O * S8_W1)}; pg8::gemm_phase<EpiResidual, TileSched<true>, false, true>(F.lds, g, S, E); }
    SEAM(15);
    if (RUN(16)) for (int rep_ = 0; rep_ < 1 + ((REPMASK >> 16) & 1); ++rep_) p5_norm_route<true>(F, 1);
    SEAM(16);
    if (RUN(18)) for (int rep_ = 0; rep_ < 1 + ((REPMASK >> 18) & 1); ++rep_) moe_gemms(F, 1, 0);
    SEAM(18);
    if (RUN(19)) for (int rep_ = 0; rep_ < 1 + ((REPMASK >> 19) & 1); ++rep_) moe_gemms(F, 1, 1);
    SEAM(19);
    ka_launder(F);
    if (IN(20) && ((PHMASK >> 20) & 1)) p16_final(F);
#undef IN
#undef SEAM
#undef RUN
}

#ifndef MK_N_LAUNCHES
#define MK_N_LAUNCHES 1
#endif
extern "C" void kernel_launch(void* const* d_in, const int* in_sizes, int n_in, void* d_out, int out_size, void* d_ws, size_t ws_size, hipStream_t stream) {
    static int grid = 0;
    if (grid == 0) {
        if (n_in != 28 || out_size != NB * SEQ * DM || ws_size < WS_END) { fprintf(stderr, "kernel_launch: unexpected shapes (n_in %d out %d ws %zu)\n", n_in, out_size, ws_size); grid = -1; return; }
        int dev = 0, cus = 0, per_cu = 0;
        if (hipGetDevice(&dev) != hipSuccess || hipDeviceGetAttribute(&cus, hipDeviceAttributeMultiprocessorCount, dev) != hipSuccess) { grid = -1; return; }
        if (hipFuncSetAttribute((const void*)mega_fwd, hipFuncAttributeMaxDynamicSharedMemorySize, LDS_BYTES) != hipSuccess) { fprintf(stderr, "kernel_launch: hipFuncSetAttribute failed\n"); grid = -1; return; }
        if (hipOccupancyMaxActiveBlocksPerMultiprocessor(&per_cu, (const void*)mega_fwd, 512, LDS_BYTES) != hipSuccess || per_cu < 1) { fprintf(stderr, "kernel_launch: occupancy query says %d blocks/CU\n", per_cu); per_cu = 1; }
        (void)hipGetLastError();
        grid = cus;
    }
    if (grid < 0) return;
    (void)hipMemsetAsync((char*)d_ws + WS_CTL, 0, CTL_ZERO_BYTES, stream);
    Args a{};
    for (int i = 0; i < 28; ++i) a.in[i] = (const float*)d_in[i];
    a.out = (float*)d_out; a.ws = (unsigned char*)d_ws;
    if (MK_N_LAUNCHES == 1) {
        a.ph_lo = 0; a.ph_hi = NPH; a.nobar = 0;
        void* kargs[] = {&a};
        hipError_t e = hipLaunchCooperativeKernel((const void*)mega_fwd, dim3(grid), dim3(512), kargs, LDS_BYTES, stream);
        if (e != hipSuccess) { (void)hipGetLastError(); fprintf(stderr, "kernel_launch: cooperative launch failed (%s), plain launch instead\n", hipGetErrorString(e)); hipLaunchKernelGGL(mega_fwd, dim3(grid), dim3(512), LDS_BYTES, stream, a); }
    } else {
        for (int p = 0; p < NPH; ++p) { a.ph_lo = p; a.ph_hi = p + 1; a.nobar = 1; hipLaunchKernelGGL(mega_fwd, dim3(grid), dim3(512), LDS_BYTES, stream, a); }
    }
}
```
